# Optimizing an MI355X kernel written in HIP

```python
import jax, jax.numpy as jnp
from jax import lax
import numpy as np

D_MODEL = 1024
BATCH = 4
SEQ = 4096
DEPTH = 2

MIX_WIDTH = D_MODEL
N_MIXERS = 4
GROUP_WIDTH = MIX_WIDTH // N_MIXERS
N_GROUP_HEADS = 4
HEAD_DIM = GROUP_WIDTH // N_GROUP_HEADS
SHORT_CONV_WIDTH = 3
CHUNK = 128
IDX_HEADS = 4
IDX_DIM = 64
TOPK_MAX = 256
CONF_CONV_WIDTH = 31
Q_BLOCK = 128
ROPE_THETA = 10000.0
FFN_HIDDEN = -(-8 * D_MODEL // (3 * 256)) * 256
NORM_EPS = 1e-6
LN_EPS = 1e-5
NEG = -1e30
SPLIT_SIZES = (GROUP_WIDTH, GROUP_WIDTH, GROUP_WIDTH,
               GROUP_WIDTH, GROUP_WIDTH,
               GROUP_WIDTH, GROUP_WIDTH, GROUP_WIDTH,
               IDX_HEADS * IDX_DIM, IDX_DIM, IDX_HEADS,
               GROUP_WIDTH, GROUP_WIDTH)
IN_COLS = sum(SPLIT_SIZES)

kernel_name = "hymba_style_four_mixer_hybrid"


def rmsnorm(x, g):
    xf = x.astype(jnp.float32)
    y = xf * lax.rsqrt(jnp.mean(xf * xf, axis=-1, keepdims=True) + NORM_EPS)
    return (y * g.astype(jnp.float32)).astype(x.dtype)


def layernorm(x, g, b):
    xf = x.astype(jnp.float32)
    mu = jnp.mean(xf, axis=-1, keepdims=True)
    var = jnp.mean(jnp.square(xf - mu), axis=-1, keepdims=True)
    y = (xf - mu) * lax.rsqrt(var + LN_EPS)
    return (y * g.astype(jnp.float32) + b.astype(jnp.float32)).astype(x.dtype)


def causal_dwconv(x, w):
    width, chans = w.shape
    return lax.conv_general_dilated(
        x, w[:, None, :].astype(x.dtype), window_strides=(1,),
        padding=[(width - 1, 0)], dimension_numbers=('NWC', 'WIO', 'NWC'),
        feature_group_count=chans)


def rope_tables(seq, dim):
    inv_freq = ROPE_THETA ** (-jnp.arange(0, dim, 2, dtype=jnp.float32) / dim)
    ang = jnp.arange(seq, dtype=jnp.float32)[:, None] * inv_freq[None, :]
    return jnp.cos(ang), jnp.sin(ang)


def apply_rope(x, cos, sin):
    half = x.shape[-1] // 2
    c = cos[None, :, None, :].astype(x.dtype)
    s = sin[None, :, None, :].astype(x.dtype)
    x1, x2 = x[..., :half], x[..., half:]
    return jnp.concatenate([x1 * c - x2 * s, x2 * c + x1 * s], axis=-1)


def short_conv_mixer(b, c, h, w_conv):
    return b * causal_dwconv(c * h, w_conv)


def gmlp_mixer(u, v, ln_g, ln_b, w_s, b_s):
    bsz, seq, _ = v.shape
    vn = layernorm(v, ln_g, ln_b)
    vc = vn.reshape(bsz, seq // CHUNK, CHUNK, N_GROUP_HEADS, HEAD_DIM)
    mask = jnp.tril(jnp.ones((CHUNK, CHUNK), dtype=bool))
    ws = jnp.where(mask[None], w_s, 0).astype(v.dtype)
    mixed = jnp.einsum('hts,bnshd->bnthd', ws, vc)
    mixed = mixed + b_s.T[None, None, :, :, None].astype(v.dtype)
    return u * mixed.reshape(bsz, seq, GROUP_WIDTH)


def dsa_mixer(q, k, v, q_idx, k_idx, w_idx):
    bsz, seq, _ = q.shape
    topk = min(TOPK_MAX, seq // 4)
    cos_a, sin_a = rope_tables(seq, HEAD_DIM)
    cos_i, sin_i = rope_tables(seq, IDX_DIM)
    q = apply_rope(q.reshape(bsz, seq, N_GROUP_HEADS, HEAD_DIM), cos_a, sin_a)
    k = apply_rope(k.reshape(bsz, seq, N_GROUP_HEADS, HEAD_DIM), cos_a, sin_a)
    v = v.reshape(bsz, seq, N_GROUP_HEADS, HEAD_DIM)
    qi = apply_rope(q_idx.reshape(bsz, seq, IDX_HEADS, IDX_DIM), cos_i, sin_i).astype(jnp.float32)
    ki = apply_rope(k_idx[:, :, None, :], cos_i, sin_i)[:, :, 0, :].astype(jnp.float32)
    wi = w_idx.astype(jnp.float32) * (IDX_HEADS ** -0.5) * (IDX_DIM ** -0.5)
    scale = HEAD_DIM ** -0.5
    nblk = seq // Q_BLOCK

    def to_blocks(t):
        return jnp.swapaxes(t.reshape((bsz, nblk, Q_BLOCK) + t.shape[2:]), 0, 1)

    kpos = jnp.arange(seq)
    tpos = kpos.reshape(nblk, Q_BLOCK)

    def block(args):
        qb, qib, wib, tb = args
        rel = jax.nn.relu(jnp.einsum('bqjd,bsd->bqjs', qib, ki))
        score = jnp.einsum('bqjs,bqj->bqs', rel, wib)
        admissible = kpos[None, :] <= tb[:, None]
        score = jnp.where(admissible[None], score, NEG)
        _, idx = lax.top_k(score, topk)
        valid = idx <= tb[None, :, None]
        kg = jax.vmap(lambda kk, ii: kk[ii])(k, idx)
        vg = jax.vmap(lambda vv, ii: vv[ii])(v, idx)
        logits = jnp.einsum('bqhd,bqkhd->bqhk', qb, kg).astype(jnp.float32) * scale
        logits = jnp.where(valid[:, :, None, :], logits, NEG)
        p = jax.nn.softmax(logits, axis=-1).astype(v.dtype)
        return jnp.einsum('bqhk,bqkhd->bqhd', p, vg)

    out = lax.map(block, (to_blocks(q), to_blocks(qi), to_blocks(wi), tpos))
    return jnp.swapaxes(out, 0, 1).reshape(bsz, seq, GROUP_WIDTH)


def conformer_conv_mixer(a, gate, w_dw, b_dw, ln_g, ln_b):
    y = a * jax.nn.sigmoid(gate)
    y = causal_dwconv(y, w_dw) + b_dw.astype(y.dtype)
    y = layernorm(y, ln_g, ln_b)
    return jax.nn.silu(y)


def hybrid_layer(x, g_mix, w_in, w_conv_a, gmlp_ln_g, gmlp_ln_b, w_s, b_s,
                 w_conf, b_conf, conf_ln_g, conf_ln_b, w_out,
                 g_ffn, w_gate, w_up, w_down):
    h = rmsnorm(x, g_mix)
    z = h @ w_in
    cuts, acc = [], 0
    for sz in SPLIT_SIZES[:-1]:
        acc += sz
        cuts.append(acc)
    (a_b, a_c, a_h, g_u, g_v, q, k, v, q_idx, k_idx, w_idx, d_a, d_g) = jnp.split(z, cuts, axis=-1)
    y_a = short_conv_mixer(a_b, a_c, a_h, w_conv_a)
    y_b = gmlp_mixer(g_u, g_v, gmlp_ln_g, gmlp_ln_b, w_s, b_s)
    y_c = dsa_mixer(q, k, v, q_idx, k_idx, w_idx)
    y_d = conformer_conv_mixer(d_a, d_g, w_conf, b_conf, conf_ln_g, conf_ln_b)
    x = x + jnp.concatenate([y_a, y_b, y_c, y_d], axis=-1) @ w_out
    hf = rmsnorm(x, g_ffn)
    return x + (jax.nn.silu(hf @ w_gate) * (hf @ w_up)) @ w_down


def setup_inputs(seed: int = 0) -> dict:
    key = jax.random.key(seed)
    ks = jax.random.split(key, 20)
    f32 = jnp.float32
    G, H = GROUP_WIDTH, N_GROUP_HEADS

    def nrm(k, shape, scale):
        return jax.random.normal(k, shape, f32) * scale

    def gain(k, shape):
        return 1.0 + 0.05 * jax.random.normal(k, shape, f32)

    return {
        "x": jax.random.normal(ks[0], (BATCH, SEQ, D_MODEL), f32),
        "g_mix": gain(ks[1], (DEPTH, D_MODEL)),
        "w_in": nrm(ks[2], (DEPTH, D_MODEL, IN_COLS), D_MODEL ** -0.5),
        "w_conv_a": nrm(ks[3], (DEPTH, SHORT_CONV_WIDTH, G), SHORT_CONV_WIDTH ** -0.5),
        "gmlp_ln_g": gain(ks[4], (DEPTH, G)),
        "gmlp_ln_b": nrm(ks[5], (DEPTH, G), 0.02),
        "w_s": nrm(ks[6], (DEPTH, H, CHUNK, CHUNK), 0.5 * CHUNK ** -0.5),
        "b_s": 1.0 + nrm(ks[7], (DEPTH, H, CHUNK), 0.1),
        "w_conf": nrm(ks[8], (DEPTH, CONF_CONV_WIDTH, G), CONF_CONV_WIDTH ** -0.5),
        "b_conf": nrm(ks[9], (DEPTH, G), 0.02),
        "conf_ln_g": gain(ks[10], (DEPTH, G)),
        "conf_ln_b": nrm(ks[11], (DEPTH, G), 0.02),
        "w_out": nrm(ks[12], (DEPTH, MIX_WIDTH, D_MODEL), 0.5 * MIX_WIDTH ** -0.5),
        "g_ffn": gain(ks[13], (DEPTH, D_MODEL)),
        "w_gate": nrm(ks[14], (DEPTH, D_MODEL, FFN_HIDDEN), D_MODEL ** -0.5),
        "w_up": nrm(ks[15], (DEPTH, D_MODEL, FFN_HIDDEN), D_MODEL ** -0.5),
        "w_down": nrm(ks[16], (DEPTH, FFN_HIDDEN, D_MODEL), 0.5 * FFN_HIDDEN ** -0.5),
        "g_final": gain(ks[17], (D_MODEL,)),
    }


def reference(x, g_mix, w_in, w_conv_a, gmlp_ln_g, gmlp_ln_b, w_s, b_s,
              w_conf, b_conf, conf_ln_g, conf_ln_b, w_out,
              g_ffn, w_gate, w_up, w_down, g_final):
    for l in range(DEPTH):
        x = hybrid_layer(x, g_mix[l], w_in[l], w_conv_a[l], gmlp_ln_g[l], gmlp_ln_b[l],
                         w_s[l], b_s[l], w_conf[l], b_conf[l], conf_ln_g[l], conf_ln_b[l],
                         w_out[l], g_ffn[l], w_gate[l], w_up[l], w_down[l])
    return rmsnorm(x, g_final)
```

```cpp
#include <hip/hip_runtime.h>
#include <hip/hip_cooperative_groups.h>
#include <cstdio>
#include <cstdint>
namespace cg = cooperative_groups;
namespace pg8 {
#define PG8_LAS __attribute__((address_space(3)))
typedef unsigned short bf16_t;
typedef short bf16x8 __attribute__((ext_vector_type(8)));
typedef float f32x4 __attribute__((ext_vector_type(4)));
typedef unsigned u32x4 __attribute__((ext_vector_type(4)));
constexpr int BM = 256, BK = 64, HALF = 128, HTB = HALF * BK * 2  , STAGE_BYTES = 8 * HTB, NXCD = 8, WGM = 8;

__host__ __device__ __forceinline__ int lds_byte(int r, int c) { const int st = (r >> 4) * 2 + (c >> 5), rr = r & 15, cc = c & 31, ob = rr * 64 + cc * 2; return st * 1024 + (ob ^ (((ob >> 9) & 1) << 5)); }
__host__ __device__ __forceinline__ void stage_rc(int b, int& R, int& C) { const int st = b / 1024, sb = b % 1024, swz = sb ^ (((sb >> 9) & 1) << 5); R = (st >> 1) * 16 + swz / 64; C = (st & 1) * 32 + (swz % 64) / 2; }
__host__ __device__ __forceinline__ int perm32(int rho) { const int n = rho >> 4, i = rho & 15; return 8 * (i >> 2) + 4 * n + (i & 3); }

struct Unit { int pm, pn; };
struct Gemm { const bf16_t* A; const bf16_t* Bt; int M, N, K; };

struct StaticOrder {
    int nM, nN, nwg, G, c;
    __host__ __device__ void init(int M, int N, int G_, int c_) { nM = M / BM; nN = N / BM; nwg = nM * nN; G = G_; c = c_; }
    __host__ __device__ bool next(int i, Unit& u) const {
        const long L = (long)i * G + c; if (L >= nwg) return false;
        int wgid = (int)L; { const int q = nwg / NXCD, r = nwg % NXCD, xcd = wgid % NXCD, off = wgid / NXCD; wgid = (xcd < r ? xcd * (q + 1) : r * (q + 1) + (xcd - r) * q) + off; }
        const int nig = WGM * nN, gid = wgid / nig, fm = gid * WGM, gsz = (nM - fm) < WGM ? (nM - fm) : WGM;
        u.pm = fm + ((wgid % nig) % gsz); u.pn = (wgid % nig) / gsz; return true;
    }
    __device__ __forceinline__ void a_ready(const Unit&) const {}
    __device__ __forceinline__ void done(const Unit&) const {}
};

__device__ __forceinline__ unsigned cvt_pk_bf16(float lo, float hi) { unsigned r; asm volatile("v_cvt_pk_bf16_f32 %0, %1, %2" : "=v"(r) : "v"(lo), "v"(hi)); return r; }
template <class Epi, class Sched, bool ALIGN_EPI = false, bool SP2 = false>
__device__ __forceinline__ void gemm_phase(PG8_LAS unsigned char* lds, const Gemm g, const Sched& S, const Epi& E) {
    int tid_l = threadIdx.x; asm volatile("" : "+v"(tid_l));
    const int tid = tid_l, wid = __builtin_amdgcn_readfirstlane(tid >> 6), lane = tid & 63, wr = wid >> 2, wc = wid & 3, fr = lane & 15, fq = lane >> 4;
    const int K = g.K, nt = K / BK;
    unsigned voffA[2], voffB[2];
#pragma unroll
    for (int i = 0; i < 2; ++i) { int R, C; stage_rc(tid * 16 + i * 8192, R, C); const int Rb = Epi::PERM ? ((R & ~31) + perm32(R & 31)) : R;
        voffA[i] = (unsigned)(R * K + C) * 2u; voffB[i] = (unsigned)(Rb * K + C) * 2u; }
    const size_t kstep = (size_t)(BK * 2);
    const size_t hstep = (size_t)HALF * K * 2;
    const size_t tstep = 2 * hstep;
    const unsigned ldsw = (unsigned)wid * 1024u;
    const int aoff = lds_byte(wr * 64 + fr, fq * 8), boff = lds_byte(wc * 32 + fr, fq * 8);
#define PG8_SA(b, h) (((b) * 2 + (h)) * HTB)
#define PG8_SB(b, h) ((4 + (b) * 2 + (h)) * HTB)
#define PG8_STAGE(bufoff, gbase, voff) do { _Pragma("unroll") for (int _i = 0; _i < 2; ++_i) \
        __builtin_amdgcn_global_load_lds((const unsigned*)((const char*)(gbase) + (voff)[_i]), (PG8_LAS unsigned*)(lds + (bufoff) + ldsw + _i * 8192), 16, 0, 0); } while (0)
#define PG8_LDA(dst, b, h) do { _Pragma("unroll") for (int m = 0; m < 4; ++m) _Pragma("unroll") for (int k = 0; k < 2; ++k) dst[m][k] = *(const PG8_LAS bf16x8*)(lds + PG8_SA(b, h) + aoff + m * 2048 + k * 1024); } while (0)
#define PG8_LDB(dst, b, h) do { _Pragma("unroll") for (int n = 0; n < 2; ++n) _Pragma("unroll") for (int k = 0; k < 2; ++k) dst[n][k] = *(const PG8_LAS bf16x8*)(lds + PG8_SB(b, h) + boff + n * 2048 + k * 1024); } while (0)
#define PG8_MMA(ai, bj, At, Bt) do { __builtin_amdgcn_s_setprio(1); _Pragma("unroll") for (int m = 0; m < 4; ++m) _Pragma("unroll") for (int n = 0; n < 2; ++n) _Pragma("unroll") for (int k = 0; k < 2; ++k) \
        acc[ai][bj][m][n] = __builtin_amdgcn_mfma_f32_16x16x32_bf16(Bt[n][k], At[m][k], acc[ai][bj][m][n], 0, 0, 0); __builtin_amdgcn_s_setprio(0); } while (0)
#define PG8_WAIT_V(n) asm volatile("s_waitcnt vmcnt(" #n ")" ::: "memory")
#define PG8_WAIT_L(n) asm volatile("s_waitcnt lgkmcnt(" #n ")" ::: "memory")
#define PG8_BAR __builtin_amdgcn_s_barrier()
#define PG8_SCHED __builtin_amdgcn_sched_barrier(0)
    Unit cur, nxt; int ui = 0;
    if (!S.next(0, cur)) return;
    f32x4 acc[2][2][4][2];
#pragma unroll
    for (int a = 0; a < 2; ++a)
#pragma unroll
        for (int b = 0; b < 2; ++b)
#pragma unroll
            for (int m = 0; m < 4; ++m)
#pragma unroll
                for (int n = 0; n < 2; ++n) acc[a][b][m][n] = (f32x4){0.f, 0.f, 0.f, 0.f};
    bf16x8 At[4][2], B0[2][2], B1[2][2];
    const char* cA = (const char*)g.A + (size_t)cur.pm * tstep; const char* cB = (const char*)g.Bt + (size_t)cur.pn * tstep;
    S.a_ready(cur);
    if constexpr (SP2) {
        PG8_STAGE(PG8_SB(0, 0), cB, voffB); PG8_STAGE(PG8_SB(0, 1), cB + hstep, voffB); PG8_STAGE(PG8_SA(0, 0), cA, voffA); PG8_STAGE(PG8_SA(0, 1), cA + hstep, voffA);
        if (wr == 1) PG8_BAR;
        PG8_WAIT_V(2); PG8_BAR;
        PG8_STAGE(PG8_SB(1, 0), cB + kstep, voffB); PG8_STAGE(PG8_SA(1, 0), cA + kstep, voffA); PG8_STAGE(PG8_SB(1, 1), cB + hstep + kstep, voffB);
        PG8_WAIT_V(6); PG8_BAR;
    } else {
        PG8_STAGE(PG8_SB(0, 0), cB, voffB); PG8_STAGE(PG8_SA(0, 0), cA, voffA); PG8_STAGE(PG8_SB(0, 1), cB + hstep, voffB); PG8_STAGE(PG8_SA(0, 1), cA + hstep, voffA);
        if (wr == 1) PG8_BAR;
        PG8_WAIT_V(4); PG8_BAR;
        PG8_STAGE(PG8_SB(1, 0), cB + kstep, voffB); PG8_STAGE(PG8_SA(1, 0), cA + kstep, voffA); PG8_STAGE(PG8_SB(1, 1), cB + hstep + kstep, voffB);
        PG8_WAIT_V(6); PG8_BAR;
    }
    for (;;) {
        const bool has_next = S.next(ui + 1, nxt);
        const char* nA = has_next ? (const char*)g.A + (size_t)nxt.pm * tstep : cA; const char* nB = has_next ? (const char*)g.Bt + (size_t)nxt.pn * tstep : cB;
        for (int t = 0; t < nt; t += 2) {
            const bool last = (t == nt - 2);
            const char* a1 = cA + (size_t)(t + 1) * kstep;
            const char* a2 = last ? nA : cA + (size_t)(t + 2) * kstep; const char* b2 = last ? nB : cB + (size_t)(t + 2) * kstep;
            const char* a3 = a2 + kstep; const char* b3 = b2 + kstep;
            if (last && has_next) S.a_ready(nxt);
            if constexpr (SP2) {
            PG8_LDB(B0, 0, 0); PG8_LDB(B1, 0, 1); PG8_SCHED; PG8_LDA(At, 0, 0); PG8_STAGE(PG8_SA(1, 1), a1 + hstep, voffA);
            PG8_WAIT_V(8); PG8_WAIT_L(0); PG8_BAR; PG8_MMA(0, 0, At, B0); PG8_MMA(0, 1, At, B1); PG8_BAR; PG8_SCHED;
            PG8_LDA(At, 0, 1); PG8_STAGE(PG8_SB(0, 0), b2, voffB); PG8_STAGE(PG8_SB(0, 1), b2 + hstep, voffB); PG8_STAGE(PG8_SA(0, 0), a2, voffA);
            PG8_WAIT_V(8); PG8_WAIT_L(0); PG8_BAR; PG8_MMA(1, 0, At, B0); PG8_MMA(1, 1, At, B1); PG8_BAR; PG8_SCHED;
            PG8_LDB(B0, 1, 0); PG8_LDB(B1, 1, 1); PG8_SCHED; PG8_LDA(At, 1, 0); PG8_STAGE(PG8_SA(0, 1), a2 + hstep, voffA);
            PG8_WAIT_V(8); PG8_WAIT_L(0); PG8_BAR; PG8_MMA(0, 0, At, B0); PG8_MMA(0, 1, At, B1); PG8_BAR; PG8_SCHED;
            PG8_LDA(At, 1, 1); PG8_STAGE(PG8_SB(1, 0), b3, voffB); PG8_STAGE(PG8_SB(1, 1), b3 + hstep, voffB); PG8_STAGE(PG8_SA(1, 0), a3, voffA);
            PG8_WAIT_V(8); PG8_WAIT_L(0); PG8_BAR; PG8_MMA(1, 0, At, B0); PG8_MMA(1, 1, At, B1); PG8_BAR; PG8_SCHED;
            } else {
            PG8_LDB(B0, 0, 0); PG8_SCHED; PG8_LDA(At, 0, 0); PG8_STAGE(PG8_SA(1, 1), a1 + hstep, voffA);
            PG8_WAIT_L(8); PG8_BAR; PG8_WAIT_L(0); PG8_MMA(0, 0, At, B0); PG8_BAR; PG8_SCHED;
            PG8_LDB(B1, 0, 1); PG8_STAGE(PG8_SB(0, 0), b2, voffB);
            PG8_BAR; PG8_WAIT_L(0); PG8_MMA(0, 1, At, B1); PG8_BAR;
            PG8_LDA(At, 0, 1); PG8_STAGE(PG8_SA(0, 0), a2, voffA);
            PG8_BAR; PG8_WAIT_L(0); PG8_MMA(1, 0, At, B0); PG8_BAR; PG8_SCHED;
            PG8_STAGE(PG8_SB(0, 1), b2 + hstep, voffB);
            PG8_WAIT_V(6); PG8_BAR; PG8_MMA(1, 1, At, B1); PG8_BAR;
            PG8_LDB(B0, 1, 0); PG8_SCHED; PG8_LDA(At, 1, 0); PG8_STAGE(PG8_SA(0, 1), a2 + hstep, voffA);
            PG8_WAIT_L(8); PG8_BAR; PG8_WAIT_L(0); PG8_MMA(0, 0, At, B0); PG8_BAR; PG8_SCHED;
            PG8_LDB(B1, 1, 1); PG8_STAGE(PG8_SB(1, 0), b3, voffB);
            PG8_BAR; PG8_WAIT_L(0); PG8_MMA(0, 1, At, B1); PG8_BAR;
            PG8_LDA(At, 1, 1); PG8_STAGE(PG8_SA(1, 0), a3, voffA);
            PG8_BAR; PG8_WAIT_L(0); PG8_MMA(1, 0, At, B0); PG8_BAR; PG8_SCHED;
            PG8_STAGE(PG8_SB(1, 1), b3 + hstep, voffB);
            PG8_WAIT_V(6); PG8_BAR; PG8_MMA(1, 1, At, B1); PG8_BAR;
            }
        }
        if constexpr (ALIGN_EPI) { if (wr == 0) PG8_BAR; }
        if constexpr (!Epi::AFTER_DRAIN) { E(acc, cur, wr, wc, fr, fq); S.done(cur); }
        if (!has_next) break;
#pragma unroll
        for (int a = 0; a < 2; ++a)
#pragma unroll
            for (int b = 0; b < 2; ++b)
#pragma unroll
                for (int m = 0; m < 4; ++m)
#pragma unroll
                    for (int n = 0; n < 2; ++n) acc[a][b][m][n] = (f32x4){0.f, 0.f, 0.f, 0.f};
        cur = nxt; cA = nA; cB = nB; ++ui;
        if constexpr (ALIGN_EPI) { if (wr == 1) PG8_BAR; }
    }
    PG8_WAIT_V(0);
    if constexpr (!ALIGN_EPI) { if (wr == 0) PG8_BAR; }
    PG8_BAR;
    if constexpr (Epi::AFTER_DRAIN) { E.fused(acc, cur, wr, wc, fr, fq, lds, wid, lane); S.done(cur); }
#undef PG8_SA
#undef PG8_SB
#undef PG8_STAGE
#undef PG8_LDA
#undef PG8_LDB
#undef PG8_MMA
#undef PG8_WAIT_V
#undef PG8_WAIT_L
#undef PG8_BAR
#undef PG8_SCHED
}
}

#define LAS __attribute__((address_space(3)))
typedef unsigned short bf16_t;
typedef short bf16x8 __attribute__((ext_vector_type(8)));
typedef float f32x4 __attribute__((ext_vector_type(4)));
typedef float f32x16 __attribute__((ext_vector_type(16)));
typedef unsigned u32x4 __attribute__((ext_vector_type(4)));
typedef unsigned u32x2 __attribute__((ext_vector_type(2)));
using pg8::cvt_pk_bf16;

constexpr int NWAVES = 8, NTHREADS = 512;
constexpr int BATCH = 4, SEQ = 4096, DM = 1024, MTOK = BATCH * SEQ, NZ = 3072, FF = 2816, NGU = 2 * FF, NLAYER = 2, INC = 2884;
constexpr float C2 = 0.125f * 1.4426950408889634f;
constexpr float NEGF = -1e30f;
constexpr int LDS_BYTES = 147456;
constexpr int NPHASE = 14;

constexpr size_t MiB = 1u << 20;
constexpr size_t WS_WIN = 0, WS_WOUT = 12 * MiB, WS_WGU = 16 * MiB, WS_WDN = 38 * MiB, WS_ROPE = 49 * MiB, WS_SSQA = 50 * MiB, WS_SSQB = 51 * MiB,
                 WS_MASK = 52 * MiB, WS_VT = 60 * MiB, WS_XB = 68 * MiB, WS_Y = 100 * MiB, WS_Z = 132 * MiB, WS_END = 228 * MiB;
constexpr size_t WIN_L = (size_t)NZ * DM, WOUT_L = (size_t)DM * DM, WGU_L = (size_t)NGU * DM, WDN_L = (size_t)DM * FF;

__device__ const double INVF[32] = {1, 0.74989420933245587, 0.56234132519034907, 0.42169650342858223, 0.31622776601683794, 0.23713737056616552, 0.17782794100389229, 0.1333521432163324,
    0.10000000000000001, 0.074989420933245579, 0.056234132519034911, 0.042169650342858224, 0.031622776601683791, 0.023713737056616554, 0.017782794100389229, 0.013335214321633241,
    0.01, 0.0074989420933245579, 0.005623413251903491, 0.0042169650342858229, 0.0031622776601683794, 0.0023713737056616554, 0.0017782794100389228, 0.0013335214321633241,
    0.001, 0.00074989420933245586, 0.0005623413251903491, 0.00042169650342858224, 0.00031622776601683794, 0.00023713737056616554, 0.00017782794100389227, 0.0001333521432163324};

#define LDS_WAIT() asm volatile("s_waitcnt lgkmcnt(0)" ::: "memory")
__device__ __forceinline__ float bf2f(unsigned short h) { return __uint_as_float((unsigned)h << 16); }
__device__ __forceinline__ float bflo(unsigned w) { return __uint_as_float(w << 16); }
__device__ __forceinline__ float bfhi(unsigned w) { return __uint_as_float(w & 0xffff0000u); }
__device__ __forceinline__ float wave_sum(float v) {
#pragma unroll
    for (int o = 1; o < 64; o <<= 1) v += __shfl_xor(v, o);
    return v;
}
__device__ __forceinline__ float swap32(float v) { auto rr = __builtin_amdgcn_permlane32_swap(__float_as_uint(v), __float_as_uint(v), false, false); return (threadIdx.x & 32) ? __uint_as_float(rr[0]) : __uint_as_float(rr[1]); }
__device__ __forceinline__ float row_rs(const float* ssq, int r) {
    const f32x4* p = (const f32x4*)(ssq + (size_t)r * 16); const f32x4 a = p[0], b = p[1], c = p[2], d = p[3];
    const float s = (((a.x + a.y) + (a.z + a.w)) + ((b.x + b.y) + (b.z + b.w))) + (((c.x + c.y) + (c.z + c.w)) + ((d.x + d.y) + (d.z + d.w)));
    return rsqrtf(s * (1.f / 1024.f) + 1e-6f);
}
__device__ __forceinline__ float sigmoidf_(float x) { return 1.f / (1.f + __expf(-x)); }

struct EpiZ {
    static constexpr bool PERM = true, AFTER_DRAIN = false;
    bf16_t* Z; bf16_t* VT; const float* ssq; const float* ropec; const float* ropes;
    __device__ __forceinline__ void operator()(const f32x4 (&acc)[2][2][4][2], const pg8::Unit& u, int wr, int wc, int fr, int fq) const {
        const int pn = u.pn; const bool rope_tile = (pn == 5) || (pn == 6) || (pn == 8) || (pn == 11);
#pragma unroll
        for (int ai = 0; ai < 2; ++ai)
#pragma unroll
            for (int m = 0; m < 4; ++m) {
                const int r = u.pm * 256 + ai * 128 + wr * 64 + m * 16 + fr; const float rs = row_rs(ssq, r); const int pos = r & (SEQ - 1);
#pragma unroll
                for (int bj = 0; bj < 2; ++bj) {
                    const int cl = bj * 128 + wc * 32 + fq * 8;
                    f32x4 v0 = acc[ai][bj][m][0] * rs, v1 = acc[ai][bj][m][1] * rs;
                    if (rope_tile && (pn != 11 || cl < 64)) {
                        const int i0 = (cl & 63) >> 1;
                        const f32x4 c4 = *(const f32x4*)(ropec + pos * 32 + i0), s4 = *(const f32x4*)(ropes + pos * 32 + i0);
                        float a, b;
                        a = v0[0]; b = v0[1]; v0[0] = a * c4[0] - b * s4[0]; v0[1] = b * c4[0] + a * s4[0];
                        a = v0[2]; b = v0[3]; v0[2] = a * c4[1] - b * s4[1]; v0[3] = b * c4[1] + a * s4[1];
                        a = v1[0]; b = v1[1]; v1[0] = a * c4[2] - b * s4[2]; v1[1] = b * c4[2] + a * s4[2];
                        a = v1[2]; b = v1[3]; v1[2] = a * c4[3] - b * s4[3]; v1[3] = b * c4[3] + a * s4[3];
                    }
                    u32x4 w; w.x = cvt_pk_bf16(v0[0], v0[1]); w.y = cvt_pk_bf16(v0[2], v0[3]); w.z = cvt_pk_bf16(v1[0], v1[1]); w.w = cvt_pk_bf16(v1[2], v1[3]);
                    if (pn == 7) {
                        const int hh = cl >> 6, d0 = cl & 63, b = r >> 12;
                        bf16_t* vp = VT + ((size_t)((b * 4 + hh) * 64 + d0)) * SEQ + pos;
                        vp[0 * SEQ] = (bf16_t)(w.x & 0xffffu); vp[1 * SEQ] = (bf16_t)(w.x >> 16); vp[2 * SEQ] = (bf16_t)(w.y & 0xffffu); vp[3 * SEQ] = (bf16_t)(w.y >> 16);
                        vp[4 * SEQ] = (bf16_t)(w.z & 0xffffu); vp[5 * SEQ] = (bf16_t)(w.z >> 16); vp[6 * SEQ] = (bf16_t)(w.w & 0xffffu); vp[7 * SEQ] = (bf16_t)(w.w >> 16);
                    } else {
                        *(u32x4*)(Z + (size_t)r * NZ + pn * 256 + cl) = w;
                    }
                }
                asm volatile("" ::: "memory");
            }
    }
};
struct EpiRes {
    static constexpr bool PERM = true, AFTER_DRAIN = false;
    const float* base; float* out; bf16_t* xb; float* ssq;
    __device__ __forceinline__ void operator()(const f32x4 (&acc)[2][2][4][2], const pg8::Unit& u, int wr, int wc, int fr, int fq) const {
#pragma unroll
        for (int ai = 0; ai < 2; ++ai)
#pragma unroll
            for (int m = 0; m < 4; ++m) {
                const int r = u.pm * 256 + ai * 128 + wr * 64 + m * 16 + fr; float sq = 0.f;
#pragma unroll
                for (int bj = 0; bj < 2; ++bj) {
                    const size_t off = (size_t)r * DM + u.pn * 256 + bj * 128 + wc * 32 + fq * 8;
                    const f32x4 v0 = acc[ai][bj][m][0] + *(const f32x4*)(base + off), v1 = acc[ai][bj][m][1] + *(const f32x4*)(base + off + 4);
                    *(f32x4*)(out + off) = v0; *(f32x4*)(out + off + 4) = v1;
                    u32x4 w; w.x = cvt_pk_bf16(v0[0], v0[1]); w.y = cvt_pk_bf16(v0[2], v0[3]); w.z = cvt_pk_bf16(v1[0], v1[1]); w.w = cvt_pk_bf16(v1[2], v1[3]);
                    *(u32x4*)(xb + off) = w;
                    sq += ((v0[0] * v0[0] + v0[1] * v0[1]) + (v0[2] * v0[2] + v0[3] * v0[3])) + ((v1[0] * v1[0] + v1[1] * v1[1]) + (v1[2] * v1[2] + v1[3] * v1[3]));
                }
                sq += __shfl_xor(sq, 16); sq += __shfl_xor(sq, 32);
                if (fq == 0) ssq[(size_t)r * 16 + u.pn * 4 + wc] = sq;
                asm volatile("" ::: "memory");
            }
    }
};
struct EpiGU {
    static constexpr bool PERM = true, AFTER_DRAIN = false;
    bf16_t* H; const float* ssq;
    __device__ __forceinline__ void operator()(const f32x4 (&acc)[2][2][4][2], const pg8::Unit& u, int wr, int wc, int fr, int fq) const {
#pragma unroll
        for (int ai = 0; ai < 2; ++ai)
#pragma unroll
            for (int m = 0; m < 4; ++m) {
                const int r = u.pm * 256 + ai * 128 + wr * 64 + m * 16 + fr; const float rs = row_rs(ssq, r);
#pragma unroll
                for (int bj = 0; bj < 2; ++bj) {
                    const int cl = bj * 128 + wc * 32 + fq * 8;
                    const f32x4 g = acc[ai][bj][m][0] * rs, up = acc[ai][bj][m][1] * rs;
                    const float h0 = g[0] * sigmoidf_(g[0]) * up[0], h1 = g[1] * sigmoidf_(g[1]) * up[1], h2 = g[2] * sigmoidf_(g[2]) * up[2], h3 = g[3] * sigmoidf_(g[3]) * up[3];
                    u32x2 w; w.x = cvt_pk_bf16(h0, h1); w.y = cvt_pk_bf16(h2, h3);
                    *(u32x2*)(H + (size_t)r * FF + u.pn * 128 + (cl >> 1)) = w;
                }
                asm volatile("" ::: "memory");
            }
    }
};

__device__ __forceinline__ int il64(int p) { return (p & 1) ? (p >> 1) + 32 : (p >> 1); }
__device__ __forceinline__ void conv_item(const float* src, int ld, float cs, const float* gk, int K, bf16_t* WT, int n0, int k0, LAS float* scr, int lane) {
#pragma unroll 8
    for (int i = 0; i < 32; ++i) {
        const int kk = 2 * i + (lane >> 5); float v = 0.f;
        if (src) { v = src[(size_t)(k0 + kk) * ld] * cs; if (gk) v *= gk[k0 + kk]; }
        scr[kk * 33 + (lane & 31)] = v;
    }
    LDS_WAIT();
    const int c = lane & 7;
#pragma unroll
    for (int j = 0; j < 4; ++j) {
        const int n = (lane >> 3) + 8 * j; const LAS float* s = scr + (8 * c) * 33 + n;
        u32x4 o; o.x = cvt_pk_bf16(s[0 * 33], s[1 * 33]); o.y = cvt_pk_bf16(s[2 * 33], s[3 * 33]); o.z = cvt_pk_bf16(s[4 * 33], s[5 * 33]); o.w = cvt_pk_bf16(s[6 * 33], s[7 * 33]);
        *(u32x4*)(WT + (size_t)(n0 + n) * K + k0 + 8 * c) = o;
    }
    LDS_WAIT();
}

struct Args { const float* in[18]; float* out; unsigned char* ws; int ph_lo, ph_hi; };
typedef const Args __attribute__((address_space(4)))* KArgs;
__device__ __forceinline__ KArgs kargs() { KArgs p = (KArgs)__builtin_amdgcn_kernarg_segment_ptr(); asm volatile("" : "+s"(p)); return p; }

__device__ __forceinline__ void prologue(KArgs A, unsigned char* ws, LAS unsigned char* lds, int tid, int wave, int lane, int bid, int G) {
    LAS float* scr = (LAS float*)(lds + wave * 16384);
    const int gw = bid * NWAVES + wave, NGW = G * NWAVES;
    constexpr int I_IN = 16 * 96, I_OUT = 16 * 32, I_GU = 16 * 176, I_DN = 44 * 32, I_L = I_IN + I_OUT + I_GU + I_DN;
    for (int it = gw; it < NLAYER * I_L; it += NGW) {
        const int l = it / I_L; int r = it % I_L;
        if (r < I_IN) {
            const int kb = r / 96, nb = r % 96, n = nb * 32 + (lane & 31), tile = n >> 8, c = n & 255;
            int src; float cs = 1.f;
            if (tile <= 4) src = n;
            else if (tile == 5) { src = 1280 + (c & ~63) + il64(c & 63); cs = C2; }
            else if (tile == 6) src = 1536 + (c & ~63) + il64(c & 63);
            else if (tile == 7) src = 1792 + c;
            else if (tile == 8) src = 2048 + (c & ~63) + il64(c & 63);
            else if (tile == 9) src = 2372 + c;
            else if (tile == 10) src = 2628 + c;
            else { if (c < 64) src = 2304 + il64(c); else if (c < 68) { src = 2368 + (c - 64); cs = 0.0625f; } else src = -1; }
            const float* wl = A->in[2] + (size_t)l * DM * INC;
            conv_item(src >= 0 ? wl + src : nullptr, INC, cs, A->in[1] + l * DM, DM, (bf16_t*)(ws + WS_WIN) + l * WIN_L, nb * 32, kb * 64, scr, lane);
            continue;
        }
        r -= I_IN;
        if (r < I_OUT) {
            const int kb = r / 32, nb = r % 32;
            conv_item(A->in[12] + (size_t)l * DM * DM + nb * 32 + (lane & 31), DM, 1.f, nullptr, DM, (bf16_t*)(ws + WS_WOUT) + l * WOUT_L, nb * 32, kb * 64, scr, lane);
            continue;
        }
        r -= I_OUT;
        if (r < I_GU) {
            const int kb = r / 176, nb = r % 176, n = nb * 32 + (lane & 31), g = n >> 3, e = n & 7, col = 4 * g + (e & 3);
            const float* wsrc = (e < 4 ? A->in[14] : A->in[15]) + (size_t)l * DM * FF + col;
            conv_item(wsrc, FF, 1.f, A->in[13] + l * DM, DM, (bf16_t*)(ws + WS_WGU) + l * WGU_L, nb * 32, kb * 64, scr, lane);
            continue;
        }
        r -= I_GU;
        { const int kb = r / 32, nb = r % 32;
          conv_item(A->in[16] + (size_t)l * FF * DM + nb * 32 + (lane & 31), DM, 1.f, nullptr, FF, (bf16_t*)(ws + WS_WDN) + l * WDN_L, nb * 32, kb * 64, scr, lane); }
    }
    float* ropec = (float*)(ws + WS_ROPE); float* ropes = ropec + SEQ * 32;
    for (int idx = bid * NTHREADS + tid; idx < SEQ * 32; idx += G * NTHREADS) {
        const int pos = idx >> 5, i = idx & 31;
        const double ang = (double)pos * INVF[i];
        const double nn = rint(ang * 0.15915494309189535);
        const double x = ang - nn * 6.283185307179586477, x2 = x * x;
        double c = 1.0, s = 1.0, tc = 1.0, ts = 1.0;
#pragma unroll
        for (int k = 1; k <= 15; ++k) { tc *= -x2 / (double)((2 * k - 1) * (2 * k)); c += tc; ts *= -x2 / (double)((2 * k) * (2 * k + 1)); s += ts; }
        ropec[idx] = (float)c; ropes[idx] = (float)(s * x);
    }
    const float* x = A->in[0]; bf16_t* XB = (bf16_t*)(ws + WS_XB); float* ssqA = (float*)(ws + WS_SSQA);
    for (int row = gw; row < MTOK; row += NGW) {
        const f32x4* xr = (const f32x4*)(x + (size_t)row * DM) + lane; u32x2* d = (u32x2*)(XB + (size_t)row * DM) + lane; float s = 0.f;
#pragma unroll
        for (int j = 0; j < 4; ++j) { const f32x4 v = xr[64 * j]; s += (v.x * v.x + v.y * v.y) + (v.z * v.z + v.w * v.w); u32x2 o; o.x = cvt_pk_bf16(v.x, v.y); o.y = cvt_pk_bf16(v.z, v.w); d[64 * j] = o; }
        s = wave_sum(s);
        if (lane < 16) ssqA[(size_t)row * 16 + lane] = lane == 0 ? s : 0.f;
    }
}

__device__ __forceinline__ int count_ge(const unsigned (&u)[64], unsigned cand, int nreg) {
    int c = 0;
#pragma unroll
    for (int g = 0; g < 8; ++g) {
        if (g * 8 < nreg) {
#pragma unroll
            for (int i = 0; i < 8; ++i) c += __builtin_popcountll(__builtin_amdgcn_ballot_w64(u[g * 8 + i] >= cand));
        }
    }
    return c;
}
__device__ __forceinline__ void select_phase(const bf16_t* Z, unsigned long long* MASK, LAS unsigned char* lds, int wave, int lane, int bid, int G) {
    constexpr int SCS = 4112;
    LAS float* sc = (LAS float*)lds;
    const int fr = lane & 15, fq = lane >> 4;
    const int nrounds = (2048 + G - 1) / G;
    for (int rd = 0; rd < nrounds; ++rd) {
        const int idx = rd * G + ((rd & 1) ? (G - 1 - bid) : bid);
        if (idx >= 2048) continue;
        const int b = idx & 3, q0 = (idx >> 2) * 8; const size_t rowbase = (size_t)b * SEQ;
        {
            const bf16_t* zq = Z + (rowbase + q0 + (fr & 7)) * NZ;
            bf16x8 qf[4][2];
#pragma unroll
            for (int j = 0; j < 4; ++j)
#pragma unroll
                for (int ks = 0; ks < 2; ++ks) qf[j][ks] = *(const bf16x8*)(zq + 2048 + j * 64 + ks * 32 + fq * 8);
            const u32x2 wraw = *(const u32x2*)(zq + 2816 + 64);
            const float w0 = bflo(wraw.x), w1 = bfhi(wraw.x), w2 = bflo(wraw.y), w3 = bfhi(wraw.y);
            const int nkt = (q0 + 8 + 15) >> 4;
            for (int kt = wave; kt < nkt; kt += 8) {
                const bf16_t* zk = Z + (rowbase + kt * 16 + fr) * NZ + 2816 + fq * 8;
                const bf16x8 k0 = *(const bf16x8*)zk, k1 = *(const bf16x8*)(zk + 32);
                f32x4 s4 = {0.f, 0.f, 0.f, 0.f};
#pragma unroll
                for (int j = 0; j < 4; ++j) {
                    f32x4 a = __builtin_amdgcn_mfma_f32_16x16x32_bf16(k0, qf[j][0], (f32x4){0.f, 0.f, 0.f, 0.f}, 0, 0, 0);
                    a = __builtin_amdgcn_mfma_f32_16x16x32_bf16(k1, qf[j][1], a, 0, 0, 0);
                    const float wj = j == 0 ? w0 : j == 1 ? w1 : j == 2 ? w2 : w3;
#pragma unroll
                    for (int i = 0; i < 4; ++i) s4[i] = fmaf(fmaxf(a[i], 0.f), wj, s4[i]);
                }
                if (fr < 8) *(LAS f32x4*)(sc + fr * SCS + kt * 16 + fq * 4) = s4;
            }
        }
        __syncthreads();
        {
            const int q = q0 + wave, n = q + 1, nreg = (n + 63) >> 6;
            unsigned u[64];
            const LAS float* srow = sc + wave * SCS + lane;
#pragma unroll
            for (int g = 0; g < 8; ++g) {
                if (g * 8 < nreg) {
#pragma unroll
                    for (int i = 0; i < 8; ++i) {
                        const int ii = g * 8 + i; const unsigned bits = __float_as_uint(srow[ii * 64]);
                        const unsigned key = bits ^ ((unsigned)((int)bits >> 31) | 0x80000000u);
                        u[ii] = (ii * 64 + lane <= q) ? key : 0u;
                    }
                } else {
#pragma unroll
                    for (int i = 0; i < 8; ++i) u[g * 8 + i] = 0u;
                }
            }
            unsigned T = 0u, TG = 0u; int rrem = 0;
            if (n > 256) {
                bool exact = false;
                for (int bit = 31; bit >= 0; --bit) {
                    const unsigned cand = T | (1u << bit);
                    const int c = count_ge(u, cand, nreg);
                    if (c >= 256) { T = cand; if (c == 256) { exact = true; break; } }
                }
                if (exact) TG = T - 1u; else { TG = T; rrem = 256 - count_ge(u, T + 1u, nreg); }
            }
            unsigned long long myw = 0ull;
#pragma unroll
            for (int i = 0; i < 64; ++i) {
                unsigned long long wsel = 0ull;
                if (i < nreg) {
                    wsel = __builtin_amdgcn_ballot_w64(u[i] > TG);
                    if (rrem > 0) {
                        const unsigned long long eq = __builtin_amdgcn_ballot_w64(u[i] == T);
                        const unsigned pre = __builtin_amdgcn_mbcnt_hi((unsigned)(eq >> 32), __builtin_amdgcn_mbcnt_lo((unsigned)eq, 0u));
                        const bool me = (u[i] == T) && ((int)pre < rrem);
                        wsel |= __builtin_amdgcn_ballot_w64(me);
                        const int ne = __builtin_popcountll(eq); rrem = rrem > ne ? rrem - ne : 0;
                    }
                }
                if (lane == i) myw = wsel;
            }
            MASK[(rowbase + q) * 64 + lane] = myw;
        }
        __syncthreads();
    }
}

__device__ __forceinline__ void mixer_a(const bf16_t* Z, bf16_t* Y, const float* wc, int gtid, int NGT) {
    for (int it = gtid; it < MTOK * 32; it += NGT) {
        const int row = it >> 5, c8 = (it & 31) * 8, pos = row & (SEQ - 1);
        const bf16_t* zr = Z + (size_t)row * NZ;
        float acc[8];
#pragma unroll
        for (int i = 0; i < 8; ++i) acc[i] = 0.f;
#pragma unroll
        for (int j = 0; j < 3; ++j) {
            const int d = 2 - j;
            if (pos >= d) {
                const bf16_t* zz = zr - (size_t)d * NZ;
                const u32x4 cc = *(const u32x4*)(zz + 256 + c8), hh = *(const u32x4*)(zz + 512 + c8);
                const f32x4 wa = *(const f32x4*)(wc + j * 256 + c8), wb = *(const f32x4*)(wc + j * 256 + c8 + 4);
                acc[0] += wa[0] * (bflo(cc.x) * bflo(hh.x)); acc[1] += wa[1] * (bfhi(cc.x) * bfhi(hh.x));
                acc[2] += wa[2] * (bflo(cc.y) * bflo(hh.y)); acc[3] += wa[3] * (bfhi(cc.y) * bfhi(hh.y));
                acc[4] += wb[0] * (bflo(cc.z) * bflo(hh.z)); acc[5] += wb[1] * (bfhi(cc.z) * bfhi(hh.z));
                acc[6] += wb[2] * (bflo(cc.w) * bflo(hh.w)); acc[7] += wb[3] * (bfhi(cc.w) * bfhi(hh.w));
            }
        }
        const u32x4 ab = *(const u32x4*)(zr + c8);
        u32x4 o;
        o.x = cvt_pk_bf16(bflo(ab.x) * acc[0], bfhi(ab.x) * acc[1]); o.y = cvt_pk_bf16(bflo(ab.y) * acc[2], bfhi(ab.y) * acc[3]);
        o.z = cvt_pk_bf16(bflo(ab.z) * acc[4], bfhi(ab.z) * acc[5]); o.w = cvt_pk_bf16(bflo(ab.w) * acc[6], bfhi(ab.w) * acc[7]);
        *(u32x4*)(Y + (size_t)row * DM + c8) = o;
    }
}

__device__ __forceinline__ void mixer_b(const bf16_t* Z, bf16_t* Y, const float* lng, const float* lnb, const float* wsp, const float* bsp,
                                        LAS unsigned char* lds, int wave, int lane, int bid, int G) {
    constexpr int VP = 132;
    LAS bf16_t* vt = (LAS bf16_t*)lds;
    const int fr = lane & 15, fq = lane >> 4;
    for (int un = bid; un < 256; un += G) {
        const int chunk = un >> 1, hf = un & 1; const size_t row0 = (size_t)chunk * 128;
        for (int k = 0; k < 16; ++k) {
            const int s = wave * 16 + k; const bf16_t* zr = Z + (row0 + s) * NZ + 4 * 256;
            const float v0 = bf2f(zr[lane]), v1 = bf2f(zr[lane + 64]), v2 = bf2f(zr[lane + 128]), v3 = bf2f(zr[lane + 192]);
            const float mean = wave_sum((v0 + v1) + (v2 + v3)) * (1.f / 256.f);
            const float d0 = v0 - mean, d1 = v1 - mean, d2 = v2 - mean, d3 = v3 - mean;
            const float var = wave_sum((d0 * d0 + d1 * d1) + (d2 * d2 + d3 * d3)) * (1.f / 256.f);
            const float rstd = rsqrtf(var + 1e-5f);
            const int ca = hf * 128 + lane, cb = ca + 64;
            const float a = (hf ? d2 : d0) * rstd * lng[ca] + lnb[ca], b = (hf ? d3 : d1) * rstd * lng[cb] + lnb[cb];
            const unsigned pk = cvt_pk_bf16(a, b);
            vt[lane * VP + s] = (bf16_t)(pk & 0xffffu); vt[(lane + 64) * VP + s] = (bf16_t)(pk >> 16);
        }
        __syncthreads();
        const int t = wave * 16 + fr;
#pragma unroll
        for (int hh = 0; hh < 2; ++hh) {
            const int h = hf * 2 + hh; const float* W = wsp + (size_t)h * 128 * 128 + (size_t)t * 128;
            f32x4 acc[4];
#pragma unroll
            for (int nt = 0; nt < 4; ++nt) acc[nt] = (f32x4){0.f, 0.f, 0.f, 0.f};
            const int nks = (wave >> 1) + 1;
            for (int ks = 0; ks < nks; ++ks) {
                const int s0 = ks * 32 + fq * 8;
                f32x4 wa = *(const f32x4*)(W + s0), wb = *(const f32x4*)(W + s0 + 4);
#pragma unroll
                for (int j = 0; j < 4; ++j) { if (s0 + j > t) wa[j] = 0.f; if (s0 + 4 + j > t) wb[j] = 0.f; }
                u32x4 wp; wp.x = cvt_pk_bf16(wa[0], wa[1]); wp.y = cvt_pk_bf16(wa[2], wa[3]); wp.z = cvt_pk_bf16(wb[0], wb[1]); wp.w = cvt_pk_bf16(wb[2], wb[3]);
                const bf16x8 wf = __builtin_bit_cast(bf16x8, wp);
#pragma unroll
                for (int nt = 0; nt < 4; ++nt) {
                    const LAS bf16_t* vp = vt + (hh * 64 + nt * 16 + fr) * VP + s0;
                    const u32x2 lo = *(const LAS u32x2*)vp, hi2 = *(const LAS u32x2*)(vp + 4);
                    u32x4 vv; vv.x = lo.x; vv.y = lo.y; vv.z = hi2.x; vv.w = hi2.y;
                    acc[nt] = __builtin_amdgcn_mfma_f32_16x16x32_bf16(__builtin_bit_cast(bf16x8, vv), wf, acc[nt], 0, 0, 0);
                }
            }
            const float bias = bsp[h * 128 + t]; const size_t row = row0 + t;
#pragma unroll
            for (int nt = 0; nt < 4; ++nt) {
                const int col = h * 64 + nt * 16 + fq * 4;
                const u32x2 uu = *(const u32x2*)(Z + row * NZ + 3 * 256 + col);
                u32x2 o; o.x = cvt_pk_bf16((acc[nt][0] + bias) * bflo(uu.x), (acc[nt][1] + bias) * bfhi(uu.x)); o.y = cvt_pk_bf16((acc[nt][2] + bias) * bflo(uu.y), (acc[nt][3] + bias) * bfhi(uu.y));
                *(u32x2*)(Y + row * DM + 256 + col) = o;
            }
        }
        __syncthreads();
    }
}

__device__ __forceinline__ void mixer_d(const bf16_t* Z, bf16_t* Y, const float* wcf, const float* bcf, const float* lng, const float* lnb,
                                        LAS unsigned char* lds, int tid, int wave, int lane, int bid, int G) {
    LAS float* yl = (LAS float*)lds;
    LAS float* cv = (LAS float*)(lds + 62 * 256 * 4);
    const int c = tid & 255, half = tid >> 8;
    float w[31];
#pragma unroll
    for (int j = 0; j < 31; ++j) w[j] = wcf[j * 256 + c];
    const float bias = bcf[c];
    const f32x4 g4 = *(const f32x4*)(lng + lane * 4), b4 = *(const f32x4*)(lnb + lane * 4);
    for (int un = bid; un < MTOK / 32; un += G) {
        const int row0 = un * 32, pos0 = row0 & (SEQ - 1);
        for (int it = tid; it < 62 * 32; it += NTHREADS) {
            const int rr = it >> 5, c8 = (it & 31) * 8, p = pos0 - 30 + rr;
            f32x4 o0 = {0.f, 0.f, 0.f, 0.f}, o1 = {0.f, 0.f, 0.f, 0.f};
            if (p >= 0) {
                const bf16_t* zr = Z + (size_t)(row0 - 30 + rr) * NZ;
                const u32x4 a = *(const u32x4*)(zr + 9 * 256 + c8), gg = *(const u32x4*)(zr + 10 * 256 + c8);
                o0[0] = bflo(a.x) * sigmoidf_(bflo(gg.x)); o0[1] = bfhi(a.x) * sigmoidf_(bfhi(gg.x)); o0[2] = bflo(a.y) * sigmoidf_(bflo(gg.y)); o0[3] = bfhi(a.y) * sigmoidf_(bfhi(gg.y));
                o1[0] = bflo(a.z) * sigmoidf_(bflo(gg.z)); o1[1] = bfhi(a.z) * sigmoidf_(bfhi(gg.z)); o1[2] = bflo(a.w) * sigmoidf_(bflo(gg.w)); o1[3] = bfhi(a.w) * sigmoidf_(bfhi(gg.w));
            }
            *(LAS f32x4*)(yl + rr * 256 + c8) = o0; *(LAS f32x4*)(yl + rr * 256 + c8 + 4) = o1;
        }
        __syncthreads();
#pragma unroll
        for (int blk = 0; blk < 2; ++blk) {
            const int tb = half * 16 + blk * 8;
            float acc[8];
#pragma unroll
            for (int o = 0; o < 8; ++o) acc[o] = bias;
#pragma unroll
            for (int jj = 0; jj < 38; ++jj) {
                const float v = yl[(tb + jj) * 256 + c];
#pragma unroll
                for (int o = 0; o < 8; ++o) { const int j = jj - o; if (j >= 0 && j < 31) acc[o] += w[j] * v; }
            }
#pragma unroll
            for (int o = 0; o < 8; ++o) cv[(tb + o) * 256 + c] = acc[o];
        }
        __syncthreads();
#pragma unroll
        for (int k = 0; k < 4; ++k) {
            const int tt = wave * 4 + k;
            const f32x4 v = *(const LAS f32x4*)(cv + tt * 256 + lane * 4);
            const float mean = wave_sum((v[0] + v[1]) + (v[2] + v[3])) * (1.f / 256.f);
            const f32x4 d = v - mean;
            const float var = wave_sum((d[0] * d[0] + d[1] * d[1]) + (d[2] * d[2] + d[3] * d[3])) * (1.f / 256.f);
            const float rstd = rsqrtf(var + 1e-5f);
            const f32x4 y = d * rstd * g4 + b4;
            u32x2 o; o.x = cvt_pk_bf16(y[0] * sigmoidf_(y[0]), y[1] * sigmoidf_(y[1])); o.y = cvt_pk_bf16(y[2] * sigmoidf_(y[2]), y[3] * sigmoidf_(y[3]));
            *(u32x2*)(Y + (size_t)(row0 + tt) * DM + 768 + lane * 4) = o;
        }
        __syncthreads();
    }
}

__device__ __forceinline__ void attn_phase(const bf16_t* Z, const bf16_t* VT, const unsigned* MASK32, bf16_t* Y, LAS unsigned char* lds, int wave, int lane, int bid, int G) {
    const int h = wave & 3, half = wave >> 2, ql = lane & 31, hi = lane >> 5;
    LAS float* mo = (LAS float*)lds + h * 2048;
    LAS float* mml = (LAS float*)(lds + 32768) + h * 128;
    LAS bf16_t* ost = (LAS bf16_t*)(lds + 36864) + h * (32 * 72);
    const unsigned NEGB = __float_as_uint(NEGF);
    for (int pu = bid; pu < 256; pu += G) {
        const int b = pu & 3, jj = pu >> 2;
        for (int rep = 0; rep < 2; ++rep) {
            const int qb = rep ? jj : 127 - jj;
            const int NT = qb + 1, n0 = (NT + 1) >> 1, tb = half ? n0 : 0, te = half ? NT : n0;
            const size_t rowq = (size_t)b * SEQ + qb * 32 + ql;
            const bf16_t* zq = Z + rowq * NZ + 1280 + h * 64 + hi * 8;
            bf16x8 qf[4];
#pragma unroll
            for (int c = 0; c < 4; ++c) qf[c] = *(const bf16x8*)(zq + 16 * c);
            const unsigned* mrow = MASK32 + rowq * 128;
            const bf16_t* kb = Z + ((size_t)b * SEQ + ql) * NZ + 1536 + h * 64 + hi * 8;
            const bf16_t* vb = VT + ((size_t)((b * 4 + h) * 64 + ql)) * SEQ + hi * 4;
            f32x16 o0, o1;
#pragma unroll
            for (int r = 0; r < 16; ++r) { o0[r] = 0.f; o1[r] = 0.f; }
            float m = NEGF, l = 0.f;
            bf16x8 kf[4]; u32x2 vr[2][2][2]; unsigned mw = 0u;
#define ATT_LOAD(kt_) do { const bf16_t* kp_ = kb + (size_t)(kt_) * 32 * NZ; _Pragma("unroll") for (int c = 0; c < 4; ++c) kf[c] = *(const bf16x8*)(kp_ + 16 * c); \
        _Pragma("unroll") for (int mt = 0; mt < 2; ++mt) _Pragma("unroll") for (int c = 0; c < 2; ++c) _Pragma("unroll") for (int e = 0; e < 2; ++e) \
            vr[mt][c][e] = *(const u32x2*)(vb + (size_t)mt * 32 * SEQ + (kt_) * 32 + 16 * c + 8 * e); \
        mw = mrow[(kt_)]; } while (0)
            if (tb < te) ATT_LOAD(tb);
            for (int kt = tb; kt < te; ++kt) {
                bf16x8 ck[4]; u32x2 cvv[2][2][2];
#pragma unroll
                for (int c = 0; c < 4; ++c) ck[c] = kf[c];
#pragma unroll
                for (int mt = 0; mt < 2; ++mt)
#pragma unroll
                    for (int c = 0; c < 2; ++c)
#pragma unroll
                        for (int e = 0; e < 2; ++e) cvv[mt][c][e] = vr[mt][c][e];
                const unsigned cm = mw;
                if (kt + 1 < te) ATT_LOAD(kt + 1);
                f32x16 s;
#pragma unroll
                for (int r = 0; r < 16; ++r) s[r] = 0.f;
#pragma unroll
                for (int c = 0; c < 4; ++c) s = __builtin_amdgcn_mfma_f32_32x32x16_bf16(ck[c], qf[c], s, 0, 0, 0);
                const int mws = (int)(cm >> (4 * hi));
                float rm = NEGF;
#pragma unroll
                for (int r = 0; r < 16; ++r) {
                    const unsigned sel = (unsigned)__builtin_amdgcn_sbfe(mws, (r & 3) + 8 * (r >> 2), 1);
                    s[r] = __uint_as_float((__float_as_uint(s[r]) & sel) | (NEGB & ~sel));
                    rm = fmaxf(rm, s[r]);
                }
                rm = fmaxf(rm, swap32(rm));
                const float mn = fmaxf(m, rm);
                if (__any(mn > m)) {
                    const float al = __builtin_amdgcn_exp2f(m - mn); l *= al;
#pragma unroll
                    for (int r = 0; r < 16; ++r) { o0[r] *= al; o1[r] *= al; }
                    m = mn;
                }
                float ps = 0.f;
#pragma unroll
                for (int r = 0; r < 16; ++r) { s[r] = __builtin_amdgcn_exp2f(s[r] - m); ps += s[r]; }
                l += ps;
                u32x4 p0, p1;
                p0.x = cvt_pk_bf16(s[0], s[1]); p0.y = cvt_pk_bf16(s[2], s[3]); p0.z = cvt_pk_bf16(s[4], s[5]); p0.w = cvt_pk_bf16(s[6], s[7]);
                p1.x = cvt_pk_bf16(s[8], s[9]); p1.y = cvt_pk_bf16(s[10], s[11]); p1.z = cvt_pk_bf16(s[12], s[13]); p1.w = cvt_pk_bf16(s[14], s[15]);
                const bf16x8 pf0 = __builtin_bit_cast(bf16x8, p0), pf1 = __builtin_bit_cast(bf16x8, p1);
                u32x4 t;
                t.x = cvv[0][0][0].x; t.y = cvv[0][0][0].y; t.z = cvv[0][0][1].x; t.w = cvv[0][0][1].y; o0 = __builtin_amdgcn_mfma_f32_32x32x16_bf16(__builtin_bit_cast(bf16x8, t), pf0, o0, 0, 0, 0);
                t.x = cvv[0][1][0].x; t.y = cvv[0][1][0].y; t.z = cvv[0][1][1].x; t.w = cvv[0][1][1].y; o0 = __builtin_amdgcn_mfma_f32_32x32x16_bf16(__builtin_bit_cast(bf16x8, t), pf1, o0, 0, 0, 0);
                t.x = cvv[1][0][0].x; t.y = cvv[1][0][0].y; t.z = cvv[1][0][1].x; t.w = cvv[1][0][1].y; o1 = __builtin_amdgcn_mfma_f32_32x32x16_bf16(__builtin_bit_cast(bf16x8, t), pf0, o1, 0, 0, 0);
                t.x = cvv[1][1][0].x; t.y = cvv[1][1][0].y; t.z = cvv[1][1][1].x; t.w = cvv[1][1][1].y; o1 = __builtin_amdgcn_mfma_f32_32x32x16_bf16(__builtin_bit_cast(bf16x8, t), pf1, o1, 0, 0, 0);
            }
#undef ATT_LOAD
            const float lt = l + swap32(l);
            if (half == 1) {
#pragma unroll
                for (int r = 0; r < 16; ++r) { mo[r * 64 + lane] = o0[r]; mo[(16 + r) * 64 + lane] = o1[r]; }
                mml[lane] = m; mml[64 + lane] = lt;
            }
            __syncthreads();
            if (half == 0) {
                const float m1 = mml[lane], l1 = mml[64 + lane];
                const float mn = fmaxf(m, m1), a0 = __builtin_amdgcn_exp2f(m - mn), a1 = __builtin_amdgcn_exp2f(m1 - mn);
                const float inv = 1.f / (lt * a0 + l1 * a1), f0 = a0 * inv, f1 = a1 * inv;
#pragma unroll
                for (int r = 0; r < 16; ++r) { o0[r] = o0[r] * f0 + mo[r * 64 + lane] * f1; o1[r] = o1[r] * f0 + mo[(16 + r) * 64 + lane] * f1; }
#pragma unroll
                for (int r = 0; r < 16; r += 2) {
                    const int d = (r & 3) + 8 * (r >> 2) + 4 * hi;
                    *(LAS unsigned*)(ost + ql * 72 + d) = cvt_pk_bf16(o0[r], o0[r + 1]);
                    *(LAS unsigned*)(ost + ql * 72 + 32 + d) = cvt_pk_bf16(o1[r], o1[r + 1]);
                }
                LDS_WAIT();
                bf16_t* yo = Y + ((size_t)b * SEQ + qb * 32 + (lane >> 1)) * DM + 512 + h * 64 + (lane & 1) * 32;
#pragma unroll
                for (int k = 0; k < 4; ++k) { const u32x4 v = *(const LAS u32x4*)(ost + (lane >> 1) * 72 + (lane & 1) * 32 + k * 8); *(u32x4*)(yo + k * 8) = v; }
            }
            __syncthreads();
        }
    }
}

__global__ void __launch_bounds__(NTHREADS, 2) mega_fwd(Args A_unused) {
    extern __shared__ __attribute__((aligned(16))) unsigned char lds_raw[];
    LAS unsigned char* lds = (LAS unsigned char*)lds_raw;
    cg::grid_group grid = cg::this_grid();
    const int G = gridDim.x;
    unsigned char* ws = kargs()->ws;
    bf16_t* XB = (bf16_t*)(ws + WS_XB); bf16_t* Yb = (bf16_t*)(ws + WS_Y); bf16_t* Zb = (bf16_t*)(ws + WS_Z); bf16_t* HID = Zb; bf16_t* VT = (bf16_t*)(ws + WS_VT);
    float* ssqA = (float*)(ws + WS_SSQA); float* ssqB = (float*)(ws + WS_SSQB);
    float* ropec = (float*)(ws + WS_ROPE); float* ropes = ropec + SEQ * 32;
    unsigned long long* MASK = (unsigned long long*)(ws + WS_MASK);
    const int ph_lo = kargs()->ph_lo, ph_hi = kargs()->ph_hi;
    for (int ph = ph_lo; ph < ph_hi; ++ph) {
        KArgs A = kargs();
        int tid = threadIdx.x, bid = blockIdx.x; asm volatile("" : "+v"(tid), "+s"(bid));
        const int lane = tid & 63, wave = __builtin_amdgcn_readfirstlane(tid >> 6);
        if (ph == 0) {
#ifndef NO_PRO
            prologue(A, ws, lds, tid, wave, lane, bid, G);
#endif
        } else if (ph == NPHASE - 1) {
            const float* gfin = A->in[17];
            for (int row = bid * NWAVES + wave; row < MTOK; row += G * NWAVES) {
                const float rs = row_rs(ssqA, row); f32x4* p = (f32x4*)(A->out + (size_t)row * DM) + lane; const f32x4* g = (const f32x4*)gfin + lane;
#pragma unroll
                for (int j = 0; j < 4; ++j) p[64 * j] = p[64 * j] * rs * g[64 * j];
            }
        } else {
            const int l = (ph - 1) / 6, k = (ph - 1) % 6;
            if (k == 0) {
                pg8::Gemm g{XB, (bf16_t*)(ws + WS_WIN) + l * WIN_L, MTOK, NZ, DM}; pg8::StaticOrder S; S.init(MTOK, NZ, G, bid);
                EpiZ E{Zb, VT, ssqA, ropec, ropes};
#ifndef NO_G0
                pg8::gemm_phase<EpiZ, pg8::StaticOrder, true, true>(lds, g, S, E);
#endif
            } else if (k == 1) {
#ifndef NO_SEL
                select_phase(Zb, MASK, lds, wave, lane, bid, G);
#endif
#ifndef NO_MB
                mixer_b(Zb, Yb, A->in[4] + l * 256, A->in[5] + l * 256, A->in[6] + (size_t)l * 4 * 128 * 128, A->in[7] + l * 4 * 128, lds, wave, lane, bid, G);
#endif
#ifndef NO_MD
                mixer_d(Zb, Yb, A->in[8] + l * 31 * 256, A->in[9] + l * 256, A->in[10] + l * 256, A->in[11] + l * 256, lds, tid, wave, lane, bid, G);
#endif
#ifndef NO_MA
                mixer_a(Zb, Yb, A->in[3] + l * 3 * 256, bid * NTHREADS + tid, G * NTHREADS);
#endif
            } else if (k == 2) {
#ifndef NO_ATT
                attn_phase(Zb, VT, (const unsigned*)MASK, Yb, lds, wave, lane, bid, G);
#endif
            } else if (k == 3) {
                pg8::Gemm g{Yb, (bf16_t*)(ws + WS_WOUT) + l * WOUT_L, MTOK, DM, DM}; pg8::StaticOrder S; S.init(MTOK, DM, G, bid);
                EpiRes E{l == 0 ? A->in[0] : A->out, A->out, XB, ssqB};
#ifndef NO_G1
                pg8::gemm_phase<EpiRes, pg8::StaticOrder, true, true>(lds, g, S, E);
#endif
            } else if (k == 4) {
                pg8::Gemm g{XB, (bf16_t*)(ws + WS_WGU) + l * WGU_L, MTOK, NGU, DM}; pg8::StaticOrder S; S.init(MTOK, NGU, G, bid);
                EpiGU E{HID, ssqB};
#ifndef NO_G2
                pg8::gemm_phase<EpiGU, pg8::StaticOrder, true, true>(lds, g, S, E);
#endif
            } else {
                pg8::Gemm g{HID, (bf16_t*)(ws + WS_WDN) + l * WDN_L, MTOK, DM, FF}; pg8::StaticOrder S; S.init(MTOK, DM, G, bid);
                EpiRes E{A->out, A->out, XB, ssqA};
#ifndef NO_G3
                pg8::gemm_phase<EpiRes, pg8::StaticOrder, true, true>(lds, g, S, E);
#endif
            }
        }
        if (ph + 1 < ph_hi) grid.sync();
    }
}

#ifndef MK_COOP
#define MK_COOP 0
#endif
extern "C" void kernel_launch(void* const* d_in, const int* in_sizes, int n_in, void* d_out, int out_size, void* d_ws, size_t ws_size, hipStream_t stream) {
    static int grid = 0;
    if (grid == 0) {
        if (n_in != 18 || out_size != MTOK * DM || ws_size < WS_END) { fprintf(stderr, "kernel_launch: unexpected shapes (n_in %d out %d ws %zu)\n", n_in, out_size, ws_size); grid = -1; return; }
        int dev = 0, cus = 0, per_cu = 0;
        if (hipGetDevice(&dev) != hipSuccess || hipDeviceGetAttribute(&cus, hipDeviceAttributeMultiprocessorCount, dev) != hipSuccess) { grid = -1; return; }
        if (hipFuncSetAttribute((const void*)mega_fwd, hipFuncAttributeMaxDynamicSharedMemorySize, LDS_BYTES) != hipSuccess) { fprintf(stderr, "kernel_launch: hipFuncSetAttribute failed\n"); grid = -1; return; }
        if (hipOccupancyMaxActiveBlocksPerMultiprocessor(&per_cu, (const void*)mega_fwd, NTHREADS, LDS_BYTES) != hipSuccess || per_cu < 1) { fprintf(stderr, "kernel_launch: occupancy query says %d\n", per_cu); (void)hipGetLastError(); }
        grid = cus;
    }
    if (grid < 0) return;
    Args a{};
    for (int i = 0; i < 18; ++i) a.in[i] = (const float*)d_in[i];
    a.out = (float*)d_out; a.ws = (unsigned char*)d_ws;
#if MK_COOP
    a.ph_lo = 0; a.ph_hi = NPHASE;
    void* args[] = {&a};
    hipError_t e = hipLaunchCooperativeKernel((const void*)mega_fwd, dim3(grid), dim3(NTHREADS), args, LDS_BYTES, stream);
    if (e != hipSuccess) fprintf(stderr, "cooperative launch failed: %s (grid %d)\n", hipGetErrorString(e), grid);
#else
    for (int ph = 0; ph < NPHASE; ++ph) {
        a.ph_lo = ph; a.ph_hi = ph + 1;
        hipLaunchKernelGGL(mega_fwd, dim3(grid), dim3(NTHREADS), LDS_BYTES, stream, a);
    }
#endif
}
```

```cpp
#include <hip/hip_runtime.h>
#include <hip/hip_cooperative_groups.h>
#include <cstdio>
#include <cstdint>
namespace cg = cooperative_groups;
namespace pg8 {
#define PG8_LAS __attribute__((address_space(3)))
typedef unsigned short bf16_t;
typedef short bf16x8 __attribute__((ext_vector_type(8)));
typedef float f32x4 __attribute__((ext_vector_type(4)));
typedef unsigned u32x4 __attribute__((ext_vector_type(4)));
constexpr int BM = 256, BK = 64, HALF = 128, HTB = HALF * BK * 2  , STAGE_BYTES = 8 * HTB, NXCD = 8, WGM = 8;

__host__ __device__ __forceinline__ int lds_byte(int r, int c) { const int st = (r >> 4) * 2 + (c >> 5), rr = r & 15, cc = c & 31, ob = rr * 64 + cc * 2; return st * 1024 + (ob ^ (((ob >> 9) & 1) << 5)); }
__host__ __device__ __forceinline__ void stage_rc(int b, int& R, int& C) { const int st = b / 1024, sb = b % 1024, swz = sb ^ (((sb >> 9) & 1) << 5); R = (st >> 1) * 16 + swz / 64; C = (st & 1) * 32 + (swz % 64) / 2; }
__host__ __device__ __forceinline__ int perm32(int rho) { const int n = rho >> 4, i = rho & 15; return 8 * (i >> 2) + 4 * n + (i & 3); }

struct Unit { int pm, pn; };
struct Gemm { const bf16_t* A; const bf16_t* Bt; int M, N, K; };

struct StaticOrder {
    int nM, nN, nwg, G, c;
    __host__ __device__ void init(int M, int N, int G_, int c_) { nM = M / BM; nN = N / BM; nwg = nM * nN; G = G_; c = c_; }
    __host__ __device__ bool next(int i, Unit& u) const {
        const long L = (long)i * G + c; if (L >= nwg) return false;
        int wgid = (int)L; { const int q = nwg / NXCD, r = nwg % NXCD, xcd = wgid % NXCD, off = wgid / NXCD; wgid = (xcd < r ? xcd * (q + 1) : r * (q + 1) + (xcd - r) * q) + off; }
        const int nig = WGM * nN, gid = wgid / nig, fm = gid * WGM, gsz = (nM - fm) < WGM ? (nM - fm) : WGM;
        u.pm = fm + ((wgid % nig) % gsz); u.pn = (wgid % nig) / gsz; return true;
    }
    __device__ __forceinline__ void a_ready(const Unit&) const {}
    __device__ __forceinline__ void done(const Unit&) const {}
};

__device__ __forceinline__ unsigned cvt_pk_bf16(float lo, float hi) { unsigned r; asm volatile("v_cvt_pk_bf16_f32 %0, %1, %2" : "=v"(r) : "v"(lo), "v"(hi)); return r; }
template <class Epi, class Sched, bool ALIGN_EPI = false, bool SP2 = false>
__device__ __forceinline__ void gemm_phase(PG8_LAS unsigned char* lds, const Gemm g, const Sched& S, const Epi& E, int tid_in) {
    int tid_l = tid_in; asm volatile("" : "+v"(tid_l));
    const int tid = tid_l, wid = __builtin_amdgcn_readfirstlane(tid >> 6), lane = tid & 63, wr = wid >> 2, wc = wid & 3, fr = lane & 15, fq = lane >> 4;
    const int K = g.K, nt = K / BK;
    unsigned voffA[2], voffB[2];
#pragma unroll
    for (int i = 0; i < 2; ++i) { int R, C; stage_rc(tid * 16 + i * 8192, R, C); const int Rb = Epi::PERM ? ((R & ~31) + perm32(R & 31)) : R;
        voffA[i] = (unsigned)(R * K + C) * 2u; voffB[i] = (unsigned)(Rb * K + C) * 2u; }
    const size_t kstep = (size_t)(BK * 2);
    const size_t hstep = (size_t)HALF * K * 2;
    const size_t tstep = 2 * hstep;
    const unsigned ldsw = (unsigned)wid * 1024u;
    const int aoff = lds_byte(wr * 64 + fr, fq * 8), boff = lds_byte(wc * 32 + fr, fq * 8);
#define PG8_SA(b, h) (((b) * 2 + (h)) * HTB)
#define PG8_SB(b, h) ((4 + (b) * 2 + (h)) * HTB)
#define PG8_STAGE(bufoff, gbase, voff) do { _Pragma("unroll") for (int _i = 0; _i < 2; ++_i) \
        __builtin_amdgcn_global_load_lds((const unsigned*)((const char*)(gbase) + (voff)[_i]), (PG8_LAS unsigned*)(lds + (bufoff) + ldsw + _i * 8192), 16, 0, 0); } while (0)
#define PG8_LDA(dst, b, h) do { _Pragma("unroll") for (int m = 0; m < 4; ++m) _Pragma("unroll") for (int k = 0; k < 2; ++k) dst[m][k] = *(const PG8_LAS bf16x8*)(lds + PG8_SA(b, h) + aoff + m * 2048 + k * 1024); } while (0)
#define PG8_LDB(dst, b, h) do { _Pragma("unroll") for (int n = 0; n < 2; ++n) _Pragma("unroll") for (int k = 0; k < 2; ++k) dst[n][k] = *(const PG8_LAS bf16x8*)(lds + PG8_SB(b, h) + boff + n * 2048 + k * 1024); } while (0)
#define PG8_MMA(ai, bj, At, Bt) do { __builtin_amdgcn_s_setprio(1); _Pragma("unroll") for (int m = 0; m < 4; ++m) _Pragma("unroll") for (int n = 0; n < 2; ++n) _Pragma("unroll") for (int k = 0; k < 2; ++k) \
        acc[ai][bj][m][n] = __builtin_amdgcn_mfma_f32_16x16x32_bf16(Bt[n][k], At[m][k], acc[ai][bj][m][n], 0, 0, 0); __builtin_amdgcn_s_setprio(0); } while (0)
#define PG8_WAIT_V(n) asm volatile("s_waitcnt vmcnt(" #n ")" ::: "memory")
#define PG8_WAIT_L(n) asm volatile("s_waitcnt lgkmcnt(" #n ")" ::: "memory")
#define PG8_BAR __builtin_amdgcn_s_barrier()
#define PG8_SCHED __builtin_amdgcn_sched_barrier(0)
    Unit cur, nxt; int ui = 0;
    if (!S.next(0, cur)) return;
    f32x4 acc[2][2][4][2];
#pragma unroll
    for (int a = 0; a < 2; ++a)
#pragma unroll
        for (int b = 0; b < 2; ++b)
#pragma unroll
            for (int m = 0; m < 4; ++m)
#pragma unroll
                for (int n = 0; n < 2; ++n) acc[a][b][m][n] = (f32x4){0.f, 0.f, 0.f, 0.f};
    bf16x8 At[4][2], B0[2][2], B1[2][2];
    const char* cA = (const char*)g.A + (size_t)cur.pm * tstep; const char* cB = (const char*)g.Bt + (size_t)cur.pn * tstep;
    S.a_ready(cur);
    if constexpr (SP2) {
        PG8_STAGE(PG8_SB(0, 0), cB, voffB); PG8_STAGE(PG8_SB(0, 1), cB + hstep, voffB); PG8_STAGE(PG8_SA(0, 0), cA, voffA); PG8_STAGE(PG8_SA(0, 1), cA + hstep, voffA);
        if (wr == 1) PG8_BAR;
        PG8_WAIT_V(2); PG8_BAR;
        PG8_STAGE(PG8_SB(1, 0), cB + kstep, voffB); PG8_STAGE(PG8_SA(1, 0), cA + kstep, voffA); PG8_STAGE(PG8_SB(1, 1), cB + hstep + kstep, voffB);
        PG8_WAIT_V(6); PG8_BAR;
    } else {
        PG8_STAGE(PG8_SB(0, 0), cB, voffB); PG8_STAGE(PG8_SA(0, 0), cA, voffA); PG8_STAGE(PG8_SB(0, 1), cB + hstep, voffB); PG8_STAGE(PG8_SA(0, 1), cA + hstep, voffA);
        if (wr == 1) PG8_BAR;
        PG8_WAIT_V(4); PG8_BAR;
        PG8_STAGE(PG8_SB(1, 0), cB + kstep, voffB); PG8_STAGE(PG8_SA(1, 0), cA + kstep, voffA); PG8_STAGE(PG8_SB(1, 1), cB + hstep + kstep, voffB);
        PG8_WAIT_V(6); PG8_BAR;
    }
    for (;;) {
        const bool has_next = S.next(ui + 1, nxt);
        const char* nA = has_next ? (const char*)g.A + (size_t)nxt.pm * tstep : cA; const char* nB = has_next ? (const char*)g.Bt + (size_t)nxt.pn * tstep : cB;
        for (int t = 0; t < nt; t += 2) {
            const bool last = (t == nt - 2);
            const char* a1 = cA + (size_t)(t + 1) * kstep;
            const char* a2 = last ? nA : cA + (size_t)(t + 2) * kstep; const char* b2 = last ? nB : cB + (size_t)(t + 2) * kstep;
            const char* a3 = a2 + kstep; const char* b3 = b2 + kstep;
            if (last && has_next) S.a_ready(nxt);
            if constexpr (SP2) {
            PG8_LDB(B0, 0, 0); PG8_LDB(B1, 0, 1); PG8_SCHED; PG8_LDA(At, 0, 0); PG8_STAGE(PG8_SA(1, 1), a1 + hstep, voffA);
            PG8_WAIT_V(8); PG8_WAIT_L(0); PG8_BAR; PG8_MMA(0, 0, At, B0); PG8_MMA(0, 1, At, B1); PG8_BAR; PG8_SCHED;
            PG8_LDA(At, 0, 1); PG8_STAGE(PG8_SB(0, 0), b2, voffB); PG8_STAGE(PG8_SB(0, 1), b2 + hstep, voffB); PG8_STAGE(PG8_SA(0, 0), a2, voffA);
            PG8_WAIT_V(8); PG8_WAIT_L(0); PG8_BAR; PG8_MMA(1, 0, At, B0); PG8_MMA(1, 1, At, B1); PG8_BAR; PG8_SCHED;
            PG8_LDB(B0, 1, 0); PG8_LDB(B1, 1, 1); PG8_SCHED; PG8_LDA(At, 1, 0); PG8_STAGE(PG8_SA(0, 1), a2 + hstep, voffA);
            PG8_WAIT_V(8); PG8_WAIT_L(0); PG8_BAR; PG8_MMA(0, 0, At, B0); PG8_MMA(0, 1, At, B1); PG8_BAR; PG8_SCHED;
            PG8_LDA(At, 1, 1); PG8_STAGE(PG8_SB(1, 0), b3, voffB); PG8_STAGE(PG8_SB(1, 1), b3 + hstep, voffB); PG8_STAGE(PG8_SA(1, 0), a3, voffA);
            PG8_WAIT_V(8); PG8_WAIT_L(0); PG8_BAR; PG8_MMA(1, 0, At, B0); PG8_MMA(1, 1, At, B1); PG8_BAR; PG8_SCHED;
            } else {
            PG8_LDB(B0, 0, 0); PG8_SCHED; PG8_LDA(At, 0, 0); PG8_STAGE(PG8_SA(1, 1), a1 + hstep, voffA);
            PG8_WAIT_L(8); PG8_BAR; PG8_WAIT_L(0); PG8_MMA(0, 0, At, B0); PG8_BAR; PG8_SCHED;
            PG8_LDB(B1, 0, 1); PG8_STAGE(PG8_SB(0, 0), b2, voffB);
            PG8_BAR; PG8_WAIT_L(0); PG8_MMA(0, 1, At, B1); PG8_BAR;
            PG8_LDA(At, 0, 1); PG8_STAGE(PG8_SA(0, 0), a2, voffA);
            PG8_BAR; PG8_WAIT_L(0); PG8_MMA(1, 0, At, B0); PG8_BAR; PG8_SCHED;
            PG8_STAGE(PG8_SB(0, 1), b2 + hstep, voffB);
            PG8_WAIT_V(6); PG8_BAR; PG8_MMA(1, 1, At, B1); PG8_BAR;
            PG8_LDB(B0, 1, 0); PG8_SCHED; PG8_LDA(At, 1, 0); PG8_STAGE(PG8_SA(0, 1), a2 + hstep, voffA);
            PG8_WAIT_L(8); PG8_BAR; PG8_WAIT_L(0); PG8_MMA(0, 0, At, B0); PG8_BAR; PG8_SCHED;
            PG8_LDB(B1, 1, 1); PG8_STAGE(PG8_SB(1, 0), b3, voffB);
            PG8_BAR; PG8_WAIT_L(0); PG8_MMA(0, 1, At, B1); PG8_BAR;
            PG8_LDA(At, 1, 1); PG8_STAGE(PG8_SA(1, 0), a3, voffA);
            PG8_BAR; PG8_WAIT_L(0); PG8_MMA(1, 0, At, B0); PG8_BAR; PG8_SCHED;
            PG8_STAGE(PG8_SB(1, 1), b3 + hstep, voffB);
            PG8_WAIT_V(6); PG8_BAR; PG8_MMA(1, 1, At, B1); PG8_BAR;
            }
        }
        if constexpr (ALIGN_EPI) { if (wr == 0) PG8_BAR; }
        if constexpr (!Epi::AFTER_DRAIN) { E(acc, cur, wr, wc, fr, fq); S.done(cur); }
        if (!has_next) break;
#pragma unroll
        for (int a = 0; a < 2; ++a)
#pragma unroll
            for (int b = 0; b < 2; ++b)
#pragma unroll
                for (int m = 0; m < 4; ++m)
#pragma unroll
                    for (int n = 0; n < 2; ++n) acc[a][b][m][n] = (f32x4){0.f, 0.f, 0.f, 0.f};
        cur = nxt; cA = nA; cB = nB; ++ui;
        if constexpr (ALIGN_EPI) { if (wr == 1) PG8_BAR; }
    }
    PG8_WAIT_V(0);
    if constexpr (!ALIGN_EPI) { if (wr == 0) PG8_BAR; }
    PG8_BAR;
    if constexpr (Epi::AFTER_DRAIN) { E.fused(acc, cur, wr, wc, fr, fq, lds, wid, lane); S.done(cur); }
#undef PG8_SA
#undef PG8_SB
#undef PG8_STAGE
#undef PG8_LDA
#undef PG8_LDB
#undef PG8_MMA
#undef PG8_WAIT_V
#undef PG8_WAIT_L
#undef PG8_BAR
#undef PG8_SCHED
}
}
#define PROBE_PH -1
#define PROBE_SUB 0

#define LAS __attribute__((address_space(3)))
typedef unsigned short bf16_t;
typedef short bf16x8 __attribute__((ext_vector_type(8)));
typedef float f32x4 __attribute__((ext_vector_type(4)));
typedef float f32x16 __attribute__((ext_vector_type(16)));
typedef unsigned u32x4 __attribute__((ext_vector_type(4)));
typedef unsigned u32x2 __attribute__((ext_vector_type(2)));
using pg8::cvt_pk_bf16;

constexpr int NWAVES = 8, NTHREADS = 512;
constexpr int BATCH = 4, SEQ = 4096, DM = 1024, MTOK = BATCH * SEQ, NZ = 3072, FF = 2816, NGU = 2 * FF, NLAYER = 2, INC = 2884;
constexpr float C2 = 0.125f * 1.4426950408889634f;
constexpr float NEGF = -1e30f;
constexpr int LDS_BYTES = 153600;
constexpr int NPHASE = 14;

constexpr size_t MiB = 1u << 20;
constexpr size_t WS_WIN = 0, WS_WOUT = 12 * MiB, WS_WGU = 16 * MiB, WS_WDN = 38 * MiB, WS_ROPE = 49 * MiB, WS_SSQA = 50 * MiB, WS_SSQB = 51 * MiB,
                 WS_MASK = 52 * MiB, WS_VB = 60 * MiB, WS_XB = 68 * MiB, WS_Y = 100 * MiB, WS_Z = 132 * MiB, WS_KB = 228 * MiB, WS_KI = 236 * MiB, WS_CTL = 250 * MiB, WS_END = 251 * MiB;
constexpr size_t CTL_BYTES = 40960;
constexpr int CW_ITEM = 8192;
constexpr int CW_PANEL = 4096;
constexpr int LDS_BAR_OFF = LDS_BYTES - 64;
constexpr size_t WIN_L = (size_t)NZ * DM, WOUT_L = (size_t)DM * DM, WGU_L = (size_t)NGU * DM, WDN_L = (size_t)DM * FF;

__device__ const double INVF[32] = {1, 0.74989420933245587, 0.56234132519034907, 0.42169650342858223, 0.31622776601683794, 0.23713737056616552, 0.17782794100389229, 0.1333521432163324,
    0.10000000000000001, 0.074989420933245579, 0.056234132519034911, 0.042169650342858224, 0.031622776601683791, 0.023713737056616554, 0.017782794100389229, 0.013335214321633241,
    0.01, 0.0074989420933245579, 0.005623413251903491, 0.0042169650342858229, 0.0031622776601683794, 0.0023713737056616554, 0.0017782794100389228, 0.0013335214321633241,
    0.001, 0.00074989420933245586, 0.0005623413251903491, 0.00042169650342858224, 0.00031622776601683794, 0.00023713737056616554, 0.00017782794100389227, 0.0001333521432163324};

#define LDS_WAIT() asm volatile("s_waitcnt lgkmcnt(0)" ::: "memory")
__device__ __forceinline__ float bf2f(unsigned short h) { return __uint_as_float((unsigned)h << 16); }
__device__ __forceinline__ float bflo(unsigned w) { return __uint_as_float(w << 16); }
__device__ __forceinline__ float bfhi(unsigned w) { return __uint_as_float(w & 0xffff0000u); }
#define DPPF(v, ctrl, rm) __int_as_float(__builtin_amdgcn_update_dpp(0, __float_as_int(v), ctrl, rm, 0xf, false))
__device__ __forceinline__ float wave_sum(float v) {
    v += DPPF(v, 0x111, 0xf); v += DPPF(v, 0x112, 0xf); v += DPPF(v, 0x114, 0xf); v += DPPF(v, 0x118, 0xf);
    v += DPPF(v, 0x142, 0xa); v += DPPF(v, 0x143, 0xc);
    return __int_as_float(__builtin_amdgcn_readlane(__float_as_int(v), 63));
}
__device__ __forceinline__ unsigned wave_umax(unsigned v) {
#define DPPU(v, ctrl, rm) (unsigned)__builtin_amdgcn_update_dpp(0, (int)(v), ctrl, rm, 0xf, false)
    v = max(v, DPPU(v, 0x111, 0xf)); v = max(v, DPPU(v, 0x112, 0xf)); v = max(v, DPPU(v, 0x114, 0xf)); v = max(v, DPPU(v, 0x118, 0xf));
    v = max(v, DPPU(v, 0x142, 0xa)); v = max(v, DPPU(v, 0x143, 0xc));
    return (unsigned)__builtin_amdgcn_readlane((int)v, 63);
#undef DPPU
}
__device__ __forceinline__ float swap32(float v, int hi) { auto rr = __builtin_amdgcn_permlane32_swap(__float_as_uint(v), __float_as_uint(v), false, false); return hi ? __uint_as_float(rr[0]) : __uint_as_float(rr[1]); }
__device__ __forceinline__ float row_rs(const float* ssq, int r) {
    const f32x4* p = (const f32x4*)(ssq + (size_t)r * 16); const f32x4 a = p[0], b = p[1], c = p[2], d = p[3];
    const float s = (((a.x + a.y) + (a.z + a.w)) + ((b.x + b.y) + (b.z + b.w))) + (((c.x + c.y) + (c.z + c.w)) + ((d.x + d.y) + (d.z + d.w)));
    return rsqrtf(s * (1.f / 1024.f) + 1e-6f);
}
__device__ __forceinline__ float xor16_add(float v) { auto rr = __builtin_amdgcn_permlane16_swap(__float_as_uint(v), __float_as_uint(v), false, false); return __uint_as_float(rr[0]) + __uint_as_float(rr[1]); }
__device__ __forceinline__ float xor32_add(float v) { auto rr = __builtin_amdgcn_permlane32_swap(__float_as_uint(v), __float_as_uint(v), false, false); return __uint_as_float(rr[0]) + __uint_as_float(rr[1]); }
__device__ __forceinline__ void row_rs8(const float* ssq, int rbase  , int fq, float (&rs)[8]) {
    f32x4 p[8];
#pragma unroll
    for (int i = 0; i < 8; ++i) p[i] = *(const f32x4*)(ssq + (size_t)(rbase + (i >> 2) * 128 + (i & 3) * 16) * 16 + fq * 4);
#pragma unroll
    for (int i = 0; i < 8; ++i) { float s = (p[i].x + p[i].y) + (p[i].z + p[i].w); s = xor16_add(s); s = xor32_add(s); rs[i] = rsqrtf(s * (1.f / 1024.f) + 1e-6f); }
}
__device__ __forceinline__ float sigmoidf_(float x) { return 1.f / (1.f + __expf(-x)); }

struct EpiZ {
    static constexpr bool PERM = true, AFTER_DRAIN = false;
    bf16_t* Z; bf16_t* Vb; bf16_t* Kb; bf16_t* KIb; const float* ssq; const float* ropec; const float* ropes;
    __device__ __forceinline__ void operator()(const f32x4 (&acc)[2][2][4][2], const pg8::Unit& u, int wr, int wc, int fr, int fq) const {
        const int pn = u.pn; const bool rope_tile = (pn == 5) || (pn == 6) || (pn == 8) || (pn == 11);
        float rs8[8]; row_rs8(ssq, u.pm * 256 + wr * 64 + fr, fq, rs8);
#pragma unroll
        for (int ai = 0; ai < 2; ++ai)
        {
            f32x4 rc[4], rsn[4]; const int ri0 = ((wc * 32 + fq * 8) & 63) >> 1;
            if (rope_tile) {
#pragma unroll
                for (int m = 0; m < 4; ++m) { const int pos_ = (u.pm * 256 + ai * 128 + wr * 64 + m * 16 + fr) & (SEQ - 1); rc[m] = *(const f32x4*)(ropec + pos_ * 32 + ri0); rsn[m] = *(const f32x4*)(ropes + pos_ * 32 + ri0); }
            }
#pragma unroll
            for (int m = 0; m < 4; ++m) {
                const int r = u.pm * 256 + ai * 128 + wr * 64 + m * 16 + fr; const float rs = rs8[ai * 4 + m]; const int pos = r & (SEQ - 1);
#pragma unroll
                for (int bj = 0; bj < 2; ++bj) {
                    const int cl = bj * 128 + wc * 32 + fq * 8;
                    f32x4 v0 = acc[ai][bj][m][0] * rs, v1 = acc[ai][bj][m][1] * rs;
                    if (rope_tile && (pn != 11 || cl < 64)) {
                        const f32x4 c4 = rc[m], s4 = rsn[m];
                        float a, b;
                        a = v0[0]; b = v0[1]; v0[0] = a * c4[0] - b * s4[0]; v0[1] = b * c4[0] + a * s4[0];
                        a = v0[2]; b = v0[3]; v0[2] = a * c4[1] - b * s4[1]; v0[3] = b * c4[1] + a * s4[1];
                        a = v1[0]; b = v1[1]; v1[0] = a * c4[2] - b * s4[2]; v1[1] = b * c4[2] + a * s4[2];
                        a = v1[2]; b = v1[3]; v1[2] = a * c4[3] - b * s4[3]; v1[3] = b * c4[3] + a * s4[3];
                    }
                    u32x4 w; w.x = cvt_pk_bf16(v0[0], v0[1]); w.y = cvt_pk_bf16(v0[2], v0[3]); w.z = cvt_pk_bf16(v1[0], v1[1]); w.w = cvt_pk_bf16(v1[2], v1[3]);
                    const int b = r >> 12;
                    if (pn == 7) {
                        const int hh = cl >> 6, d0 = cl & 63, kt = pos >> 5, k32 = pos & 31, c = k32 >> 4, kk = k32 & 15, vh = (kk >> 2) & 1, e = (kk & 3) + 4 * (kk >> 3);
                        bf16_t* vp = Vb + ((((size_t)((b * 4 + hh) * 128 + kt) * 2 + (d0 >> 5)) * 2 + c) * 32 + (d0 & 31)) * 16 + vh * 8 + e;
                        vp[0 * 16] = (bf16_t)(w.x & 0xffffu); vp[1 * 16] = (bf16_t)(w.x >> 16); vp[2 * 16] = (bf16_t)(w.y & 0xffffu); vp[3 * 16] = (bf16_t)(w.y >> 16);
                        vp[4 * 16] = (bf16_t)(w.z & 0xffffu); vp[5 * 16] = (bf16_t)(w.z >> 16); vp[6 * 16] = (bf16_t)(w.w & 0xffffu); vp[7 * 16] = (bf16_t)(w.w >> 16);
                    } else if (pn == 6) {
                        const int hh = cl >> 6, c = (cl >> 4) & 3, kh = (cl >> 3) & 1;
                        *(u32x4*)(Kb + ((((size_t)((b * 4 + hh) * 128 + (pos >> 5)) * 4 + c) * 32 + (pos & 31)) * 16 + kh * 8)) = w;
                    } else if (pn == 11) {
                        if (cl < 64) *(u32x4*)(KIb + ((((size_t)(b * 256 + (pos >> 4)) * 2 + (cl >> 5)) * 16 + (pos & 15)) * 32 + ((cl >> 3) & 3) * 8)) = w;
                        else if (cl == 64) *(u32x4*)(Z + (size_t)r * NZ + pn * 256 + cl) = w;
                    } else {
                        *(u32x4*)(Z + (size_t)r * NZ + pn * 256 + cl) = w;
                    }
                }
                asm volatile("" ::: "memory");
            }
        }
    }
};
#ifndef RES_LO
#define RES_LO 0
#endif
struct XL2 { bf16_t* a; bf16_t* b; };
__device__ __forceinline__ bf16_t* xl_row(const XL2& x, int r) { return r < 8192 ? x.a + (size_t)r * DM : x.b + (size_t)(r - 8192) * DM; }
__device__ __forceinline__ void split_hilo(const f32x4& v0, const f32x4& v1, u32x4& hi, u32x4& lo) {
    hi.x = cvt_pk_bf16(v0[0], v0[1]); hi.y = cvt_pk_bf16(v0[2], v0[3]); hi.z = cvt_pk_bf16(v1[0], v1[1]); hi.w = cvt_pk_bf16(v1[2], v1[3]);
    lo.x = cvt_pk_bf16(v0[0] - bflo(hi.x), v0[1] - bfhi(hi.x)); lo.y = cvt_pk_bf16(v0[2] - bflo(hi.y), v0[3] - bfhi(hi.y));
    lo.z = cvt_pk_bf16(v1[0] - bflo(hi.z), v1[1] - bfhi(hi.z)); lo.w = cvt_pk_bf16(v1[2] - bflo(hi.w), v1[3] - bfhi(hi.w));
}
__device__ __forceinline__ void join_hilo(const u32x4& hi, const u32x4& lo, f32x4& v0, f32x4& v1) {
    v0[0] = bflo(hi.x) + bflo(lo.x); v0[1] = bfhi(hi.x) + bfhi(lo.x); v0[2] = bflo(hi.y) + bflo(lo.y); v0[3] = bfhi(hi.y) + bfhi(lo.y);
    v1[0] = bflo(hi.z) + bflo(lo.z); v1[1] = bfhi(hi.z) + bfhi(lo.z); v1[2] = bflo(hi.w) + bflo(lo.w); v1[3] = bfhi(hi.w) + bfhi(lo.w);
}
template <bool BASE_F32> struct EpiRes {
    static constexpr bool PERM = true, AFTER_DRAIN = false;
    const float* basef; XL2 xlin; XL2 xlout; bf16_t* xb; float* ssq;
    __device__ __forceinline__ void operator()(const f32x4 (&acc)[2][2][4][2], const pg8::Unit& u, int wr, int wc, int fr, int fq) const {
#pragma unroll
        for (int ai = 0; ai < 2; ++ai)
#pragma unroll
            for (int m = 0; m < 4; ++m) {
                const int r = u.pm * 256 + ai * 128 + wr * 64 + m * 16 + fr; float sq = 0.f;
#pragma unroll
                for (int bj = 0; bj < 2; ++bj) {
                    const int col = u.pn * 256 + bj * 128 + wc * 32 + fq * 8; const size_t off = (size_t)r * DM + col;
                    f32x4 b0, b1;
                    if (BASE_F32) { b0 = *(const f32x4*)(basef + off); b1 = *(const f32x4*)(basef + off + 4); }
                    else { const u32x4 hi_in = *(const u32x4*)(xb + off); u32x4 lo_in = {0u, 0u, 0u, 0u}; if (RES_LO) lo_in = *(const u32x4*)(xl_row(xlin, r) + col); join_hilo(hi_in, lo_in, b0, b1); }
                    const f32x4 v0 = acc[ai][bj][m][0] + b0, v1 = acc[ai][bj][m][1] + b1;
                    u32x4 hi, lo; split_hilo(v0, v1, hi, lo);
                    *(u32x4*)(xb + off) = hi; if (RES_LO) *(u32x4*)(xl_row(xlout, r) + col) = lo;
                    sq += ((v0[0] * v0[0] + v0[1] * v0[1]) + (v0[2] * v0[2] + v0[3] * v0[3])) + ((v1[0] * v1[0] + v1[1] * v1[1]) + (v1[2] * v1[2] + v1[3] * v1[3]));
                }
                sq += __shfl_xor(sq, 16); sq += __shfl_xor(sq, 32);
                if (fq == 0) ssq[(size_t)r * 16 + u.pn * 4 + wc] = sq;
                if (m == 3) asm volatile("" ::: "memory");
            }
    }
};
struct EpiFinal {
    static constexpr bool PERM = true, AFTER_DRAIN = true;
    const bf16_t* xb; XL2 xlin; float* out; const float* gfin; float* xbuf; unsigned* cnt;
    __device__ __forceinline__ void fused(f32x4 (&acc)[2][2][4][2], const pg8::Unit& u, int wr, int wc, int fr, int fq, LAS unsigned char* lds, int wid, int lane) const {
        LAS float* P = (LAS float*)lds;
        LAS float* S = (LAS float*)(lds + 4096);
#pragma unroll
        for (int ai = 0; ai < 2; ++ai)
#pragma unroll
            for (int m = 0; m < 4; ++m) {
                const int rl = ai * 128 + wr * 64 + m * 16 + fr; float sq = 0.f;
#pragma unroll
                for (int bj = 0; bj < 2; ++bj) {
                    const size_t off = (size_t)(u.pm * 256 + rl) * DM + u.pn * 256 + bj * 128 + wc * 32 + fq * 8;
                    f32x4 b0, b1; { const u32x4 hi_in = *(const u32x4*)(xb + off); u32x4 lo_in = {0u, 0u, 0u, 0u}; if (RES_LO) lo_in = *(const u32x4*)(xl_row(xlin, u.pm * 256 + rl) + (off - (size_t)(u.pm * 256 + rl) * DM)); join_hilo(hi_in, lo_in, b0, b1); }
                    const f32x4 v0 = acc[ai][bj][m][0] + b0, v1 = acc[ai][bj][m][1] + b1;
                    acc[ai][bj][m][0] = v0; acc[ai][bj][m][1] = v1;
                    sq += ((v0[0] * v0[0] + v0[1] * v0[1]) + (v0[2] * v0[2] + v0[3] * v0[3])) + ((v1[0] * v1[0] + v1[1] * v1[1]) + (v1[2] * v1[2] + v1[3] * v1[3]));
                }
                sq += __shfl_xor(sq, 16); sq += __shfl_xor(sq, 32);
                if (fq == 0) P[rl * 4 + wc] = sq;
                if (m == 3) asm volatile("" ::: "memory");
            }
        asm volatile("s_waitcnt lgkmcnt(0)" ::: "memory"); __builtin_amdgcn_s_barrier(); asm volatile("" ::: "memory");
        const int tid = wid * 64 + lane;
        if (tid < 256) {
            const float s = (P[tid * 4 + 0] + P[tid * 4 + 1]) + (P[tid * 4 + 2] + P[tid * 4 + 3]);
            __hip_atomic_store(xbuf + (size_t)(u.pm * 256 + tid) * 4 + u.pn, s, __ATOMIC_RELAXED, __HIP_MEMORY_SCOPE_AGENT);
        }
        asm volatile("s_waitcnt vmcnt(0)" ::: "memory");
        if (lane == 0) __hip_atomic_fetch_add(cnt + 64 * u.pm, 1u, __ATOMIC_RELAXED, __HIP_MEMORY_SCOPE_AGENT);
        if (wid == 0) {
            unsigned spins = 0;
            while ((unsigned)__builtin_amdgcn_readfirstlane(__hip_atomic_load(cnt + 64 * u.pm, __ATOMIC_RELAXED, __HIP_MEMORY_SCOPE_AGENT)) < 32u) { __builtin_amdgcn_s_sleep(2); if (++spins > (1u << 22)) break; }
            __builtin_amdgcn_fence(__ATOMIC_ACQUIRE, "agent");
        }
        asm volatile("s_waitcnt vmcnt(0) lgkmcnt(0)" ::: "memory"); __builtin_amdgcn_s_barrier(); asm volatile("" ::: "memory");
        if (tid < 256) {
            const float* xp = xbuf + (size_t)(u.pm * 256 + tid) * 4;
            const float a = __hip_atomic_load(xp + 0, __ATOMIC_RELAXED, __HIP_MEMORY_SCOPE_AGENT), b = __hip_atomic_load(xp + 1, __ATOMIC_RELAXED, __HIP_MEMORY_SCOPE_AGENT),
                        c = __hip_atomic_load(xp + 2, __ATOMIC_RELAXED, __HIP_MEMORY_SCOPE_AGENT), d = __hip_atomic_load(xp + 3, __ATOMIC_RELAXED, __HIP_MEMORY_SCOPE_AGENT);
            S[tid] = rsqrtf(((a + b) + (c + d)) * (1.f / 1024.f) + 1e-6f);
        }
        asm volatile("s_waitcnt vmcnt(0) lgkmcnt(0)" ::: "memory"); __builtin_amdgcn_s_barrier(); asm volatile("" ::: "memory");
#pragma unroll
        for (int ai = 0; ai < 2; ++ai)
#pragma unroll
            for (int m = 0; m < 4; ++m) {
                const int rl = ai * 128 + wr * 64 + m * 16 + fr; const float rs = S[rl];
#pragma unroll
                for (int bj = 0; bj < 2; ++bj) {
                    const int col = u.pn * 256 + bj * 128 + wc * 32 + fq * 8; const size_t off = (size_t)(u.pm * 256 + rl) * DM + col;
                    *(f32x4*)(out + off) = acc[ai][bj][m][0] * rs * *(const f32x4*)(gfin + col); *(f32x4*)(out + off + 4) = acc[ai][bj][m][1] * rs * *(const f32x4*)(gfin + col + 4);
                }
            }
    }
};
struct EpiGU {
    static constexpr bool PERM = true, AFTER_DRAIN = false;
    bf16_t* H; const float* ssq;
    __device__ __forceinline__ void operator()(const f32x4 (&acc)[2][2][4][2], const pg8::Unit& u, int wr, int wc, int fr, int fq) const {
        float rs8[8]; row_rs8(ssq, u.pm * 256 + wr * 64 + fr, fq, rs8);
#pragma unroll
        for (int ai = 0; ai < 2; ++ai)
#pragma unroll
            for (int m = 0; m < 4; ++m) {
                const int r = u.pm * 256 + ai * 128 + wr * 64 + m * 16 + fr; const float rs = rs8[ai * 4 + m];
                u32x4 w;
#pragma unroll
                for (int n = 0; n < 2; ++n) {
                    const f32x4 g = acc[ai][0][m][n] * rs, up = acc[ai][1][m][n] * rs;
                    const float h0 = g[0] * sigmoidf_(g[0]) * up[0], h1 = g[1] * sigmoidf_(g[1]) * up[1], h2 = g[2] * sigmoidf_(g[2]) * up[2], h3 = g[3] * sigmoidf_(g[3]) * up[3];
                    if (n == 0) { w.x = cvt_pk_bf16(h0, h1); w.y = cvt_pk_bf16(h2, h3); } else { w.z = cvt_pk_bf16(h0, h1); w.w = cvt_pk_bf16(h2, h3); }
                }
                *(u32x4*)(H + (size_t)r * FF + u.pn * 128 + wc * 32 + fq * 8) = w;
            }
    }
};

__device__ __forceinline__ int il64(int p) { return (p & 1) ? (p >> 1) + 32 : (p >> 1); }
__device__ __forceinline__ void conv_item(const float* src, int ld, float cs, const float* gk, int K, bf16_t* WT, int n0, int k0, LAS float* scr, int lane) {
    float v[32];
    const float* sp = src + (size_t)(k0 + (lane >> 5)) * ld;
#pragma unroll
    for (int i = 0; i < 32; ++i) v[i] = sp[(size_t)(2 * i) * ld];
    if (gk) {
        float g[32];
#pragma unroll
        for (int i = 0; i < 32; ++i) g[i] = gk[k0 + 2 * i + (lane >> 5)];
#pragma unroll
        for (int i = 0; i < 32; ++i) v[i] *= g[i];
    }
#pragma unroll
    for (int i = 0; i < 32; ++i) scr[(2 * i + (lane >> 5)) * 33 + (lane & 31)] = v[i] * cs;
    LDS_WAIT();
    const int c = lane & 7;
#pragma unroll
    for (int j = 0; j < 4; ++j) {
        const int n = (lane >> 3) + 8 * j; const LAS float* s = scr + (8 * c) * 33 + n;
        u32x4 o; o.x = cvt_pk_bf16(s[0 * 33], s[1 * 33]); o.y = cvt_pk_bf16(s[2 * 33], s[3 * 33]); o.z = cvt_pk_bf16(s[4 * 33], s[5 * 33]); o.w = cvt_pk_bf16(s[6 * 33], s[7 * 33]);
        *(u32x4*)(WT + (size_t)(n0 + n) * K + k0 + 8 * c) = o;
    }
    LDS_WAIT();
}

struct Args { const float* in[18]; float* out; unsigned char* ws; int ph_lo, ph_hi; };
typedef const Args __attribute__((address_space(4)))* KArgs;
__device__ __forceinline__ KArgs kargs() { KArgs p = (KArgs)__builtin_amdgcn_kernarg_segment_ptr(); asm volatile("" : "+s"(p)); return p; }

constexpr int CV_I_IN = 16 * 96, CV_I_OUT = 16 * 32, CV_I_GU = 16 * 176, CV_I_DN = 44 * 32, CV_I_L = CV_I_IN + CV_I_OUT + CV_I_GU + CV_I_DN;
__device__ __forceinline__ void convert_weights(KArgs A, unsigned char* ws, LAS unsigned char* lds, int wave, int lane, int it_lo, int it_hi, int gw, int NGW) {
    LAS float* scr = (LAS float*)(lds + wave * 16384);
    constexpr int I_IN = CV_I_IN, I_OUT = CV_I_OUT, I_GU = CV_I_GU, I_L = CV_I_L;
    for (int it = it_lo + gw; it < it_hi; it += NGW) {
        const int l = it / I_L; int r = it % I_L;
        if (r < I_IN) {
            const int kb = r / 96, nb = r % 96, n = nb * 32 + (lane & 31), tile = n >> 8, c = n & 255;
            int src; float cs = 1.f;
            if (tile <= 4) src = n;
            else if (tile == 5) { src = 1280 + (c & ~63) + il64(c & 63); cs = C2; }
            else if (tile == 6) src = 1536 + (c & ~63) + il64(c & 63);
            else if (tile == 7) src = 1792 + c;
            else if (tile == 8) src = 2048 + (c & ~63) + il64(c & 63);
            else if (tile == 9) src = 2372 + c;
            else if (tile == 10) src = 2628 + c;
            else { if (c < 64) src = 2304 + il64(c); else if (c < 68) { src = 2368 + (c - 64); cs = 0.0625f; } else { src = 0; cs = 0.f; } }
            const float* wl = A->in[2] + (size_t)l * DM * INC;
            conv_item(wl + src, INC, cs, A->in[1] + l * DM, DM, (bf16_t*)(ws + WS_WIN) + l * WIN_L, nb * 32, kb * 64, scr, lane);
            continue;
        }
        r -= I_IN;
        if (r < I_OUT) {
            const int kb = r / 32, nb = r % 32;
            conv_item(A->in[12] + (size_t)l * DM * DM + nb * 32 + (lane & 31), DM, 1.f, nullptr, DM, (bf16_t*)(ws + WS_WOUT) + l * WOUT_L, nb * 32, kb * 64, scr, lane);
            continue;
        }
        r -= I_OUT;
        if (r < I_GU) {
            const int kb = r / 176, nb = r % 176, n = nb * 32 + (lane & 31), c = n & 255, col = (n >> 8) * 128 + (c & 127);
            const float* wsrc = (c < 128 ? A->in[14] : A->in[15]) + (size_t)l * DM * FF + col;
            conv_item(wsrc, FF, 1.f, A->in[13] + l * DM, DM, (bf16_t*)(ws + WS_WGU) + l * WGU_L, nb * 32, kb * 64, scr, lane);
            continue;
        }
        r -= I_GU;
        { const int kb = r / 32, nb = r % 32;
          conv_item(A->in[16] + (size_t)l * FF * DM + nb * 32 + (lane & 31), DM, 1.f, nullptr, FF, (bf16_t*)(ws + WS_WDN) + l * WDN_L, nb * 32, kb * 64, scr, lane); }
    }
}
__device__ __forceinline__ void prologue(KArgs A, unsigned char* ws, LAS unsigned char* lds, int tid, int wave, int lane, int bid, int G, int sub) {
    const int gw = bid * NWAVES + wave, NGW = G * NWAVES;
    if (sub == 0 || sub == 1) convert_weights(A, ws, lds, wave, lane, 0, CV_I_L - CV_I_DN, gw, NGW);
    float* ropec = (float*)(ws + WS_ROPE); float* ropes = ropec + SEQ * 32;
    if (sub == 0 || sub == 2) for (int idx = bid * NTHREADS + tid; idx < SEQ * 32; idx += G * NTHREADS) {
        const int pos = idx >> 5, i = idx & 31;
        const double ang = (double)pos * INVF[i];
        const double nn = rint(ang * 0.15915494309189535);
        const double x = ang - nn * 6.283185307179586477, x2 = x * x;
        double c = 1.0, s = 1.0, tc = 1.0, ts = 1.0;
#pragma unroll
        for (int k = 1; k <= 15; ++k) { tc *= -x2 * (1.0 / (double)((2 * k - 1) * (2 * k))); c += tc; ts *= -x2 * (1.0 / (double)((2 * k) * (2 * k + 1))); s += ts; }
        ropec[idx] = (float)c; ropes[idx] = (float)(s * x);
    }
    const float* x = A->in[0]; bf16_t* XB = (bf16_t*)(ws + WS_XB); float* ssqA = (float*)(ws + WS_SSQA);
    if (sub == 0 || sub == 3) for (int row0 = gw; row0 < MTOK; row0 += 4 * NGW) {
        f32x4 v[4][4];
#pragma unroll
        for (int rr = 0; rr < 4; ++rr) { const int row = min(row0 + rr * NGW, MTOK - 1); const f32x4* xr = (const f32x4*)(x + (size_t)row * DM) + lane;
#pragma unroll
            for (int j = 0; j < 4; ++j) v[rr][j] = xr[64 * j]; }
#pragma unroll
        for (int rr = 0; rr < 4; ++rr) { const int row = row0 + rr * NGW; if (row < MTOK) { u32x2* d = (u32x2*)(XB + (size_t)row * DM) + lane; float s = 0.f;
#pragma unroll
            for (int j = 0; j < 4; ++j) { const f32x4 t = v[rr][j]; s += (t.x * t.x + t.y * t.y) + (t.z * t.z + t.w * t.w); u32x2 o; o.x = cvt_pk_bf16(t.x, t.y); o.y = cvt_pk_bf16(t.z, t.w); d[64 * j] = o; }
            s = wave_sum(s);
            if (lane < 16) ssqA[(size_t)row * 16 + lane] = lane == 0 ? s : 0.f; } }
    }
}

__device__ __forceinline__ int wave_isum(int v) {
    v += __builtin_amdgcn_update_dpp(0, v, 0x111, 0xf, 0xf, false);
    v += __builtin_amdgcn_update_dpp(0, v, 0x112, 0xf, 0xf, false);
    v += __builtin_amdgcn_update_dpp(0, v, 0x114, 0xf, 0xf, false);
    v += __builtin_amdgcn_update_dpp(0, v, 0x118, 0xf, 0xf, false);
    v += __builtin_amdgcn_update_dpp(0, v, 0x142, 0xa, 0xf, false);
    v += __builtin_amdgcn_update_dpp(0, v, 0x143, 0xc, 0xf, false);
    return __builtin_amdgcn_readlane(v, 63);
}
#define CNT4(c0, c1, t, x0, x1, x2, x3) do { unsigned long long m0_, m1_, m2_, m3_, j0_, j1_; \
    asm("v_cmp_le_u32_e64 %[m0], %[tt], %[a0]\n\tv_cmp_le_u32_e64 %[m1], %[tt], %[a1]\n\tv_cmp_le_u32_e64 %[m2], %[tt], %[a2]\n\tv_cmp_le_u32_e64 %[m3], %[tt], %[a3]\n\t" \
        "v_addc_co_u32_e64 %[k0], %[j0], 0, %[k0], %[m0]\n\tv_addc_co_u32_e64 %[k1], %[j1], 0, %[k1], %[m1]\n\t" \
        "v_addc_co_u32_e64 %[k0], %[j0], 0, %[k0], %[m2]\n\tv_addc_co_u32_e64 %[k1], %[j1], 0, %[k1], %[m3]" \
        : [k0] "+v"(c0), [k1] "+v"(c1), [m0] "=&s"(m0_), [m1] "=&s"(m1_), [m2] "=&s"(m2_), [m3] "=&s"(m3_), [j0] "=&s"(j0_), [j1] "=&s"(j1_) \
        : [tt] "s"(t), [a0] "v"(x0), [a1] "v"(x1), [a2] "v"(x2), [a3] "v"(x3)); } while (0)
#define BIT4(w, t, x0, x1, x2, x3) do { unsigned long long m0_, m1_, m2_, m3_, j0_; \
    asm("v_cmp_gt_u32_e64 %[m0], %[a0], %[tt]\n\tv_cmp_gt_u32_e64 %[m1], %[a1], %[tt]\n\tv_cmp_gt_u32_e64 %[m2], %[a2], %[tt]\n\tv_cmp_gt_u32_e64 %[m3], %[a3], %[tt]\n\t" \
        "v_addc_co_u32_e64 %[k0], %[j0], %[k0], %[k0], %[m0]\n\tv_addc_co_u32_e64 %[k0], %[j0], %[k0], %[k0], %[m1]\n\t" \
        "v_addc_co_u32_e64 %[k0], %[j0], %[k0], %[k0], %[m2]\n\tv_addc_co_u32_e64 %[k0], %[j0], %[k0], %[k0], %[m3]" \
        : [k0] "+v"(w), [m0] "=&s"(m0_), [m1] "=&s"(m1_), [m2] "=&s"(m2_), [m3] "=&s"(m3_), [j0] "=&s"(j0_) \
        : [tt] "s"(t), [a0] "v"(x0), [a1] "v"(x1), [a2] "v"(x2), [a3] "v"(x3)); } while (0)
__device__ __forceinline__ int count_ge(const unsigned (&u)[64], unsigned cand, int nblk) {
    int c0 = 0, c1 = 0;
    const unsigned ts = __builtin_amdgcn_readfirstlane(cand);
#pragma unroll
    for (int B = 0; B < 2; ++B) {
        if (B < nblk) {
#pragma unroll
            for (int i = 0; i < 32; i += 4) CNT4(c0, c1, ts, u[B * 32 + i], u[B * 32 + i + 1], u[B * 32 + i + 2], u[B * 32 + i + 3]);
        }
    }
    return wave_isum(c0 + c1);
}
__device__ __forceinline__ float keyval(unsigned k) { return __uint_as_float((k & 0x80000000u) ? (k ^ 0x80000000u) : ~k); }
__device__ __forceinline__ unsigned valkey(float f) { const unsigned b = __float_as_uint(f); return b ^ ((unsigned)((int)b >> 31) | 0x80000000u); }
__device__ __forceinline__ void select_query(const unsigned (&u)[64], unsigned vmax, int q, int b, int lane, unsigned* MASKb) {
    const int n = q + 1, nblk = (n + 2047) >> 11;
    unsigned T = 0u, TG = 0u; int rrem = 0;
    if (n > 256) {
        const unsigned kmax = wave_umax(vmax);
        const unsigned K0 = 0x80000000u;
        bool exact = false, done = false;
        unsigned lo = 0u, hi = 0u; float Llo = 1.f, Lhi = 1.f;
        const float L256 = 8.0028150156f;
        const int cpos = count_ge(u, K0 + 1u, nblk);
        if (cpos == 256) { T = K0 + 1u; exact = true; done = true; }
        else if (cpos > 256) { lo = K0 + 1u; Llo = __log2f((float)cpos) - L256; hi = kmax + 1u; Lhi = L256 + 1.f; }
        else {
            const int c0 = count_ge(u, K0, nblk);
            if (c0 >= 256) { T = K0; exact = (c0 == 256); done = true; }
            else {
                unsigned vmin = 0xffffffffu;
#pragma unroll
                for (int i = 0; i < 64; ++i) vmin = min(vmin, u[i] - 1u);
                lo = ~wave_umax(~vmin) + 1u; Llo = __log2f((float)n) - L256; hi = K0; Lhi = L256 - __log2f(fmaxf((float)c0, 0.5f));
            }
        }
        int it = 0, last = 0;
        while (!done) {
            if (hi - lo <= 1u) { T = lo; exact = false; break; }
            const float vlo = keyval(lo), vhi = keyval(hi);
            const float frac = (it >= 9 && (it & 1)) ? 0.5f : Llo / (Llo + Lhi);
            unsigned mid = valkey(vlo + frac * (vhi - vlo));
            if (mid <= lo) mid = lo + 1u;
            if (mid >= hi) mid = hi - 1u;
            mid = __builtin_amdgcn_readfirstlane(mid);
            const int c = count_ge(u, mid, nblk);
            if (c == 256) { T = mid; exact = true; break; }
            if (c > 256) { lo = mid; Llo = __log2f((float)c) - L256; if (last == 1) Lhi *= 0.5f; last = 1; }
            else { hi = mid; Lhi = L256 - __log2f(fmaxf((float)c, 0.5f)); if (last == 2) Llo *= 0.5f; last = 2; }
            ++it;
        }
        if (exact) TG = T - 1u; else { TG = T; rrem = 256 - count_ge(u, T + 1u, nblk); }
    }
    int tbase = 0;
#pragma unroll
    for (int B = 0; B < 2; ++B) {
        if (B < nblk) {
            unsigned w = 0u; const unsigned tgs = __builtin_amdgcn_readfirstlane(TG);
#pragma unroll
            for (int e = 31; e >= 3; e -= 4) BIT4(w, tgs, u[B * 32 + e], u[B * 32 + e - 1], u[B * 32 + e - 2], u[B * 32 + e - 3]);
            if (rrem > 0) {
                int ec = 0;
#pragma unroll
                for (int e = 0; e < 32; ++e) ec += (u[B * 32 + e] == T) ? 1 : 0;
                int incl = ec;
#pragma unroll
                for (int o = 1; o < 64; o <<= 1) { const int t = __shfl_up(incl, o); if (lane >= o) incl += t; }
                const int total = __builtin_amdgcn_readlane(incl, 63);
                const int quota = rrem - tbase - (incl - ec);
                int taken = 0;
#pragma unroll
                for (int e = 0; e < 32; ++e) { const bool is = (u[B * 32 + e] == T) && (taken < quota); w |= is ? (1u << e) : 0u; taken += is ? 1 : 0; }
                tbase += total;
            }
            if (64 * B + lane <= (q >> 5)) __hip_atomic_store(MASKb + ((size_t)(b * 128 + (q >> 5)) * 128 + 64 * B + lane) * 32 + (q & 31), w, __ATOMIC_RELAXED, __HIP_MEMORY_SCOPE_AGENT);
        }
    }
}
__device__ __forceinline__ void select_phase(const bf16_t* Z, const bf16_t* KIb, unsigned* MASKb, unsigned* itemcnt, LAS unsigned char* lds, int wave_in, int lane_in, int bid, int G, int sub) {
    constexpr int SCS = 2312;
    LAS float* sc = (LAS float*)lds;
    const int nrounds = (1024 + G - 1) / G;
    bf16x8 qf[4][2]; u32x2 wraw;
#define SEL_LOADQ(idx_) do { const int i_ = (idx_) < 1023 ? (idx_) : 1023; const bf16_t* zq_ = Z + ((size_t)(i_ & 3) * SEQ + (i_ >> 2) * 16 + (lane_in & 15)) * NZ; \
        _Pragma("unroll") for (int j = 0; j < 4; ++j) _Pragma("unroll") for (int ks = 0; ks < 2; ++ks) qf[j][ks] = *(const bf16x8*)(zq_ + 2048 + j * 64 + ks * 32 + (lane_in >> 4) * 8); \
        wraw = *(const u32x2*)(zq_ + 2816 + 64); } while (0)
    SEL_LOADQ(bid);
    for (int rd = 0; rd < nrounds; ++rd) {
        const int idx = rd * G + ((rd & 1) ? (G - 1 - bid) : bid);
        const int idxn = (rd + 1) * G + (((rd + 1) & 1) ? (G - 1 - bid) : bid);
        if (idx >= 1024) continue;
        const int b = idx & 3, q0 = (idx >> 2) * 16;
        int wave = wave_in, lane = lane_in; asm volatile("" : "+s"(wave), "+v"(lane));
        const int fr = lane & 15, fq = lane >> 4;
        const float w0 = bflo(wraw.x), w1 = bfhi(wraw.x), w2 = bflo(wraw.y), w3 = bfhi(wraw.y);
        const int nkt = (q0 >> 4) + 1, nch = (nkt + 127) >> 7;
        const bf16_t* kib = KIb + (size_t)b * 256 * 1024 + fr * 32 + fq * 8;
        const int qa = q0 + 2 * wave, qb = qa + 1;
        unsigned ua[64], ub[64]; unsigned vmaxa = 0u, vmaxb = 0u;
#pragma unroll
        for (int c = 0; c < 2; ++c) {
            if (c < nch) {
                const int ktlo = 128 * c, kthi = min(nkt, ktlo + 128);
                bf16x8 ka[2][2], kb2[2][2];
#define KI_LOAD(dst, i0) do { _Pragma("unroll") for (int t_ = 0; t_ < 2; ++t_) { int kt_ = ktlo + wave + 8 * ((i0) + t_); kt_ = kt_ < kthi ? kt_ : kthi - 1; \
                dst[t_][0] = *(const bf16x8*)(kib + (size_t)kt_ * 1024); dst[t_][1] = *(const bf16x8*)(kib + (size_t)kt_ * 1024 + 512); } } while (0)
#define KI_COMP(src, i0) do { _Pragma("unroll") for (int t_ = 0; t_ < 2; ++t_) { int kt_ = ktlo + wave + 8 * ((i0) + t_); kt_ = (kt_ < kthi ? kt_ : kthi - 1) - ktlo; \
                f32x4 s4 = {0.f, 0.f, 0.f, 0.f}; \
                _Pragma("unroll") for (int j = 0; j < 4; ++j) { \
                    f32x4 a = __builtin_amdgcn_mfma_f32_16x16x32_bf16(src[t_][0], qf[j][0], (f32x4){0.f, 0.f, 0.f, 0.f}, 0, 0, 0); \
                    a = __builtin_amdgcn_mfma_f32_16x16x32_bf16(src[t_][1], qf[j][1], a, 0, 0, 0); \
                    const float wj = j == 0 ? w0 : j == 1 ? w1 : j == 2 ? w2 : w3; \
                    _Pragma("unroll") for (int i = 0; i < 4; ++i) s4[i] = fmaf(__int_as_float(max(__float_as_int(a[i]), 0)), wj, s4[i]); } \
                *(LAS f32x4*)(sc + fr * SCS + kt_ * 16 + (kt_ >> 1) * 4 + fq * 4) = s4; } } while (0)
                KI_LOAD(ka, 0);
                for (int i0 = 0; ktlo + wave + 8 * i0 < kthi; i0 += 4) { KI_LOAD(kb2, i0 + 2); KI_COMP(ka, i0); KI_LOAD(ka, i0 + 4); KI_COMP(kb2, i0 + 2); }
#undef KI_LOAD
#undef KI_COMP
                __syncthreads();
                if (c + 1 == nch) SEL_LOADQ(idxn);
                const LAS float* srow = sc + (2 * wave) * SCS + 36 * lane;
                const int ema = qa - 2048 * c - 32 * lane, emb = ema + 1;
                const int adma = (int)(ema >= 31 ? 0xffffffffu : ema < 0 ? 0u : ((2u << ema) - 1u)), admb = (int)(emb >= 31 ? 0xffffffffu : emb < 0 ? 0u : ((2u << emb) - 1u));
#pragma unroll
                for (int e4 = 0; e4 < 8; ++e4) {
                    const f32x4 va = *(const LAS f32x4*)(srow + 4 * e4), vb = *(const LAS f32x4*)(srow + SCS + 4 * e4);
#pragma unroll
                    for (int e = 0; e < 4; ++e) {
                        const int ii = c * 32 + e4 * 4 + e;
                        const unsigned ba = __float_as_uint(va[e]), bb = __float_as_uint(vb[e]);
                        ua[ii] = (ba ^ ((unsigned)((int)ba >> 31) | 0x80000000u)) & (unsigned)__builtin_amdgcn_sbfe(adma, e4 * 4 + e, 1);
                        ub[ii] = (bb ^ ((unsigned)((int)bb >> 31) | 0x80000000u)) & (unsigned)__builtin_amdgcn_sbfe(admb, e4 * 4 + e, 1);
                        vmaxa = max(vmaxa, ua[ii]); vmaxb = max(vmaxb, ub[ii]);
                    }
                }
                asm volatile("s_waitcnt lgkmcnt(0)" ::: "memory");
                __syncthreads();
            } else {
#pragma unroll
                for (int e = 0; e < 32; ++e) { ua[c * 32 + e] = 0u; ub[c * 32 + e] = 0u; }
            }
        }
        if (sub != 3) {
            select_query(ua, vmaxa, qa, b, lane, MASKb);
            select_query(ub, vmaxb, qb, b, lane, MASKb);
            asm volatile("s_waitcnt vmcnt(0)" ::: "memory");
            if (lane == 0) __hip_atomic_fetch_add(itemcnt + idx, 1u, __ATOMIC_RELAXED, __HIP_MEMORY_SCOPE_AGENT);
        }
    }
    __syncthreads();
#undef SEL_LOADQ
}

__device__ __forceinline__ void mixer_a(const bf16_t* __restrict__ Z, bf16_t* __restrict__ Y, const float* __restrict__ wc, int gtid, int NGT) {
#pragma unroll 2
    for (int it = gtid; it < MTOK * 32; it += NGT) {
        const int row = it >> 5, c8 = (it & 31) * 8, pos = row & (SEQ - 1);
        const bf16_t* zr = Z + (size_t)row * NZ;
        float acc[8];
#pragma unroll
        for (int i = 0; i < 8; ++i) acc[i] = 0.f;
#pragma unroll
        for (int j = 0; j < 3; ++j) {
            const int d = 2 - j; const float ok = (pos >= d) ? 1.f : 0.f;
            {
                const bf16_t* zz = zr - (size_t)((pos >= d) ? d : 0) * NZ;
                const u32x4 cc = *(const u32x4*)(zz + 256 + c8), hh = *(const u32x4*)(zz + 512 + c8);
                const f32x4 wa = *(const f32x4*)(wc + j * 256 + c8) * ok, wb = *(const f32x4*)(wc + j * 256 + c8 + 4) * ok;
                acc[0] += wa[0] * (bflo(cc.x) * bflo(hh.x)); acc[1] += wa[1] * (bfhi(cc.x) * bfhi(hh.x));
                acc[2] += wa[2] * (bflo(cc.y) * bflo(hh.y)); acc[3] += wa[3] * (bfhi(cc.y) * bfhi(hh.y));
                acc[4] += wb[0] * (bflo(cc.z) * bflo(hh.z)); acc[5] += wb[1] * (bfhi(cc.z) * bfhi(hh.z));
                acc[6] += wb[2] * (bflo(cc.w) * bflo(hh.w)); acc[7] += wb[3] * (bfhi(cc.w) * bfhi(hh.w));
            }
        }
        const u32x4 ab = *(const u32x4*)(zr + c8);
        u32x4 o;
        o.x = cvt_pk_bf16(bflo(ab.x) * acc[0], bfhi(ab.x) * acc[1]); o.y = cvt_pk_bf16(bflo(ab.y) * acc[2], bfhi(ab.y) * acc[3]);
        o.z = cvt_pk_bf16(bflo(ab.z) * acc[4], bfhi(ab.z) * acc[5]); o.w = cvt_pk_bf16(bflo(ab.w) * acc[6], bfhi(ab.w) * acc[7]);
        *(u32x4*)(Y + (size_t)row * DM + c8) = o;
    }
}

__device__ __forceinline__ void mixer_b(const bf16_t* __restrict__ Z, bf16_t* __restrict__ Y, const float* __restrict__ lng, const float* __restrict__ lnb, const float* __restrict__ wsp, const float* __restrict__ bsp,
                                        LAS unsigned char* lds, int wave, int lane, int bid, int G) {
    constexpr int VP = 132;
    LAS bf16_t* vt = (LAS bf16_t*)lds;
    const int fr = lane & 15, fq = lane >> 4;
    for (int un = bid; un < 256; un += G) {
        const int chunk = un >> 1, hf = un & 1; const size_t row0 = (size_t)chunk * 128;
#pragma unroll 8
        for (int k = 0; k < 16; ++k) {
            const int s = wave * 16 + k; const bf16_t* zr = Z + (row0 + s) * NZ + 4 * 256;
            const float v0 = bf2f(zr[lane]), v1 = bf2f(zr[lane + 64]), v2 = bf2f(zr[lane + 128]), v3 = bf2f(zr[lane + 192]);
            const float mean = wave_sum((v0 + v1) + (v2 + v3)) * (1.f / 256.f);
            const float d0 = v0 - mean, d1 = v1 - mean, d2 = v2 - mean, d3 = v3 - mean;
            const float var = wave_sum((d0 * d0 + d1 * d1) + (d2 * d2 + d3 * d3)) * (1.f / 256.f);
            const float rstd = rsqrtf(var + 1e-5f);
            const int ca = hf * 128 + lane, cb = ca + 64;
            const float a = (hf ? d2 : d0) * rstd * lng[ca] + lnb[ca], b = (hf ? d3 : d1) * rstd * lng[cb] + lnb[cb];
            const unsigned pk = cvt_pk_bf16(a, b);
            vt[lane * VP + s] = (bf16_t)(pk & 0xffffu); vt[(lane + 64) * VP + s] = (bf16_t)(pk >> 16);
        }
        __syncthreads();
        const int t = wave * 16 + fr;
#pragma unroll
        for (int hh = 0; hh < 2; ++hh) {
            const int h = hf * 2 + hh; const float* W = wsp + (size_t)h * 128 * 128 + (size_t)t * 128;
            f32x4 acc[4];
#pragma unroll
            for (int nt = 0; nt < 4; ++nt) acc[nt] = (f32x4){0.f, 0.f, 0.f, 0.f};
#pragma unroll
            for (int ks = 0; ks < 4; ++ks) {
                const int s0 = ks * 32 + fq * 8;
                f32x4 wa = *(const f32x4*)(W + s0), wb = *(const f32x4*)(W + s0 + 4);
#pragma unroll
                for (int j = 0; j < 4; ++j) { if (s0 + j > t) wa[j] = 0.f; if (s0 + 4 + j > t) wb[j] = 0.f; }
                u32x4 wp; wp.x = cvt_pk_bf16(wa[0], wa[1]); wp.y = cvt_pk_bf16(wa[2], wa[3]); wp.z = cvt_pk_bf16(wb[0], wb[1]); wp.w = cvt_pk_bf16(wb[2], wb[3]);
                const bf16x8 wf = __builtin_bit_cast(bf16x8, wp);
#pragma unroll
                for (int nt = 0; nt < 4; ++nt) {
                    const LAS bf16_t* vp = vt + (hh * 64 + nt * 16 + fr) * VP + s0;
                    const u32x2 lo = *(const LAS u32x2*)vp, hi2 = *(const LAS u32x2*)(vp + 4);
                    u32x4 vv; vv.x = lo.x; vv.y = lo.y; vv.z = hi2.x; vv.w = hi2.y;
                    acc[nt] = __builtin_amdgcn_mfma_f32_16x16x32_bf16(__builtin_bit_cast(bf16x8, vv), wf, acc[nt], 0, 0, 0);
                }
            }
            const float bias = bsp[h * 128 + t]; const size_t row = row0 + t;
#pragma unroll
            for (int nt = 0; nt < 4; ++nt) {
                const int col = h * 64 + nt * 16 + fq * 4;
                const u32x2 uu = *(const u32x2*)(Z + row * NZ + 3 * 256 + col);
                u32x2 o; o.x = cvt_pk_bf16((acc[nt][0] + bias) * bflo(uu.x), (acc[nt][1] + bias) * bfhi(uu.x)); o.y = cvt_pk_bf16((acc[nt][2] + bias) * bflo(uu.y), (acc[nt][3] + bias) * bfhi(uu.y));
                *(u32x2*)(Y + row * DM + 256 + col) = o;
            }
        }
        __syncthreads();
    }
}

__device__ __forceinline__ void mixer_d(const bf16_t* Z, bf16_t* Y, const float* wcf, const float* bcf, const float* lng, const float* lnb,
                                        LAS unsigned char* lds, int tid, int wave, int lane, int bid, int G) {
    LAS float* yl = (LAS float*)lds;
    LAS float* cv = (LAS float*)(lds + 62 * 256 * 4);
    const int c = tid & 255, half = tid >> 8;
    float w[31];
#pragma unroll
    for (int j = 0; j < 31; ++j) w[j] = wcf[j * 256 + c];
    const float bias = bcf[c];
    const f32x4 g4 = *(const f32x4*)(lng + lane * 4), b4 = *(const f32x4*)(lnb + lane * 4);
    for (int un = bid; un < MTOK / 32; un += G) {
        const int row0 = un * 32, pos0 = row0 & (SEQ - 1);
#pragma unroll
        for (int i4 = 0; i4 < 4; ++i4) {
            const int it0 = tid + i4 * NTHREADS, it = it0 < 62 * 32 ? it0 : 62 * 32 - 1;
            const int rr = it >> 5, c8 = (it & 31) * 8, p = pos0 - 30 + rr;
            f32x4 o0, o1; const float ok = (p >= 0) ? 1.f : 0.f;
            {
                const bf16_t* zr = Z + (size_t)(row0 + ((p >= 0) ? rr - 30 : 0)) * NZ;
                const u32x4 a = *(const u32x4*)(zr + 9 * 256 + c8), gg = *(const u32x4*)(zr + 10 * 256 + c8);
                o0[0] = bflo(a.x) * sigmoidf_(bflo(gg.x)); o0[1] = bfhi(a.x) * sigmoidf_(bfhi(gg.x)); o0[2] = bflo(a.y) * sigmoidf_(bflo(gg.y)); o0[3] = bfhi(a.y) * sigmoidf_(bfhi(gg.y));
                o1[0] = bflo(a.z) * sigmoidf_(bflo(gg.z)); o1[1] = bfhi(a.z) * sigmoidf_(bfhi(gg.z)); o1[2] = bflo(a.w) * sigmoidf_(bflo(gg.w)); o1[3] = bfhi(a.w) * sigmoidf_(bfhi(gg.w));
            }
            *(LAS f32x4*)(yl + rr * 256 + c8) = o0 * ok; *(LAS f32x4*)(yl + rr * 256 + c8 + 4) = o1 * ok;
        }
        __syncthreads();
#pragma unroll
        for (int blk = 0; blk < 2; ++blk) {
            const int tb = half * 16 + blk * 8;
            float acc[8];
#pragma unroll
            for (int o = 0; o < 8; ++o) acc[o] = bias;
#pragma unroll
            for (int jj = 0; jj < 38; ++jj) {
                const float v = yl[(tb + jj) * 256 + c];
#pragma unroll
                for (int o = 0; o < 8; ++o) { const int j = jj - o; if (j >= 0 && j < 31) acc[o] += w[j] * v; }
            }
#pragma unroll
            for (int o = 0; o < 8; ++o) cv[(tb + o) * 256 + c] = acc[o];
        }
        __syncthreads();
#pragma unroll
        for (int k = 0; k < 4; ++k) {
            const int tt = wave * 4 + k;
            const f32x4 v = *(const LAS f32x4*)(cv + tt * 256 + lane * 4);
            const float mean = wave_sum((v[0] + v[1]) + (v[2] + v[3])) * (1.f / 256.f);
            const f32x4 d = v - mean;
            const float var = wave_sum((d[0] * d[0] + d[1] * d[1]) + (d[2] * d[2] + d[3] * d[3])) * (1.f / 256.f);
            const float rstd = rsqrtf(var + 1e-5f);
            const f32x4 y = d * rstd * g4 + b4;
            u32x2 o; o.x = cvt_pk_bf16(y[0] * sigmoidf_(y[0]), y[1] * sigmoidf_(y[1])); o.y = cvt_pk_bf16(y[2] * sigmoidf_(y[2]), y[3] * sigmoidf_(y[3]));
            *(u32x2*)(Y + (size_t)(row0 + tt) * DM + 768 + lane * 4) = o;
        }
        __syncthreads();
    }
}

__device__ __forceinline__ void mixer_bd(const bf16_t* __restrict__ Z, bf16_t* __restrict__ Y, const float* __restrict__ lng, const float* __restrict__ lnb, const float* __restrict__ wsp, const float* __restrict__ bsp,
                                         const float* __restrict__ wcf, const float* __restrict__ bcf, const float* __restrict__ dlng, const float* __restrict__ dlnb,
                                         LAS unsigned char* lds, int tid, int wave, int lane, int bid, int G) {
    constexpr int VP = 132;
    LAS bf16_t* vt = (LAS bf16_t*)lds;
    LAS float* yl = (LAS float*)(lds + 36864);
    LAS float* cv = (LAS float*)(lds + 100352);
    const int fr = lane & 15, fq = lane >> 4;
    const int c = tid & 255, half = tid >> 8;
    float w[31];
#pragma unroll
    for (int j = 0; j < 31; ++j) w[j] = wcf[j * 256 + c];
    const float dbias = bcf[c];
    const f32x4 g4 = *(const f32x4*)(dlng + lane * 4), b4 = *(const f32x4*)(dlnb + lane * 4);
#define MD_GLU(dun) do { const int row0_ = (dun) * 32, pos0_ = row0_ & (SEQ - 1); \
        _Pragma("unroll") for (int i4 = 0; i4 < 4; ++i4) { \
            const int it0 = tid + i4 * NTHREADS, it = it0 < 62 * 32 ? it0 : 62 * 32 - 1; \
            const int rr = it >> 5, c8 = (it & 31) * 8, p = pos0_ - 30 + rr; \
            f32x4 o0, o1; const float ok = (p >= 0) ? 1.f : 0.f; \
            const bf16_t* zr = Z + (size_t)(row0_ + ((p >= 0) ? rr - 30 : 0)) * NZ; \
            const u32x4 a = *(const u32x4*)(zr + 9 * 256 + c8), gg = *(const u32x4*)(zr + 10 * 256 + c8); \
            o0[0] = bflo(a.x) * sigmoidf_(bflo(gg.x)); o0[1] = bfhi(a.x) * sigmoidf_(bfhi(gg.x)); o0[2] = bflo(a.y) * sigmoidf_(bflo(gg.y)); o0[3] = bfhi(a.y) * sigmoidf_(bfhi(gg.y)); \
            o1[0] = bflo(a.z) * sigmoidf_(bflo(gg.z)); o1[1] = bfhi(a.z) * sigmoidf_(bfhi(gg.z)); o1[2] = bflo(a.w) * sigmoidf_(bflo(gg.w)); o1[3] = bfhi(a.w) * sigmoidf_(bfhi(gg.w)); \
            *(LAS f32x4*)(yl + rr * 256 + c8) = o0 * ok; *(LAS f32x4*)(yl + rr * 256 + c8 + 4) = o1 * ok; } } while (0)
#define MD_CONV() do { _Pragma("unroll") for (int blk = 0; blk < 2; ++blk) { const int tb = half * 16 + blk * 8; float acc_[8]; \
            _Pragma("unroll") for (int o = 0; o < 8; ++o) acc_[o] = dbias; \
            _Pragma("unroll") for (int jj = 0; jj < 38; ++jj) { const float v = yl[(tb + jj) * 256 + c]; \
                _Pragma("unroll") for (int o = 0; o < 8; ++o) { const int j = jj - o; if (j >= 0 && j < 31) acc_[o] += w[j] * v; } } \
            _Pragma("unroll") for (int o = 0; o < 8; ++o) cv[(tb + o) * 256 + c] = acc_[o]; } } while (0)
#define MD_LN(dun) do { const int row0_ = (dun) * 32; _Pragma("unroll") for (int k = 0; k < 4; ++k) { const int tt = wave * 4 + k; \
            const f32x4 v = *(const LAS f32x4*)(cv + tt * 256 + lane * 4); \
            const float mean = wave_sum((v[0] + v[1]) + (v[2] + v[3])) * (1.f / 256.f); const f32x4 d = v - mean; \
            const float var = wave_sum((d[0] * d[0] + d[1] * d[1]) + (d[2] * d[2] + d[3] * d[3])) * (1.f / 256.f); const float rstd = rsqrtf(var + 1e-5f); \
            const f32x4 y = d * rstd * g4 + b4; \
            u32x2 o; o.x = cvt_pk_bf16(y[0] * sigmoidf_(y[0]), y[1] * sigmoidf_(y[1])); o.y = cvt_pk_bf16(y[2] * sigmoidf_(y[2]), y[3] * sigmoidf_(y[3])); \
            *(u32x2*)(Y + (size_t)(row0_ + tt) * DM + 768 + lane * 4) = o; } } while (0)
    for (int un = bid; un < 256; un += G) {
        const int chunk = un >> 1, hf = un & 1; const size_t row0 = (size_t)chunk * 128;
        const int t = wave * 16 + fr; const size_t row = row0 + t;
        bf16x8 wf[2][4]; u32x2 uu[2][4]; float bias[2];
#pragma unroll
        for (int hh = 0; hh < 2; ++hh) {
            const int h = hf * 2 + hh; const float* W = wsp + (size_t)h * 128 * 128 + (size_t)t * 128;
            f32x4 wa[4], wb[4];
#pragma unroll
            for (int ks = 0; ks < 4; ++ks) { wa[ks] = *(const f32x4*)(W + ks * 32 + fq * 8); wb[ks] = *(const f32x4*)(W + ks * 32 + fq * 8 + 4); }
#pragma unroll
            for (int nt = 0; nt < 4; ++nt) uu[hh][nt] = *(const u32x2*)(Z + row * NZ + 3 * 256 + h * 64 + nt * 16 + fq * 4);
            bias[hh] = bsp[h * 128 + t];
#pragma unroll
            for (int ks = 0; ks < 4; ++ks) {
                const int s0 = ks * 32 + fq * 8;
#pragma unroll
                for (int j = 0; j < 4; ++j) { if (s0 + j > t) wa[ks][j] = 0.f; if (s0 + 4 + j > t) wb[ks][j] = 0.f; }
                u32x4 wp; wp.x = cvt_pk_bf16(wa[ks][0], wa[ks][1]); wp.y = cvt_pk_bf16(wa[ks][2], wa[ks][3]); wp.z = cvt_pk_bf16(wb[ks][0], wb[ks][1]); wp.w = cvt_pk_bf16(wb[ks][2], wb[ks][3]);
                wf[hh][ks] = __builtin_bit_cast(bf16x8, wp);
            }
        }
#pragma unroll 8
        for (int k = 0; k < 16; ++k) {
            const int s = wave * 16 + k; const bf16_t* zr = Z + (row0 + s) * NZ + 4 * 256;
            const float v0 = bf2f(zr[lane]), v1 = bf2f(zr[lane + 64]), v2 = bf2f(zr[lane + 128]), v3 = bf2f(zr[lane + 192]);
            const float mean = wave_sum((v0 + v1) + (v2 + v3)) * (1.f / 256.f);
            const float d0 = v0 - mean, d1 = v1 - mean, d2 = v2 - mean, d3 = v3 - mean;
            const float var = wave_sum((d0 * d0 + d1 * d1) + (d2 * d2 + d3 * d3)) * (1.f / 256.f);
            const float rstd = rsqrtf(var + 1e-5f);
            const int ca = hf * 128 + lane, cb = ca + 64;
            const float a = (hf ? d2 : d0) * rstd * lng[ca] + lnb[ca], b = (hf ? d3 : d1) * rstd * lng[cb] + lnb[cb];
            const unsigned pk = cvt_pk_bf16(a, b);
            vt[lane * VP + s] = (bf16_t)(pk & 0xffffu); vt[(lane + 64) * VP + s] = (bf16_t)(pk >> 16);
        }
        MD_GLU(2 * un);
        __syncthreads();
#pragma unroll
        for (int hh = 0; hh < 2; ++hh) {
            const int h = hf * 2 + hh;
            f32x4 acc[4];
#pragma unroll
            for (int nt = 0; nt < 4; ++nt) acc[nt] = (f32x4){0.f, 0.f, 0.f, 0.f};
#pragma unroll
            for (int ks = 0; ks < 4; ++ks) {
                const int s0 = ks * 32 + fq * 8;
#pragma unroll
                for (int nt = 0; nt < 4; ++nt) {
                    const LAS bf16_t* vp = vt + (hh * 64 + nt * 16 + fr) * VP + s0;
                    const u32x2 lo = *(const LAS u32x2*)vp, hi2 = *(const LAS u32x2*)(vp + 4);
                    u32x4 vv; vv.x = lo.x; vv.y = lo.y; vv.z = hi2.x; vv.w = hi2.y;
                    acc[nt] = __builtin_amdgcn_mfma_f32_16x16x32_bf16(__builtin_bit_cast(bf16x8, vv), wf[hh][ks], acc[nt], 0, 0, 0);
                }
            }
#pragma unroll
            for (int nt = 0; nt < 4; ++nt) {
                const int col = h * 64 + nt * 16 + fq * 4; const u32x2 u2 = uu[hh][nt]; const float bs_ = bias[hh];
                u32x2 o; o.x = cvt_pk_bf16((acc[nt][0] + bs_) * bflo(u2.x), (acc[nt][1] + bs_) * bfhi(u2.x)); o.y = cvt_pk_bf16((acc[nt][2] + bs_) * bflo(u2.y), (acc[nt][3] + bs_) * bfhi(u2.y));
                *(u32x2*)(Y + row * DM + 256 + col) = o;
            }
        }
        MD_CONV();
        __syncthreads();
        MD_LN(2 * un);
        MD_GLU(2 * un + 1);
        __syncthreads();
        MD_CONV();
        __syncthreads();
        MD_LN(2 * un + 1);
        __syncthreads();
    }
#undef MD_GLU
#undef MD_CONV
#undef MD_LN
}

__device__ __forceinline__ void attn_phase(const bf16_t* Z, const bf16_t* Kb, const bf16_t* Vb, unsigned* MASKb, unsigned* itemcnt, bf16_t* Y, LAS unsigned char* lds, int wave, int lane, int bid, int G) {
    const int h = wave & 3, half = wave >> 2, ql = lane & 31, hi = lane >> 5;
    LAS float* mo = (LAS float*)lds + h * 2048;
    LAS float* mml = (LAS float*)(lds + 32768) + h * 128;
    LAS bf16_t* ost = (LAS bf16_t*)(lds + 36864) + h * (32 * 72);
    const unsigned NEGB = __float_as_uint(NEGF);
    for (int pu = bid; pu < 256; pu += G) {
        const int b = pu & 3, jj = pu >> 2;
        for (int rep = 0; rep < 2; ++rep) {
            const int qb = rep ? jj : 127 - jj;
            const int NT = qb + 1, n0 = (NT + 1) >> 1, tb = half ? n0 : 0, te = half ? NT : n0;
            if (wave == 0) {
                unsigned* c0 = itemcnt + (2 * qb) * 4 + b; unsigned* c1 = c0 + 4; unsigned spins = 0;
                while ((unsigned)__builtin_amdgcn_readfirstlane(__hip_atomic_load(c0, __ATOMIC_RELAXED, __HIP_MEMORY_SCOPE_AGENT)) < 8u ||
                       (unsigned)__builtin_amdgcn_readfirstlane(__hip_atomic_load(c1, __ATOMIC_RELAXED, __HIP_MEMORY_SCOPE_AGENT)) < 8u) { __builtin_amdgcn_s_sleep(4); if (++spins > (1u << 22)) break; }
                __builtin_amdgcn_fence(__ATOMIC_ACQUIRE, "agent");
            }
            __syncthreads();
            const size_t rowq = (size_t)b * SEQ + qb * 32 + ql;
            const bf16_t* zq = Z + rowq * NZ + 1280 + h * 64 + hi * 8;
            bf16x8 qf[4];
#pragma unroll
            for (int c = 0; c < 4; ++c) qf[c] = *(const bf16x8*)(zq + 16 * c);
            unsigned* mrow = MASKb + ((size_t)(b * 128 + qb) * 128) * 32 + ql;
            const bf16_t* kb = Kb + ((size_t)(b * 4 + h) * 128) * 2048 + ql * 16 + hi * 8;
            const bf16_t* vb = Vb + ((size_t)(b * 4 + h) * 128) * 2048 + ql * 16 + hi * 8;
            f32x16 o0, o1;
#pragma unroll
            for (int r = 0; r < 16; ++r) { o0[r] = 0.f; o1[r] = 0.f; }
            float m = NEGF, l = 0.f;
            bf16x8 kf[4]; bf16x8 vr[2][2]; unsigned mw = 0u;
#define ATT_LOAD(kt_) do { const bf16_t* kp_ = kb + (size_t)(kt_) * 2048; const bf16_t* vp_ = vb + (size_t)(kt_) * 2048; _Pragma("unroll") for (int c = 0; c < 4; ++c) kf[c] = *(const bf16x8*)(kp_ + c * 512); \
        _Pragma("unroll") for (int mt = 0; mt < 2; ++mt) _Pragma("unroll") for (int c = 0; c < 2; ++c) vr[mt][c] = *(const bf16x8*)(vp_ + (mt * 2 + c) * 512); \
        mw = __hip_atomic_load(mrow + (kt_) * 32, __ATOMIC_RELAXED, __HIP_MEMORY_SCOPE_AGENT); } while (0)
            if (tb < te) ATT_LOAD(tb);
            for (int kt = tb; kt < te; ++kt) {
                bf16x8 ck[4]; bf16x8 cvv[2][2];
#pragma unroll
                for (int c = 0; c < 4; ++c) ck[c] = kf[c];
#pragma unroll
                for (int mt = 0; mt < 2; ++mt)
#pragma unroll
                    for (int c = 0; c < 2; ++c) cvv[mt][c] = vr[mt][c];
                const unsigned cm = mw;
                { const int ktn = (kt + 1 < te) ? kt + 1 : kt; ATT_LOAD(ktn); }
                f32x16 s;
#pragma unroll
                for (int r = 0; r < 16; ++r) s[r] = 0.f;
                __builtin_amdgcn_s_setprio(1);
#pragma unroll
                for (int c = 0; c < 4; ++c) s = __builtin_amdgcn_mfma_f32_32x32x16_bf16(ck[c], qf[c], s, 0, 0, 0);
                __builtin_amdgcn_s_setprio(0);
                const int mws = (int)(cm >> (4 * hi));
                float rm = NEGF;
#pragma unroll
                for (int r = 0; r < 16; ++r) {
                    const unsigned sel = (unsigned)__builtin_amdgcn_sbfe(mws, (r & 3) + 8 * (r >> 2), 1);
                    s[r] = __uint_as_float((__float_as_uint(s[r]) & sel) | (NEGB & ~sel));
                    rm = fmaxf(rm, s[r]);
                }
                rm = fmaxf(rm, swap32(rm, hi));
                const float mn = fmaxf(m, rm);
                if (__any(mn > m)) {
                    const float al = __builtin_amdgcn_exp2f(m - mn); l *= al;
#pragma unroll
                    for (int r = 0; r < 16; ++r) { o0[r] *= al; o1[r] *= al; }
                    m = mn;
                }
                float ps = 0.f;
#pragma unroll
                for (int r = 0; r < 16; ++r) { s[r] = __builtin_amdgcn_exp2f(s[r] - m); ps += s[r]; }
                l += ps;
                u32x4 p0, p1;
                p0.x = cvt_pk_bf16(s[0], s[1]); p0.y = cvt_pk_bf16(s[2], s[3]); p0.z = cvt_pk_bf16(s[4], s[5]); p0.w = cvt_pk_bf16(s[6], s[7]);
                p1.x = cvt_pk_bf16(s[8], s[9]); p1.y = cvt_pk_bf16(s[10], s[11]); p1.z = cvt_pk_bf16(s[12], s[13]); p1.w = cvt_pk_bf16(s[14], s[15]);
                const bf16x8 pf0 = __builtin_bit_cast(bf16x8, p0), pf1 = __builtin_bit_cast(bf16x8, p1);
                __builtin_amdgcn_s_setprio(1);
                o0 = __builtin_amdgcn_mfma_f32_32x32x16_bf16(cvv[0][0], pf0, o0, 0, 0, 0); o1 = __builtin_amdgcn_mfma_f32_32x32x16_bf16(cvv[1][0], pf0, o1, 0, 0, 0);
                o0 = __builtin_amdgcn_mfma_f32_32x32x16_bf16(cvv[0][1], pf1, o0, 0, 0, 0); o1 = __builtin_amdgcn_mfma_f32_32x32x16_bf16(cvv[1][1], pf1, o1, 0, 0, 0);
                __builtin_amdgcn_s_setprio(0);
            }
#undef ATT_LOAD
            const float lt = l + swap32(l, hi);
            if (half == 1) {
#pragma unroll
                for (int r = 0; r < 16; ++r) { mo[r * 64 + lane] = o0[r]; mo[(16 + r) * 64 + lane] = o1[r]; }
                mml[lane] = m; mml[64 + lane] = lt;
            }
            __syncthreads();
            if (half == 0) {
                const float m1 = mml[lane], l1 = mml[64 + lane];
                const float mn = fmaxf(m, m1), a0 = __builtin_amdgcn_exp2f(m - mn), a1 = __builtin_amdgcn_exp2f(m1 - mn);
                const float inv = 1.f / (lt * a0 + l1 * a1), f0 = a0 * inv, f1 = a1 * inv;
#pragma unroll
                for (int r = 0; r < 16; ++r) { o0[r] = o0[r] * f0 + mo[r * 64 + lane] * f1; o1[r] = o1[r] * f0 + mo[(16 + r) * 64 + lane] * f1; }
#pragma unroll
                for (int r = 0; r < 16; r += 2) {
                    const int d = (r & 3) + 8 * (r >> 2) + 4 * hi;
                    *(LAS unsigned*)(ost + ql * 72 + d) = cvt_pk_bf16(o0[r], o0[r + 1]);
                    *(LAS unsigned*)(ost + ql * 72 + 32 + d) = cvt_pk_bf16(o1[r], o1[r + 1]);
                }
                LDS_WAIT();
                bf16_t* yo = Y + ((size_t)b * SEQ + qb * 32 + (lane >> 1)) * DM + 512 + h * 64 + (lane & 1) * 32;
#pragma unroll
                for (int k = 0; k < 4; ++k) { const u32x4 v = *(const LAS u32x4*)(ost + (lane >> 1) * 72 + (lane & 1) * 32 + k * 8); *(u32x4*)(yo + k * 8) = v; }
            }
            __syncthreads();
        }
    }
}

#define RLX_AGENT __ATOMIC_RELAXED, __HIP_MEMORY_SCOPE_AGENT
#define XB_TMO      128
#define XB_XCNT(j)  (256  + 64 * (j))
#define XB_XSUB(j)  (1280 + 64 * (j))
#define XB_XGEN(j)  (2304 + 64 * (j))
#define XB_TOP      3328
#define XB_TOPGEN   3392
#define XCD_BAR_WORDS 3456
#define XB_SPIN_CAP (1u << 18)

__device__ __forceinline__ unsigned xb_ld(unsigned* p)              { return __hip_atomic_load(p, __ATOMIC_RELAXED, __HIP_MEMORY_SCOPE_AGENT); }
__device__ __forceinline__ unsigned xb_add(unsigned* p, unsigned v) { return __hip_atomic_fetch_add(p, v, __ATOMIC_RELAXED, __HIP_MEMORY_SCOPE_AGENT); }
__device__ __forceinline__ unsigned xb_xcc_id() { return (unsigned)__builtin_amdgcn_s_getreg((3 << 11) | 20) & 0xFu; }
#define XB_SPIN(cond, bar) do { unsigned _sp = 0; while (cond) { __builtin_amdgcn_s_sleep(1); \
    if ((++_sp & 255u) == 0u) { if (xb_ld(&(bar)[XB_TMO])) break; if (_sp > XB_SPIN_CAP) { atomicAdd(&(bar)[XB_TMO], 1u); break; } } } } while (0)

struct XcdBarrier {
    unsigned* bar; unsigned x;
    volatile LAS unsigned* st;
};

__device__ __forceinline__ XcdBarrier xcd_barrier_post(unsigned* bar, volatile LAS unsigned* st, int tid) {
    XcdBarrier b; b.bar = bar; b.x = xb_xcc_id(); b.st = st;
    if (tid == 0) (void)xb_add(&bar[XB_XCNT(b.x)], 1u);
    return b;
}
__device__ __forceinline__ void xcd_barrier_complete(unsigned* bar, unsigned x, unsigned& nloc, unsigned& nx) {
    const unsigned G = gridDim.x * gridDim.y * gridDim.z;
    unsigned sum, cnt, mine, sp = 0u;
    for (;;) {
        sum = 0u; cnt = 0u; mine = 0u;
#pragma unroll
        for (unsigned j = 0; j < 16; ++j) { const unsigned c = xb_ld(&bar[XB_XCNT(j)]); sum += c; cnt += (c > 0u) ? 1u : 0u; mine = (j == x) ? c : mine; }
        if (sum == G) break;
        __builtin_amdgcn_s_sleep(1);
        if ((++sp & 255u) == 0u) { if (xb_ld(&bar[XB_TMO])) break; if (sp > XB_SPIN_CAP) { atomicAdd(&bar[XB_TMO], 1u); break; } }
    }
    nloc = mine > 0u ? mine : 1u; nx = cnt > 0u ? cnt : 1u;
}

__device__ __forceinline__ void xcd_barrier(const XcdBarrier& b, int tid) {
    asm volatile("s_waitcnt vmcnt(0)" ::: "memory");
    __syncthreads();
    if (tid == 0) {
        unsigned* bar = b.bar;
        __builtin_amdgcn_s_waitcnt(0);
        unsigned nloc = b.st[0], nx = b.st[1];
        if (nloc == 0u) { xcd_barrier_complete(bar, b.x, nloc, nx); b.st[0] = nloc; b.st[1] = nx; }
        const unsigned old = xb_add(&bar[XB_XSUB(b.x)], 1u);
        const unsigned gen = old / nloc;
        if (old + 1u == (gen + 1u) * nloc) {
            __builtin_amdgcn_fence(__ATOMIC_RELEASE, "agent");
            asm volatile("s_waitcnt vmcnt(0)" ::: "memory");
            const unsigned og = xb_add(&bar[XB_TOP], 1u);
            const unsigned tg = og / nx, target = (tg + 1u) * nx;
            if (og + 1u != target) XB_SPIN(xb_ld(&bar[XB_TOP]) < target, bar);
            __builtin_amdgcn_fence(__ATOMIC_ACQUIRE, "agent");
            xb_add(&bar[XB_XGEN(b.x)], 1u);
            asm volatile("s_waitcnt vmcnt(0)" ::: "memory");
        } else {
            XB_SPIN(xb_ld(&bar[XB_XGEN(b.x)]) == gen, bar);
            __builtin_amdgcn_fence(__ATOMIC_ACQUIRE, "agent");
            asm volatile("s_waitcnt vmcnt(0)" ::: "memory");
        }
    }
    __syncthreads();
}

#ifndef PROBE_PH
#define PROBE_PH -1
#endif
#ifndef PROBE_SUB
#define PROBE_SUB 0
#endif
__global__ void __launch_bounds__(NTHREADS, 2) mega_fwd(Args A_unused) {
    extern __shared__ __attribute__((aligned(16))) unsigned char lds_raw[];
    LAS unsigned char* lds = (LAS unsigned char*)lds_raw;
    cg::grid_group grid = cg::this_grid();
    const int ph_lo = kargs()->ph_lo, ph_hi = kargs()->ph_hi;
    const int wave0 = __builtin_amdgcn_readfirstlane((int)(threadIdx.x >> 6));
    if (threadIdx.x < 16) ((volatile LAS unsigned*)(lds + LDS_BAR_OFF))[threadIdx.x] = 0u;
    __syncthreads();
    if (ph_hi - ph_lo > 1) { (void)xcd_barrier_post((unsigned*)(kargs()->ws + WS_CTL), (volatile LAS unsigned*)(lds + LDS_BAR_OFF), (int)threadIdx.x); }
    const int st_hi = (PROBE_PH >= 0) ? ph_hi + 1 : ph_hi;
    for (int st = ph_lo; st < st_hi; ++st) {
        const int ph = (PROBE_PH >= 0 && st > PROBE_PH) ? st - 1 : st;
        const int sub = (PROBE_PH >= 0 && st == PROBE_PH + 1) ? PROBE_SUB : 0;
        KArgs A = kargs();
        int G = gridDim.x; asm volatile("" : "+s"(G));
        unsigned char* ws = A->ws;
        bf16_t* XB = (bf16_t*)(ws + WS_XB); bf16_t* Yb = (bf16_t*)(ws + WS_Y); bf16_t* Zb = (bf16_t*)(ws + WS_Z); bf16_t* HID = Zb; bf16_t* Vb = (bf16_t*)(ws + WS_VB); bf16_t* Kb = (bf16_t*)(ws + WS_KB); bf16_t* KIb = (bf16_t*)(ws + WS_KI);
        float* ssqA = (float*)(ws + WS_SSQA); float* ssqB = (float*)(ws + WS_SSQB);
        float* ropec = (float*)(ws + WS_ROPE); float* ropes = ropec + SEQ * 32;
        unsigned* MASKb = (unsigned*)(ws + WS_MASK);
        int bid = blockIdx.x, wave = wave0; asm volatile("" : "+s"(bid), "+s"(wave));
        int lane = (int)__builtin_amdgcn_mbcnt_hi(~0u, __builtin_amdgcn_mbcnt_lo(~0u, 0u)); asm volatile("" : "+v"(lane));
        const int tid = wave * 64 + lane;
        if (ph == 0) {
#ifndef NO_PRO
            prologue(A, ws, lds, tid, wave, lane, bid, G, sub);
#endif
        } else if (ph == NPHASE - 1) {
            const float* gfin = A->in[17];
            if (G != 256) for (int row = bid * NWAVES + wave; row < MTOK; row += G * NWAVES) {
                const XL2 XLS{(bf16_t*)(ws + WS_MASK), (bf16_t*)(ws + WS_KB)};
                const float rs = row_rs(ssqA, row); f32x4* p = (f32x4*)(A->out + (size_t)row * DM) + lane; const f32x4* g = (const f32x4*)gfin + lane;
                const u32x2* ph_ = (const u32x2*)(XB + (size_t)row * DM) + lane; const u32x2* pl_ = (const u32x2*)xl_row(XLS, row) + lane;
#pragma unroll
                for (int j = 0; j < 4; ++j) { const u32x2 h2 = ph_[64 * j]; u32x2 l2 = {0u, 0u}; if (RES_LO) l2 = pl_[64 * j]; f32x4 v; v[0] = bflo(h2.x) + bflo(l2.x); v[1] = bfhi(h2.x) + bfhi(l2.x); v[2] = bflo(h2.y) + bflo(l2.y); v[3] = bfhi(h2.y) + bfhi(l2.y); p[64 * j] = v * rs * g[64 * j]; }
            }
        } else {
            const int l = (ph - 1) / 6, k = (ph - 1) % 6;
            if (k == 0) {
                pg8::Gemm g{XB, (bf16_t*)(ws + WS_WIN) + l * WIN_L, MTOK, NZ, DM}; pg8::StaticOrder S; S.init(MTOK, NZ, G, bid);
                EpiZ E{Zb, Vb, Kb, KIb, ssqA, ropec, ropes};
#ifndef NO_G0
                pg8::gemm_phase<EpiZ, pg8::StaticOrder, true, true>(lds, g, S, E, tid);
#endif
            } else if (k == 1) {
#ifndef NO_SEL
                if (sub != 2 && sub < 6) select_phase(Zb, KIb, MASKb, (unsigned*)(ws + WS_CTL) + CW_ITEM + l * 1024, lds, wave, lane, bid, G, sub);
#endif
#ifndef NO_MA
                if (sub == 0 || sub == 2 || sub == 8) mixer_a(Zb, Yb, A->in[3] + l * 3 * 256, bid * NTHREADS + tid, G * NTHREADS);
#endif
#ifndef NO_MB
                if (sub == 0 || sub == 2 || sub == 6 || sub == 7) mixer_bd(Zb, Yb, A->in[4] + l * 256, A->in[5] + l * 256, A->in[6] + (size_t)l * 4 * 128 * 128, A->in[7] + l * 4 * 128,
                                                                      A->in[8] + l * 31 * 256, A->in[9] + l * 256, A->in[10] + l * 256, A->in[11] + l * 256, lds, tid, wave, lane, bid, G);
#endif
            } else if (k == 2) {
#ifndef NO_ATT
                attn_phase(Zb, Kb, Vb, MASKb, (unsigned*)(ws + WS_CTL) + CW_ITEM + l * 1024, Yb, lds, wave, lane, bid, G);
#endif
            } else if (k == 3 || k == 5) {
                const XL2 XLD{(bf16_t*)A->out, (bf16_t*)A->out + (size_t)8192 * DM}, XLS{(bf16_t*)(ws + WS_MASK), (bf16_t*)(ws + WS_KB)};
                const bool last = (l == NLAYER - 1);
                pg8::Gemm g{k == 3 ? Yb : HID, k == 3 ? (bf16_t*)(ws + WS_WOUT) + l * WOUT_L : (bf16_t*)(ws + WS_WDN) + l * WDN_L, MTOK, DM, k == 3 ? DM : FF}; pg8::StaticOrder S; S.init(MTOK, DM, G, bid);
                if (k == 3 && l == 0) {
                    EpiRes<true> E{A->in[0], XLD, last ? XLS : XLD, XB, ssqB};
                    pg8::gemm_phase<EpiRes<true>, pg8::StaticOrder, true, true>(lds, g, S, E, tid);
                } else if (k == 5 && last && G == 256) {
                    EpiFinal E{XB, XLS, A->out, A->in[17], ssqB, (unsigned*)(ws + WS_CTL) + CW_PANEL};
                    pg8::gemm_phase<EpiFinal, pg8::StaticOrder, false, true>(lds, g, S, E, tid);
                } else {
                    EpiRes<false> E{nullptr, (k == 5 && last) ? XLS : XLD, last ? XLS : XLD, XB, k == 3 ? ssqB : ssqA};
                    pg8::gemm_phase<EpiRes<false>, pg8::StaticOrder, true, true>(lds, g, S, E, tid);
                }
            } else if (k == 4) {
                pg8::Gemm g{XB, (bf16_t*)(ws + WS_WGU) + l * WGU_L, MTOK, NGU, DM}; pg8::StaticOrder S; S.init(MTOK, NGU, G, bid);
                EpiGU E{HID, ssqB};
#ifndef NO_G2
                pg8::gemm_phase<EpiGU, pg8::StaticOrder, true, true>(lds, g, S, E, tid);
#endif
                if (l == 0) {
                    const int nwg = (MTOK / 256) * (NGU / 256), rem = nwg % G;
                    if (rem == 0) convert_weights(A, ws, lds, wave, lane, CV_I_L - CV_I_DN, NLAYER * CV_I_L, bid * NWAVES + wave, G * NWAVES);
                    else if (bid >= rem) convert_weights(A, ws, lds, wave, lane, CV_I_L - CV_I_DN, NLAYER * CV_I_L, (bid - rem) * NWAVES + wave, (G - rem) * NWAVES);
                }
            }
        }
        const bool flag_seam = (PROBE_PH < 0) && ph >= 1 && ph <= 12 && ((ph - 1) % 6) == 1;
        if (st + 1 < st_hi && !flag_seam) {
            if (ph_hi > 100000) grid.sync();
            XcdBarrier xb; xb.bar = (unsigned*)(ws + WS_CTL); xb.x = xb_xcc_id(); xb.st = (volatile LAS unsigned*)(lds + LDS_BAR_OFF);
            xcd_barrier(xb, tid);
        }
    }
}

#ifndef MK_COOP
#define MK_COOP 1
#endif
extern "C" void kernel_launch(void* const* d_in, const int* in_sizes, int n_in, void* d_out, int out_size, void* d_ws, size_t ws_size, hipStream_t stream) {
    static int grid = 0;
    if (grid == 0) {
        if (n_in != 18 || out_size != MTOK * DM || ws_size < WS_END) { fprintf(stderr, "kernel_launch: unexpected shapes (n_in %d out %d ws %zu)\n", n_in, out_size, ws_size); grid = -1; return; }
        int dev = 0, cus = 0, per_cu = 0;
        if (hipGetDevice(&dev) != hipSuccess || hipDeviceGetAttribute(&cus, hipDeviceAttributeMultiprocessorCount, dev) != hipSuccess) { grid = -1; return; }
        if (hipFuncSetAttribute((const void*)mega_fwd, hipFuncAttributeMaxDynamicSharedMemorySize, LDS_BYTES) != hipSuccess) { fprintf(stderr, "kernel_launch: hipFuncSetAttribute failed\n"); grid = -1; return; }
        if (hipOccupancyMaxActiveBlocksPerMultiprocessor(&per_cu, (const void*)mega_fwd, NTHREADS, LDS_BYTES) != hipSuccess || per_cu < 1) { fprintf(stderr, "kernel_launch: occupancy query says %d\n", per_cu); (void)hipGetLastError(); }
        grid = cus;
    }
    if (grid < 0) return;
    if (hipMemsetAsync((char*)d_ws + WS_CTL, 0, CTL_BYTES, stream) != hipSuccess) { fprintf(stderr, "kernel_launch: memset failed\n"); return; }
    Args a{};
    for (int i = 0; i < 18; ++i) a.in[i] = (const float*)d_in[i];
    a.out = (float*)d_out; a.ws = (unsigned char*)d_ws;
#if MK_COOP
    a.ph_lo = 0; a.ph_hi = (grid == 256) ? NPHASE - 1 : NPHASE;
    void* args[] = {&a};
    hipError_t e = hipLaunchCooperativeKernel((const void*)mega_fwd, dim3(grid), dim3(NTHREADS), args, LDS_BYTES, stream);
    if (e != hipSuccess) fprintf(stderr, "cooperative launch failed: %s (grid %d)\n", hipGetErrorString(e), grid);
#else
    for (int ph = 0; ph < NPHASE; ++ph) {
        a.ph_lo = ph; a.ph_hi = ph + 1;
        hipLaunchKernelGGL(mega_fwd, dim3(grid), dim3(NTHREADS), LDS_BYTES, stream, a);
    }
#endif
}
```

```cpp
#include <hip/hip_runtime.h>
#include <hip/hip_cooperative_groups.h>
#include <cstdio>
#include <cstdint>
namespace cg = cooperative_groups;
namespace pg8 {
#define PG8_LAS __attribute__((address_space(3)))
typedef unsigned short bf16_t;
typedef short bf16x8 __attribute__((ext_vector_type(8)));
typedef float f32x4 __attribute__((ext_vector_type(4)));
typedef unsigned u32x4 __attribute__((ext_vector_type(4)));
constexpr int BM = 256, BK = 64, HALF = 128, HTB = HALF * BK * 2  , STAGE_BYTES = 8 * HTB, NXCD = 8, WGM = 8;

__host__ __device__ __forceinline__ int lds_byte(int r, int c) { const int st = (r >> 4) * 2 + (c >> 5), rr = r & 15, cc = c & 31, ob = rr * 64 + cc * 2; return st * 1024 + (ob ^ (((ob >> 9) & 1) << 5)); }
__host__ __device__ __forceinline__ void stage_rc(int b, int& R, int& C) { const int st = b / 1024, sb = b % 1024, swz = sb ^ (((sb >> 9) & 1) << 5); R = (st >> 1) * 16 + swz / 64; C = (st & 1) * 32 + (swz % 64) / 2; }
__host__ __device__ __forceinline__ int perm32(int rho) { const int n = rho >> 4, i = rho & 15; return 8 * (i >> 2) + 4 * n + (i & 3); }

struct Unit { int pm, pn; };
struct Gemm { const bf16_t* A; const bf16_t* Bt; int M, N, K; };

struct StaticOrder {
    int nM, nN, nwg, G, c;
    __host__ __device__ void init(int M, int N, int G_, int c_) { nM = M / BM; nN = N / BM; nwg = nM * nN; G = G_; c = c_; }
    __host__ __device__ bool next(int i, Unit& u) const {
        const long L = (long)i * G + c; if (L >= nwg) return false;
        int wgid = (int)L; { const int q = nwg / NXCD, r = nwg % NXCD, xcd = wgid % NXCD, off = wgid / NXCD; wgid = (xcd < r ? xcd * (q + 1) : r * (q + 1) + (xcd - r) * q) + off; }
        const int nig = WGM * nN, gid = wgid / nig, fm = gid * WGM, gsz = (nM - fm) < WGM ? (nM - fm) : WGM;
        u.pm = fm + ((wgid % nig) % gsz); u.pn = (wgid % nig) / gsz; return true;
    }
    __device__ __forceinline__ void a_ready(const Unit&) const {}
    __device__ __forceinline__ void done(const Unit&) const {}
};

__device__ __forceinline__ unsigned cvt_pk_bf16(float lo, float hi) { unsigned r; asm volatile("v_cvt_pk_bf16_f32 %0, %1, %2" : "=v"(r) : "v"(lo), "v"(hi)); return r; }
template <class Epi, class Sched, bool ALIGN_EPI = false, bool SP2 = false>
__device__ __forceinline__ void gemm_phase(PG8_LAS unsigned char* lds, const Gemm g, const Sched& S, const Epi& E, int tid_in) {
    int tid_l = tid_in; asm volatile("" : "+v"(tid_l));
    const int tid = tid_l, wid = __builtin_amdgcn_readfirstlane(tid >> 6), lane = tid & 63, wr = wid >> 2, wc = wid & 3, fr = lane & 15, fq = lane >> 4;
    const int K = g.K, nt = K / BK;
    unsigned voffA[2], voffB[2];
#pragma unroll
    for (int i = 0; i < 2; ++i) { int R, C; stage_rc(tid * 16 + i * 8192, R, C); const int Rb = Epi::PERM ? ((R & ~31) + perm32(R & 31)) : R;
        voffA[i] = (unsigned)(R * K + C) * 2u; voffB[i] = (unsigned)(Rb * K + C) * 2u; }
    const size_t kstep = (size_t)(BK * 2);
    const size_t hstep = (size_t)HALF * K * 2;
    const size_t tstep = 2 * hstep;
    const unsigned ldsw = (unsigned)wid * 1024u;
    const int aoff = lds_byte(wr * 64 + fr, fq * 8), boff = lds_byte(wc * 32 + fr, fq * 8);
#define PG8_SA(b, h) (((b) * 2 + (h)) * HTB)
#define PG8_SB(b, h) ((4 + (b) * 2 + (h)) * HTB)
#define PG8_STAGE(bufoff, gbase, voff) do { _Pragma("unroll") for (int _i = 0; _i < 2; ++_i) \
        __builtin_amdgcn_global_load_lds((const unsigned*)((const char*)(gbase) + (voff)[_i]), (PG8_LAS unsigned*)(lds + (bufoff) + ldsw + _i * 8192), 16, 0, 0); } while (0)
#define PG8_LDA(dst, b, h) do { _Pragma("unroll") for (int m = 0; m < 4; ++m) _Pragma("unroll") for (int k = 0; k < 2; ++k) dst[m][k] = *(const PG8_LAS bf16x8*)(lds + PG8_SA(b, h) + aoff + m * 2048 + k * 1024); } while (0)
#define PG8_LDB(dst, b, h) do { _Pragma("unroll") for (int n = 0; n < 2; ++n) _Pragma("unroll") for (int k = 0; k < 2; ++k) dst[n][k] = *(const PG8_LAS bf16x8*)(lds + PG8_SB(b, h) + boff + n * 2048 + k * 1024); } while (0)
#define PG8_MMA(ai, bj, At, Bt) do { __builtin_amdgcn_s_setprio(1); _Pragma("unroll") for (int m = 0; m < 4; ++m) _Pragma("unroll") for (int n = 0; n < 2; ++n) _Pragma("unroll") for (int k = 0; k < 2; ++k) \
        acc[ai][bj][m][n] = __builtin_amdgcn_mfma_f32_16x16x32_bf16(Bt[n][k], At[m][k], acc[ai][bj][m][n], 0, 0, 0); __builtin_amdgcn_s_setprio(0); } while (0)
#define PG8_WAIT_V(n) asm volatile("s_waitcnt vmcnt(" #n ")" ::: "memory")
#define PG8_WAIT_L(n) asm volatile("s_waitcnt lgkmcnt(" #n ")" ::: "memory")
#define PG8_BAR __builtin_amdgcn_s_barrier()
#define PG8_SCHED __builtin_amdgcn_sched_barrier(0)
    Unit cur, nxt; int ui = 0;
    if (!S.next(0, cur)) return;
    f32x4 acc[2][2][4][2];
#pragma unroll
    for (int a = 0; a < 2; ++a)
#pragma unroll
        for (int b = 0; b < 2; ++b)
#pragma unroll
            for (int m = 0; m < 4; ++m)
#pragma unroll
                for (int n = 0; n < 2; ++n) acc[a][b][m][n] = (f32x4){0.f, 0.f, 0.f, 0.f};
    bf16x8 At[4][2], B0[2][2], B1[2][2];
    const char* cA = (const char*)g.A + (size_t)cur.pm * tstep; const char* cB = (const char*)g.Bt + (size_t)cur.pn * tstep;
    S.a_ready(cur);
    if constexpr (SP2) {
        PG8_STAGE(PG8_SB(0, 0), cB, voffB); PG8_STAGE(PG8_SB(0, 1), cB + hstep, voffB); PG8_STAGE(PG8_SA(0, 0), cA, voffA); PG8_STAGE(PG8_SA(0, 1), cA + hstep, voffA);
        if (wr == 1) PG8_BAR;
        PG8_WAIT_V(2); PG8_BAR;
        PG8_STAGE(PG8_SB(1, 0), cB + kstep, voffB); PG8_STAGE(PG8_SA(1, 0), cA + kstep, voffA); PG8_STAGE(PG8_SB(1, 1), cB + hstep + kstep, voffB);
        PG8_WAIT_V(6); PG8_BAR;
    } else {
        PG8_STAGE(PG8_SB(0, 0), cB, voffB); PG8_STAGE(PG8_SA(0, 0), cA, voffA); PG8_STAGE(PG8_SB(0, 1), cB + hstep, voffB); PG8_STAGE(PG8_SA(0, 1), cA + hstep, voffA);
        if (wr == 1) PG8_BAR;
        PG8_WAIT_V(4); PG8_BAR;
        PG8_STAGE(PG8_SB(1, 0), cB + kstep, voffB); PG8_STAGE(PG8_SA(1, 0), cA + kstep, voffA); PG8_STAGE(PG8_SB(1, 1), cB + hstep + kstep, voffB);
        PG8_WAIT_V(6); PG8_BAR;
    }
    for (;;) {
        const bool has_next = S.next(ui + 1, nxt);
        const char* nA = has_next ? (const char*)g.A + (size_t)nxt.pm * tstep : cA; const char* nB = has_next ? (const char*)g.Bt + (size_t)nxt.pn * tstep : cB;
        for (int t = 0; t < nt; t += 2) {
            const bool last = (t == nt - 2);
            const char* a1 = cA + (size_t)(t + 1) * kstep;
            const char* a2 = last ? nA : cA + (size_t)(t + 2) * kstep; const char* b2 = last ? nB : cB + (size_t)(t + 2) * kstep;
            const char* a3 = a2 + kstep; const char* b3 = b2 + kstep;
            if (last && has_next) S.a_ready(nxt);
            if constexpr (SP2) {
            PG8_LDB(B0, 0, 0); PG8_LDB(B1, 0, 1); PG8_SCHED; PG8_LDA(At, 0, 0); PG8_STAGE(PG8_SA(1, 1), a1 + hstep, voffA);
            PG8_WAIT_V(8); PG8_WAIT_L(0); PG8_BAR; PG8_MMA(0, 0, At, B0); PG8_MMA(0, 1, At, B1); PG8_BAR; PG8_SCHED;
            PG8_LDA(At, 0, 1); PG8_STAGE(PG8_SB(0, 0), b2, voffB); PG8_STAGE(PG8_SB(0, 1), b2 + hstep, voffB); PG8_STAGE(PG8_SA(0, 0), a2, voffA);
            PG8_WAIT_V(8); PG8_WAIT_L(0); PG8_BAR; PG8_MMA(1, 0, At, B0); PG8_MMA(1, 1, At, B1); PG8_BAR; PG8_SCHED;
            PG8_LDB(B0, 1, 0); PG8_LDB(B1, 1, 1); PG8_SCHED; PG8_LDA(At, 1, 0); PG8_STAGE(PG8_SA(0, 1), a2 + hstep, voffA);
            PG8_WAIT_V(8); PG8_WAIT_L(0); PG8_BAR; PG8_MMA(0, 0, At, B0); PG8_MMA(0, 1, At, B1); PG8_BAR; PG8_SCHED;
            PG8_LDA(At, 1, 1); PG8_STAGE(PG8_SB(1, 0), b3, voffB); PG8_STAGE(PG8_SB(1, 1), b3 + hstep, voffB); PG8_STAGE(PG8_SA(1, 0), a3, voffA);
            PG8_WAIT_V(8); PG8_WAIT_L(0); PG8_BAR; PG8_MMA(1, 0, At, B0); PG8_MMA(1, 1, At, B1); PG8_BAR; PG8_SCHED;
            } else {
            PG8_LDB(B0, 0, 0); PG8_SCHED; PG8_LDA(At, 0, 0); PG8_STAGE(PG8_SA(1, 1), a1 + hstep, voffA);
            PG8_WAIT_L(8); PG8_BAR; PG8_WAIT_L(0); PG8_MMA(0, 0, At, B0); PG8_BAR; PG8_SCHED;
            PG8_LDB(B1, 0, 1); PG8_STAGE(PG8_SB(0, 0), b2, voffB);
            PG8_BAR; PG8_WAIT_L(0); PG8_MMA(0, 1, At, B1); PG8_BAR;
            PG8_LDA(At, 0, 1); PG8_STAGE(PG8_SA(0, 0), a2, voffA);
            PG8_BAR; PG8_WAIT_L(0); PG8_MMA(1, 0, At, B0); PG8_BAR; PG8_SCHED;
            PG8_STAGE(PG8_SB(0, 1), b2 + hstep, voffB);
            PG8_WAIT_V(6); PG8_BAR; PG8_MMA(1, 1, At, B1); PG8_BAR;
            PG8_LDB(B0, 1, 0); PG8_SCHED; PG8_LDA(At, 1, 0); PG8_STAGE(PG8_SA(0, 1), a2 + hstep, voffA);
            PG8_WAIT_L(8); PG8_BAR; PG8_WAIT_L(0); PG8_MMA(0, 0, At, B0); PG8_BAR; PG8_SCHED;
            PG8_LDB(B1, 1, 1); PG8_STAGE(PG8_SB(1, 0), b3, voffB);
            PG8_BAR; PG8_WAIT_L(0); PG8_MMA(0, 1, At, B1); PG8_BAR;
            PG8_LDA(At, 1, 1); PG8_STAGE(PG8_SA(1, 0), a3, voffA);
            PG8_BAR; PG8_WAIT_L(0); PG8_MMA(1, 0, At, B0); PG8_BAR; PG8_SCHED;
            PG8_STAGE(PG8_SB(1, 1), b3 + hstep, voffB);
            PG8_WAIT_V(6); PG8_BAR; PG8_MMA(1, 1, At, B1); PG8_BAR;
            }
        }
        if constexpr (ALIGN_EPI) { if (wr == 0) PG8_BAR; }
        if constexpr (!Epi::AFTER_DRAIN) { E(acc, cur, wr, wc, fr, fq); S.done(cur); }
        if (!has_next) break;
#pragma unroll
        for (int a = 0; a < 2; ++a)
#pragma unroll
            for (int b = 0; b < 2; ++b)
#pragma unroll
                for (int m = 0; m < 4; ++m)
#pragma unroll
                    for (int n = 0; n < 2; ++n) acc[a][b][m][n] = (f32x4){0.f, 0.f, 0.f, 0.f};
        cur = nxt; cA = nA; cB = nB; ++ui;
        if constexpr (ALIGN_EPI) { if (wr == 1) PG8_BAR; }
    }
    PG8_WAIT_V(0);
    if constexpr (!ALIGN_EPI) { if (wr == 0) PG8_BAR; }
    PG8_BAR;
    if constexpr (Epi::AFTER_DRAIN) { E.fused(acc, cur, wr, wc, fr, fq, lds, wid, lane); S.done(cur); }
#undef PG8_SA
#undef PG8_SB
#undef PG8_STAGE
#undef PG8_LDA
#undef PG8_LDB
#undef PG8_MMA
#undef PG8_WAIT_V
#undef PG8_WAIT_L
#undef PG8_BAR
#undef PG8_SCHED
}
}
#define PROBE_PH -1
#define PROBE_SUB 0

#define LAS __attribute__((address_space(3)))
typedef unsigned short bf16_t;
typedef short bf16x8 __attribute__((ext_vector_type(8)));
typedef float f32x4 __attribute__((ext_vector_type(4)));
typedef float f32x16 __attribute__((ext_vector_type(16)));
typedef unsigned u32x4 __attribute__((ext_vector_type(4)));
typedef unsigned u32x2 __attribute__((ext_vector_type(2)));
using pg8::cvt_pk_bf16;

constexpr int NWAVES = 8, NTHREADS = 512;
constexpr int BATCH = 4, SEQ = 4096, DM = 1024, MTOK = BATCH * SEQ, NZ = 3072, FF = 2816, NGU = 2 * FF, NLAYER = 2, INC = 2884;
constexpr float C2 = 0.125f * 1.4426950408889634f;
constexpr float NEGF = -1e30f;
constexpr int LDS_BYTES = 153600;
constexpr int NPHASE = 14;

constexpr size_t MiB = 1u << 20;
constexpr size_t WS_WIN = 0, WS_WOUT = 12 * MiB, WS_WGU = 16 * MiB, WS_WDN = 38 * MiB, WS_ROPE = 49 * MiB, WS_SSQA = 50 * MiB, WS_SSQB = 51 * MiB,
                 WS_MASK = 52 * MiB, WS_VB = 60 * MiB, WS_XB = 68 * MiB, WS_Y = 100 * MiB, WS_Z = 132 * MiB, WS_KB = 228 * MiB, WS_KI = 236 * MiB, WS_CTL = 250 * MiB, WS_END = 251 * MiB;
constexpr size_t CTL_BYTES = 40960;
constexpr int CW_ITEM = 8192;
constexpr int CW_PANEL = 4096;
constexpr int LDS_BAR_OFF = LDS_BYTES - 64;
constexpr size_t WIN_L = (size_t)NZ * DM, WOUT_L = (size_t)DM * DM, WGU_L = (size_t)NGU * DM, WDN_L = (size_t)DM * FF;

__device__ const double INVF[32] = {1, 0.74989420933245587, 0.56234132519034907, 0.42169650342858223, 0.31622776601683794, 0.23713737056616552, 0.17782794100389229, 0.1333521432163324,
    0.10000000000000001, 0.074989420933245579, 0.056234132519034911, 0.042169650342858224, 0.031622776601683791, 0.023713737056616554, 0.017782794100389229, 0.013335214321633241,
    0.01, 0.0074989420933245579, 0.005623413251903491, 0.0042169650342858229, 0.0031622776601683794, 0.0023713737056616554, 0.0017782794100389228, 0.0013335214321633241,
    0.001, 0.00074989420933245586, 0.0005623413251903491, 0.00042169650342858224, 0.00031622776601683794, 0.00023713737056616554, 0.00017782794100389227, 0.0001333521432163324};

#define LDS_WAIT() asm volatile("s_waitcnt lgkmcnt(0)" ::: "memory")
__device__ __forceinline__ float bf2f(unsigned short h) { return __uint_as_float((unsigned)h << 16); }
__device__ __forceinline__ float bflo(unsigned w) { return __uint_as_float(w << 16); }
__device__ __forceinline__ float bfhi(unsigned w) { return __uint_as_float(w & 0xffff0000u); }
#define DPPF(v, ctrl, rm) __int_as_float(__builtin_amdgcn_update_dpp(0, __float_as_int(v), ctrl, rm, 0xf, false))
__device__ __forceinline__ float wave_sum(float v) {
    v += DPPF(v, 0x111, 0xf); v += DPPF(v, 0x112, 0xf); v += DPPF(v, 0x114, 0xf); v += DPPF(v, 0x118, 0xf);
    v += DPPF(v, 0x142, 0xa); v += DPPF(v, 0x143, 0xc);
    return __int_as_float(__builtin_amdgcn_readlane(__float_as_int(v), 63));
}
__device__ __forceinline__ unsigned wave_umax(unsigned v) {
#define DPPU(v, ctrl, rm) (unsigned)__builtin_amdgcn_update_dpp(0, (int)(v), ctrl, rm, 0xf, false)
    v = max(v, DPPU(v, 0x111, 0xf)); v = max(v, DPPU(v, 0x112, 0xf)); v = max(v, DPPU(v, 0x114, 0xf)); v = max(v, DPPU(v, 0x118, 0xf));
    v = max(v, DPPU(v, 0x142, 0xa)); v = max(v, DPPU(v, 0x143, 0xc));
    return (unsigned)__builtin_amdgcn_readlane((int)v, 63);
#undef DPPU
}
__device__ __forceinline__ float swap32(float v, int hi) { auto rr = __builtin_amdgcn_permlane32_swap(__float_as_uint(v), __float_as_uint(v), false, false); return hi ? __uint_as_float(rr[0]) : __uint_as_float(rr[1]); }
__device__ __forceinline__ float row_rs(const float* ssq, int r) {
    const f32x4* p = (const f32x4*)(ssq + (size_t)r * 16); const f32x4 a = p[0], b = p[1], c = p[2], d = p[3];
    const float s = (((a.x + a.y) + (a.z + a.w)) + ((b.x + b.y) + (b.z + b.w))) + (((c.x + c.y) + (c.z + c.w)) + ((d.x + d.y) + (d.z + d.w)));
    return __builtin_amdgcn_rsqf(s * (1.f / 1024.f) + 1e-6f);
}
__device__ __forceinline__ float xor16_add(float v) { auto rr = __builtin_amdgcn_permlane16_swap(__float_as_uint(v), __float_as_uint(v), false, false); return __uint_as_float(rr[0]) + __uint_as_float(rr[1]); }
__device__ __forceinline__ float xor32_add(float v) { auto rr = __builtin_amdgcn_permlane32_swap(__float_as_uint(v), __float_as_uint(v), false, false); return __uint_as_float(rr[0]) + __uint_as_float(rr[1]); }
__device__ __forceinline__ void row_rs8(const float* ssq, int rbase  , int fq, float (&rs)[8]) {
    f32x4 p[8];
#pragma unroll
    for (int i = 0; i < 8; ++i) p[i] = *(const f32x4*)(ssq + (size_t)(rbase + (i >> 2) * 128 + (i & 3) * 16) * 16 + fq * 4);
#pragma unroll
    for (int i = 0; i < 8; ++i) { float s = (p[i].x + p[i].y) + (p[i].z + p[i].w); s = xor16_add(s); s = xor32_add(s); rs[i] = __builtin_amdgcn_rsqf(s * (1.f / 1024.f) + 1e-6f); }
}
__device__ __forceinline__ float sigmoidf_(float x) { return __builtin_amdgcn_rcpf(1.f + __expf(-x)); }

struct EpiZ {
    static constexpr bool PERM = true, AFTER_DRAIN = false;
    bf16_t* Z; bf16_t* Vb; bf16_t* Kb; bf16_t* KIb; const float* ssq; const float* ropec; const float* ropes;
    __device__ __forceinline__ void operator()(const f32x4 (&acc)[2][2][4][2], const pg8::Unit& u, int wr, int wc, int fr, int fq) const {
        const int pn = u.pn; const bool rope_tile = (pn == 5) || (pn == 6) || (pn == 8) || (pn == 11);
        float rs8[8]; row_rs8(ssq, u.pm * 256 + wr * 64 + fr, fq, rs8);
#pragma unroll
        for (int ai = 0; ai < 2; ++ai)
        {
            f32x4 rc[4], rsn[4]; const int ri0 = ((wc * 32 + fq * 8) & 63) >> 1;
            if (rope_tile) {
#pragma unroll
                for (int m = 0; m < 4; ++m) { const int pos_ = (u.pm * 256 + ai * 128 + wr * 64 + m * 16 + fr) & (SEQ - 1); rc[m] = *(const f32x4*)(ropec + pos_ * 32 + ri0); rsn[m] = *(const f32x4*)(ropes + pos_ * 32 + ri0); }
            }
#pragma unroll
            for (int m = 0; m < 4; ++m) {
                const int r = u.pm * 256 + ai * 128 + wr * 64 + m * 16 + fr; const float rs = rs8[ai * 4 + m]; const int pos = r & (SEQ - 1);
#pragma unroll
                for (int bj = 0; bj < 2; ++bj) {
                    const int cl = bj * 128 + wc * 32 + fq * 8;
                    f32x4 v0 = acc[ai][bj][m][0] * rs, v1 = acc[ai][bj][m][1] * rs;
                    if (rope_tile && (pn != 11 || cl < 64)) {
                        const f32x4 c4 = rc[m], s4 = rsn[m];
                        float a, b;
                        a = v0[0]; b = v0[1]; v0[0] = a * c4[0] - b * s4[0]; v0[1] = b * c4[0] + a * s4[0];
                        a = v0[2]; b = v0[3]; v0[2] = a * c4[1] - b * s4[1]; v0[3] = b * c4[1] + a * s4[1];
                        a = v1[0]; b = v1[1]; v1[0] = a * c4[2] - b * s4[2]; v1[1] = b * c4[2] + a * s4[2];
                        a = v1[2]; b = v1[3]; v1[2] = a * c4[3] - b * s4[3]; v1[3] = b * c4[3] + a * s4[3];
                    }
                    u32x4 w; w.x = cvt_pk_bf16(v0[0], v0[1]); w.y = cvt_pk_bf16(v0[2], v0[3]); w.z = cvt_pk_bf16(v1[0], v1[1]); w.w = cvt_pk_bf16(v1[2], v1[3]);
                    const int b = r >> 12;
                    if (pn == 7) {
                        const int hh = cl >> 6, d0 = cl & 63, kt = pos >> 5, k32 = pos & 31, c = k32 >> 4, kk = k32 & 15, vh = (kk >> 2) & 1, e = (kk & 3) + 4 * (kk >> 3);
                        bf16_t* vp = Vb + ((((size_t)((b * 4 + hh) * 128 + kt) * 2 + (d0 >> 5)) * 2 + c) * 32 + (d0 & 31)) * 16 + vh * 8 + e;
                        vp[0 * 16] = (bf16_t)(w.x & 0xffffu); vp[1 * 16] = (bf16_t)(w.x >> 16); vp[2 * 16] = (bf16_t)(w.y & 0xffffu); vp[3 * 16] = (bf16_t)(w.y >> 16);
                        vp[4 * 16] = (bf16_t)(w.z & 0xffffu); vp[5 * 16] = (bf16_t)(w.z >> 16); vp[6 * 16] = (bf16_t)(w.w & 0xffffu); vp[7 * 16] = (bf16_t)(w.w >> 16);
                    } else if (pn == 6) {
                        const int hh = cl >> 6, c = (cl >> 4) & 3, kh = (cl >> 3) & 1;
                        *(u32x4*)(Kb + ((((size_t)((b * 4 + hh) * 128 + (pos >> 5)) * 4 + c) * 32 + (pos & 31)) * 16 + kh * 8)) = w;
                    } else if (pn == 11) {
                        if (cl < 64) *(u32x4*)(KIb + ((((size_t)(b * 256 + (pos >> 4)) * 2 + (cl >> 5)) * 16 + (pos & 15)) * 32 + ((cl >> 3) & 3) * 8)) = w;
                        else if (cl == 64) *(u32x4*)(Z + (size_t)r * NZ + pn * 256 + cl) = w;
                    } else {
                        *(u32x4*)(Z + (size_t)r * NZ + pn * 256 + cl) = w;
                    }
                }
                asm volatile("" ::: "memory");
            }
        }
    }
};
#ifndef RES_LO
#define RES_LO 0
#endif
struct XL2 { bf16_t* a; bf16_t* b; };
__device__ __forceinline__ bf16_t* xl_row(const XL2& x, int r) { return r < 8192 ? x.a + (size_t)r * DM : x.b + (size_t)(r - 8192) * DM; }
__device__ __forceinline__ void split_hilo(const f32x4& v0, const f32x4& v1, u32x4& hi, u32x4& lo) {
    hi.x = cvt_pk_bf16(v0[0], v0[1]); hi.y = cvt_pk_bf16(v0[2], v0[3]); hi.z = cvt_pk_bf16(v1[0], v1[1]); hi.w = cvt_pk_bf16(v1[2], v1[3]);
    lo.x = cvt_pk_bf16(v0[0] - bflo(hi.x), v0[1] - bfhi(hi.x)); lo.y = cvt_pk_bf16(v0[2] - bflo(hi.y), v0[3] - bfhi(hi.y));
    lo.z = cvt_pk_bf16(v1[0] - bflo(hi.z), v1[1] - bfhi(hi.z)); lo.w = cvt_pk_bf16(v1[2] - bflo(hi.w), v1[3] - bfhi(hi.w));
}
__device__ __forceinline__ void join_hilo(const u32x4& hi, const u32x4& lo, f32x4& v0, f32x4& v1) {
    v0[0] = bflo(hi.x) + bflo(lo.x); v0[1] = bfhi(hi.x) + bfhi(lo.x); v0[2] = bflo(hi.y) + bflo(lo.y); v0[3] = bfhi(hi.y) + bfhi(lo.y);
    v1[0] = bflo(hi.z) + bflo(lo.z); v1[1] = bfhi(hi.z) + bfhi(lo.z); v1[2] = bflo(hi.w) + bflo(lo.w); v1[3] = bfhi(hi.w) + bfhi(lo.w);
}
template <bool BASE_F32> struct EpiRes {
    static constexpr bool PERM = true, AFTER_DRAIN = false;
    const float* basef; XL2 xlin; XL2 xlout; bf16_t* xb; float* ssq;
    __device__ __forceinline__ void operator()(const f32x4 (&acc)[2][2][4][2], const pg8::Unit& u, int wr, int wc, int fr, int fq) const {
#pragma unroll
        for (int ai = 0; ai < 2; ++ai)
#pragma unroll
            for (int m = 0; m < 4; ++m) {
                const int r = u.pm * 256 + ai * 128 + wr * 64 + m * 16 + fr; float sq = 0.f;
#pragma unroll
                for (int bj = 0; bj < 2; ++bj) {
                    const int col = u.pn * 256 + bj * 128 + wc * 32 + fq * 8; const size_t off = (size_t)r * DM + col;
                    f32x4 b0, b1;
                    if (BASE_F32) { b0 = *(const f32x4*)(basef + off); b1 = *(const f32x4*)(basef + off + 4); }
                    else { const u32x4 hi_in = *(const u32x4*)(xb + off); u32x4 lo_in = {0u, 0u, 0u, 0u}; if (RES_LO) lo_in = *(const u32x4*)(xl_row(xlin, r) + col); join_hilo(hi_in, lo_in, b0, b1); }
                    const f32x4 v0 = acc[ai][bj][m][0] + b0, v1 = acc[ai][bj][m][1] + b1;
                    u32x4 hi, lo; split_hilo(v0, v1, hi, lo);
                    *(u32x4*)(xb + off) = hi; if (RES_LO) *(u32x4*)(xl_row(xlout, r) + col) = lo;
                    sq += ((v0[0] * v0[0] + v0[1] * v0[1]) + (v0[2] * v0[2] + v0[3] * v0[3])) + ((v1[0] * v1[0] + v1[1] * v1[1]) + (v1[2] * v1[2] + v1[3] * v1[3]));
                }
                sq += __shfl_xor(sq, 16); sq += __shfl_xor(sq, 32);
                if (fq == 0) ssq[(size_t)r * 16 + u.pn * 4 + wc] = sq;
                if (m == 3) asm volatile("" ::: "memory");
            }
    }
};
struct EpiFinal {
    static constexpr bool PERM = true, AFTER_DRAIN = true;
    const bf16_t* xb; XL2 xlin; float* out; const float* gfin; float* xbuf; unsigned* cnt;
    __device__ __forceinline__ void fused(f32x4 (&acc)[2][2][4][2], const pg8::Unit& u, int wr, int wc, int fr, int fq, LAS unsigned char* lds, int wid, int lane) const {
        LAS float* P = (LAS float*)lds;
        LAS float* S = (LAS float*)(lds + 4096);
#pragma unroll
        for (int ai = 0; ai < 2; ++ai)
#pragma unroll
            for (int m = 0; m < 4; ++m) {
                const int rl = ai * 128 + wr * 64 + m * 16 + fr; float sq = 0.f;
#pragma unroll
                for (int bj = 0; bj < 2; ++bj) {
                    const size_t off = (size_t)(u.pm * 256 + rl) * DM + u.pn * 256 + bj * 128 + wc * 32 + fq * 8;
                    f32x4 b0, b1; { const u32x4 hi_in = *(const u32x4*)(xb + off); u32x4 lo_in = {0u, 0u, 0u, 0u}; if (RES_LO) lo_in = *(const u32x4*)(xl_row(xlin, u.pm * 256 + rl) + (off - (size_t)(u.pm * 256 + rl) * DM)); join_hilo(hi_in, lo_in, b0, b1); }
                    const f32x4 v0 = acc[ai][bj][m][0] + b0, v1 = acc[ai][bj][m][1] + b1;
                    acc[ai][bj][m][0] = v0; acc[ai][bj][m][1] = v1;
                    sq += ((v0[0] * v0[0] + v0[1] * v0[1]) + (v0[2] * v0[2] + v0[3] * v0[3])) + ((v1[0] * v1[0] + v1[1] * v1[1]) + (v1[2] * v1[2] + v1[3] * v1[3]));
                }
                sq += __shfl_xor(sq, 16); sq += __shfl_xor(sq, 32);
                if (fq == 0) P[rl * 4 + wc] = sq;
                if (m == 3) asm volatile("" ::: "memory");
            }
        asm volatile("s_waitcnt lgkmcnt(0)" ::: "memory"); __builtin_amdgcn_s_barrier(); asm volatile("" ::: "memory");
        const int tid = wid * 64 + lane;
        if (tid < 256) {
            const float s = (P[tid * 4 + 0] + P[tid * 4 + 1]) + (P[tid * 4 + 2] + P[tid * 4 + 3]);
            __hip_atomic_store(xbuf + (size_t)(u.pm * 256 + tid) * 4 + u.pn, s, __ATOMIC_RELAXED, __HIP_MEMORY_SCOPE_AGENT);
        }
        asm volatile("s_waitcnt vmcnt(0)" ::: "memory");
        if (lane == 0) __hip_atomic_fetch_add(cnt + 64 * u.pm, 1u, __ATOMIC_RELAXED, __HIP_MEMORY_SCOPE_AGENT);
        if (wid == 0) {
            unsigned spins = 0;
            while ((unsigned)__builtin_amdgcn_readfirstlane(__hip_atomic_load(cnt + 64 * u.pm, __ATOMIC_RELAXED, __HIP_MEMORY_SCOPE_AGENT)) < 32u) { __builtin_amdgcn_s_sleep(2); if (++spins > (1u << 22)) break; }
            __builtin_amdgcn_fence(__ATOMIC_ACQUIRE, "agent");
        }
        asm volatile("s_waitcnt vmcnt(0) lgkmcnt(0)" ::: "memory"); __builtin_amdgcn_s_barrier(); asm volatile("" ::: "memory");
        if (tid < 256) {
            const float* xp = xbuf + (size_t)(u.pm * 256 + tid) * 4;
            const float a = __hip_atomic_load(xp + 0, __ATOMIC_RELAXED, __HIP_MEMORY_SCOPE_AGENT), b = __hip_atomic_load(xp + 1, __ATOMIC_RELAXED, __HIP_MEMORY_SCOPE_AGENT),
                        c = __hip_atomic_load(xp + 2, __ATOMIC_RELAXED, __HIP_MEMORY_SCOPE_AGENT), d = __hip_atomic_load(xp + 3, __ATOMIC_RELAXED, __HIP_MEMORY_SCOPE_AGENT);
            S[tid] = __builtin_amdgcn_rsqf(((a + b) + (c + d)) * (1.f / 1024.f) + 1e-6f);
        }
        asm volatile("s_waitcnt vmcnt(0) lgkmcnt(0)" ::: "memory"); __builtin_amdgcn_s_barrier(); asm volatile("" ::: "memory");
#pragma unroll
        for (int ai = 0; ai < 2; ++ai)
#pragma unroll
            for (int m = 0; m < 4; ++m) {
                const int rl = ai * 128 + wr * 64 + m * 16 + fr; const float rs = S[rl];
#pragma unroll
                for (int bj = 0; bj < 2; ++bj) {
                    const int col = u.pn * 256 + bj * 128 + wc * 32 + fq * 8; const size_t off = (size_t)(u.pm * 256 + rl) * DM + col;
                    *(f32x4*)(out + off) = acc[ai][bj][m][0] * rs * *(const f32x4*)(gfin + col); *(f32x4*)(out + off + 4) = acc[ai][bj][m][1] * rs * *(const f32x4*)(gfin + col + 4);
                }
            }
    }
};
struct EpiGU {
    static constexpr bool PERM = true, AFTER_DRAIN = false;
    bf16_t* H; const float* ssq;
    __device__ __forceinline__ void operator()(const f32x4 (&acc)[2][2][4][2], const pg8::Unit& u, int wr, int wc, int fr, int fq) const {
        float rs8[8]; row_rs8(ssq, u.pm * 256 + wr * 64 + fr, fq, rs8);
#pragma unroll
        for (int ai = 0; ai < 2; ++ai)
#pragma unroll
            for (int m = 0; m < 4; ++m) {
                const int r = u.pm * 256 + ai * 128 + wr * 64 + m * 16 + fr; const float rs = rs8[ai * 4 + m];
                u32x4 w;
#pragma unroll
                for (int n = 0; n < 2; ++n) {
                    const f32x4 g = acc[ai][0][m][n] * rs, up = acc[ai][1][m][n] * rs;
                    const float h0 = g[0] * sigmoidf_(g[0]) * up[0], h1 = g[1] * sigmoidf_(g[1]) * up[1], h2 = g[2] * sigmoidf_(g[2]) * up[2], h3 = g[3] * sigmoidf_(g[3]) * up[3];
                    if (n == 0) { w.x = cvt_pk_bf16(h0, h1); w.y = cvt_pk_bf16(h2, h3); } else { w.z = cvt_pk_bf16(h0, h1); w.w = cvt_pk_bf16(h2, h3); }
                }
                *(u32x4*)(H + (size_t)r * FF + u.pn * 128 + wc * 32 + fq * 8) = w;
            }
    }
};

__device__ __forceinline__ int il64(int p) { return (p & 1) ? (p >> 1) + 32 : (p >> 1); }
__device__ __forceinline__ void conv_item(const float* src, int ld, float cs, const float* gk, int K, bf16_t* WT, int n0, int k0, LAS float* scr, int lane) {
    float v[32];
    const float* sp = src + (size_t)(k0 + (lane >> 5)) * ld;
#pragma unroll
    for (int i = 0; i < 32; ++i) v[i] = sp[(size_t)(2 * i) * ld];
    if (gk) {
        float g[32];
#pragma unroll
        for (int i = 0; i < 32; ++i) g[i] = gk[k0 + 2 * i + (lane >> 5)];
#pragma unroll
        for (int i = 0; i < 32; ++i) v[i] *= g[i];
    }
#pragma unroll
    for (int i = 0; i < 32; ++i) scr[(2 * i + (lane >> 5)) * 33 + (lane & 31)] = v[i] * cs;
    LDS_WAIT();
    const int c = lane & 7;
#pragma unroll
    for (int j = 0; j < 4; ++j) {
        const int n = (lane >> 3) + 8 * j; const LAS float* s = scr + (8 * c) * 33 + n;
        u32x4 o; o.x = cvt_pk_bf16(s[0 * 33], s[1 * 33]); o.y = cvt_pk_bf16(s[2 * 33], s[3 * 33]); o.z = cvt_pk_bf16(s[4 * 33], s[5 * 33]); o.w = cvt_pk_bf16(s[6 * 33], s[7 * 33]);
        *(u32x4*)(WT + (size_t)(n0 + n) * K + k0 + 8 * c) = o;
    }
    LDS_WAIT();
}

struct Args { const float* in[18]; float* out; unsigned char* ws; int ph_lo, ph_hi; };
typedef const Args __attribute__((address_space(4)))* KArgs;
__device__ __forceinline__ KArgs kargs() { KArgs p = (KArgs)__builtin_amdgcn_kernarg_segment_ptr(); asm volatile("" : "+s"(p)); return p; }

constexpr int CV_I_IN = 16 * 96, CV_I_OUT = 16 * 32, CV_I_GU = 16 * 176, CV_I_DN = 44 * 32, CV_I_L = CV_I_IN + CV_I_OUT + CV_I_GU + CV_I_DN;
__device__ __forceinline__ void convert_weights(KArgs A, unsigned char* ws, LAS unsigned char* lds, int wave, int lane, int it_lo, int it_hi, int gw, int NGW) {
    LAS float* scr = (LAS float*)(lds + wave * 16384);
    constexpr int I_IN = CV_I_IN, I_OUT = CV_I_OUT, I_GU = CV_I_GU, I_L = CV_I_L;
    for (int it = it_lo + gw; it < it_hi; it += NGW) {
        const int l = it / I_L; int r = it % I_L;
        if (r < I_IN) {
            const int kb = r / 96, nb = r % 96, n = nb * 32 + (lane & 31), tile = n >> 8, c = n & 255;
            int src; float cs = 1.f;
            if (tile <= 4) src = n;
            else if (tile == 5) { src = 1280 + (c & ~63) + il64(c & 63); cs = C2; }
            else if (tile == 6) src = 1536 + (c & ~63) + il64(c & 63);
            else if (tile == 7) src = 1792 + c;
            else if (tile == 8) src = 2048 + (c & ~63) + il64(c & 63);
            else if (tile == 9) src = 2372 + c;
            else if (tile == 10) src = 2628 + c;
            else { if (c < 64) src = 2304 + il64(c); else if (c < 68) { src = 2368 + (c - 64); cs = 0.0625f; } else { src = 0; cs = 0.f; } }
            const float* wl = A->in[2] + (size_t)l * DM * INC;
            conv_item(wl + src, INC, cs, A->in[1] + l * DM, DM, (bf16_t*)(ws + WS_WIN) + l * WIN_L, nb * 32, kb * 64, scr, lane);
            continue;
        }
        r -= I_IN;
        if (r < I_OUT) {
            const int kb = r / 32, nb = r % 32;
            conv_item(A->in[12] + (size_t)l * DM * DM + nb * 32 + (lane & 31), DM, 1.f, nullptr, DM, (bf16_t*)(ws + WS_WOUT) + l * WOUT_L, nb * 32, kb * 64, scr, lane);
            continue;
        }
        r -= I_OUT;
        if (r < I_GU) {
            const int kb = r / 176, nb = r % 176, n = nb * 32 + (lane & 31), c = n & 255, col = (n >> 8) * 128 + (c & 127);
            const float* wsrc = (c < 128 ? A->in[14] : A->in[15]) + (size_t)l * DM * FF + col;
            conv_item(wsrc, FF, 1.f, A->in[13] + l * DM, DM, (bf16_t*)(ws + WS_WGU) + l * WGU_L, nb * 32, kb * 64, scr, lane);
            continue;
        }
        r -= I_GU;
        { const int kb = r / 32, nb = r % 32;
          conv_item(A->in[16] + (size_t)l * FF * DM + nb * 32 + (lane & 31), DM, 1.f, nullptr, FF, (bf16_t*)(ws + WS_WDN) + l * WDN_L, nb * 32, kb * 64, scr, lane); }
    }
}
__device__ __forceinline__ void prologue(KArgs A, unsigned char* ws, LAS unsigned char* lds, int tid, int wave, int lane, int bid, int G, int sub) {
    const int gw = bid * NWAVES + wave, NGW = G * NWAVES;
    if (sub == 0 || sub == 1) convert_weights(A, ws, lds, wave, lane, 0, CV_I_L - CV_I_DN, gw, NGW);
    float* ropec = (float*)(ws + WS_ROPE); float* ropes = ropec + SEQ * 32;
    if (sub == 0 || sub == 2) for (int idx = bid * NTHREADS + tid; idx < SEQ * 32; idx += G * NTHREADS) {
        const int pos = idx >> 5, i = idx & 31;
        const double ang = (double)pos * INVF[i];
        const double nn = rint(ang * 0.15915494309189535);
        const double x = ang - nn * 6.283185307179586477, x2 = x * x;
        double c = 1.0, s = 1.0, tc = 1.0, ts = 1.0;
#pragma unroll
        for (int k = 1; k <= 15; ++k) { tc *= -x2 * (1.0 / (double)((2 * k - 1) * (2 * k))); c += tc; ts *= -x2 * (1.0 / (double)((2 * k) * (2 * k + 1))); s += ts; }
        ropec[idx] = (float)c; ropes[idx] = (float)(s * x);
    }
    const float* x = A->in[0]; bf16_t* XB = (bf16_t*)(ws + WS_XB); float* ssqA = (float*)(ws + WS_SSQA);
    if (sub == 0 || sub == 3) for (int row0 = gw; row0 < MTOK; row0 += 4 * NGW) {
        f32x4 v[4][4];
#pragma unroll
        for (int rr = 0; rr < 4; ++rr) { const int row = min(row0 + rr * NGW, MTOK - 1); const f32x4* xr = (const f32x4*)(x + (size_t)row * DM) + lane;
#pragma unroll
            for (int j = 0; j < 4; ++j) v[rr][j] = xr[64 * j]; }
#pragma unroll
        for (int rr = 0; rr < 4; ++rr) { const int row = row0 + rr * NGW; if (row < MTOK) { u32x2* d = (u32x2*)(XB + (size_t)row * DM) + lane; float s = 0.f;
#pragma unroll
            for (int j = 0; j < 4; ++j) { const f32x4 t = v[rr][j]; s += (t.x * t.x + t.y * t.y) + (t.z * t.z + t.w * t.w); u32x2 o; o.x = cvt_pk_bf16(t.x, t.y); o.y = cvt_pk_bf16(t.z, t.w); d[64 * j] = o; }
            s = wave_sum(s);
            if (lane < 16) ssqA[(size_t)row * 16 + lane] = lane == 0 ? s : 0.f; } }
    }
}

__device__ __forceinline__ int wave_isum(int v) {
    v += __builtin_amdgcn_update_dpp(0, v, 0x111, 0xf, 0xf, false);
    v += __builtin_amdgcn_update_dpp(0, v, 0x112, 0xf, 0xf, false);
    v += __builtin_amdgcn_update_dpp(0, v, 0x114, 0xf, 0xf, false);
    v += __builtin_amdgcn_update_dpp(0, v, 0x118, 0xf, 0xf, false);
    v += __builtin_amdgcn_update_dpp(0, v, 0x142, 0xa, 0xf, false);
    v += __builtin_amdgcn_update_dpp(0, v, 0x143, 0xc, 0xf, false);
    return __builtin_amdgcn_readlane(v, 63);
}
#define CNT4(c0, c1, t, x0, x1, x2, x3) do { unsigned long long m0_, m1_, m2_, m3_, j0_, j1_; \
    asm("v_cmp_le_u32_e64 %[m0], %[tt], %[a0]\n\tv_cmp_le_u32_e64 %[m1], %[tt], %[a1]\n\tv_cmp_le_u32_e64 %[m2], %[tt], %[a2]\n\tv_cmp_le_u32_e64 %[m3], %[tt], %[a3]\n\t" \
        "v_addc_co_u32_e64 %[k0], %[j0], 0, %[k0], %[m0]\n\tv_addc_co_u32_e64 %[k1], %[j1], 0, %[k1], %[m1]\n\t" \
        "v_addc_co_u32_e64 %[k0], %[j0], 0, %[k0], %[m2]\n\tv_addc_co_u32_e64 %[k1], %[j1], 0, %[k1], %[m3]" \
        : [k0] "+v"(c0), [k1] "+v"(c1), [m0] "=&s"(m0_), [m1] "=&s"(m1_), [m2] "=&s"(m2_), [m3] "=&s"(m3_), [j0] "=&s"(j0_), [j1] "=&s"(j1_) \
        : [tt] "s"(t), [a0] "v"(x0), [a1] "v"(x1), [a2] "v"(x2), [a3] "v"(x3)); } while (0)
#define BIT4(w, t, x0, x1, x2, x3) do { unsigned long long m0_, m1_, m2_, m3_, j0_; \
    asm("v_cmp_gt_u32_e64 %[m0], %[a0], %[tt]\n\tv_cmp_gt_u32_e64 %[m1], %[a1], %[tt]\n\tv_cmp_gt_u32_e64 %[m2], %[a2], %[tt]\n\tv_cmp_gt_u32_e64 %[m3], %[a3], %[tt]\n\t" \
        "v_addc_co_u32_e64 %[k0], %[j0], %[k0], %[k0], %[m0]\n\tv_addc_co_u32_e64 %[k0], %[j0], %[k0], %[k0], %[m1]\n\t" \
        "v_addc_co_u32_e64 %[k0], %[j0], %[k0], %[k0], %[m2]\n\tv_addc_co_u32_e64 %[k0], %[j0], %[k0], %[k0], %[m3]" \
        : [k0] "+v"(w), [m0] "=&s"(m0_), [m1] "=&s"(m1_), [m2] "=&s"(m2_), [m3] "=&s"(m3_), [j0] "=&s"(j0_) \
        : [tt] "s"(t), [a0] "v"(x0), [a1] "v"(x1), [a2] "v"(x2), [a3] "v"(x3)); } while (0)
__device__ __forceinline__ int count_ge(const unsigned (&u)[64], unsigned cand, int nblk) {
    int c0 = 0, c1 = 0;
    const unsigned ts = __builtin_amdgcn_readfirstlane(cand);
#pragma unroll
    for (int B = 0; B < 2; ++B) {
        if (B < nblk) {
#pragma unroll
            for (int i = 0; i < 32; i += 4) CNT4(c0, c1, ts, u[B * 32 + i], u[B * 32 + i + 1], u[B * 32 + i + 2], u[B * 32 + i + 3]);
        }
    }
    return wave_isum(c0 + c1);
}
__device__ __forceinline__ float keyval(unsigned k) { return __uint_as_float((k & 0x80000000u) ? (k ^ 0x80000000u) : ~k); }
__device__ __forceinline__ unsigned valkey(float f) { const unsigned b = __float_as_uint(f); return b ^ ((unsigned)((int)b >> 31) | 0x80000000u); }
__device__ __forceinline__ void select_query(const unsigned (&u)[64], unsigned vmax, int q, int b, int lane, unsigned* MASKb) {
    const int n = q + 1, nblk = (n + 2047) >> 11;
    unsigned T = 0u, TG = 0u; int rrem = 0;
    if (n > 256) {
        const unsigned kmax = wave_umax(vmax);
        const unsigned K0 = 0x80000000u;
        bool exact = false, done = false;
        unsigned lo = 0u, hi = 0u; float Llo = 1.f, Lhi = 1.f;
        const float L256 = 8.0028150156f;
        const int cpos = count_ge(u, K0 + 1u, nblk);
        if (cpos == 256) { T = K0 + 1u; exact = true; done = true; }
        else if (cpos > 256) { lo = K0 + 1u; Llo = __log2f((float)cpos) - L256; hi = kmax + 1u; Lhi = L256 + 1.f; }
        else {
            const int c0 = count_ge(u, K0, nblk);
            if (c0 >= 256) { T = K0; exact = (c0 == 256); done = true; }
            else {
                unsigned vmin = 0xffffffffu;
#pragma unroll
                for (int i = 0; i < 64; ++i) vmin = min(vmin, u[i] - 1u);
                lo = ~wave_umax(~vmin) + 1u; Llo = __log2f((float)n) - L256; hi = K0; Lhi = L256 - __log2f(fmaxf((float)c0, 0.5f));
            }
        }
        int it = 0, last = 0;
        while (!done) {
            if (hi - lo <= 1u) { T = lo; exact = false; break; }
            const float vlo = keyval(lo), vhi = keyval(hi);
            const float frac = (it >= 9 && (it & 1)) ? 0.5f : Llo * __builtin_amdgcn_rcpf(Llo + Lhi);
            unsigned mid = valkey(vlo + frac * (vhi - vlo));
            if (mid <= lo) mid = lo + 1u;
            if (mid >= hi) mid = hi - 1u;
            mid = __builtin_amdgcn_readfirstlane(mid);
            const int c = count_ge(u, mid, nblk);
            if (c == 256) { T = mid; exact = true; break; }
            if (c > 256) { lo = mid; Llo = __log2f((float)c) - L256; if (last == 1) Lhi *= 0.5f; last = 1; }
            else { hi = mid; Lhi = L256 - __log2f(fmaxf((float)c, 0.5f)); if (last == 2) Llo *= 0.5f; last = 2; }
            ++it;
        }
        if (exact) TG = T - 1u; else { TG = T; rrem = 256 - count_ge(u, T + 1u, nblk); }
    }
    int tbase = 0;
#pragma unroll
    for (int B = 0; B < 2; ++B) {
        if (B < nblk) {
            unsigned w = 0u; const unsigned tgs = __builtin_amdgcn_readfirstlane(TG);
#pragma unroll
            for (int e = 31; e >= 3; e -= 4) BIT4(w, tgs, u[B * 32 + e], u[B * 32 + e - 1], u[B * 32 + e - 2], u[B * 32 + e - 3]);
            if (rrem > 0) {
                int ec = 0;
#pragma unroll
                for (int e = 0; e < 32; ++e) ec += (u[B * 32 + e] == T) ? 1 : 0;
                int incl = ec;
#pragma unroll
                for (int o = 1; o < 64; o <<= 1) { const int t = __shfl_up(incl, o); if (lane >= o) incl += t; }
                const int total = __builtin_amdgcn_readlane(incl, 63);
                const int quota = rrem - tbase - (incl - ec);
                int taken = 0;
#pragma unroll
                for (int e = 0; e < 32; ++e) { const bool is = (u[B * 32 + e] == T) && (taken < quota); w |= is ? (1u << e) : 0u; taken += is ? 1 : 0; }
                tbase += total;
            }
            if (64 * B + lane <= (q >> 5)) __hip_atomic_store(MASKb + ((size_t)(b * 128 + (q >> 5)) * 128 + 64 * B + lane) * 32 + (q & 31), w, __ATOMIC_RELAXED, __HIP_MEMORY_SCOPE_AGENT);
        }
    }
}
__device__ __forceinline__ void select_phase(const bf16_t* Z, const bf16_t* KIb, unsigned* MASKb, unsigned* itemcnt, LAS unsigned char* lds, int wave_in, int lane_in, int bid, int G, int sub) {
    constexpr int SCS = 2312;
    LAS float* sc = (LAS float*)lds;
    const int nrounds = (1024 + G - 1) / G;
    bf16x8 qf[4][2]; u32x2 wraw;
#define SEL_LOADQ(idx_) do { const int i_ = (idx_) < 1023 ? (idx_) : 1023; const bf16_t* zq_ = Z + ((size_t)(i_ & 3) * SEQ + (i_ >> 2) * 16 + (lane_in & 15)) * NZ; \
        _Pragma("unroll") for (int j = 0; j < 4; ++j) _Pragma("unroll") for (int ks = 0; ks < 2; ++ks) qf[j][ks] = *(const bf16x8*)(zq_ + 2048 + j * 64 + ks * 32 + (lane_in >> 4) * 8); \
        wraw = *(const u32x2*)(zq_ + 2816 + 64); } while (0)
    SEL_LOADQ(bid);
    for (int rd = 0; rd < nrounds; ++rd) {
        const int idx = rd * G + ((rd & 1) ? (G - 1 - bid) : bid);
        const int idxn = (rd + 1) * G + (((rd + 1) & 1) ? (G - 1 - bid) : bid);
        if (idx >= 1024) continue;
        const int b = idx & 3, q0 = (idx >> 2) * 16;
        int wave = wave_in, lane = lane_in; asm volatile("" : "+s"(wave), "+v"(lane));
        const int fr = lane & 15, fq = lane >> 4;
        const float w0 = bflo(wraw.x), w1 = bfhi(wraw.x), w2 = bflo(wraw.y), w3 = bfhi(wraw.y);
        const int nkt = (q0 >> 4) + 1, nch = (nkt + 127) >> 7;
        const bf16_t* kib = KIb + (size_t)b * 256 * 1024 + fr * 32 + fq * 8;
        const int qa = q0 + 2 * wave, qb = qa + 1;
        unsigned ua[64], ub[64]; unsigned vmaxa = 0u, vmaxb = 0u;
#pragma unroll
        for (int c = 0; c < 2; ++c) {
            if (c < nch) {
                const int ktlo = 128 * c, kthi = min(nkt, ktlo + 128);
                bf16x8 ka[2][2], kb2[2][2];
#define KI_LOAD(dst, i0) do { _Pragma("unroll") for (int t_ = 0; t_ < 2; ++t_) { int kt_ = ktlo + wave + 8 * ((i0) + t_); kt_ = kt_ < kthi ? kt_ : kthi - 1; \
                dst[t_][0] = *(const bf16x8*)(kib + (size_t)kt_ * 1024); dst[t_][1] = *(const bf16x8*)(kib + (size_t)kt_ * 1024 + 512); } } while (0)
#define KI_COMP(src, i0) do { _Pragma("unroll") for (int t_ = 0; t_ < 2; ++t_) { int kt_ = ktlo + wave + 8 * ((i0) + t_); kt_ = (kt_ < kthi ? kt_ : kthi - 1) - ktlo; \
                f32x4 s4 = {0.f, 0.f, 0.f, 0.f}; \
                _Pragma("unroll") for (int j = 0; j < 4; ++j) { \
                    f32x4 a = __builtin_amdgcn_mfma_f32_16x16x32_bf16(src[t_][0], qf[j][0], (f32x4){0.f, 0.f, 0.f, 0.f}, 0, 0, 0); \
                    a = __builtin_amdgcn_mfma_f32_16x16x32_bf16(src[t_][1], qf[j][1], a, 0, 0, 0); \
                    const float wj = j == 0 ? w0 : j == 1 ? w1 : j == 2 ? w2 : w3; \
                    _Pragma("unroll") for (int i = 0; i < 4; ++i) s4[i] = fmaf(__int_as_float(max(__float_as_int(a[i]), 0)), wj, s4[i]); } \
                *(LAS f32x4*)(sc + fr * SCS + kt_ * 16 + (kt_ >> 1) * 4 + fq * 4) = s4; } } while (0)
                KI_LOAD(ka, 0);
                for (int i0 = 0; ktlo + wave + 8 * i0 < kthi; i0 += 4) { KI_LOAD(kb2, i0 + 2); KI_COMP(ka, i0); KI_LOAD(ka, i0 + 4); KI_COMP(kb2, i0 + 2); }
#undef KI_LOAD
#undef KI_COMP
                __syncthreads();
                if (c + 1 == nch) SEL_LOADQ(idxn);
                const LAS float* srow = sc + (2 * wave) * SCS + 36 * lane;
                const int ema = qa - 2048 * c - 32 * lane, emb = ema + 1;
                const int adma = (int)(ema >= 31 ? 0xffffffffu : ema < 0 ? 0u : ((2u << ema) - 1u)), admb = (int)(emb >= 31 ? 0xffffffffu : emb < 0 ? 0u : ((2u << emb) - 1u));
#pragma unroll
                for (int e4 = 0; e4 < 8; ++e4) {
                    const f32x4 va = *(const LAS f32x4*)(srow + 4 * e4), vb = *(const LAS f32x4*)(srow + SCS + 4 * e4);
#pragma unroll
                    for (int e = 0; e < 4; ++e) {
                        const int ii = c * 32 + e4 * 4 + e;
                        const unsigned ba = __float_as_uint(va[e]), bb = __float_as_uint(vb[e]);
                        ua[ii] = (ba ^ ((unsigned)((int)ba >> 31) | 0x80000000u)) & (unsigned)__builtin_amdgcn_sbfe(adma, e4 * 4 + e, 1);
                        ub[ii] = (bb ^ ((unsigned)((int)bb >> 31) | 0x80000000u)) & (unsigned)__builtin_amdgcn_sbfe(admb, e4 * 4 + e, 1);
                        vmaxa = max(vmaxa, ua[ii]); vmaxb = max(vmaxb, ub[ii]);
                    }
                }
                asm volatile("s_waitcnt lgkmcnt(0)" ::: "memory");
                __syncthreads();
            } else {
#pragma unroll
                for (int e = 0; e < 32; ++e) { ua[c * 32 + e] = 0u; ub[c * 32 + e] = 0u; }
            }
        }
        if (sub != 3) {
            select_query(ua, vmaxa, qa, b, lane, MASKb);
            select_query(ub, vmaxb, qb, b, lane, MASKb);
            asm volatile("s_waitcnt vmcnt(0)" ::: "memory");
            if (lane == 0) __hip_atomic_fetch_add(itemcnt + idx, 1u, __ATOMIC_RELAXED, __HIP_MEMORY_SCOPE_AGENT);
        }
    }
    __syncthreads();
#undef SEL_LOADQ
}

__device__ __forceinline__ void mixer_a(const bf16_t* __restrict__ Z, bf16_t* __restrict__ Y, const float* __restrict__ wc, int gtid, int NGT) {
#pragma unroll 2
    for (int it = gtid; it < MTOK * 32; it += NGT) {
        const int row = it >> 5, c8 = (it & 31) * 8, pos = row & (SEQ - 1);
        const bf16_t* zr = Z + (size_t)row * NZ;
        float acc[8];
#pragma unroll
        for (int i = 0; i < 8; ++i) acc[i] = 0.f;
#pragma unroll
        for (int j = 0; j < 3; ++j) {
            const int d = 2 - j; const float ok = (pos >= d) ? 1.f : 0.f;
            {
                const bf16_t* zz = zr - (size_t)((pos >= d) ? d : 0) * NZ;
                const u32x4 cc = *(const u32x4*)(zz + 256 + c8), hh = *(const u32x4*)(zz + 512 + c8);
                const f32x4 wa = *(const f32x4*)(wc + j * 256 + c8) * ok, wb = *(const f32x4*)(wc + j * 256 + c8 + 4) * ok;
                acc[0] += wa[0] * (bflo(cc.x) * bflo(hh.x)); acc[1] += wa[1] * (bfhi(cc.x) * bfhi(hh.x));
                acc[2] += wa[2] * (bflo(cc.y) * bflo(hh.y)); acc[3] += wa[3] * (bfhi(cc.y) * bfhi(hh.y));
                acc[4] += wb[0] * (bflo(cc.z) * bflo(hh.z)); acc[5] += wb[1] * (bfhi(cc.z) * bfhi(hh.z));
                acc[6] += wb[2] * (bflo(cc.w) * bflo(hh.w)); acc[7] += wb[3] * (bfhi(cc.w) * bfhi(hh.w));
            }
        }
        const u32x4 ab = *(const u32x4*)(zr + c8);
        u32x4 o;
        o.x = cvt_pk_bf16(bflo(ab.x) * acc[0], bfhi(ab.x) * acc[1]); o.y = cvt_pk_bf16(bflo(ab.y) * acc[2], bfhi(ab.y) * acc[3]);
        o.z = cvt_pk_bf16(bflo(ab.z) * acc[4], bfhi(ab.z) * acc[5]); o.w = cvt_pk_bf16(bflo(ab.w) * acc[6], bfhi(ab.w) * acc[7]);
        *(u32x4*)(Y + (size_t)row * DM + c8) = o;
    }
}

__device__ __forceinline__ void mixer_b(const bf16_t* __restrict__ Z, bf16_t* __restrict__ Y, const float* __restrict__ lng, const float* __restrict__ lnb, const float* __restrict__ wsp, const float* __restrict__ bsp,
                                        LAS unsigned char* lds, int wave, int lane, int bid, int G) {
    constexpr int VP = 132;
    LAS bf16_t* vt = (LAS bf16_t*)lds;
    const int fr = lane & 15, fq = lane >> 4;
    for (int un = bid; un < 256; un += G) {
        const int chunk = un >> 1, hf = un & 1; const size_t row0 = (size_t)chunk * 128;
#pragma unroll 8
        for (int k = 0; k < 16; ++k) {
            const int s = wave * 16 + k; const bf16_t* zr = Z + (row0 + s) * NZ + 4 * 256;
            const float v0 = bf2f(zr[lane]), v1 = bf2f(zr[lane + 64]), v2 = bf2f(zr[lane + 128]), v3 = bf2f(zr[lane + 192]);
            const float mean = wave_sum((v0 + v1) + (v2 + v3)) * (1.f / 256.f);
            const float d0 = v0 - mean, d1 = v1 - mean, d2 = v2 - mean, d3 = v3 - mean;
            const float var = wave_sum((d0 * d0 + d1 * d1) + (d2 * d2 + d3 * d3)) * (1.f / 256.f);
            const float rstd = __builtin_amdgcn_rsqf(var + 1e-5f);
            const int ca = hf * 128 + lane, cb = ca + 64;
            const float a = (hf ? d2 : d0) * rstd * lng[ca] + lnb[ca], b = (hf ? d3 : d1) * rstd * lng[cb] + lnb[cb];
            const unsigned pk = cvt_pk_bf16(a, b);
            vt[lane * VP + s] = (bf16_t)(pk & 0xffffu); vt[(lane + 64) * VP + s] = (bf16_t)(pk >> 16);
        }
        __syncthreads();
        const int t = wave * 16 + fr;
#pragma unroll
        for (int hh = 0; hh < 2; ++hh) {
            const int h = hf * 2 + hh; const float* W = wsp + (size_t)h * 128 * 128 + (size_t)t * 128;
            f32x4 acc[4];
#pragma unroll
            for (int nt = 0; nt < 4; ++nt) acc[nt] = (f32x4){0.f, 0.f, 0.f, 0.f};
#pragma unroll
            for (int ks = 0; ks < 4; ++ks) {
                const int s0 = ks * 32 + fq * 8;
                f32x4 wa = *(const f32x4*)(W + s0), wb = *(const f32x4*)(W + s0 + 4);
#pragma unroll
                for (int j = 0; j < 4; ++j) { if (s0 + j > t) wa[j] = 0.f; if (s0 + 4 + j > t) wb[j] = 0.f; }
                u32x4 wp; wp.x = cvt_pk_bf16(wa[0], wa[1]); wp.y = cvt_pk_bf16(wa[2], wa[3]); wp.z = cvt_pk_bf16(wb[0], wb[1]); wp.w = cvt_pk_bf16(wb[2], wb[3]);
                const bf16x8 wf = __builtin_bit_cast(bf16x8, wp);
#pragma unroll
                for (int nt = 0; nt < 4; ++nt) {
                    const LAS bf16_t* vp = vt + (hh * 64 + nt * 16 + fr) * VP + s0;
                    const u32x2 lo = *(const LAS u32x2*)vp, hi2 = *(const LAS u32x2*)(vp + 4);
                    u32x4 vv; vv.x = lo.x; vv.y = lo.y; vv.z = hi2.x; vv.w = hi2.y;
                    acc[nt] = __builtin_amdgcn_mfma_f32_16x16x32_bf16(__builtin_bit_cast(bf16x8, vv), wf, acc[nt], 0, 0, 0);
                }
            }
            const float bias = bsp[h * 128 + t]; const size_t row = row0 + t;
#pragma unroll
            for (int nt = 0; nt < 4; ++nt) {
                const int col = h * 64 + nt * 16 + fq * 4;
                const u32x2 uu = *(const u32x2*)(Z + row * NZ + 3 * 256 + col);
                u32x2 o; o.x = cvt_pk_bf16((acc[nt][0] + bias) * bflo(uu.x), (acc[nt][1] + bias) * bfhi(uu.x)); o.y = cvt_pk_bf16((acc[nt][2] + bias) * bflo(uu.y), (acc[nt][3] + bias) * bfhi(uu.y));
                *(u32x2*)(Y + row * DM + 256 + col) = o;
            }
        }
        __syncthreads();
    }
}

__device__ __forceinline__ void mixer_d(const bf16_t* Z, bf16_t* Y, const float* wcf, const float* bcf, const float* lng, const float* lnb,
                                        LAS unsigned char* lds, int tid, int wave, int lane, int bid, int G) {
    LAS float* yl = (LAS float*)lds;
    LAS float* cv = (LAS float*)(lds + 62 * 256 * 4);
    const int c = tid & 255, half = tid >> 8;
    float w[31];
#pragma unroll
    for (int j = 0; j < 31; ++j) w[j] = wcf[j * 256 + c];
    const float bias = bcf[c];
    const f32x4 g4 = *(const f32x4*)(lng + lane * 4), b4 = *(const f32x4*)(lnb + lane * 4);
    for (int un = bid; un < MTOK / 32; un += G) {
        const int row0 = un * 32, pos0 = row0 & (SEQ - 1);
#pragma unroll
        for (int i4 = 0; i4 < 4; ++i4) {
            const int it0 = tid + i4 * NTHREADS, it = it0 < 62 * 32 ? it0 : 62 * 32 - 1;
            const int rr = it >> 5, c8 = (it & 31) * 8, p = pos0 - 30 + rr;
            f32x4 o0, o1; const float ok = (p >= 0) ? 1.f : 0.f;
            {
                const bf16_t* zr = Z + (size_t)(row0 + ((p >= 0) ? rr - 30 : 0)) * NZ;
                const u32x4 a = *(const u32x4*)(zr + 9 * 256 + c8), gg = *(const u32x4*)(zr + 10 * 256 + c8);
                o0[0] = bflo(a.x) * sigmoidf_(bflo(gg.x)); o0[1] = bfhi(a.x) * sigmoidf_(bfhi(gg.x)); o0[2] = bflo(a.y) * sigmoidf_(bflo(gg.y)); o0[3] = bfhi(a.y) * sigmoidf_(bfhi(gg.y));
                o1[0] = bflo(a.z) * sigmoidf_(bflo(gg.z)); o1[1] = bfhi(a.z) * sigmoidf_(bfhi(gg.z)); o1[2] = bflo(a.w) * sigmoidf_(bflo(gg.w)); o1[3] = bfhi(a.w) * sigmoidf_(bfhi(gg.w));
            }
            *(LAS f32x4*)(yl + rr * 256 + c8) = o0 * ok; *(LAS f32x4*)(yl + rr * 256 + c8 + 4) = o1 * ok;
        }
        __syncthreads();
#pragma unroll
        for (int blk = 0; blk < 2; ++blk) {
            const int tb = half * 16 + blk * 8;
            float acc[8];
#pragma unroll
            for (int o = 0; o < 8; ++o) acc[o] = bias;
#pragma unroll
            for (int jj = 0; jj < 38; ++jj) {
                const float v = yl[(tb + jj) * 256 + c];
#pragma unroll
                for (int o = 0; o < 8; ++o) { const int j = jj - o; if (j >= 0 && j < 31) acc[o] += w[j] * v; }
            }
#pragma unroll
            for (int o = 0; o < 8; ++o) cv[(tb + o) * 256 + c] = acc[o];
        }
        __syncthreads();
#pragma unroll
        for (int k = 0; k < 4; ++k) {
            const int tt = wave * 4 + k;
            const f32x4 v = *(const LAS f32x4*)(cv + tt * 256 + lane * 4);
            const float mean = wave_sum((v[0] + v[1]) + (v[2] + v[3])) * (1.f / 256.f);
            const f32x4 d = v - mean;
            const float var = wave_sum((d[0] * d[0] + d[1] * d[1]) + (d[2] * d[2] + d[3] * d[3])) * (1.f / 256.f);
            const float rstd = __builtin_amdgcn_rsqf(var + 1e-5f);
            const f32x4 y = d * rstd * g4 + b4;
            u32x2 o; o.x = cvt_pk_bf16(y[0] * sigmoidf_(y[0]), y[1] * sigmoidf_(y[1])); o.y = cvt_pk_bf16(y[2] * sigmoidf_(y[2]), y[3] * sigmoidf_(y[3]));
            *(u32x2*)(Y + (size_t)(row0 + tt) * DM + 768 + lane * 4) = o;
        }
        __syncthreads();
    }
}

__device__ __forceinline__ void mixer_bd(const bf16_t* __restrict__ Z, bf16_t* __restrict__ Y, const float* __restrict__ lng, const float* __restrict__ lnb, const float* __restrict__ wsp, const float* __restrict__ bsp,
                                         const float* __restrict__ wcf, const float* __restrict__ bcf, const float* __restrict__ dlng, const float* __restrict__ dlnb,
                                         LAS unsigned char* lds, int tid, int wave, int lane, int bid, int G) {
    constexpr int VP = 132;
    LAS bf16_t* vt = (LAS bf16_t*)lds;
    LAS float* yl = (LAS float*)(lds + 36864);
    LAS float* cv = (LAS float*)(lds + 100352);
    const int fr = lane & 15, fq = lane >> 4;
    const int c = tid & 255, half = tid >> 8;
    float w[31];
#pragma unroll
    for (int j = 0; j < 31; ++j) w[j] = wcf[j * 256 + c];
    const float dbias = bcf[c];
    const f32x4 g4 = *(const f32x4*)(dlng + lane * 4), b4 = *(const f32x4*)(dlnb + lane * 4);
#define MD_GLU(dun) do { const int row0_ = (dun) * 32, pos0_ = row0_ & (SEQ - 1); \
        _Pragma("unroll") for (int i4 = 0; i4 < 4; ++i4) { \
            const int it0 = tid + i4 * NTHREADS, it = it0 < 62 * 32 ? it0 : 62 * 32 - 1; \
            const int rr = it >> 5, c8 = (it & 31) * 8, p = pos0_ - 30 + rr; \
            f32x4 o0, o1; const float ok = (p >= 0) ? 1.f : 0.f; \
            const bf16_t* zr = Z + (size_t)(row0_ + ((p >= 0) ? rr - 30 : 0)) * NZ; \
            const u32x4 a = *(const u32x4*)(zr + 9 * 256 + c8), gg = *(const u32x4*)(zr + 10 * 256 + c8); \
            o0[0] = bflo(a.x) * sigmoidf_(bflo(gg.x)); o0[1] = bfhi(a.x) * sigmoidf_(bfhi(gg.x)); o0[2] = bflo(a.y) * sigmoidf_(bflo(gg.y)); o0[3] = bfhi(a.y) * sigmoidf_(bfhi(gg.y)); \
            o1[0] = bflo(a.z) * sigmoidf_(bflo(gg.z)); o1[1] = bfhi(a.z) * sigmoidf_(bfhi(gg.z)); o1[2] = bflo(a.w) * sigmoidf_(bflo(gg.w)); o1[3] = bfhi(a.w) * sigmoidf_(bfhi(gg.w)); \
            *(LAS f32x4*)(yl + rr * 256 + c8) = o0 * ok; *(LAS f32x4*)(yl + rr * 256 + c8 + 4) = o1 * ok; } } while (0)
#define MD_CONV() do { _Pragma("unroll") for (int blk = 0; blk < 2; ++blk) { const int tb = half * 16 + blk * 8; float acc_[8]; \
            _Pragma("unroll") for (int o = 0; o < 8; ++o) acc_[o] = dbias; \
            _Pragma("unroll") for (int jj = 0; jj < 38; ++jj) { const float v = yl[(tb + jj) * 256 + c]; \
                _Pragma("unroll") for (int o = 0; o < 8; ++o) { const int j = jj - o; if (j >= 0 && j < 31) acc_[o] += w[j] * v; } } \
            _Pragma("unroll") for (int o = 0; o < 8; ++o) cv[(tb + o) * 256 + c] = acc_[o]; } } while (0)
#define MD_LN(dun) do { const int row0_ = (dun) * 32; _Pragma("unroll") for (int k = 0; k < 4; ++k) { const int tt = wave * 4 + k; \
            const f32x4 v = *(const LAS f32x4*)(cv + tt * 256 + lane * 4); \
            const float mean = wave_sum((v[0] + v[1]) + (v[2] + v[3])) * (1.f / 256.f); const f32x4 d = v - mean; \
            const float var = wave_sum((d[0] * d[0] + d[1] * d[1]) + (d[2] * d[2] + d[3] * d[3])) * (1.f / 256.f); const float rstd = __builtin_amdgcn_rsqf(var + 1e-5f); \
            const f32x4 y = d * rstd * g4 + b4; \
            u32x2 o; o.x = cvt_pk_bf16(y[0] * sigmoidf_(y[0]), y[1] * sigmoidf_(y[1])); o.y = cvt_pk_bf16(y[2] * sigmoidf_(y[2]), y[3] * sigmoidf_(y[3])); \
            *(u32x2*)(Y + (size_t)(row0_ + tt) * DM + 768 + lane * 4) = o; } } while (0)
    for (int un = bid; un < 256; un += G) {
        const int chunk = un >> 1, hf = un & 1; const size_t row0 = (size_t)chunk * 128;
        const int t = wave * 16 + fr; const size_t row = row0 + t;
        bf16x8 wf[2][4]; u32x2 uu[2][4]; float bias[2];
#pragma unroll
        for (int hh = 0; hh < 2; ++hh) {
            const int h = hf * 2 + hh; const float* W = wsp + (size_t)h * 128 * 128 + (size_t)t * 128;
            f32x4 wa[4], wb[4];
#pragma unroll
            for (int ks = 0; ks < 4; ++ks) { wa[ks] = *(const f32x4*)(W + ks * 32 + fq * 8); wb[ks] = *(const f32x4*)(W + ks * 32 + fq * 8 + 4); }
#pragma unroll
            for (int nt = 0; nt < 4; ++nt) uu[hh][nt] = *(const u32x2*)(Z + row * NZ + 3 * 256 + h * 64 + nt * 16 + fq * 4);
            bias[hh] = bsp[h * 128 + t];
#pragma unroll
            for (int ks = 0; ks < 4; ++ks) {
                const int s0 = ks * 32 + fq * 8;
#pragma unroll
                for (int j = 0; j < 4; ++j) { if (s0 + j > t) wa[ks][j] = 0.f; if (s0 + 4 + j > t) wb[ks][j] = 0.f; }
                u32x4 wp; wp.x = cvt_pk_bf16(wa[ks][0], wa[ks][1]); wp.y = cvt_pk_bf16(wa[ks][2], wa[ks][3]); wp.z = cvt_pk_bf16(wb[ks][0], wb[ks][1]); wp.w = cvt_pk_bf16(wb[ks][2], wb[ks][3]);
                wf[hh][ks] = __builtin_bit_cast(bf16x8, wp);
            }
        }
#pragma unroll 8
        for (int k = 0; k < 16; ++k) {
            const int s = wave * 16 + k; const bf16_t* zr = Z + (row0 + s) * NZ + 4 * 256;
            const float v0 = bf2f(zr[lane]), v1 = bf2f(zr[lane + 64]), v2 = bf2f(zr[lane + 128]), v3 = bf2f(zr[lane + 192]);
            const float mean = wave_sum((v0 + v1) + (v2 + v3)) * (1.f / 256.f);
            const float d0 = v0 - mean, d1 = v1 - mean, d2 = v2 - mean, d3 = v3 - mean;
            const float var = wave_sum((d0 * d0 + d1 * d1) + (d2 * d2 + d3 * d3)) * (1.f / 256.f);
            const float rstd = __builtin_amdgcn_rsqf(var + 1e-5f);
            const int ca = hf * 128 + lane, cb = ca + 64;
            const float a = (hf ? d2 : d0) * rstd * lng[ca] + lnb[ca], b = (hf ? d3 : d1) * rstd * lng[cb] + lnb[cb];
            const unsigned pk = cvt_pk_bf16(a, b);
            vt[lane * VP + s] = (bf16_t)(pk & 0xffffu); vt[(lane + 64) * VP + s] = (bf16_t)(pk >> 16);
        }
        MD_GLU(2 * un);
        __syncthreads();
#pragma unroll
        for (int hh = 0; hh < 2; ++hh) {
            const int h = hf * 2 + hh;
            f32x4 acc[4];
#pragma unroll
            for (int nt = 0; nt < 4; ++nt) acc[nt] = (f32x4){0.f, 0.f, 0.f, 0.f};
#pragma unroll
            for (int ks = 0; ks < 4; ++ks) {
                const int s0 = ks * 32 + fq * 8;
#pragma unroll
                for (int nt = 0; nt < 4; ++nt) {
                    const LAS bf16_t* vp = vt + (hh * 64 + nt * 16 + fr) * VP + s0;
                    const u32x2 lo = *(const LAS u32x2*)vp, hi2 = *(const LAS u32x2*)(vp + 4);
                    u32x4 vv; vv.x = lo.x; vv.y = lo.y; vv.z = hi2.x; vv.w = hi2.y;
                    acc[nt] = __builtin_amdgcn_mfma_f32_16x16x32_bf16(__builtin_bit_cast(bf16x8, vv), wf[hh][ks], acc[nt], 0, 0, 0);
                }
            }
#pragma unroll
            for (int nt = 0; nt < 4; ++nt) {
                const int col = h * 64 + nt * 16 + fq * 4; const u32x2 u2 = uu[hh][nt]; const float bs_ = bias[hh];
                u32x2 o; o.x = cvt_pk_bf16((acc[nt][0] + bs_) * bflo(u2.x), (acc[nt][1] + bs_) * bfhi(u2.x)); o.y = cvt_pk_bf16((acc[nt][2] + bs_) * bflo(u2.y), (acc[nt][3] + bs_) * bfhi(u2.y));
                *(u32x2*)(Y + row * DM + 256 + col) = o;
            }
        }
        MD_CONV();
        __syncthreads();
        MD_LN(2 * un);
        MD_GLU(2 * un + 1);
        __syncthreads();
        MD_CONV();
        __syncthreads();
        MD_LN(2 * un + 1);
        __syncthreads();
    }
#undef MD_GLU
#undef MD_CONV
#undef MD_LN
}

__device__ __forceinline__ void attn_phase(const bf16_t* Z, const bf16_t* Kb, const bf16_t* Vb, unsigned* MASKb, unsigned* itemcnt, bf16_t* Y, LAS unsigned char* lds, int wave, int lane, int bid, int G) {
    const int h = wave & 3, half = wave >> 2, ql = lane & 31, hi = lane >> 5;
    LAS float* mo = (LAS float*)lds + h * 2048;
    LAS float* mml = (LAS float*)(lds + 32768) + h * 128;
    LAS bf16_t* ost = (LAS bf16_t*)(lds + 36864) + h * (32 * 72);
    const unsigned NEGB = __float_as_uint(NEGF);
    for (int pu = bid; pu < 256; pu += G) {
        const int b = pu & 3, jj = pu >> 2;
        for (int rep = 0; rep < 2; ++rep) {
            const int qb = rep ? jj : 127 - jj;
            const int NT = qb + 1, n0 = (NT + 1) >> 1, tb = half ? n0 : 0, te = half ? NT : n0;
            if (wave == 0) {
                unsigned* c0 = itemcnt + (2 * qb) * 4 + b; unsigned* c1 = c0 + 4; unsigned spins = 0;
                while ((unsigned)__builtin_amdgcn_readfirstlane(__hip_atomic_load(c0, __ATOMIC_RELAXED, __HIP_MEMORY_SCOPE_AGENT)) < 8u ||
                       (unsigned)__builtin_amdgcn_readfirstlane(__hip_atomic_load(c1, __ATOMIC_RELAXED, __HIP_MEMORY_SCOPE_AGENT)) < 8u) { __builtin_amdgcn_s_sleep(4); if (++spins > (1u << 22)) break; }
                __builtin_amdgcn_fence(__ATOMIC_ACQUIRE, "agent");
            }
            __syncthreads();
            const size_t rowq = (size_t)b * SEQ + qb * 32 + ql;
            const bf16_t* zq = Z + rowq * NZ + 1280 + h * 64 + hi * 8;
            bf16x8 qf[4];
#pragma unroll
            for (int c = 0; c < 4; ++c) qf[c] = *(const bf16x8*)(zq + 16 * c);
            unsigned* mrow = MASKb + ((size_t)(b * 128 + qb) * 128) * 32 + ql;
            const bf16_t* kb = Kb + ((size_t)(b * 4 + h) * 128) * 2048 + ql * 16 + hi * 8;
            const bf16_t* vb = Vb + ((size_t)(b * 4 + h) * 128) * 2048 + ql * 16 + hi * 8;
            f32x16 o0, o1;
#pragma unroll
            for (int r = 0; r < 16; ++r) { o0[r] = 0.f; o1[r] = 0.f; }
            float m = NEGF, l = 0.f;
            bf16x8 kf[4]; bf16x8 vr[2][2]; unsigned mw = 0u;
#define ATT_LOAD(kt_) do { const bf16_t* kp_ = kb + (size_t)(kt_) * 2048; const bf16_t* vp_ = vb + (size_t)(kt_) * 2048; _Pragma("unroll") for (int c = 0; c < 4; ++c) kf[c] = *(const bf16x8*)(kp_ + c * 512); \
        _Pragma("unroll") for (int mt = 0; mt < 2; ++mt) _Pragma("unroll") for (int c = 0; c < 2; ++c) vr[mt][c] = *(const bf16x8*)(vp_ + (mt * 2 + c) * 512); \
        mw = __hip_atomic_load(mrow + (kt_) * 32, __ATOMIC_RELAXED, __HIP_MEMORY_SCOPE_AGENT); } while (0)
            if (tb < te) ATT_LOAD(tb);
            for (int kt = tb; kt < te; ++kt) {
                bf16x8 ck[4]; bf16x8 cvv[2][2];
#pragma unroll
                for (int c = 0; c < 4; ++c) ck[c] = kf[c];
#pragma unroll
                for (int mt = 0; mt < 2; ++mt)
#pragma unroll
                    for (int c = 0; c < 2; ++c) cvv[mt][c] = vr[mt][c];
                const unsigned cm = mw;
                { const int ktn = (kt + 1 < te) ? kt + 1 : kt; ATT_LOAD(ktn); }
                f32x16 s;
#pragma unroll
                for (int r = 0; r < 16; ++r) s[r] = 0.f;
                __builtin_amdgcn_s_setprio(1);
#pragma unroll
                for (int c = 0; c < 4; ++c) s = __builtin_amdgcn_mfma_f32_32x32x16_bf16(ck[c], qf[c], s, 0, 0, 0);
                __builtin_amdgcn_s_setprio(0);
                const int mws = (int)(cm >> (4 * hi));
                float rm = NEGF;
#pragma unroll
                for (int r = 0; r < 16; ++r) {
                    const unsigned sel = (unsigned)__builtin_amdgcn_sbfe(mws, (r & 3) + 8 * (r >> 2), 1);
                    s[r] = __uint_as_float((__float_as_uint(s[r]) & sel) | (NEGB & ~sel));
                    rm = fmaxf(rm, s[r]);
                }
                rm = fmaxf(rm, swap32(rm, hi));
                const float mn = fmaxf(m, rm);
                if (__any(mn > m)) {
                    const float al = __builtin_amdgcn_exp2f(m - mn); l *= al;
#pragma unroll
                    for (int r = 0; r < 16; ++r) { o0[r] *= al; o1[r] *= al; }
                    m = mn;
                }
                float ps = 0.f;
#pragma unroll
                for (int r = 0; r < 16; ++r) { s[r] = __builtin_amdgcn_exp2f(s[r] - m); ps += s[r]; }
                l += ps;
                u32x4 p0, p1;
                p0.x = cvt_pk_bf16(s[0], s[1]); p0.y = cvt_pk_bf16(s[2], s[3]); p0.z = cvt_pk_bf16(s[4], s[5]); p0.w = cvt_pk_bf16(s[6], s[7]);
                p1.x = cvt_pk_bf16(s[8], s[9]); p1.y = cvt_pk_bf16(s[10], s[11]); p1.z = cvt_pk_bf16(s[12], s[13]); p1.w = cvt_pk_bf16(s[14], s[15]);
                const bf16x8 pf0 = __builtin_bit_cast(bf16x8, p0), pf1 = __builtin_bit_cast(bf16x8, p1);
                __builtin_amdgcn_s_setprio(1);
                o0 = __builtin_amdgcn_mfma_f32_32x32x16_bf16(cvv[0][0], pf0, o0, 0, 0, 0); o1 = __builtin_amdgcn_mfma_f32_32x32x16_bf16(cvv[1][0], pf0, o1, 0, 0, 0);
                o0 = __builtin_amdgcn_mfma_f32_32x32x16_bf16(cvv[0][1], pf1, o0, 0, 0, 0); o1 = __builtin_amdgcn_mfma_f32_32x32x16_bf16(cvv[1][1], pf1, o1, 0, 0, 0);
                __builtin_amdgcn_s_setprio(0);
            }
#undef ATT_LOAD
            const float lt = l + swap32(l, hi);
            if (half == 1) {
#pragma unroll
                for (int r = 0; r < 16; ++r) { mo[r * 64 + lane] = o0[r]; mo[(16 + r) * 64 + lane] = o1[r]; }
                mml[lane] = m; mml[64 + lane] = lt;
            }
            __syncthreads();
            if (half == 0) {
                const float m1 = mml[lane], l1 = mml[64 + lane];
                const float mn = fmaxf(m, m1), a0 = __builtin_amdgcn_exp2f(m - mn), a1 = __builtin_amdgcn_exp2f(m1 - mn);
                const float inv = __builtin_amdgcn_rcpf(lt * a0 + l1 * a1), f0 = a0 * inv, f1 = a1 * inv;
#pragma unroll
                for (int r = 0; r < 16; ++r) { o0[r] = o0[r] * f0 + mo[r * 64 + lane] * f1; o1[r] = o1[r] * f0 + mo[(16 + r) * 64 + lane] * f1; }
#pragma unroll
                for (int r = 0; r < 16; r += 2) {
                    const int d = (r & 3) + 8 * (r >> 2) + 4 * hi;
                    *(LAS unsigned*)(ost + ql * 72 + d) = cvt_pk_bf16(o0[r], o0[r + 1]);
                    *(LAS unsigned*)(ost + ql * 72 + 32 + d) = cvt_pk_bf16(o1[r], o1[r + 1]);
                }
                LDS_WAIT();
                bf16_t* yo = Y + ((size_t)b * SEQ + qb * 32 + (lane >> 1)) * DM + 512 + h * 64 + (lane & 1) * 32;
#pragma unroll
                for (int k = 0; k < 4; ++k) { const u32x4 v = *(const LAS u32x4*)(ost + (lane >> 1) * 72 + (lane & 1) * 32 + k * 8); *(u32x4*)(yo + k * 8) = v; }
            }
            __syncthreads();
        }
    }
}

#define RLX_AGENT __ATOMIC_RELAXED, __HIP_MEMORY_SCOPE_AGENT
#define XB_TMO      128
#define XB_XCNT(j)  (256  + 64 * (j))
#define XB_XSUB(j)  (1280 + 64 * (j))
#define XB_XGEN(j)  (2304 + 64 * (j))
#define XB_TOP      3328
#define XB_TOPGEN   3392
#define XCD_BAR_WORDS 3456
#define XB_SPIN_CAP (1u << 18)

__device__ __forceinline__ unsigned xb_ld(unsigned* p)              { return __hip_atomic_load(p, __ATOMIC_RELAXED, __HIP_MEMORY_SCOPE_AGENT); }
__device__ __forceinline__ unsigned xb_add(unsigned* p, unsigned v) { return __hip_atomic_fetch_add(p, v, __ATOMIC_RELAXED, __HIP_MEMORY_SCOPE_AGENT); }
__device__ __forceinline__ unsigned xb_xcc_id() { return (unsigned)__builtin_amdgcn_s_getreg((3 << 11) | 20) & 0xFu; }
#define XB_SPIN(cond, bar) do { unsigned _sp = 0; while (cond) { __builtin_amdgcn_s_sleep(1); \
    if ((++_sp & 255u) == 0u) { if (xb_ld(&(bar)[XB_TMO])) break; if (_sp > XB_SPIN_CAP) { atomicAdd(&(bar)[XB_TMO], 1u); break; } } } } while (0)

struct XcdBarrier {
    unsigned* bar; unsigned x;
    volatile LAS unsigned* st;
};

__device__ __forceinline__ XcdBarrier xcd_barrier_post(unsigned* bar, volatile LAS unsigned* st, int tid) {
    XcdBarrier b; b.bar = bar; b.x = xb_xcc_id(); b.st = st;
    if (tid == 0) (void)xb_add(&bar[XB_XCNT(b.x)], 1u);
    return b;
}
__device__ __forceinline__ void xcd_barrier_complete(unsigned* bar, unsigned x, unsigned& nloc, unsigned& nx) {
    const unsigned G = gridDim.x * gridDim.y * gridDim.z;
    unsigned sum, cnt, mine, sp = 0u;
    for (;;) {
        sum = 0u; cnt = 0u; mine = 0u;
#pragma unroll
        for (unsigned j = 0; j < 16; ++j) { const unsigned c = xb_ld(&bar[XB_XCNT(j)]); sum += c; cnt += (c > 0u) ? 1u : 0u; mine = (j == x) ? c : mine; }
        if (sum == G) break;
        __builtin_amdgcn_s_sleep(1);
        if ((++sp & 255u) == 0u) { if (xb_ld(&bar[XB_TMO])) break; if (sp > XB_SPIN_CAP) { atomicAdd(&bar[XB_TMO], 1u); break; } }
    }
    nloc = mine > 0u ? mine : 1u; nx = cnt > 0u ? cnt : 1u;
}

__device__ __forceinline__ void xcd_barrier(const XcdBarrier& b, int tid) {
    asm volatile("s_waitcnt vmcnt(0)" ::: "memory");
    __syncthreads();
    if (tid == 0) {
        unsigned* bar = b.bar;
        __builtin_amdgcn_s_waitcnt(0);
        unsigned nloc = b.st[0], nx = b.st[1];
        if (nloc == 0u) { xcd_barrier_complete(bar, b.x, nloc, nx); b.st[0] = nloc; b.st[1] = nx; }
        const unsigned old = xb_add(&bar[XB_XSUB(b.x)], 1u);
        const unsigned gen = old / nloc;
        if (old + 1u == (gen + 1u) * nloc) {
            __builtin_amdgcn_fence(__ATOMIC_RELEASE, "agent");
            asm volatile("s_waitcnt vmcnt(0)" ::: "memory");
            const unsigned og = xb_add(&bar[XB_TOP], 1u);
            const unsigned tg = og / nx, target = (tg + 1u) * nx;
            if (og + 1u != target) XB_SPIN(xb_ld(&bar[XB_TOP]) < target, bar);
            __builtin_amdgcn_fence(__ATOMIC_ACQUIRE, "agent");
            xb_add(&bar[XB_XGEN(b.x)], 1u);
            asm volatile("s_waitcnt vmcnt(0)" ::: "memory");
        } else {
            XB_SPIN(xb_ld(&bar[XB_XGEN(b.x)]) == gen, bar);
            __builtin_amdgcn_fence(__ATOMIC_ACQUIRE, "agent");
            asm volatile("s_waitcnt vmcnt(0)" ::: "memory");
        }
    }
    __syncthreads();
}

#ifndef PROBE_PH
#define PROBE_PH -1
#endif
#ifndef PROBE_SUB
#define PROBE_SUB 0
#endif
__global__ void __launch_bounds__(NTHREADS, 2) mega_fwd(Args A_unused) {
    extern __shared__ __attribute__((aligned(16))) unsigned char lds_raw[];
    LAS unsigned char* lds = (LAS unsigned char*)lds_raw;
    cg::grid_group grid = cg::this_grid();
    const int ph_lo = kargs()->ph_lo, ph_hi = kargs()->ph_hi;
    const int wave0 = __builtin_amdgcn_readfirstlane((int)(threadIdx.x >> 6));
    if (threadIdx.x < 16) ((volatile LAS unsigned*)(lds + LDS_BAR_OFF))[threadIdx.x] = 0u;
    __syncthreads();
    if (ph_hi - ph_lo > 1) { (void)xcd_barrier_post((unsigned*)(kargs()->ws + WS_CTL), (volatile LAS unsigned*)(lds + LDS_BAR_OFF), (int)threadIdx.x); }
    const int st_hi = (PROBE_PH >= 0) ? ph_hi + 1 : ph_hi;
    for (int st = ph_lo; st < st_hi; ++st) {
        const int ph = (PROBE_PH >= 0 && st > PROBE_PH) ? st - 1 : st;
        const int sub = (PROBE_PH >= 0 && st == PROBE_PH + 1) ? PROBE_SUB : 0;
        KArgs A = kargs();
        int G = gridDim.x; asm volatile("" : "+s"(G));
        unsigned char* ws = A->ws;
        bf16_t* XB = (bf16_t*)(ws + WS_XB); bf16_t* Yb = (bf16_t*)(ws + WS_Y); bf16_t* Zb = (bf16_t*)(ws + WS_Z); bf16_t* HID = Zb; bf16_t* Vb = (bf16_t*)(ws + WS_VB); bf16_t* Kb = (bf16_t*)(ws + WS_KB); bf16_t* KIb = (bf16_t*)(ws + WS_KI);
        float* ssqA = (float*)(ws + WS_SSQA); float* ssqB = (float*)(ws + WS_SSQB);
        float* ropec = (float*)(ws + WS_ROPE); float* ropes = ropec + SEQ * 32;
        unsigned* MASKb = (unsigned*)(ws + WS_MASK);
        int bid = blockIdx.x, wave = wave0; asm volatile("" : "+s"(bid), "+s"(wave));
        int lane = (int)__builtin_amdgcn_mbcnt_hi(~0u, __builtin_amdgcn_mbcnt_lo(~0u, 0u)); asm volatile("" : "+v"(lane));
        const int tid = wave * 64 + lane;
        if (ph == 0) {
#ifndef NO_PRO
            prologue(A, ws, lds, tid, wave, lane, bid, G, sub);
#endif
        } else if (ph == NPHASE - 1) {
            const float* gfin = A->in[17];
            if (G != 256) for (int row = bid * NWAVES + wave; row < MTOK; row += G * NWAVES) {
                const XL2 XLS{(bf16_t*)(ws + WS_MASK), (bf16_t*)(ws + WS_KB)};
                const float rs = row_rs(ssqA, row); f32x4* p = (f32x4*)(A->out + (size_t)row * DM) + lane; const f32x4* g = (const f32x4*)gfin + lane;
                const u32x2* ph_ = (const u32x2*)(XB + (size_t)row * DM) + lane; const u32x2* pl_ = (const u32x2*)xl_row(XLS, row) + lane;
#pragma unroll
                for (int j = 0; j < 4; ++j) { const u32x2 h2 = ph_[64 * j]; u32x2 l2 = {0u, 0u}; if (RES_LO) l2 = pl_[64 * j]; f32x4 v; v[0] = bflo(h2.x) + bflo(l2.x); v[1] = bfhi(h2.x) + bfhi(l2.x); v[2] = bflo(h2.y) + bflo(l2.y); v[3] = bfhi(h2.y) + bfhi(l2.y); p[64 * j] = v * rs * g[64 * j]; }
            }
        } else {
            const int l = (ph - 1) / 6, k = (ph - 1) % 6;
            if (k == 0) {
                pg8::Gemm g{XB, (bf16_t*)(ws + WS_WIN) + l * WIN_L, MTOK, NZ, DM}; pg8::StaticOrder S; S.init(MTOK, NZ, G, bid);
                EpiZ E{Zb, Vb, Kb, KIb, ssqA, ropec, ropes};
#ifndef NO_G0
                pg8::gemm_phase<EpiZ, pg8::StaticOrder, true, true>(lds, g, S, E, tid);
#endif
            } else if (k == 1) {
#ifndef NO_SEL
                if (sub != 2 && sub < 6) select_phase(Zb, KIb, MASKb, (unsigned*)(ws + WS_CTL) + CW_ITEM + l * 1024, lds, wave, lane, bid, G, sub);
#endif
#ifndef NO_MA
                if (sub == 0 || sub == 2 || sub == 8) mixer_a(Zb, Yb, A->in[3] + l * 3 * 256, bid * NTHREADS + tid, G * NTHREADS);
#endif
#ifndef NO_MB
                if (sub == 0 || sub == 2 || sub == 6 || sub == 7) mixer_bd(Zb, Yb, A->in[4] + l * 256, A->in[5] + l * 256, A->in[6] + (size_t)l * 4 * 128 * 128, A->in[7] + l * 4 * 128,
                                                                      A->in[8] + l * 31 * 256, A->in[9] + l * 256, A->in[10] + l * 256, A->in[11] + l * 256, lds, tid, wave, lane, bid, G);
#endif
            } else if (k == 2) {
#ifndef NO_ATT
                attn_phase(Zb, Kb, Vb, MASKb, (unsigned*)(ws + WS_CTL) + CW_ITEM + l * 1024, Yb, lds, wave, lane, bid, G);
#endif
            } else if (k == 3 || k == 5) {
                const XL2 XLD{(bf16_t*)A->out, (bf16_t*)A->out + (size_t)8192 * DM}, XLS{(bf16_t*)(ws + WS_MASK), (bf16_t*)(ws + WS_KB)};
                const bool last = (l == NLAYER - 1);
                pg8::Gemm g{k == 3 ? Yb : HID, k == 3 ? (bf16_t*)(ws + WS_WOUT) + l * WOUT_L : (bf16_t*)(ws + WS_WDN) + l * WDN_L, MTOK, DM, k == 3 ? DM : FF}; pg8::StaticOrder S; S.init(MTOK, DM, G, bid);
                if (k == 3 && l == 0) {
                    EpiRes<true> E{A->in[0], XLD, last ? XLS : XLD, XB, ssqB};
                    pg8::gemm_phase<EpiRes<true>, pg8::StaticOrder, true, true>(lds, g, S, E, tid);
                } else if (k == 5 && last && G == 256) {
                    EpiFinal E{XB, XLS, A->out, A->in[17], ssqB, (unsigned*)(ws + WS_CTL) + CW_PANEL};
                    pg8::gemm_phase<EpiFinal, pg8::StaticOrder, false, true>(lds, g, S, E, tid);
                } else {
                    EpiRes<false> E{nullptr, (k == 5 && last) ? XLS : XLD, last ? XLS : XLD, XB, k == 3 ? ssqB : ssqA};
                    pg8::gemm_phase<EpiRes<false>, pg8::StaticOrder, true, true>(lds, g, S, E, tid);
                }
            } else if (k == 4) {
                pg8::Gemm g{XB, (bf16_t*)(ws + WS_WGU) + l * WGU_L, MTOK, NGU, DM}; pg8::StaticOrder S; S.init(MTOK, NGU, G, bid);
                EpiGU E{HID, ssqB};
#ifndef NO_G2
                pg8::gemm_phase<EpiGU, pg8::StaticOrder, true, true>(lds, g, S, E, tid);
#endif
                if (l == 0) {
                    const int nwg = (MTOK / 256) * (NGU / 256), rem = nwg % G;
                    if (rem == 0) convert_weights(A, ws, lds, wave, lane, CV_I_L - CV_I_DN, NLAYER * CV_I_L, bid * NWAVES + wave, G * NWAVES);
                    else if (bid >= rem) convert_weights(A, ws, lds, wave, lane, CV_I_L - CV_I_DN, NLAYER * CV_I_L, (bid - rem) * NWAVES + wave, (G - rem) * NWAVES);
                }
            }
        }
        const bool flag_seam = (PROBE_PH < 0) && ph >= 1 && ph <= 12 && ((ph - 1) % 6) == 1;
        if (st + 1 < st_hi && !flag_seam) {
            if (ph_hi > 100000) grid.sync();
            XcdBarrier xb; xb.bar = (unsigned*)(ws + WS_CTL); xb.x = xb_xcc_id(); xb.st = (volatile LAS unsigned*)(lds + LDS_BAR_OFF);
            xcd_barrier(xb, tid);
        }
    }
}

#ifndef MK_COOP
#define MK_COOP 1
#endif
extern "C" void kernel_launch(void* const* d_in, const int* in_sizes, int n_in, void* d_out, int out_size, void* d_ws, size_t ws_size, hipStream_t stream) {
    static int grid = 0;
    if (grid == 0) {
        if (n_in != 18 || out_size != MTOK * DM || ws_size < WS_END) { fprintf(stderr, "kernel_launch: unexpected shapes (n_in %d out %d ws %zu)\n", n_in, out_size, ws_size); grid = -1; return; }
        int dev = 0, cus = 0, per_cu = 0;
        if (hipGetDevice(&dev) != hipSuccess || hipDeviceGetAttribute(&cus, hipDeviceAttributeMultiprocessorCount, dev) != hipSuccess) { grid = -1; return; }
        if (hipFuncSetAttribute((const void*)mega_fwd, hipFuncAttributeMaxDynamicSharedMemorySize, LDS_BYTES) != hipSuccess) { fprintf(stderr, "kernel_launch: hipFuncSetAttribute failed\n"); grid = -1; return; }
        if (hipOccupancyMaxActiveBlocksPerMultiprocessor(&per_cu, (const void*)mega_fwd, NTHREADS, LDS_BYTES) != hipSuccess || per_cu < 1) { fprintf(stderr, "kernel_launch: occupancy query says %d\n", per_cu); (void)hipGetLastError(); }
        grid = cus;
    }
    if (grid < 0) return;
    if (hipMemsetAsync((char*)d_ws + WS_CTL, 0, CTL_BYTES, stream) != hipSuccess) { fprintf(stderr, "kernel_launch: memset failed\n"); return; }
    Args a{};
    for (int i = 0; i < 18; ++i) a.in[i] = (const float*)d_in[i];
    a.out = (float*)d_out; a.ws = (unsigned char*)d_ws;
#if MK_COOP
    a.ph_lo = 0; a.ph_hi = (grid == 256) ? NPHASE - 1 : NPHASE;
    void* args[] = {&a};
    hipError_t e = hipLaunchCooperativeKernel((const void*)mega_fwd, dim3(grid), dim3(NTHREADS), args, LDS_BYTES, stream);
    if (e != hipSuccess) fprintf(stderr, "cooperative launch failed: %s (grid %d)\n", hipGetErrorString(e), grid);
#else
    for (int ph = 0; ph < NPHASE; ++ph) {
        a.ph_lo = ph; a.ph_hi = ph + 1;
        hipLaunchKernelGGL(mega_fwd, dim3(grid), dim3(NTHREADS), LDS_BYTES, stream, a);
    }
#endif
}
```

```cpp
#include <hip/hip_runtime.h>
#include <hip/hip_cooperative_groups.h>
#include <cstdio>
#include <cstdint>
namespace cg = cooperative_groups;
namespace pg8 {
#define PG8_LAS __attribute__((address_space(3)))
typedef unsigned short bf16_t;
typedef short bf16x8 __attribute__((ext_vector_type(8)));
typedef float f32x4 __attribute__((ext_vector_type(4)));
typedef unsigned u32x4 __attribute__((ext_vector_type(4)));
constexpr int BM = 256, BK = 64, HALF = 128, HTB = HALF * BK * 2  , STAGE_BYTES = 8 * HTB, NXCD = 8, WGM = 8;

__host__ __device__ __forceinline__ int lds_byte(int r, int c) { const int st = (r >> 4) * 2 + (c >> 5), rr = r & 15, cc = c & 31, ob = rr * 64 + cc * 2; return st * 1024 + (ob ^ (((ob >> 9) & 1) << 5)); }
__host__ __device__ __forceinline__ void stage_rc(int b, int& R, int& C) { const int st = b / 1024, sb = b % 1024, swz = sb ^ (((sb >> 9) & 1) << 5); R = (st >> 1) * 16 + swz / 64; C = (st & 1) * 32 + (swz % 64) / 2; }
__host__ __device__ __forceinline__ int perm32(int rho) { const int n = rho >> 4, i = rho & 15; return 8 * (i >> 2) + 4 * n + (i & 3); }

struct Unit { int pm, pn; };
struct Gemm { const bf16_t* A; const bf16_t* Bt; int M, N, K; };

struct StaticOrder {
    int nM, nN, nwg, G, c;
    __host__ __device__ void init(int M, int N, int G_, int c_) { nM = M / BM; nN = N / BM; nwg = nM * nN; G = G_; c = c_; }
    __host__ __device__ bool next(int i, Unit& u) const {
        const long L = (long)i * G + c; if (L >= nwg) return false;
        int wgid = (int)L; { const int q = nwg / NXCD, r = nwg % NXCD, xcd = wgid % NXCD, off = wgid / NXCD; wgid = (xcd < r ? xcd * (q + 1) : r * (q + 1) + (xcd - r) * q) + off; }
        const int nig = WGM * nN, gid = wgid / nig, fm = gid * WGM, gsz = (nM - fm) < WGM ? (nM - fm) : WGM;
        u.pm = fm + ((wgid % nig) % gsz); u.pn = (wgid % nig) / gsz; return true;
    }
    __device__ __forceinline__ void a_ready(const Unit&) const {}
    __device__ __forceinline__ void done(const Unit&) const {}
};

__device__ __forceinline__ unsigned cvt_pk_bf16(float lo, float hi) { unsigned r; asm volatile("v_cvt_pk_bf16_f32 %0, %1, %2" : "=v"(r) : "v"(lo), "v"(hi)); return r; }
template <class Epi, class Sched, bool ALIGN_EPI = false, bool SP2 = false>
__device__ __forceinline__ void gemm_phase(PG8_LAS unsigned char* lds, const Gemm g, const Sched& S, const Epi& E, int tid_in) {
    int tid_l = tid_in; asm volatile("" : "+v"(tid_l));
    const int tid = tid_l, wid = __builtin_amdgcn_readfirstlane(tid >> 6), lane = tid & 63, wr = wid >> 2, wc = wid & 3, fr = lane & 15, fq = lane >> 4;
    const int K = g.K, nt = K / BK;
    unsigned voffA[2], voffB[2];
#pragma unroll
    for (int i = 0; i < 2; ++i) { int R, C; stage_rc(tid * 16 + i * 8192, R, C); const int Rb = Epi::PERM ? ((R & ~31) + perm32(R & 31)) : R;
        voffA[i] = (unsigned)(R * K + C) * 2u; voffB[i] = (unsigned)(Rb * K + C) * 2u; }
    const size_t kstep = (size_t)(BK * 2);
    const size_t hstep = (size_t)HALF * K * 2;
    const size_t tstep = 2 * hstep;
    const unsigned ldsw = (unsigned)wid * 1024u;
    const int aoff = lds_byte(wr * 64 + fr, fq * 8), boff = lds_byte(wc * 32 + fr, fq * 8);
#define PG8_SA(b, h) (((b) * 2 + (h)) * HTB)
#define PG8_SB(b, h) ((4 + (b) * 2 + (h)) * HTB)
#define PG8_STAGE(bufoff, gbase, voff) do { _Pragma("unroll") for (int _i = 0; _i < 2; ++_i) \
        __builtin_amdgcn_global_load_lds((const unsigned*)((const char*)(gbase) + (voff)[_i]), (PG8_LAS unsigned*)(lds + (bufoff) + ldsw + _i * 8192), 16, 0, 0); } while (0)
#define PG8_LDA(dst, b, h) do { _Pragma("unroll") for (int m = 0; m < 4; ++m) _Pragma("unroll") for (int k = 0; k < 2; ++k) dst[m][k] = *(const PG8_LAS bf16x8*)(lds + PG8_SA(b, h) + aoff + m * 2048 + k * 1024); } while (0)
#define PG8_LDB(dst, b, h) do { _Pragma("unroll") for (int n = 0; n < 2; ++n) _Pragma("unroll") for (int k = 0; k < 2; ++k) dst[n][k] = *(const PG8_LAS bf16x8*)(lds + PG8_SB(b, h) + boff + n * 2048 + k * 1024); } while (0)
#define PG8_MMA(ai, bj, At, Bt) do { __builtin_amdgcn_s_setprio(1); _Pragma("unroll") for (int m = 0; m < 4; ++m) _Pragma("unroll") for (int n = 0; n < 2; ++n) _Pragma("unroll") for (int k = 0; k < 2; ++k) \
        acc[ai][bj][m][n] = __builtin_amdgcn_mfma_f32_16x16x32_bf16(Bt[n][k], At[m][k], acc[ai][bj][m][n], 0, 0, 0); __builtin_amdgcn_s_setprio(0); } while (0)
#define PG8_WAIT_V(n) asm volatile("s_waitcnt vmcnt(" #n ")" ::: "memory")
#define PG8_WAIT_L(n) asm volatile("s_waitcnt lgkmcnt(" #n ")" ::: "memory")
#define PG8_BAR __builtin_amdgcn_s_barrier()
#define PG8_SCHED __builtin_amdgcn_sched_barrier(0)
    Unit cur, nxt; int ui = 0;
    if (!S.next(0, cur)) return;
    f32x4 acc[2][2][4][2];
#pragma unroll
    for (int a = 0; a < 2; ++a)
#pragma unroll
        for (int b = 0; b < 2; ++b)
#pragma unroll
            for (int m = 0; m < 4; ++m)
#pragma unroll
                for (int n = 0; n < 2; ++n) acc[a][b][m][n] = (f32x4){0.f, 0.f, 0.f, 0.f};
    bf16x8 At[4][2], B0[2][2], B1[2][2];
    const char* cA = (const char*)g.A + (size_t)cur.pm * tstep; const char* cB = (const char*)g.Bt + (size_t)cur.pn * tstep;
    S.a_ready(cur);
    if constexpr (SP2) {
        PG8_STAGE(PG8_SB(0, 0), cB, voffB); PG8_STAGE(PG8_SB(0, 1), cB + hstep, voffB); PG8_STAGE(PG8_SA(0, 0), cA, voffA); PG8_STAGE(PG8_SA(0, 1), cA + hstep, voffA);
        if (wr == 1) PG8_BAR;
        PG8_WAIT_V(2); PG8_BAR;
        PG8_STAGE(PG8_SB(1, 0), cB + kstep, voffB); PG8_STAGE(PG8_SA(1, 0), cA + kstep, voffA); PG8_STAGE(PG8_SB(1, 1), cB + hstep + kstep, voffB);
        PG8_WAIT_V(6); PG8_BAR;
    } else {
        PG8_STAGE(PG8_SB(0, 0), cB, voffB); PG8_STAGE(PG8_SA(0, 0), cA, voffA); PG8_STAGE(PG8_SB(0, 1), cB + hstep, voffB); PG8_STAGE(PG8_SA(0, 1), cA + hstep, voffA);
        if (wr == 1) PG8_BAR;
        PG8_WAIT_V(4); PG8_BAR;
        PG8_STAGE(PG8_SB(1, 0), cB + kstep, voffB); PG8_STAGE(PG8_SA(1, 0), cA + kstep, voffA); PG8_STAGE(PG8_SB(1, 1), cB + hstep + kstep, voffB);
        PG8_WAIT_V(6); PG8_BAR;
    }
    for (;;) {
        const bool has_next = S.next(ui + 1, nxt);
        const char* nA = has_next ? (const char*)g.A + (size_t)nxt.pm * tstep : cA; const char* nB = has_next ? (const char*)g.Bt + (size_t)nxt.pn * tstep : cB;
        for (int t = 0; t < nt; t += 2) {
            const bool last = (t == nt - 2);
            const char* a1 = cA + (size_t)(t + 1) * kstep;
            const char* a2 = last ? nA : cA + (size_t)(t + 2) * kstep; const char* b2 = last ? nB : cB + (size_t)(t + 2) * kstep;
            const char* a3 = a2 + kstep; const char* b3 = b2 + kstep;
            if (last && has_next) S.a_ready(nxt);
            if constexpr (SP2) {
            PG8_LDB(B0, 0, 0); PG8_LDB(B1, 0, 1); PG8_SCHED; PG8_LDA(At, 0, 0); PG8_STAGE(PG8_SA(1, 1), a1 + hstep, voffA);
            PG8_WAIT_V(8); PG8_WAIT_L(0); PG8_BAR; PG8_MMA(0, 0, At, B0); PG8_MMA(0, 1, At, B1); PG8_BAR; PG8_SCHED;
            PG8_LDA(At, 0, 1); PG8_STAGE(PG8_SB(0, 0), b2, voffB); PG8_STAGE(PG8_SB(0, 1), b2 + hstep, voffB); PG8_STAGE(PG8_SA(0, 0), a2, voffA);
            PG8_WAIT_V(8); PG8_WAIT_L(0); PG8_BAR; PG8_MMA(1, 0, At, B0); PG8_MMA(1, 1, At, B1); PG8_BAR; PG8_SCHED;
            PG8_LDB(B0, 1, 0); PG8_LDB(B1, 1, 1); PG8_SCHED; PG8_LDA(At, 1, 0); PG8_STAGE(PG8_SA(0, 1), a2 + hstep, voffA);
            PG8_WAIT_V(8); PG8_WAIT_L(0); PG8_BAR; PG8_MMA(0, 0, At, B0); PG8_MMA(0, 1, At, B1); PG8_BAR; PG8_SCHED;
            PG8_LDA(At, 1, 1); PG8_STAGE(PG8_SB(1, 0), b3, voffB); PG8_STAGE(PG8_SB(1, 1), b3 + hstep, voffB); PG8_STAGE(PG8_SA(1, 0), a3, voffA);
            PG8_WAIT_V(8); PG8_WAIT_L(0); PG8_BAR; PG8_MMA(1, 0, At, B0); PG8_MMA(1, 1, At, B1); PG8_BAR; PG8_SCHED;
            } else {
            PG8_LDB(B0, 0, 0); PG8_SCHED; PG8_LDA(At, 0, 0); PG8_STAGE(PG8_SA(1, 1), a1 + hstep, voffA);
            PG8_WAIT_L(8); PG8_BAR; PG8_WAIT_L(0); PG8_MMA(0, 0, At, B0); PG8_BAR; PG8_SCHED;
            PG8_LDB(B1, 0, 1); PG8_STAGE(PG8_SB(0, 0), b2, voffB);
            PG8_BAR; PG8_WAIT_L(0); PG8_MMA(0, 1, At, B1); PG8_BAR;
            PG8_LDA(At, 0, 1); PG8_STAGE(PG8_SA(0, 0), a2, voffA);
            PG8_BAR; PG8_WAIT_L(0); PG8_MMA(1, 0, At, B0); PG8_BAR; PG8_SCHED;
            PG8_STAGE(PG8_SB(0, 1), b2 + hstep, voffB);
            PG8_WAIT_V(6); PG8_BAR; PG8_MMA(1, 1, At, B1); PG8_BAR;
            PG8_LDB(B0, 1, 0); PG8_SCHED; PG8_LDA(At, 1, 0); PG8_STAGE(PG8_SA(0, 1), a2 + hstep, voffA);
            PG8_WAIT_L(8); PG8_BAR; PG8_WAIT_L(0); PG8_MMA(0, 0, At, B0); PG8_BAR; PG8_SCHED;
            PG8_LDB(B1, 1, 1); PG8_STAGE(PG8_SB(1, 0), b3, voffB);
            PG8_BAR; PG8_WAIT_L(0); PG8_MMA(0, 1, At, B1); PG8_BAR;
            PG8_LDA(At, 1, 1); PG8_STAGE(PG8_SA(1, 0), a3, voffA);
            PG8_BAR; PG8_WAIT_L(0); PG8_MMA(1, 0, At, B0); PG8_BAR; PG8_SCHED;
            PG8_STAGE(PG8_SB(1, 1), b3 + hstep, voffB);
            PG8_WAIT_V(6); PG8_BAR; PG8_MMA(1, 1, At, B1); PG8_BAR;
            }
        }
        if constexpr (ALIGN_EPI) { if (wr == 0) PG8_BAR; }
        if constexpr (!Epi::AFTER_DRAIN) { E(acc, cur, wr, wc, fr, fq); S.done(cur); }
        if (!has_next) break;
#pragma unroll
        for (int a = 0; a < 2; ++a)
#pragma unroll
            for (int b = 0; b < 2; ++b)
#pragma unroll
                for (int m = 0; m < 4; ++m)
#pragma unroll
                    for (int n = 0; n < 2; ++n) acc[a][b][m][n] = (f32x4){0.f, 0.f, 0.f, 0.f};
        cur = nxt; cA = nA; cB = nB; ++ui;
        if constexpr (ALIGN_EPI) { if (wr == 1) PG8_BAR; }
    }
    PG8_WAIT_V(0);
    if constexpr (!ALIGN_EPI) { if (wr == 0) PG8_BAR; }
    PG8_BAR;
    if constexpr (Epi::AFTER_DRAIN) { E.fused(acc, cur, wr, wc, fr, fq, lds, wid, lane); S.done(cur); }
#undef PG8_SA
#undef PG8_SB
#undef PG8_STAGE
#undef PG8_LDA
#undef PG8_LDB
#undef PG8_MMA
#undef PG8_WAIT_V
#undef PG8_WAIT_L
#undef PG8_BAR
#undef PG8_SCHED
}
}
#define PROBE_PH -1
#define PROBE_SUB 0

#define LAS __attribute__((address_space(3)))
typedef unsigned short bf16_t;
typedef short bf16x8 __attribute__((ext_vector_type(8)));
typedef float f32x4 __attribute__((ext_vector_type(4)));
typedef float f32x16 __attribute__((ext_vector_type(16)));
typedef unsigned u32x4 __attribute__((ext_vector_type(4)));
typedef unsigned u32x2 __attribute__((ext_vector_type(2)));
using pg8::cvt_pk_bf16;

constexpr int NWAVES = 8, NTHREADS = 512;
constexpr int BATCH = 4, SEQ = 4096, DM = 1024, MTOK = BATCH * SEQ, NZ = 3072, FF = 2816, NGU = 2 * FF, NLAYER = 2, INC = 2884;
constexpr float C2 = 0.125f * 1.4426950408889634f;
constexpr float NEGF = -1e30f;
constexpr int LDS_BYTES = 153600;
constexpr int NPHASE = 14;

constexpr size_t MiB = 1u << 20;
constexpr size_t WS_WIN = 0, WS_WOUT = 12 * MiB, WS_WGU = 16 * MiB, WS_WDN = 38 * MiB, WS_ROPE = 49 * MiB, WS_SSQA = 50 * MiB, WS_SSQB = 51 * MiB,
                 WS_MASK = 52 * MiB, WS_VB = 60 * MiB, WS_XB = 68 * MiB, WS_Y = 100 * MiB, WS_Z = 132 * MiB, WS_KB = 228 * MiB, WS_KI = 236 * MiB, WS_CTL = 250 * MiB, WS_END = 251 * MiB;
constexpr size_t CTL_BYTES = 40960;
constexpr int CW_ITEM = 8192;
constexpr int CW_PANEL = 4096;
constexpr int LDS_BAR_OFF = LDS_BYTES - 64;
constexpr size_t WIN_L = (size_t)NZ * DM, WOUT_L = (size_t)DM * DM, WGU_L = (size_t)NGU * DM, WDN_L = (size_t)DM * FF;

__device__ const double INVF[32] = {1, 0.74989420933245587, 0.56234132519034907, 0.42169650342858223, 0.31622776601683794, 0.23713737056616552, 0.17782794100389229, 0.1333521432163324,
    0.10000000000000001, 0.074989420933245579, 0.056234132519034911, 0.042169650342858224, 0.031622776601683791, 0.023713737056616554, 0.017782794100389229, 0.013335214321633241,
    0.01, 0.0074989420933245579, 0.005623413251903491, 0.0042169650342858229, 0.0031622776601683794, 0.0023713737056616554, 0.0017782794100389228, 0.0013335214321633241,
    0.001, 0.00074989420933245586, 0.0005623413251903491, 0.00042169650342858224, 0.00031622776601683794, 0.00023713737056616554, 0.00017782794100389227, 0.0001333521432163324};

#define LDS_WAIT() asm volatile("s_waitcnt lgkmcnt(0)" ::: "memory")
__device__ __forceinline__ float bf2f(unsigned short h) { return __uint_as_float((unsigned)h << 16); }
__device__ __forceinline__ float bflo(unsigned w) { return __uint_as_float(w << 16); }
__device__ __forceinline__ float bfhi(unsigned w) { return __uint_as_float(w & 0xffff0000u); }
#define DPPF(v, ctrl, rm) __int_as_float(__builtin_amdgcn_update_dpp(0, __float_as_int(v), ctrl, rm, 0xf, false))
__device__ __forceinline__ float wave_sum(float v) {
    v += DPPF(v, 0x111, 0xf); v += DPPF(v, 0x112, 0xf); v += DPPF(v, 0x114, 0xf); v += DPPF(v, 0x118, 0xf);
    v += DPPF(v, 0x142, 0xa); v += DPPF(v, 0x143, 0xc);
    return __int_as_float(__builtin_amdgcn_readlane(__float_as_int(v), 63));
}
__device__ __forceinline__ unsigned wave_umax(unsigned v) {
#define DPPU(v, ctrl, rm) (unsigned)__builtin_amdgcn_update_dpp(0, (int)(v), ctrl, rm, 0xf, false)
    v = max(v, DPPU(v, 0x111, 0xf)); v = max(v, DPPU(v, 0x112, 0xf)); v = max(v, DPPU(v, 0x114, 0xf)); v = max(v, DPPU(v, 0x118, 0xf));
    v = max(v, DPPU(v, 0x142, 0xa)); v = max(v, DPPU(v, 0x143, 0xc));
    return (unsigned)__builtin_amdgcn_readlane((int)v, 63);
#undef DPPU
}
__device__ __forceinline__ float swap32(float v, int hi) { auto rr = __builtin_amdgcn_permlane32_swap(__float_as_uint(v), __float_as_uint(v), false, false); return hi ? __uint_as_float(rr[0]) : __uint_as_float(rr[1]); }
__device__ __forceinline__ float row_rs(const float* ssq, int r) {
    const f32x4* p = (const f32x4*)(ssq + (size_t)r * 16); const f32x4 a = p[0], b = p[1], c = p[2], d = p[3];
    const float s = (((a.x + a.y) + (a.z + a.w)) + ((b.x + b.y) + (b.z + b.w))) + (((c.x + c.y) + (c.z + c.w)) + ((d.x + d.y) + (d.z + d.w)));
    return __builtin_amdgcn_rsqf(s * (1.f / 1024.f) + 1e-6f);
}
__device__ __forceinline__ float xor16_add(float v) { auto rr = __builtin_amdgcn_permlane16_swap(__float_as_uint(v), __float_as_uint(v), false, false); return __uint_as_float(rr[0]) + __uint_as_float(rr[1]); }
__device__ __forceinline__ float xor32_add(float v) { auto rr = __builtin_amdgcn_permlane32_swap(__float_as_uint(v), __float_as_uint(v), false, false); return __uint_as_float(rr[0]) + __uint_as_float(rr[1]); }
__device__ __forceinline__ void row_rs8(const float* ssq, int rbase  , int fq, float (&rs)[8]) {
    f32x4 p[8];
#pragma unroll
    for (int i = 0; i < 8; ++i) p[i] = *(const f32x4*)(ssq + (size_t)(rbase + (i >> 2) * 128 + (i & 3) * 16) * 16 + fq * 4);
#pragma unroll
    for (int i = 0; i < 8; ++i) { float s = (p[i].x + p[i].y) + (p[i].z + p[i].w); s = xor16_add(s); s = xor32_add(s); rs[i] = __builtin_amdgcn_rsqf(s * (1.f / 1024.f) + 1e-6f); }
}
__device__ __forceinline__ float sigmoidf_(float x) { return __builtin_amdgcn_rcpf(1.f + __expf(-x)); }

struct EpiZ {
    static constexpr bool PERM = true, AFTER_DRAIN = false;
    bf16_t* Z; bf16_t* Vb; bf16_t* Kb; bf16_t* KIb; const float* ssq; const float* ropec; const float* ropes;
    __device__ __forceinline__ void operator()(const f32x4 (&acc)[2][2][4][2], const pg8::Unit& u, int wr, int wc, int fr, int fq) const {
        const int pn = u.pn; const bool rope_tile = (pn == 5) || (pn == 6) || (pn == 8) || (pn == 11);
        float rs8[8]; row_rs8(ssq, u.pm * 256 + wr * 64 + fr, fq, rs8);
#pragma unroll
        for (int ai = 0; ai < 2; ++ai)
        {
            f32x4 rc[4], rsn[4]; const int ri0 = ((wc * 32 + fq * 8) & 63) >> 1;
            if (rope_tile) {
#pragma unroll
                for (int m = 0; m < 4; ++m) { const int pos_ = (u.pm * 256 + ai * 128 + wr * 64 + m * 16 + fr) & (SEQ - 1); rc[m] = *(const f32x4*)(ropec + pos_ * 32 + ri0); rsn[m] = *(const f32x4*)(ropes + pos_ * 32 + ri0); }
            }
#pragma unroll
            for (int m = 0; m < 4; ++m) {
                const int r = u.pm * 256 + ai * 128 + wr * 64 + m * 16 + fr; const float rs = rs8[ai * 4 + m]; const int pos = r & (SEQ - 1);
#pragma unroll
                for (int bj = 0; bj < 2; ++bj) {
                    const int cl = bj * 128 + wc * 32 + fq * 8;
                    f32x4 v0 = acc[ai][bj][m][0] * rs, v1 = acc[ai][bj][m][1] * rs;
                    if (rope_tile && (pn != 11 || cl < 64)) {
                        const f32x4 c4 = rc[m], s4 = rsn[m];
                        float a, b;
                        a = v0[0]; b = v0[1]; v0[0] = a * c4[0] - b * s4[0]; v0[1] = b * c4[0] + a * s4[0];
                        a = v0[2]; b = v0[3]; v0[2] = a * c4[1] - b * s4[1]; v0[3] = b * c4[1] + a * s4[1];
                        a = v1[0]; b = v1[1]; v1[0] = a * c4[2] - b * s4[2]; v1[1] = b * c4[2] + a * s4[2];
                        a = v1[2]; b = v1[3]; v1[2] = a * c4[3] - b * s4[3]; v1[3] = b * c4[3] + a * s4[3];
                    }
                    u32x4 w; w.x = cvt_pk_bf16(v0[0], v0[1]); w.y = cvt_pk_bf16(v0[2], v0[3]); w.z = cvt_pk_bf16(v1[0], v1[1]); w.w = cvt_pk_bf16(v1[2], v1[3]);
                    const int b = r >> 12;
                    if (pn == 7) {
                        const int hh = cl >> 6, d0 = cl & 63, kt = pos >> 5, k32 = pos & 31, c = k32 >> 4, kk = k32 & 15, vh = (kk >> 2) & 1, e = (kk & 3) + 4 * (kk >> 3);
                        bf16_t* vp = Vb + ((((size_t)((b * 4 + hh) * 128 + kt) * 2 + (d0 >> 5)) * 2 + c) * 32 + (d0 & 31)) * 16 + vh * 8 + e;
                        vp[0 * 16] = (bf16_t)(w.x & 0xffffu); vp[1 * 16] = (bf16_t)(w.x >> 16); vp[2 * 16] = (bf16_t)(w.y & 0xffffu); vp[3 * 16] = (bf16_t)(w.y >> 16);
                        vp[4 * 16] = (bf16_t)(w.z & 0xffffu); vp[5 * 16] = (bf16_t)(w.z >> 16); vp[6 * 16] = (bf16_t)(w.w & 0xffffu); vp[7 * 16] = (bf16_t)(w.w >> 16);
                    } else if (pn == 6) {
                        const int hh = cl >> 6, c = (cl >> 4) & 3, kh = (cl >> 3) & 1;
                        *(u32x4*)(Kb + ((((size_t)((b * 4 + hh) * 128 + (pos >> 5)) * 4 + c) * 32 + (pos & 31)) * 16 + kh * 8)) = w;
                    } else if (pn == 11) {
                        if (cl < 64) *(u32x4*)(KIb + ((((size_t)(b * 256 + (pos >> 4)) * 2 + (cl >> 5)) * 16 + (pos & 15)) * 32 + ((cl >> 3) & 3) * 8)) = w;
                        else if (cl == 64) *(u32x4*)(Z + (size_t)r * NZ + pn * 256 + cl) = w;
                    } else {
                        *(u32x4*)(Z + (size_t)r * NZ + pn * 256 + cl) = w;
                    }
                }
                asm volatile("" ::: "memory");
            }
        }
    }
};
#ifndef RES_LO
#define RES_LO 0
#endif
struct XL2 { bf16_t* a; bf16_t* b; };
__device__ __forceinline__ bf16_t* xl_row(const XL2& x, int r) { return r < 8192 ? x.a + (size_t)r * DM : x.b + (size_t)(r - 8192) * DM; }
__device__ __forceinline__ void split_hilo(const f32x4& v0, const f32x4& v1, u32x4& hi, u32x4& lo) {
    hi.x = cvt_pk_bf16(v0[0], v0[1]); hi.y = cvt_pk_bf16(v0[2], v0[3]); hi.z = cvt_pk_bf16(v1[0], v1[1]); hi.w = cvt_pk_bf16(v1[2], v1[3]);
    lo.x = cvt_pk_bf16(v0[0] - bflo(hi.x), v0[1] - bfhi(hi.x)); lo.y = cvt_pk_bf16(v0[2] - bflo(hi.y), v0[3] - bfhi(hi.y));
    lo.z = cvt_pk_bf16(v1[0] - bflo(hi.z), v1[1] - bfhi(hi.z)); lo.w = cvt_pk_bf16(v1[2] - bflo(hi.w), v1[3] - bfhi(hi.w));
}
__device__ __forceinline__ void join_hilo(const u32x4& hi, const u32x4& lo, f32x4& v0, f32x4& v1) {
    v0[0] = bflo(hi.x) + bflo(lo.x); v0[1] = bfhi(hi.x) + bfhi(lo.x); v0[2] = bflo(hi.y) + bflo(lo.y); v0[3] = bfhi(hi.y) + bfhi(lo.y);
    v1[0] = bflo(hi.z) + bflo(lo.z); v1[1] = bfhi(hi.z) + bfhi(lo.z); v1[2] = bflo(hi.w) + bflo(lo.w); v1[3] = bfhi(hi.w) + bfhi(lo.w);
}
template <bool BASE_F32> struct EpiRes {
    static constexpr bool PERM = true, AFTER_DRAIN = false;
    const float* basef; XL2 xlin; XL2 xlout; bf16_t* xb; float* ssq;
    __device__ __forceinline__ void operator()(const f32x4 (&acc)[2][2][4][2], const pg8::Unit& u, int wr, int wc, int fr, int fq) const {
#pragma unroll
        for (int ai = 0; ai < 2; ++ai)
#pragma unroll
            for (int m = 0; m < 4; ++m) {
                const int r = u.pm * 256 + ai * 128 + wr * 64 + m * 16 + fr; float sq = 0.f;
#pragma unroll
                for (int bj = 0; bj < 2; ++bj) {
                    const int col = u.pn * 256 + bj * 128 + wc * 32 + fq * 8; const size_t off = (size_t)r * DM + col;
                    f32x4 b0, b1;
                    if (BASE_F32) { b0 = *(const f32x4*)(basef + off); b1 = *(const f32x4*)(basef + off + 4); }
                    else { const u32x4 hi_in = *(const u32x4*)(xb + off); u32x4 lo_in = {0u, 0u, 0u, 0u}; if (RES_LO) lo_in = *(const u32x4*)(xl_row(xlin, r) + col); join_hilo(hi_in, lo_in, b0, b1); }
                    const f32x4 v0 = acc[ai][bj][m][0] + b0, v1 = acc[ai][bj][m][1] + b1;
                    u32x4 hi, lo; split_hilo(v0, v1, hi, lo);
                    *(u32x4*)(xb + off) = hi; if (RES_LO) *(u32x4*)(xl_row(xlout, r) + col) = lo;
                    sq += ((v0[0] * v0[0] + v0[1] * v0[1]) + (v0[2] * v0[2] + v0[3] * v0[3])) + ((v1[0] * v1[0] + v1[1] * v1[1]) + (v1[2] * v1[2] + v1[3] * v1[3]));
                }
                sq = xor16_add(sq); sq = xor32_add(sq);
                if (fq == 0) ssq[(size_t)r * 16 + u.pn * 4 + wc] = sq;
                if (m == 3) asm volatile("" ::: "memory");
            }
    }
};
struct EpiFinal {
    static constexpr bool PERM = true, AFTER_DRAIN = true;
    const bf16_t* xb; XL2 xlin; float* out; const float* gfin; float* xbuf; unsigned* cnt;
    __device__ __forceinline__ void fused(f32x4 (&acc)[2][2][4][2], const pg8::Unit& u, int wr, int wc, int fr, int fq, LAS unsigned char* lds, int wid, int lane) const {
        LAS float* P = (LAS float*)lds;
        LAS float* S = (LAS float*)(lds + 4096);
#pragma unroll
        for (int ai = 0; ai < 2; ++ai)
#pragma unroll
            for (int m = 0; m < 4; ++m) {
                const int rl = ai * 128 + wr * 64 + m * 16 + fr; float sq = 0.f;
#pragma unroll
                for (int bj = 0; bj < 2; ++bj) {
                    const size_t off = (size_t)(u.pm * 256 + rl) * DM + u.pn * 256 + bj * 128 + wc * 32 + fq * 8;
                    f32x4 b0, b1; { const u32x4 hi_in = *(const u32x4*)(xb + off); u32x4 lo_in = {0u, 0u, 0u, 0u}; if (RES_LO) lo_in = *(const u32x4*)(xl_row(xlin, u.pm * 256 + rl) + (off - (size_t)(u.pm * 256 + rl) * DM)); join_hilo(hi_in, lo_in, b0, b1); }
                    const f32x4 v0 = acc[ai][bj][m][0] + b0, v1 = acc[ai][bj][m][1] + b1;
                    acc[ai][bj][m][0] = v0; acc[ai][bj][m][1] = v1;
                    sq += ((v0[0] * v0[0] + v0[1] * v0[1]) + (v0[2] * v0[2] + v0[3] * v0[3])) + ((v1[0] * v1[0] + v1[1] * v1[1]) + (v1[2] * v1[2] + v1[3] * v1[3]));
                }
                sq = xor16_add(sq); sq = xor32_add(sq);
                if (fq == 0) P[rl * 4 + wc] = sq;
                if (m == 3) asm volatile("" ::: "memory");
            }
        asm volatile("s_waitcnt lgkmcnt(0)" ::: "memory"); __builtin_amdgcn_s_barrier(); asm volatile("" ::: "memory");
        const int tid = wid * 64 + lane;
        if (tid < 256) {
            const float s = (P[tid * 4 + 0] + P[tid * 4 + 1]) + (P[tid * 4 + 2] + P[tid * 4 + 3]);
            __hip_atomic_store(xbuf + (size_t)(u.pm * 256 + tid) * 4 + u.pn, s, __ATOMIC_RELAXED, __HIP_MEMORY_SCOPE_AGENT);
        }
        asm volatile("s_waitcnt vmcnt(0)" ::: "memory");
        if (lane == 0) __hip_atomic_fetch_add(cnt + 64 * u.pm, 1u, __ATOMIC_RELAXED, __HIP_MEMORY_SCOPE_AGENT);
        if (wid == 0) {
            unsigned spins = 0;
            while ((unsigned)__builtin_amdgcn_readfirstlane(__hip_atomic_load(cnt + 64 * u.pm, __ATOMIC_RELAXED, __HIP_MEMORY_SCOPE_AGENT)) < 32u) { __builtin_amdgcn_s_sleep(2); if (++spins > (1u << 22)) break; }
            __builtin_amdgcn_fence(__ATOMIC_ACQUIRE, "agent");
        }
        asm volatile("s_waitcnt vmcnt(0) lgkmcnt(0)" ::: "memory"); __builtin_amdgcn_s_barrier(); asm volatile("" ::: "memory");
        if (tid < 256) {
            const float* xp = xbuf + (size_t)(u.pm * 256 + tid) * 4;
            const float a = __hip_atomic_load(xp + 0, __ATOMIC_RELAXED, __HIP_MEMORY_SCOPE_AGENT), b = __hip_atomic_load(xp + 1, __ATOMIC_RELAXED, __HIP_MEMORY_SCOPE_AGENT),
                        c = __hip_atomic_load(xp + 2, __ATOMIC_RELAXED, __HIP_MEMORY_SCOPE_AGENT), d = __hip_atomic_load(xp + 3, __ATOMIC_RELAXED, __HIP_MEMORY_SCOPE_AGENT);
            S[tid] = __builtin_amdgcn_rsqf(((a + b) + (c + d)) * (1.f / 1024.f) + 1e-6f);
        }
        asm volatile("s_waitcnt vmcnt(0) lgkmcnt(0)" ::: "memory"); __builtin_amdgcn_s_barrier(); asm volatile("" ::: "memory");
#pragma unroll
        for (int ai = 0; ai < 2; ++ai)
#pragma unroll
            for (int m = 0; m < 4; ++m) {
                const int rl = ai * 128 + wr * 64 + m * 16 + fr; const float rs = S[rl];
#pragma unroll
                for (int bj = 0; bj < 2; ++bj) {
                    const int col = u.pn * 256 + bj * 128 + wc * 32 + fq * 8; const size_t off = (size_t)(u.pm * 256 + rl) * DM + col;
                    *(f32x4*)(out + off) = acc[ai][bj][m][0] * rs * *(const f32x4*)(gfin + col); *(f32x4*)(out + off + 4) = acc[ai][bj][m][1] * rs * *(const f32x4*)(gfin + col + 4);
                }
            }
    }
};
struct EpiGU {
    static constexpr bool PERM = true, AFTER_DRAIN = false;
    bf16_t* H; const float* ssq;
    __device__ __forceinline__ void operator()(const f32x4 (&acc)[2][2][4][2], const pg8::Unit& u, int wr, int wc, int fr, int fq) const {
        float rs8[8]; row_rs8(ssq, u.pm * 256 + wr * 64 + fr, fq, rs8);
#pragma unroll
        for (int ai = 0; ai < 2; ++ai)
#pragma unroll
            for (int m = 0; m < 4; ++m) {
                const int r = u.pm * 256 + ai * 128 + wr * 64 + m * 16 + fr; const float rs = rs8[ai * 4 + m];
                u32x4 w;
#pragma unroll
                for (int n = 0; n < 2; ++n) {
                    const f32x4 g = acc[ai][0][m][n] * rs, up = acc[ai][1][m][n] * rs;
                    const float h0 = g[0] * sigmoidf_(g[0]) * up[0], h1 = g[1] * sigmoidf_(g[1]) * up[1], h2 = g[2] * sigmoidf_(g[2]) * up[2], h3 = g[3] * sigmoidf_(g[3]) * up[3];
                    if (n == 0) { w.x = cvt_pk_bf16(h0, h1); w.y = cvt_pk_bf16(h2, h3); } else { w.z = cvt_pk_bf16(h0, h1); w.w = cvt_pk_bf16(h2, h3); }
                }
                *(u32x4*)(H + (size_t)r * FF + u.pn * 128 + wc * 32 + fq * 8) = w;
            }
    }
};

__device__ __forceinline__ int il64(int p) { return (p & 1) ? (p >> 1) + 32 : (p >> 1); }
__device__ __forceinline__ void conv_item(const float* src, int ld, float cs, const float* gk, int K, bf16_t* WT, int n0, int k0, LAS float* scr, int lane) {
    float v[32];
    const float* sp = src + (size_t)(k0 + (lane >> 5)) * ld;
#pragma unroll
    for (int i = 0; i < 32; ++i) v[i] = sp[(size_t)(2 * i) * ld];
    if (gk) {
        float g[32];
#pragma unroll
        for (int i = 0; i < 32; ++i) g[i] = gk[k0 + 2 * i + (lane >> 5)];
#pragma unroll
        for (int i = 0; i < 32; ++i) v[i] *= g[i];
    }
#pragma unroll
    for (int i = 0; i < 32; ++i) scr[(2 * i + (lane >> 5)) * 33 + (lane & 31)] = v[i] * cs;
    LDS_WAIT();
    const int c = lane & 7;
#pragma unroll
    for (int j = 0; j < 4; ++j) {
        const int n = (lane >> 3) + 8 * j; const LAS float* s = scr + (8 * c) * 33 + n;
        u32x4 o; o.x = cvt_pk_bf16(s[0 * 33], s[1 * 33]); o.y = cvt_pk_bf16(s[2 * 33], s[3 * 33]); o.z = cvt_pk_bf16(s[4 * 33], s[5 * 33]); o.w = cvt_pk_bf16(s[6 * 33], s[7 * 33]);
        *(u32x4*)(WT + (size_t)(n0 + n) * K + k0 + 8 * c) = o;
    }
    LDS_WAIT();
}

struct Args { const float* in[18]; float* out; unsigned char* ws; int ph_lo, ph_hi; };
typedef const Args __attribute__((address_space(4)))* KArgs;
__device__ __forceinline__ KArgs kargs() { KArgs p = (KArgs)__builtin_amdgcn_kernarg_segment_ptr(); asm volatile("" : "+s"(p)); return p; }

constexpr int CV_I_IN = 16 * 96, CV_I_OUT = 16 * 32, CV_I_GU = 16 * 176, CV_I_DN = 44 * 32, CV_I_L = CV_I_IN + CV_I_OUT + CV_I_GU + CV_I_DN;
__device__ __forceinline__ void convert_weights(KArgs A, unsigned char* ws, LAS unsigned char* lds, int wave, int lane, int it_lo, int it_hi, int gw, int NGW) {
    LAS float* scr = (LAS float*)(lds + wave * 16384);
    constexpr int I_IN = CV_I_IN, I_OUT = CV_I_OUT, I_GU = CV_I_GU, I_L = CV_I_L;
    for (int it = it_lo + gw; it < it_hi; it += NGW) {
        const int l = it / I_L; int r = it % I_L;
        if (r < I_IN) {
            const int kb = r / 96, nb = r % 96, n = nb * 32 + (lane & 31), tile = n >> 8, c = n & 255;
            int src; float cs = 1.f;
            if (tile <= 4) src = n;
            else if (tile == 5) { src = 1280 + (c & ~63) + il64(c & 63); cs = C2; }
            else if (tile == 6) src = 1536 + (c & ~63) + il64(c & 63);
            else if (tile == 7) src = 1792 + c;
            else if (tile == 8) src = 2048 + (c & ~63) + il64(c & 63);
            else if (tile == 9) src = 2372 + c;
            else if (tile == 10) src = 2628 + c;
            else { if (c < 64) src = 2304 + il64(c); else if (c < 68) { src = 2368 + (c - 64); cs = 0.0625f; } else { src = 0; cs = 0.f; } }
            const float* wl = A->in[2] + (size_t)l * DM * INC;
            conv_item(wl + src, INC, cs, A->in[1] + l * DM, DM, (bf16_t*)(ws + WS_WIN) + l * WIN_L, nb * 32, kb * 64, scr, lane);
            continue;
        }
        r -= I_IN;
        if (r < I_OUT) {
            const int kb = r / 32, nb = r % 32;
            conv_item(A->in[12] + (size_t)l * DM * DM + nb * 32 + (lane & 31), DM, 1.f, nullptr, DM, (bf16_t*)(ws + WS_WOUT) + l * WOUT_L, nb * 32, kb * 64, scr, lane);
            continue;
        }
        r -= I_OUT;
        if (r < I_GU) {
            const int kb = r / 176, nb = r % 176, n = nb * 32 + (lane & 31), c = n & 255, col = (n >> 8) * 128 + (c & 127);
            const float* wsrc = (c < 128 ? A->in[14] : A->in[15]) + (size_t)l * DM * FF + col;
            conv_item(wsrc, FF, 1.f, A->in[13] + l * DM, DM, (bf16_t*)(ws + WS_WGU) + l * WGU_L, nb * 32, kb * 64, scr, lane);
            continue;
        }
        r -= I_GU;
        { const int kb = r / 32, nb = r % 32;
          conv_item(A->in[16] + (size_t)l * FF * DM + nb * 32 + (lane & 31), DM, 1.f, nullptr, FF, (bf16_t*)(ws + WS_WDN) + l * WDN_L, nb * 32, kb * 64, scr, lane); }
    }
}
__device__ __forceinline__ void prologue(KArgs A, unsigned char* ws, LAS unsigned char* lds, int tid, int wave, int lane, int bid, int G, int sub) {
    const int gw = bid * NWAVES + wave, NGW = G * NWAVES;
    if (sub == 0 || sub == 1) convert_weights(A, ws, lds, wave, lane, 0, CV_I_L - CV_I_DN, gw, NGW);
    float* ropec = (float*)(ws + WS_ROPE); float* ropes = ropec + SEQ * 32;
    if (sub == 0 || sub == 2) for (int idx = bid * NTHREADS + tid; idx < SEQ * 32; idx += G * NTHREADS) {
        const int pos = idx >> 5, i = idx & 31;
        const double ang = (double)pos * INVF[i];
        const double nn = rint(ang * 0.15915494309189535);
        const double x = ang - nn * 6.283185307179586477, x2 = x * x;
        double c = 1.0, s = 1.0, tc = 1.0, ts = 1.0;
#pragma unroll
        for (int k = 1; k <= 15; ++k) { tc *= -x2 * (1.0 / (double)((2 * k - 1) * (2 * k))); c += tc; ts *= -x2 * (1.0 / (double)((2 * k) * (2 * k + 1))); s += ts; }
        ropec[idx] = (float)c; ropes[idx] = (float)(s * x);
    }
    const float* x = A->in[0]; bf16_t* XB = (bf16_t*)(ws + WS_XB); float* ssqA = (float*)(ws + WS_SSQA);
    if (sub == 0 || sub == 3) for (int row0 = gw; row0 < MTOK; row0 += 4 * NGW) {
        f32x4 v[4][4];
#pragma unroll
        for (int rr = 0; rr < 4; ++rr) { const int row = min(row0 + rr * NGW, MTOK - 1); const f32x4* xr = (const f32x4*)(x + (size_t)row * DM) + lane;
#pragma unroll
            for (int j = 0; j < 4; ++j) v[rr][j] = xr[64 * j]; }
#pragma unroll
        for (int rr = 0; rr < 4; ++rr) { const int row = row0 + rr * NGW; if (row < MTOK) { u32x2* d = (u32x2*)(XB + (size_t)row * DM) + lane; float s = 0.f;
#pragma unroll
            for (int j = 0; j < 4; ++j) { const f32x4 t = v[rr][j]; s += (t.x * t.x + t.y * t.y) + (t.z * t.z + t.w * t.w); u32x2 o; o.x = cvt_pk_bf16(t.x, t.y); o.y = cvt_pk_bf16(t.z, t.w); d[64 * j] = o; }
            s = wave_sum(s);
            if (lane < 16) ssqA[(size_t)row * 16 + lane] = lane == 0 ? s : 0.f; } }
    }
}

__device__ __forceinline__ int wave_isum(int v) {
    v += __builtin_amdgcn_update_dpp(0, v, 0x111, 0xf, 0xf, false);
    v += __builtin_amdgcn_update_dpp(0, v, 0x112, 0xf, 0xf, false);
    v += __builtin_amdgcn_update_dpp(0, v, 0x114, 0xf, 0xf, false);
    v += __builtin_amdgcn_update_dpp(0, v, 0x118, 0xf, 0xf, false);
    v += __builtin_amdgcn_update_dpp(0, v, 0x142, 0xa, 0xf, false);
    v += __builtin_amdgcn_update_dpp(0, v, 0x143, 0xc, 0xf, false);
    return __builtin_amdgcn_readlane(v, 63);
}
#define CNT4(c0, c1, t, x0, x1, x2, x3) do { unsigned long long m0_, m1_, m2_, m3_, j0_, j1_; \
    asm("v_cmp_le_u32_e64 %[m0], %[tt], %[a0]\n\tv_cmp_le_u32_e64 %[m1], %[tt], %[a1]\n\tv_cmp_le_u32_e64 %[m2], %[tt], %[a2]\n\tv_cmp_le_u32_e64 %[m3], %[tt], %[a3]\n\t" \
        "v_addc_co_u32_e64 %[k0], %[j0], 0, %[k0], %[m0]\n\tv_addc_co_u32_e64 %[k1], %[j1], 0, %[k1], %[m1]\n\t" \
        "v_addc_co_u32_e64 %[k0], %[j0], 0, %[k0], %[m2]\n\tv_addc_co_u32_e64 %[k1], %[j1], 0, %[k1], %[m3]" \
        : [k0] "+v"(c0), [k1] "+v"(c1), [m0] "=&s"(m0_), [m1] "=&s"(m1_), [m2] "=&s"(m2_), [m3] "=&s"(m3_), [j0] "=&s"(j0_), [j1] "=&s"(j1_) \
        : [tt] "s"(t), [a0] "v"(x0), [a1] "v"(x1), [a2] "v"(x2), [a3] "v"(x3)); } while (0)
#define BIT4(w, t, x0, x1, x2, x3) do { unsigned long long m0_, m1_, m2_, m3_, j0_; \
    asm("v_cmp_gt_u32_e64 %[m0], %[a0], %[tt]\n\tv_cmp_gt_u32_e64 %[m1], %[a1], %[tt]\n\tv_cmp_gt_u32_e64 %[m2], %[a2], %[tt]\n\tv_cmp_gt_u32_e64 %[m3], %[a3], %[tt]\n\t" \
        "v_addc_co_u32_e64 %[k0], %[j0], %[k0], %[k0], %[m0]\n\tv_addc_co_u32_e64 %[k0], %[j0], %[k0], %[k0], %[m1]\n\t" \
        "v_addc_co_u32_e64 %[k0], %[j0], %[k0], %[k0], %[m2]\n\tv_addc_co_u32_e64 %[k0], %[j0], %[k0], %[k0], %[m3]" \
        : [k0] "+v"(w), [m0] "=&s"(m0_), [m1] "=&s"(m1_), [m2] "=&s"(m2_), [m3] "=&s"(m3_), [j0] "=&s"(j0_) \
        : [tt] "s"(t), [a0] "v"(x0), [a1] "v"(x1), [a2] "v"(x2), [a3] "v"(x3)); } while (0)
__device__ __forceinline__ int count_ge(const unsigned (&u)[64], unsigned cand, int nblk) {
    int c0 = 0, c1 = 0;
    const unsigned ts = __builtin_amdgcn_readfirstlane(cand);
#pragma unroll
    for (int B = 0; B < 2; ++B) {
        if (B < nblk) {
#pragma unroll
            for (int i = 0; i < 32; i += 4) CNT4(c0, c1, ts, u[B * 32 + i], u[B * 32 + i + 1], u[B * 32 + i + 2], u[B * 32 + i + 3]);
        }
    }
    return wave_isum(c0 + c1);
}
__device__ __forceinline__ float keyval(unsigned k) { return __uint_as_float((k & 0x80000000u) ? (k ^ 0x80000000u) : ~k); }
__device__ __forceinline__ unsigned valkey(float f) { const unsigned b = __float_as_uint(f); return b ^ ((unsigned)((int)b >> 31) | 0x80000000u); }
__device__ __forceinline__ void select_query(const unsigned (&u)[64], unsigned vmax, int q, int b, int lane, unsigned* MASKb) {
    const int n = q + 1, nblk = (n + 2047) >> 11;
    unsigned T = 0u, TG = 0u; int rrem = 0;
    if (n > 256) {
        const unsigned kmax = wave_umax(vmax);
        const unsigned K0 = 0x80000000u;
        bool exact = false, done = false;
        unsigned lo = 0u, hi = 0u; float Llo = 1.f, Lhi = 1.f;
        const float L256 = 8.0028150156f;
        const int cpos = count_ge(u, K0 + 1u, nblk);
        if (cpos == 256) { T = K0 + 1u; exact = true; done = true; }
        else if (cpos > 256) { lo = K0 + 1u; Llo = __log2f((float)cpos) - L256; hi = kmax + 1u; Lhi = L256 + 1.f; }
        else {
            const int c0 = count_ge(u, K0, nblk);
            if (c0 >= 256) { T = K0; exact = (c0 == 256); done = true; }
            else {
                unsigned vmin = 0xffffffffu;
#pragma unroll
                for (int i = 0; i < 64; ++i) vmin = min(vmin, u[i] - 1u);
                lo = ~wave_umax(~vmin) + 1u; Llo = __log2f((float)n) - L256; hi = K0; Lhi = L256 - __log2f(fmaxf((float)c0, 0.5f));
            }
        }
        int it = 0, last = 0;
        while (!done) {
            if (hi - lo <= 1u) { T = lo; exact = false; break; }
            const float vlo = keyval(lo), vhi = keyval(hi);
            const float frac = (it >= 9 && (it & 1)) ? 0.5f : Llo * __builtin_amdgcn_rcpf(Llo + Lhi);
            unsigned mid = valkey(vlo + frac * (vhi - vlo));
            if (mid <= lo) mid = lo + 1u;
            if (mid >= hi) mid = hi - 1u;
            mid = __builtin_amdgcn_readfirstlane(mid);
            const int c = count_ge(u, mid, nblk);
            if (c == 256) { T = mid; exact = true; break; }
            if (c > 256) { lo = mid; Llo = __log2f((float)c) - L256; if (last == 1) Lhi *= 0.5f; last = 1; }
            else { hi = mid; Lhi = L256 - __log2f(fmaxf((float)c, 0.5f)); if (last == 2) Llo *= 0.5f; last = 2; }
            ++it;
        }
        if (exact) TG = T - 1u; else { TG = T; rrem = 256 - count_ge(u, T + 1u, nblk); }
    }
    int tbase = 0;
#pragma unroll
    for (int B = 0; B < 2; ++B) {
        if (B < nblk) {
            unsigned w = 0u; const unsigned tgs = __builtin_amdgcn_readfirstlane(TG);
#pragma unroll
            for (int e = 31; e >= 3; e -= 4) BIT4(w, tgs, u[B * 32 + e], u[B * 32 + e - 1], u[B * 32 + e - 2], u[B * 32 + e - 3]);
            if (rrem > 0) {
                int ec = 0;
#pragma unroll
                for (int e = 0; e < 32; ++e) ec += (u[B * 32 + e] == T) ? 1 : 0;
                int incl = ec;
#pragma unroll
                for (int o = 1; o < 64; o <<= 1) { const int t = __shfl_up(incl, o); if (lane >= o) incl += t; }
                const int total = __builtin_amdgcn_readlane(incl, 63);
                const int quota = rrem - tbase - (incl - ec);
                int taken = 0;
#pragma unroll
                for (int e = 0; e < 32; ++e) { const bool is = (u[B * 32 + e] == T) && (taken < quota); w |= is ? (1u << e) : 0u; taken += is ? 1 : 0; }
                tbase += total;
            }
            if (64 * B + lane <= (q >> 5)) __hip_atomic_store(MASKb + ((size_t)(b * 128 + (q >> 5)) * 128 + 64 * B + lane) * 32 + (q & 31), w, __ATOMIC_RELAXED, __HIP_MEMORY_SCOPE_AGENT);
        }
    }
}
__device__ __forceinline__ void select_phase(const bf16_t* Z, const bf16_t* KIb, unsigned* MASKb, unsigned* itemcnt, LAS unsigned char* lds, int wave_in, int lane_in, int bid, int G, int sub) {
    constexpr int SCS = 2312;
    LAS float* sc = (LAS float*)lds;
    const int nrounds = (1024 + G - 1) / G;
    bf16x8 qf[4][2]; u32x2 wraw;
#define SEL_LOADQ(idx_) do { const int i_ = (idx_) < 1023 ? (idx_) : 1023; const bf16_t* zq_ = Z + ((size_t)(i_ & 3) * SEQ + (i_ >> 2) * 16 + (lane_in & 15)) * NZ; \
        _Pragma("unroll") for (int j = 0; j < 4; ++j) _Pragma("unroll") for (int ks = 0; ks < 2; ++ks) qf[j][ks] = *(const bf16x8*)(zq_ + 2048 + j * 64 + ks * 32 + (lane_in >> 4) * 8); \
        wraw = *(const u32x2*)(zq_ + 2816 + 64); } while (0)
    SEL_LOADQ(bid);
    for (int rd = 0; rd < nrounds; ++rd) {
        const int idx = rd * G + ((rd & 1) ? (G - 1 - bid) : bid);
        const int idxn = (rd + 1) * G + (((rd + 1) & 1) ? (G - 1 - bid) : bid);
        if (idx >= 1024) continue;
        const int b = idx & 3, q0 = (idx >> 2) * 16;
        int wave = wave_in, lane = lane_in; asm volatile("" : "+s"(wave), "+v"(lane));
        const int fr = lane & 15, fq = lane >> 4;
        const float w0 = bflo(wraw.x), w1 = bfhi(wraw.x), w2 = bflo(wraw.y), w3 = bfhi(wraw.y);
        const int nkt = (q0 >> 4) + 1, nch = (nkt + 127) >> 7;
        const bf16_t* kib = KIb + (size_t)b * 256 * 1024 + fr * 32 + fq * 8;
        const int qa = q0 + 2 * wave, qb = qa + 1;
        unsigned ua[64], ub[64]; unsigned vmaxa = 0u, vmaxb = 0u;
#pragma unroll
        for (int c = 0; c < 2; ++c) {
            if (c < nch) {
                const int ktlo = 128 * c, kthi = min(nkt, ktlo + 128);
                bf16x8 ka[2][2], kb2[2][2];
#define KI_LOAD(dst, i0) do { _Pragma("unroll") for (int t_ = 0; t_ < 2; ++t_) { int kt_ = ktlo + wave + 8 * ((i0) + t_); kt_ = kt_ < kthi ? kt_ : kthi - 1; \
                dst[t_][0] = *(const bf16x8*)(kib + (size_t)kt_ * 1024); dst[t_][1] = *(const bf16x8*)(kib + (size_t)kt_ * 1024 + 512); } } while (0)
#define KI_COMP(src, i0) do { _Pragma("unroll") for (int t_ = 0; t_ < 2; ++t_) { int kt_ = ktlo + wave + 8 * ((i0) + t_); kt_ = (kt_ < kthi ? kt_ : kthi - 1) - ktlo; \
                f32x4 s4 = {0.f, 0.f, 0.f, 0.f}; \
                _Pragma("unroll") for (int j = 0; j < 4; ++j) { \
                    f32x4 a = __builtin_amdgcn_mfma_f32_16x16x32_bf16(src[t_][0], qf[j][0], (f32x4){0.f, 0.f, 0.f, 0.f}, 0, 0, 0); \
                    a = __builtin_amdgcn_mfma_f32_16x16x32_bf16(src[t_][1], qf[j][1], a, 0, 0, 0); \
                    const float wj = j == 0 ? w0 : j == 1 ? w1 : j == 2 ? w2 : w3; \
                    _Pragma("unroll") for (int i = 0; i < 4; ++i) s4[i] = fmaf(__int_as_float(max(__float_as_int(a[i]), 0)), wj, s4[i]); } \
                *(LAS f32x4*)(sc + fr * SCS + kt_ * 16 + (kt_ >> 1) * 4 + fq * 4) = s4; } } while (0)
                KI_LOAD(ka, 0);
                for (int i0 = 0; ktlo + wave + 8 * i0 < kthi; i0 += 4) { KI_LOAD(kb2, i0 + 2); KI_COMP(ka, i0); KI_LOAD(ka, i0 + 4); KI_COMP(kb2, i0 + 2); }
#undef KI_LOAD
#undef KI_COMP
                __syncthreads();
                if (c + 1 == nch) SEL_LOADQ(idxn);
                const LAS float* srow = sc + (2 * wave) * SCS + 36 * lane;
                const int ema = qa - 2048 * c - 32 * lane, emb = ema + 1;
                const int adma = (int)(ema >= 31 ? 0xffffffffu : ema < 0 ? 0u : ((2u << ema) - 1u)), admb = (int)(emb >= 31 ? 0xffffffffu : emb < 0 ? 0u : ((2u << emb) - 1u));
#pragma unroll
                for (int e4 = 0; e4 < 8; ++e4) {
                    const f32x4 va = *(const LAS f32x4*)(srow + 4 * e4), vb = *(const LAS f32x4*)(srow + SCS + 4 * e4);
#pragma unroll
                    for (int e = 0; e < 4; ++e) {
                        const int ii = c * 32 + e4 * 4 + e;
                        const unsigned ba = __float_as_uint(va[e]), bb = __float_as_uint(vb[e]);
                        ua[ii] = (ba ^ ((unsigned)((int)ba >> 31) | 0x80000000u)) & (unsigned)__builtin_amdgcn_sbfe(adma, e4 * 4 + e, 1);
                        ub[ii] = (bb ^ ((unsigned)((int)bb >> 31) | 0x80000000u)) & (unsigned)__builtin_amdgcn_sbfe(admb, e4 * 4 + e, 1);
                        vmaxa = max(vmaxa, ua[ii]); vmaxb = max(vmaxb, ub[ii]);
                    }
                }
                asm volatile("s_waitcnt lgkmcnt(0)" ::: "memory");
                __syncthreads();
            } else {
#pragma unroll
                for (int e = 0; e < 32; ++e) { ua[c * 32 + e] = 0u; ub[c * 32 + e] = 0u; }
            }
        }
        if (sub != 3) {
            select_query(ua, vmaxa, qa, b, lane, MASKb);
            select_query(ub, vmaxb, qb, b, lane, MASKb);
            asm volatile("s_waitcnt vmcnt(0)" ::: "memory");
            if (lane == 0) __hip_atomic_fetch_add(itemcnt + idx, 1u, __ATOMIC_RELAXED, __HIP_MEMORY_SCOPE_AGENT);
        }
    }
    __syncthreads();
#undef SEL_LOADQ
}

__device__ __forceinline__ void mixer_a(const bf16_t* __restrict__ Z, bf16_t* __restrict__ Y, const float* __restrict__ wc, int gtid, int NGT) {
#pragma unroll 2
    for (int it = gtid; it < MTOK * 32; it += NGT) {
        const int row = it >> 5, c8 = (it & 31) * 8, pos = row & (SEQ - 1);
        const bf16_t* zr = Z + (size_t)row * NZ;
        float acc[8];
#pragma unroll
        for (int i = 0; i < 8; ++i) acc[i] = 0.f;
#pragma unroll
        for (int j = 0; j < 3; ++j) {
            const int d = 2 - j; const float ok = (pos >= d) ? 1.f : 0.f;
            {
                const bf16_t* zz = zr - (size_t)((pos >= d) ? d : 0) * NZ;
                const u32x4 cc = *(const u32x4*)(zz + 256 + c8), hh = *(const u32x4*)(zz + 512 + c8);
                const f32x4 wa = *(const f32x4*)(wc + j * 256 + c8) * ok, wb = *(const f32x4*)(wc + j * 256 + c8 + 4) * ok;
                acc[0] += wa[0] * (bflo(cc.x) * bflo(hh.x)); acc[1] += wa[1] * (bfhi(cc.x) * bfhi(hh.x));
                acc[2] += wa[2] * (bflo(cc.y) * bflo(hh.y)); acc[3] += wa[3] * (bfhi(cc.y) * bfhi(hh.y));
                acc[4] += wb[0] * (bflo(cc.z) * bflo(hh.z)); acc[5] += wb[1] * (bfhi(cc.z) * bfhi(hh.z));
                acc[6] += wb[2] * (bflo(cc.w) * bflo(hh.w)); acc[7] += wb[3] * (bfhi(cc.w) * bfhi(hh.w));
            }
        }
        const u32x4 ab = *(const u32x4*)(zr + c8);
        u32x4 o;
        o.x = cvt_pk_bf16(bflo(ab.x) * acc[0], bfhi(ab.x) * acc[1]); o.y = cvt_pk_bf16(bflo(ab.y) * acc[2], bfhi(ab.y) * acc[3]);
        o.z = cvt_pk_bf16(bflo(ab.z) * acc[4], bfhi(ab.z) * acc[5]); o.w = cvt_pk_bf16(bflo(ab.w) * acc[6], bfhi(ab.w) * acc[7]);
        *(u32x4*)(Y + (size_t)row * DM + c8) = o;
    }
}

__device__ __forceinline__ void mixer_b(const bf16_t* __restrict__ Z, bf16_t* __restrict__ Y, const float* __restrict__ lng, const float* __restrict__ lnb, const float* __restrict__ wsp, const float* __restrict__ bsp,
                                        LAS unsigned char* lds, int wave, int lane, int bid, int G) {
    constexpr int VP = 132;
    LAS bf16_t* vt = (LAS bf16_t*)lds;
    const int fr = lane & 15, fq = lane >> 4;
    for (int un = bid; un < 256; un += G) {
        const int chunk = un >> 1, hf = un & 1; const size_t row0 = (size_t)chunk * 128;
#pragma unroll 8
        for (int k = 0; k < 16; ++k) {
            const int s = wave * 16 + k; const bf16_t* zr = Z + (row0 + s) * NZ + 4 * 256;
            const float v0 = bf2f(zr[lane]), v1 = bf2f(zr[lane + 64]), v2 = bf2f(zr[lane + 128]), v3 = bf2f(zr[lane + 192]);
            const float mean = wave_sum((v0 + v1) + (v2 + v3)) * (1.f / 256.f);
            const float d0 = v0 - mean, d1 = v1 - mean, d2 = v2 - mean, d3 = v3 - mean;
            const float var = wave_sum((d0 * d0 + d1 * d1) + (d2 * d2 + d3 * d3)) * (1.f / 256.f);
            const float rstd = __builtin_amdgcn_rsqf(var + 1e-5f);
            const int ca = hf * 128 + lane, cb = ca + 64;
            const float a = (hf ? d2 : d0) * rstd * lng[ca] + lnb[ca], b = (hf ? d3 : d1) * rstd * lng[cb] + lnb[cb];
            const unsigned pk = cvt_pk_bf16(a, b);
            vt[lane * VP + s] = (bf16_t)(pk & 0xffffu); vt[(lane + 64) * VP + s] = (bf16_t)(pk >> 16);
        }
        __syncthreads();
        const int t = wave * 16 + fr;
#pragma unroll
        for (int hh = 0; hh < 2; ++hh) {
            const int h = hf * 2 + hh; const float* W = wsp + (size_t)h * 128 * 128 + (size_t)t * 128;
            f32x4 acc[4];
#pragma unroll
            for (int nt = 0; nt < 4; ++nt) acc[nt] = (f32x4){0.f, 0.f, 0.f, 0.f};
#pragma unroll
            for (int ks = 0; ks < 4; ++ks) {
                const int s0 = ks * 32 + fq * 8;
                f32x4 wa = *(const f32x4*)(W + s0), wb = *(const f32x4*)(W + s0 + 4);
#pragma unroll
                for (int j = 0; j < 4; ++j) { if (s0 + j > t) wa[j] = 0.f; if (s0 + 4 + j > t) wb[j] = 0.f; }
                u32x4 wp; wp.x = cvt_pk_bf16(wa[0], wa[1]); wp.y = cvt_pk_bf16(wa[2], wa[3]); wp.z = cvt_pk_bf16(wb[0], wb[1]); wp.w = cvt_pk_bf16(wb[2], wb[3]);
                const bf16x8 wf = __builtin_bit_cast(bf16x8, wp);
#pragma unroll
                for (int nt = 0; nt < 4; ++nt) {
                    const LAS bf16_t* vp = vt + (hh * 64 + nt * 16 + fr) * VP + s0;
                    const u32x2 lo = *(const LAS u32x2*)vp, hi2 = *(const LAS u32x2*)(vp + 4);
                    u32x4 vv; vv.x = lo.x; vv.y = lo.y; vv.z = hi2.x; vv.w = hi2.y;
                    acc[nt] = __builtin_amdgcn_mfma_f32_16x16x32_bf16(__builtin_bit_cast(bf16x8, vv), wf, acc[nt], 0, 0, 0);
                }
            }
            const float bias = bsp[h * 128 + t]; const size_t row = row0 + t;
#pragma unroll
            for (int nt = 0; nt < 4; ++nt) {
                const int col = h * 64 + nt * 16 + fq * 4;
                const u32x2 uu = *(const u32x2*)(Z + row * NZ + 3 * 256 + col);
                u32x2 o; o.x = cvt_pk_bf16((acc[nt][0] + bias) * bflo(uu.x), (acc[nt][1] + bias) * bfhi(uu.x)); o.y = cvt_pk_bf16((acc[nt][2] + bias) * bflo(uu.y), (acc[nt][3] + bias) * bfhi(uu.y));
                *(u32x2*)(Y + row * DM + 256 + col) = o;
            }
        }
        __syncthreads();
    }
}

__device__ __forceinline__ void mixer_d(const bf16_t* Z, bf16_t* Y, const float* wcf, const float* bcf, const float* lng, const float* lnb,
                                        LAS unsigned char* lds, int tid, int wave, int lane, int bid, int G) {
    LAS float* yl = (LAS float*)lds;
    LAS float* cv = (LAS float*)(lds + 62 * 256 * 4);
    const int c = tid & 255, half = tid >> 8;
    float w[31];
#pragma unroll
    for (int j = 0; j < 31; ++j) w[j] = wcf[j * 256 + c];
    const float bias = bcf[c];
    const f32x4 g4 = *(const f32x4*)(lng + lane * 4), b4 = *(const f32x4*)(lnb + lane * 4);
    for (int un = bid; un < MTOK / 32; un += G) {
        const int row0 = un * 32, pos0 = row0 & (SEQ - 1);
#pragma unroll
        for (int i4 = 0; i4 < 4; ++i4) {
            const int it0 = tid + i4 * NTHREADS, it = it0 < 62 * 32 ? it0 : 62 * 32 - 1;
            const int rr = it >> 5, c8 = (it & 31) * 8, p = pos0 - 30 + rr;
            f32x4 o0, o1; const float ok = (p >= 0) ? 1.f : 0.f;
            {
                const bf16_t* zr = Z + (size_t)(row0 + ((p >= 0) ? rr - 30 : 0)) * NZ;
                const u32x4 a = *(const u32x4*)(zr + 9 * 256 + c8), gg = *(const u32x4*)(zr + 10 * 256 + c8);
                o0[0] = bflo(a.x) * sigmoidf_(bflo(gg.x)); o0[1] = bfhi(a.x) * sigmoidf_(bfhi(gg.x)); o0[2] = bflo(a.y) * sigmoidf_(bflo(gg.y)); o0[3] = bfhi(a.y) * sigmoidf_(bfhi(gg.y));
                o1[0] = bflo(a.z) * sigmoidf_(bflo(gg.z)); o1[1] = bfhi(a.z) * sigmoidf_(bfhi(gg.z)); o1[2] = bflo(a.w) * sigmoidf_(bflo(gg.w)); o1[3] = bfhi(a.w) * sigmoidf_(bfhi(gg.w));
            }
            *(LAS f32x4*)(yl + rr * 256 + c8) = o0 * ok; *(LAS f32x4*)(yl + rr * 256 + c8 + 4) = o1 * ok;
        }
        __syncthreads();
#pragma unroll
        for (int blk = 0; blk < 2; ++blk) {
            const int tb = half * 16 + blk * 8;
            float acc[8];
#pragma unroll
            for (int o = 0; o < 8; ++o) acc[o] = bias;
#pragma unroll
            for (int jj = 0; jj < 38; ++jj) {
                const float v = yl[(tb + jj) * 256 + c];
#pragma unroll
                for (int o = 0; o < 8; ++o) { const int j = jj - o; if (j >= 0 && j < 31) acc[o] += w[j] * v; }
            }
#pragma unroll
            for (int o = 0; o < 8; ++o) cv[(tb + o) * 256 + c] = acc[o];
        }
        __syncthreads();
#pragma unroll
        for (int k = 0; k < 4; ++k) {
            const int tt = wave * 4 + k;
            const f32x4 v = *(const LAS f32x4*)(cv + tt * 256 + lane * 4);
            const float mean = wave_sum((v[0] + v[1]) + (v[2] + v[3])) * (1.f / 256.f);
            const f32x4 d = v - mean;
            const float var = wave_sum((d[0] * d[0] + d[1] * d[1]) + (d[2] * d[2] + d[3] * d[3])) * (1.f / 256.f);
            const float rstd = __builtin_amdgcn_rsqf(var + 1e-5f);
            const f32x4 y = d * rstd * g4 + b4;
            u32x2 o; o.x = cvt_pk_bf16(y[0] * sigmoidf_(y[0]), y[1] * sigmoidf_(y[1])); o.y = cvt_pk_bf16(y[2] * sigmoidf_(y[2]), y[3] * sigmoidf_(y[3]));
            *(u32x2*)(Y + (size_t)(row0 + tt) * DM + 768 + lane * 4) = o;
        }
        __syncthreads();
    }
}

__device__ __forceinline__ void mixer_bd(const bf16_t* __restrict__ Z, bf16_t* __restrict__ Y, const float* __restrict__ lng, const float* __restrict__ lnb, const float* __restrict__ wsp, const float* __restrict__ bsp,
                                         const float* __restrict__ wcf, const float* __restrict__ bcf, const float* __restrict__ dlng, const float* __restrict__ dlnb,
                                         LAS unsigned char* lds, int tid, int wave, int lane, int bid, int G) {
    constexpr int VP = 132;
    LAS bf16_t* vt = (LAS bf16_t*)lds;
    LAS float* yl = (LAS float*)(lds + 36864);
    LAS float* cv = (LAS float*)(lds + 100352);
    const int fr = lane & 15, fq = lane >> 4;
    const int c = tid & 255, half = tid >> 8;
    float w[31];
#pragma unroll
    for (int j = 0; j < 31; ++j) w[j] = wcf[j * 256 + c];
    const float dbias = bcf[c];
    const f32x4 g4 = *(const f32x4*)(dlng + lane * 4), b4 = *(const f32x4*)(dlnb + lane * 4);
#define MD_GLU(dun) do { const int row0_ = (dun) * 32, pos0_ = row0_ & (SEQ - 1); \
        _Pragma("unroll") for (int i4 = 0; i4 < 4; ++i4) { \
            const int it0 = tid + i4 * NTHREADS, it = it0 < 62 * 32 ? it0 : 62 * 32 - 1; \
            const int rr = it >> 5, c8 = (it & 31) * 8, p = pos0_ - 30 + rr; \
            f32x4 o0, o1; const float ok = (p >= 0) ? 1.f : 0.f; \
            const bf16_t* zr = Z + (size_t)(row0_ + ((p >= 0) ? rr - 30 : 0)) * NZ; \
            const u32x4 a = *(const u32x4*)(zr + 9 * 256 + c8), gg = *(const u32x4*)(zr + 10 * 256 + c8); \
            o0[0] = bflo(a.x) * sigmoidf_(bflo(gg.x)); o0[1] = bfhi(a.x) * sigmoidf_(bfhi(gg.x)); o0[2] = bflo(a.y) * sigmoidf_(bflo(gg.y)); o0[3] = bfhi(a.y) * sigmoidf_(bfhi(gg.y)); \
            o1[0] = bflo(a.z) * sigmoidf_(bflo(gg.z)); o1[1] = bfhi(a.z) * sigmoidf_(bfhi(gg.z)); o1[2] = bflo(a.w) * sigmoidf_(bflo(gg.w)); o1[3] = bfhi(a.w) * sigmoidf_(bfhi(gg.w)); \
            *(LAS f32x4*)(yl + rr * 256 + c8) = o0 * ok; *(LAS f32x4*)(yl + rr * 256 + c8 + 4) = o1 * ok; } } while (0)
#define MD_CONV() do { _Pragma("unroll") for (int blk = 0; blk < 2; ++blk) { const int tb = half * 16 + blk * 8; float acc_[8]; \
            _Pragma("unroll") for (int o = 0; o < 8; ++o) acc_[o] = dbias; \
            _Pragma("unroll") for (int jj = 0; jj < 38; ++jj) { const float v = yl[(tb + jj) * 256 + c]; \
                _Pragma("unroll") for (int o = 0; o < 8; ++o) { const int j = jj - o; if (j >= 0 && j < 31) acc_[o] += w[j] * v; } } \
            _Pragma("unroll") for (int o = 0; o < 8; ++o) cv[(tb + o) * 256 + c] = acc_[o]; } } while (0)
#define MD_LN(dun) do { const int row0_ = (dun) * 32; _Pragma("unroll") for (int k = 0; k < 4; ++k) { const int tt = wave * 4 + k; \
            const f32x4 v = *(const LAS f32x4*)(cv + tt * 256 + lane * 4); \
            const float mean = wave_sum((v[0] + v[1]) + (v[2] + v[3])) * (1.f / 256.f); const f32x4 d = v - mean; \
            const float var = wave_sum((d[0] * d[0] + d[1] * d[1]) + (d[2] * d[2] + d[3] * d[3])) * (1.f / 256.f); const float rstd = __builtin_amdgcn_rsqf(var + 1e-5f); \
            const f32x4 y = d * rstd * g4 + b4; \
            u32x2 o; o.x = cvt_pk_bf16(y[0] * sigmoidf_(y[0]), y[1] * sigmoidf_(y[1])); o.y = cvt_pk_bf16(y[2] * sigmoidf_(y[2]), y[3] * sigmoidf_(y[3])); \
            *(u32x2*)(Y + (size_t)(row0_ + tt) * DM + 768 + lane * 4) = o; } } while (0)
    for (int un = bid; un < 256; un += G) {
        const int chunk = un >> 1, hf = un & 1; const size_t row0 = (size_t)chunk * 128;
        const int t = wave * 16 + fr; const size_t row = row0 + t;
        bf16x8 wf[2][4]; u32x2 uu[2][4]; float bias[2];
#pragma unroll
        for (int hh = 0; hh < 2; ++hh) {
            const int h = hf * 2 + hh; const float* W = wsp + (size_t)h * 128 * 128 + (size_t)t * 128;
            f32x4 wa[4], wb[4];
#pragma unroll
            for (int ks = 0; ks < 4; ++ks) { wa[ks] = *(const f32x4*)(W + ks * 32 + fq * 8); wb[ks] = *(const f32x4*)(W + ks * 32 + fq * 8 + 4); }
#pragma unroll
            for (int nt = 0; nt < 4; ++nt) uu[hh][nt] = *(const u32x2*)(Z + row * NZ + 3 * 256 + h * 64 + nt * 16 + fq * 4);
            bias[hh] = bsp[h * 128 + t];
#pragma unroll
            for (int ks = 0; ks < 4; ++ks) {
                const int s0 = ks * 32 + fq * 8;
#pragma unroll
                for (int j = 0; j < 4; ++j) { if (s0 + j > t) wa[ks][j] = 0.f; if (s0 + 4 + j > t) wb[ks][j] = 0.f; }
                u32x4 wp; wp.x = cvt_pk_bf16(wa[ks][0], wa[ks][1]); wp.y = cvt_pk_bf16(wa[ks][2], wa[ks][3]); wp.z = cvt_pk_bf16(wb[ks][0], wb[ks][1]); wp.w = cvt_pk_bf16(wb[ks][2], wb[ks][3]);
                wf[hh][ks] = __builtin_bit_cast(bf16x8, wp);
            }
        }
#pragma unroll 8
        for (int k = 0; k < 16; ++k) {
            const int s = wave * 16 + k; const bf16_t* zr = Z + (row0 + s) * NZ + 4 * 256;
            const float v0 = bf2f(zr[lane]), v1 = bf2f(zr[lane + 64]), v2 = bf2f(zr[lane + 128]), v3 = bf2f(zr[lane + 192]);
            const float mean = wave_sum((v0 + v1) + (v2 + v3)) * (1.f / 256.f);
            const float d0 = v0 - mean, d1 = v1 - mean, d2 = v2 - mean, d3 = v3 - mean;
            const float var = wave_sum((d0 * d0 + d1 * d1) + (d2 * d2 + d3 * d3)) * (1.f / 256.f);
            const float rstd = __builtin_amdgcn_rsqf(var + 1e-5f);
            const int ca = hf * 128 + lane, cb = ca + 64;
            const float a = (hf ? d2 : d0) * rstd * lng[ca] + lnb[ca], b = (hf ? d3 : d1) * rstd * lng[cb] + lnb[cb];
            const unsigned pk = cvt_pk_bf16(a, b);
            vt[lane * VP + s] = (bf16_t)(pk & 0xffffu); vt[(lane + 64) * VP + s] = (bf16_t)(pk >> 16);
        }
        MD_GLU(2 * un);
        __syncthreads();
#pragma unroll
        for (int hh = 0; hh < 2; ++hh) {
            const int h = hf * 2 + hh;
            f32x4 acc[4];
#pragma unroll
            for (int nt = 0; nt < 4; ++nt) acc[nt] = (f32x4){0.f, 0.f, 0.f, 0.f};
#pragma unroll
            for (int ks = 0; ks < 4; ++ks) {
                const int s0 = ks * 32 + fq * 8;
#pragma unroll
                for (int nt = 0; nt < 4; ++nt) {
                    const LAS bf16_t* vp = vt + (hh * 64 + nt * 16 + fr) * VP + s0;
                    const u32x2 lo = *(const LAS u32x2*)vp, hi2 = *(const LAS u32x2*)(vp + 4);
                    u32x4 vv; vv.x = lo.x; vv.y = lo.y; vv.z = hi2.x; vv.w = hi2.y;
                    acc[nt] = __builtin_amdgcn_mfma_f32_16x16x32_bf16(__builtin_bit_cast(bf16x8, vv), wf[hh][ks], acc[nt], 0, 0, 0);
                }
            }
#pragma unroll
            for (int nt = 0; nt < 4; ++nt) {
                const int col = h * 64 + nt * 16 + fq * 4; const u32x2 u2 = uu[hh][nt]; const float bs_ = bias[hh];
                u32x2 o; o.x = cvt_pk_bf16((acc[nt][0] + bs_) * bflo(u2.x), (acc[nt][1] + bs_) * bfhi(u2.x)); o.y = cvt_pk_bf16((acc[nt][2] + bs_) * bflo(u2.y), (acc[nt][3] + bs_) * bfhi(u2.y));
                *(u32x2*)(Y + row * DM + 256 + col) = o;
            }
        }
        MD_CONV();
        __syncthreads();
        MD_LN(2 * un);
        MD_GLU(2 * un + 1);
        __syncthreads();
        MD_CONV();
        __syncthreads();
        MD_LN(2 * un + 1);
        __syncthreads();
    }
#undef MD_GLU
#undef MD_CONV
#undef MD_LN
}

__device__ __forceinline__ void attn_phase(const bf16_t* Z, const bf16_t* Kb, const bf16_t* Vb, unsigned* MASKb, unsigned* itemcnt, bf16_t* Y, LAS unsigned char* lds, int wave, int lane, int bid, int G) {
    const int h = wave & 3, half = wave >> 2, ql = lane & 31, hi = lane >> 5;
    LAS float* mo = (LAS float*)lds + h * 2048;
    LAS float* mml = (LAS float*)(lds + 32768) + h * 128;
    LAS bf16_t* ost = (LAS bf16_t*)(lds + 36864) + h * (32 * 72);
    const unsigned NEGB = __float_as_uint(NEGF);
    for (int pu = bid; pu < 256; pu += G) {
        const int b = pu & 3, jj = pu >> 2;
        for (int rep = 0; rep < 2; ++rep) {
            const int qb = rep ? jj : 127 - jj;
            const int NT = qb + 1, n0 = (NT + 1) >> 1, tb = half ? n0 : 0, te = half ? NT : n0;
            if (wave == 0) {
                unsigned* c0 = itemcnt + (2 * qb) * 4 + b; unsigned* c1 = c0 + 4; unsigned spins = 0;
                while ((unsigned)__builtin_amdgcn_readfirstlane(__hip_atomic_load(c0, __ATOMIC_RELAXED, __HIP_MEMORY_SCOPE_AGENT)) < 8u ||
                       (unsigned)__builtin_amdgcn_readfirstlane(__hip_atomic_load(c1, __ATOMIC_RELAXED, __HIP_MEMORY_SCOPE_AGENT)) < 8u) { __builtin_amdgcn_s_sleep(4); if (++spins > (1u << 22)) break; }
                __builtin_amdgcn_fence(__ATOMIC_ACQUIRE, "agent");
            }
            __syncthreads();
            const size_t rowq = (size_t)b * SEQ + qb * 32 + ql;
            const bf16_t* zq = Z + rowq * NZ + 1280 + h * 64 + hi * 8;
            bf16x8 qf[4];
#pragma unroll
            for (int c = 0; c < 4; ++c) qf[c] = *(const bf16x8*)(zq + 16 * c);
            unsigned* mrow = MASKb + ((size_t)(b * 128 + qb) * 128) * 32 + ql;
            const bf16_t* kb = Kb + ((size_t)(b * 4 + h) * 128) * 2048 + ql * 16 + hi * 8;
            const bf16_t* vb = Vb + ((size_t)(b * 4 + h) * 128) * 2048 + ql * 16 + hi * 8;
            f32x16 o0, o1;
#pragma unroll
            for (int r = 0; r < 16; ++r) { o0[r] = 0.f; o1[r] = 0.f; }
            float m = NEGF, l = 0.f;
            bf16x8 kA[4], kB[4]; bf16x8 vA[2][2], vB[2][2]; unsigned mA = 0u, mB = 0u;
#define ATT_LOAD(KF, VR, MW, kt_) do { const bf16_t* kp_ = kb + (size_t)(kt_) * 2048; const bf16_t* vp_ = vb + (size_t)(kt_) * 2048; _Pragma("unroll") for (int c = 0; c < 4; ++c) KF[c] = *(const bf16x8*)(kp_ + c * 512); \
        _Pragma("unroll") for (int mt = 0; mt < 2; ++mt) _Pragma("unroll") for (int c = 0; c < 2; ++c) VR[mt][c] = *(const bf16x8*)(vp_ + (mt * 2 + c) * 512); \
        MW = __hip_atomic_load(mrow + (kt_) * 32, __ATOMIC_RELAXED, __HIP_MEMORY_SCOPE_AGENT); } while (0)
#define ATT_COMP(KF, VR, MW) do { \
        f32x16 s; \
        _Pragma("unroll") for (int r = 0; r < 16; ++r) s[r] = 0.f; \
        __builtin_amdgcn_s_setprio(1); \
        _Pragma("unroll") for (int c = 0; c < 4; ++c) s = __builtin_amdgcn_mfma_f32_32x32x16_bf16(KF[c], qf[c], s, 0, 0, 0); \
        __builtin_amdgcn_s_setprio(0); \
        const int mws = (int)(MW >> (4 * hi)); \
        float rm = NEGF; \
        _Pragma("unroll") for (int r = 0; r < 16; ++r) { \
            const unsigned sel = (unsigned)__builtin_amdgcn_sbfe(mws, (r & 3) + 8 * (r >> 2), 1); \
            s[r] = __uint_as_float((__float_as_uint(s[r]) & sel) | (NEGB & ~sel)); \
            rm = fmaxf(rm, s[r]); } \
        rm = fmaxf(rm, swap32(rm, hi)); \
        const float mn = fmaxf(m, rm); \
        if (__any(mn > m)) { \
            const float al = __builtin_amdgcn_exp2f(m - mn); l *= al; \
            _Pragma("unroll") for (int r = 0; r < 16; ++r) { o0[r] *= al; o1[r] *= al; } \
            m = mn; } \
        float ps = 0.f; \
        _Pragma("unroll") for (int r = 0; r < 16; ++r) { s[r] = __builtin_amdgcn_exp2f(s[r] - m); ps += s[r]; } \
        l += ps; \
        u32x4 p0, p1; \
        p0.x = cvt_pk_bf16(s[0], s[1]); p0.y = cvt_pk_bf16(s[2], s[3]); p0.z = cvt_pk_bf16(s[4], s[5]); p0.w = cvt_pk_bf16(s[6], s[7]); \
        p1.x = cvt_pk_bf16(s[8], s[9]); p1.y = cvt_pk_bf16(s[10], s[11]); p1.z = cvt_pk_bf16(s[12], s[13]); p1.w = cvt_pk_bf16(s[14], s[15]); \
        const bf16x8 pf0 = __builtin_bit_cast(bf16x8, p0), pf1 = __builtin_bit_cast(bf16x8, p1); \
        __builtin_amdgcn_s_setprio(1); \
        o0 = __builtin_amdgcn_mfma_f32_32x32x16_bf16(VR[0][0], pf0, o0, 0, 0, 0); o1 = __builtin_amdgcn_mfma_f32_32x32x16_bf16(VR[1][0], pf0, o1, 0, 0, 0); \
        o0 = __builtin_amdgcn_mfma_f32_32x32x16_bf16(VR[0][1], pf1, o0, 0, 0, 0); o1 = __builtin_amdgcn_mfma_f32_32x32x16_bf16(VR[1][1], pf1, o1, 0, 0, 0); \
        __builtin_amdgcn_s_setprio(0); } while (0)
            if (tb < te) ATT_LOAD(kA, vA, mA, tb);
            for (int kt = tb; kt < te; kt += 2) {
                { const int k1 = (kt + 1 < te) ? kt + 1 : kt; ATT_LOAD(kB, vB, mB, k1); }
                ATT_COMP(kA, vA, mA);
                { const int k2 = (kt + 2 < te) ? kt + 2 : te - 1; ATT_LOAD(kA, vA, mA, k2); }
                if (kt + 1 < te) ATT_COMP(kB, vB, mB);
            }
#undef ATT_COMP
#undef ATT_LOAD
            const float lt = l + swap32(l, hi);
            if (half == 1) {
#pragma unroll
                for (int r = 0; r < 16; ++r) { mo[r * 64 + lane] = o0[r]; mo[(16 + r) * 64 + lane] = o1[r]; }
                mml[lane] = m; mml[64 + lane] = lt;
            }
            __syncthreads();
            if (half == 0) {
                const float m1 = mml[lane], l1 = mml[64 + lane];
                const float mn = fmaxf(m, m1), a0 = __builtin_amdgcn_exp2f(m - mn), a1 = __builtin_amdgcn_exp2f(m1 - mn);
                const float inv = __builtin_amdgcn_rcpf(lt * a0 + l1 * a1), f0 = a0 * inv, f1 = a1 * inv;
#pragma unroll
                for (int r = 0; r < 16; ++r) { o0[r] = o0[r] * f0 + mo[r * 64 + lane] * f1; o1[r] = o1[r] * f0 + mo[(16 + r) * 64 + lane] * f1; }
#pragma unroll
                for (int r = 0; r < 16; r += 2) {
                    const int d = (r & 3) + 8 * (r >> 2) + 4 * hi;
                    *(LAS unsigned*)(ost + ql * 72 + d) = cvt_pk_bf16(o0[r], o0[r + 1]);
                    *(LAS unsigned*)(ost + ql * 72 + 32 + d) = cvt_pk_bf16(o1[r], o1[r + 1]);
                }
                LDS_WAIT();
                bf16_t* yo = Y + ((size_t)b * SEQ + qb * 32 + (lane >> 1)) * DM + 512 + h * 64 + (lane & 1) * 32;
#pragma unroll
                for (int k = 0; k < 4; ++k) { const u32x4 v = *(const LAS u32x4*)(ost + (lane >> 1) * 72 + (lane & 1) * 32 + k * 8); *(u32x4*)(yo + k * 8) = v; }
            }
            __syncthreads();
        }
    }
}

#define RLX_AGENT __ATOMIC_RELAXED, __HIP_MEMORY_SCOPE_AGENT
#define XB_TMO      128
#define XB_XCNT(j)  (256  + 64 * (j))
#define XB_XSUB(j)  (1280 + 64 * (j))
#define XB_XGEN(j)  (2304 + 64 * (j))
#define XB_TOP      3328
#define XB_TOPGEN   3392
#define XCD_BAR_WORDS 3456
#define XB_SPIN_CAP (1u << 18)

__device__ __forceinline__ unsigned xb_ld(unsigned* p)              { return __hip_atomic_load(p, __ATOMIC_RELAXED, __HIP_MEMORY_SCOPE_AGENT); }
__device__ __forceinline__ unsigned xb_add(unsigned* p, unsigned v) { return __hip_atomic_fetch_add(p, v, __ATOMIC_RELAXED, __HIP_MEMORY_SCOPE_AGENT); }
__device__ __forceinline__ unsigned xb_xcc_id() { return (unsigned)__builtin_amdgcn_s_getreg((3 << 11) | 20) & 0xFu; }
#define XB_SPIN(cond, bar) do { unsigned _sp = 0; while (cond) { __builtin_amdgcn_s_sleep(1); \
    if ((++_sp & 255u) == 0u) { if (xb_ld(&(bar)[XB_TMO])) break; if (_sp > XB_SPIN_CAP) { atomicAdd(&(bar)[XB_TMO], 1u); break; } } } } while (0)

struct XcdBarrier {
    unsigned* bar; unsigned x;
    volatile LAS unsigned* st;
};

__device__ __forceinline__ XcdBarrier xcd_barrier_post(unsigned* bar, volatile LAS unsigned* st, int tid) {
    XcdBarrier b; b.bar = bar; b.x = xb_xcc_id(); b.st = st;
    if (tid == 0) (void)xb_add(&bar[XB_XCNT(b.x)], 1u);
    return b;
}
__device__ __forceinline__ void xcd_barrier_complete(unsigned* bar, unsigned x, unsigned& nloc, unsigned& nx) {
    const unsigned G = gridDim.x * gridDim.y * gridDim.z;
    unsigned sum, cnt, mine, sp = 0u;
    for (;;) {
        sum = 0u; cnt = 0u; mine = 0u;
#pragma unroll
        for (unsigned j = 0; j < 16; ++j) { const unsigned c = xb_ld(&bar[XB_XCNT(j)]); sum += c; cnt += (c > 0u) ? 1u : 0u; mine = (j == x) ? c : mine; }
        if (sum == G) break;
        __builtin_amdgcn_s_sleep(1);
        if ((++sp & 255u) == 0u) { if (xb_ld(&bar[XB_TMO])) break; if (sp > XB_SPIN_CAP) { atomicAdd(&bar[XB_TMO], 1u); break; } }
    }
    nloc = mine > 0u ? mine : 1u; nx = cnt > 0u ? cnt : 1u;
}

__device__ __forceinline__ void xcd_barrier(const XcdBarrier& b, int tid) {
    asm volatile("s_waitcnt vmcnt(0)" ::: "memory");
    __syncthreads();
    if (tid == 0) {
        unsigned* bar = b.bar;
        __builtin_amdgcn_s_waitcnt(0);
        unsigned nloc = b.st[0], nx = b.st[1];
        if (nloc == 0u) { xcd_barrier_complete(bar, b.x, nloc, nx); b.st[0] = nloc; b.st[1] = nx; }
        const unsigned old = xb_add(&bar[XB_XSUB(b.x)], 1u);
        const unsigned gen = old / nloc;
        if (old + 1u == (gen + 1u) * nloc) {
            __builtin_amdgcn_fence(__ATOMIC_RELEASE, "agent");
            asm volatile("s_waitcnt vmcnt(0)" ::: "memory");
            const unsigned og = xb_add(&bar[XB_TOP], 1u);
            const unsigned tg = og / nx, target = (tg + 1u) * nx;
            if (og + 1u != target) XB_SPIN(xb_ld(&bar[XB_TOP]) < target, bar);
            __builtin_amdgcn_fence(__ATOMIC_ACQUIRE, "agent");
            xb_add(&bar[XB_XGEN(b.x)], 1u);
            asm volatile("s_waitcnt vmcnt(0)" ::: "memory");
        } else {
            XB_SPIN(xb_ld(&bar[XB_XGEN(b.x)]) == gen, bar);
            __builtin_amdgcn_fence(__ATOMIC_ACQUIRE, "agent");
            asm volatile("s_waitcnt vmcnt(0)" ::: "memory");
        }
    }
    __syncthreads();
}

#ifndef PROBE_PH
#define PROBE_PH -1
#endif
#ifndef PROBE_SUB
#define PROBE_SUB 0
#endif
__global__ void __launch_bounds__(NTHREADS, 2) mega_fwd(Args A_unused) {
    extern __shared__ __attribute__((aligned(16))) unsigned char lds_raw[];
    LAS unsigned char* lds = (LAS unsigned char*)lds_raw;
    cg::grid_group grid = cg::this_grid();
    const int ph_lo = kargs()->ph_lo, ph_hi = kargs()->ph_hi;
    const int wave0 = __builtin_amdgcn_readfirstlane((int)(threadIdx.x >> 6));
    if (threadIdx.x < 16) ((volatile LAS unsigned*)(lds + LDS_BAR_OFF))[threadIdx.x] = 0u;
    __syncthreads();
    if (ph_hi - ph_lo > 1) { (void)xcd_barrier_post((unsigned*)(kargs()->ws + WS_CTL), (volatile LAS unsigned*)(lds + LDS_BAR_OFF), (int)threadIdx.x); }
    const int st_hi = (PROBE_PH >= 0) ? ph_hi + 1 : ph_hi;
    for (int st = ph_lo; st < st_hi; ++st) {
        const int ph = (PROBE_PH >= 0 && st > PROBE_PH) ? st - 1 : st;
        const int sub = (PROBE_PH >= 0 && st == PROBE_PH + 1) ? PROBE_SUB : 0;
        KArgs A = kargs();
        int G = gridDim.x; asm volatile("" : "+s"(G));
        unsigned char* ws = A->ws;
        bf16_t* XB = (bf16_t*)(ws + WS_XB); bf16_t* Yb = (bf16_t*)(ws + WS_Y); bf16_t* Zb = (bf16_t*)(ws + WS_Z); bf16_t* HID = Zb; bf16_t* Vb = (bf16_t*)(ws + WS_VB); bf16_t* Kb = (bf16_t*)(ws + WS_KB); bf16_t* KIb = (bf16_t*)(ws + WS_KI);
        float* ssqA = (float*)(ws + WS_SSQA); float* ssqB = (float*)(ws + WS_SSQB);
        float* ropec = (float*)(ws + WS_ROPE); float* ropes = ropec + SEQ * 32;
        unsigned* MASKb = (unsigned*)(ws + WS_MASK);
        int bid = blockIdx.x, wave = wave0; asm volatile("" : "+s"(bid), "+s"(wave));
        int lane = (int)__builtin_amdgcn_mbcnt_hi(~0u, __builtin_amdgcn_mbcnt_lo(~0u, 0u)); asm volatile("" : "+v"(lane));
        const int tid = wave * 64 + lane;
        if (ph == 0) {
#ifndef NO_PRO
            prologue(A, ws, lds, tid, wave, lane, bid, G, sub);
#endif
        } else if (ph == NPHASE - 1) {
            const float* gfin = A->in[17];
            if (G != 256) for (int row = bid * NWAVES + wave; row < MTOK; row += G * NWAVES) {
                const XL2 XLS{(bf16_t*)(ws + WS_MASK), (bf16_t*)(ws + WS_KB)};
                const float rs = row_rs(ssqA, row); f32x4* p = (f32x4*)(A->out + (size_t)row * DM) + lane; const f32x4* g = (const f32x4*)gfin + lane;
                const u32x2* ph_ = (const u32x2*)(XB + (size_t)row * DM) + lane; const u32x2* pl_ = (const u32x2*)xl_row(XLS, row) + lane;
#pragma unroll
                for (int j = 0; j < 4; ++j) { const u32x2 h2 = ph_[64 * j]; u32x2 l2 = {0u, 0u}; if (RES_LO) l2 = pl_[64 * j]; f32x4 v; v[0] = bflo(h2.x) + bflo(l2.x); v[1] = bfhi(h2.x) + bfhi(l2.x); v[2] = bflo(h2.y) + bflo(l2.y); v[3] = bfhi(h2.y) + bfhi(l2.y); p[64 * j] = v * rs * g[64 * j]; }
            }
        } else {
            const int l = (ph - 1) / 6, k = (ph - 1) % 6;
            if (k == 0) {
                pg8::Gemm g{XB, (bf16_t*)(ws + WS_WIN) + l * WIN_L, MTOK, NZ, DM}; pg8::StaticOrder S; S.init(MTOK, NZ, G, bid);
                EpiZ E{Zb, Vb, Kb, KIb, ssqA, ropec, ropes};
#ifndef NO_G0
                pg8::gemm_phase<EpiZ, pg8::StaticOrder, true, true>(lds, g, S, E, tid);
#endif
            } else if (k == 1) {
#ifndef NO_SEL
                if (sub != 2 && sub < 6) select_phase(Zb, KIb, MASKb, (unsigned*)(ws + WS_CTL) + CW_ITEM + l * 1024, lds, wave, lane, bid, G, sub);
#endif
#ifndef NO_MA
                if (sub == 0 || sub == 2 || sub == 8) mixer_a(Zb, Yb, A->in[3] + l * 3 * 256, bid * NTHREADS + tid, G * NTHREADS);
#endif
#ifndef NO_MB
                if (sub == 0 || sub == 2 || sub == 6 || sub == 7) mixer_bd(Zb, Yb, A->in[4] + l * 256, A->in[5] + l * 256, A->in[6] + (size_t)l * 4 * 128 * 128, A->in[7] + l * 4 * 128,
                                                                      A->in[8] + l * 31 * 256, A->in[9] + l * 256, A->in[10] + l * 256, A->in[11] + l * 256, lds, tid, wave, lane, bid, G);
#endif
            } else if (k == 2) {
#ifndef NO_ATT
                attn_phase(Zb, Kb, Vb, MASKb, (unsigned*)(ws + WS_CTL) + CW_ITEM + l * 1024, Yb, lds, wave, lane, bid, G);
#endif
            } else if (k == 3 || k == 5) {
                const XL2 XLD{(bf16_t*)A->out, (bf16_t*)A->out + (size_t)8192 * DM}, XLS{(bf16_t*)(ws + WS_MASK), (bf16_t*)(ws + WS_KB)};
                const bool last = (l == NLAYER - 1);
                pg8::Gemm g{k == 3 ? Yb : HID, k == 3 ? (bf16_t*)(ws + WS_WOUT) + l * WOUT_L : (bf16_t*)(ws + WS_WDN) + l * WDN_L, MTOK, DM, k == 3 ? DM : FF}; pg8::StaticOrder S; S.init(MTOK, DM, G, bid);
                if (k == 3 && l == 0) {
                    EpiRes<true> E{A->in[0], XLD, last ? XLS : XLD, XB, ssqB};
                    pg8::gemm_phase<EpiRes<true>, pg8::StaticOrder, true, true>(lds, g, S, E, tid);
                } else if (k == 5 && last && G == 256) {
                    EpiFinal E{XB, XLS, A->out, A->in[17], ssqB, (unsigned*)(ws + WS_CTL) + CW_PANEL};
                    pg8::gemm_phase<EpiFinal, pg8::StaticOrder, false, true>(lds, g, S, E, tid);
                } else {
                    EpiRes<false> E{nullptr, (k == 5 && last) ? XLS : XLD, last ? XLS : XLD, XB, k == 3 ? ssqB : ssqA};
                    pg8::gemm_phase<EpiRes<false>, pg8::StaticOrder, true, true>(lds, g, S, E, tid);
                }
            } else if (k == 4) {
                pg8::Gemm g{XB, (bf16_t*)(ws + WS_WGU) + l * WGU_L, MTOK, NGU, DM}; pg8::StaticOrder S; S.init(MTOK, NGU, G, bid);
                EpiGU E{HID, ssqB};
#ifndef NO_G2
                pg8::gemm_phase<EpiGU, pg8::StaticOrder, true, true>(lds, g, S, E, tid);
#endif
                if (l == 0) {
                    const int nwg = (MTOK / 256) * (NGU / 256), rem = nwg % G;
                    if (rem == 0) convert_weights(A, ws, lds, wave, lane, CV_I_L - CV_I_DN, NLAYER * CV_I_L, bid * NWAVES + wave, G * NWAVES);
                    else if (bid >= rem) convert_weights(A, ws, lds, wave, lane, CV_I_L - CV_I_DN, NLAYER * CV_I_L, (bid - rem) * NWAVES + wave, (G - rem) * NWAVES);
                }
            }
        }
        const bool flag_seam = (PROBE_PH < 0) && ph >= 1 && ph <= 12 && ((ph - 1) % 6) == 1;
        if (st + 1 < st_hi && !flag_seam) {
            if (ph_hi > 100000) grid.sync();
            XcdBarrier xb; xb.bar = (unsigned*)(ws + WS_CTL); xb.x = xb_xcc_id(); xb.st = (volatile LAS unsigned*)(lds + LDS_BAR_OFF);
            xcd_barrier(xb, tid);
        }
    }
}

#ifndef MK_COOP
#define MK_COOP 1
#endif
extern "C" void kernel_launch(void* const* d_in, const int* in_sizes, int n_in, void* d_out, int out_size, void* d_ws, size_t ws_size, hipStream_t stream) {
    static int grid = 0;
    if (grid == 0) {
        if (n_in != 18 || out_size != MTOK * DM || ws_size < WS_END) { fprintf(stderr, "kernel_launch: unexpected shapes (n_in %d out %d ws %zu)\n", n_in, out_size, ws_size); grid = -1; return; }
        int dev = 0, cus = 0, per_cu = 0;
        if (hipGetDevice(&dev) != hipSuccess || hipDeviceGetAttribute(&cus, hipDeviceAttributeMultiprocessorCount, dev) != hipSuccess) { grid = -1; return; }
        if (hipFuncSetAttribute((const void*)mega_fwd, hipFuncAttributeMaxDynamicSharedMemorySize, LDS_BYTES) != hipSuccess) { fprintf(stderr, "kernel_launch: hipFuncSetAttribute failed\n"); grid = -1; return; }
        if (hipOccupancyMaxActiveBlocksPerMultiprocessor(&per_cu, (const void*)mega_fwd, NTHREADS, LDS_BYTES) != hipSuccess || per_cu < 1) { fprintf(stderr, "kernel_launch: occupancy query says %d\n", per_cu); (void)hipGetLastError(); }
        grid = cus;
    }
    if (grid < 0) return;
    if (hipMemsetAsync((char*)d_ws + WS_CTL, 0, CTL_BYTES, stream) != hipSuccess) { fprintf(stderr, "kernel_launch: memset failed\n"); return; }
    Args a{};
    for (int i = 0; i < 18; ++i) a.in[i] = (const float*)d_in[i];
    a.out = (float*)d_out; a.ws = (unsigned char*)d_ws;
#if MK_COOP
    a.ph_lo = 0; a.ph_hi = (grid == 256) ? NPHASE - 1 : NPHASE;
    void* args[] = {&a};
    hipError_t e = hipLaunchCooperativeKernel((const void*)mega_fwd, dim3(grid), dim3(NTHREADS), args, LDS_BYTES, stream);
    if (e != hipSuccess) fprintf(stderr, "cooperative launch failed: %s (grid %d)\n", hipGetErrorString(e), grid);
#else
    for (int ph = 0; ph < NPHASE; ++ph) {
        a.ph_lo = ph; a.ph_hi = ph + 1;
        hipLaunchKernelGGL(mega_fwd, dim3(grid), dim3(NTHREADS), LDS_BYTES, stream, a);
    }
#endif
}
```

```cpp
#include <hip/hip_runtime.h>
#include <hip/hip_cooperative_groups.h>
#include <cstdio>
#include <cstdint>
namespace cg = cooperative_groups;
namespace pg8 {
#define PG8_LAS __attribute__((address_space(3)))
typedef unsigned short bf16_t;
typedef short bf16x8 __attribute__((ext_vector_type(8)));
typedef float f32x4 __attribute__((ext_vector_type(4)));
typedef unsigned u32x4 __attribute__((ext_vector_type(4)));
constexpr int BM = 256, BK = 64, HALF = 128, HTB = HALF * BK * 2  , STAGE_BYTES = 8 * HTB, NXCD = 8, WGM = 8;

__host__ __device__ __forceinline__ int lds_byte(int r, int c) { const int st = (r >> 4) * 2 + (c >> 5), rr = r & 15, cc = c & 31, ob = rr * 64 + cc * 2; return st * 1024 + (ob ^ (((ob >> 9) & 1) << 5)); }
__host__ __device__ __forceinline__ void stage_rc(int b, int& R, int& C) { const int st = b / 1024, sb = b % 1024, swz = sb ^ (((sb >> 9) & 1) << 5); R = (st >> 1) * 16 + swz / 64; C = (st & 1) * 32 + (swz % 64) / 2; }
__host__ __device__ __forceinline__ int perm32(int rho) { const int n = rho >> 4, i = rho & 15; return 8 * (i >> 2) + 4 * n + (i & 3); }

struct Unit { int pm, pn; };
struct Gemm { const bf16_t* A; const bf16_t* Bt; int M, N, K; };

struct StaticOrder {
    int nM, nN, nwg, G, c;
    __host__ __device__ void init(int M, int N, int G_, int c_) { nM = M / BM; nN = N / BM; nwg = nM * nN; G = G_; c = c_; }
    __host__ __device__ bool next(int i, Unit& u) const {
        const long L = (long)i * G + c; if (L >= nwg) return false;
        int wgid = (int)L; { const int q = nwg / NXCD, r = nwg % NXCD, xcd = wgid % NXCD, off = wgid / NXCD; wgid = (xcd < r ? xcd * (q + 1) : r * (q + 1) + (xcd - r) * q) + off; }
        const int nig = WGM * nN, gid = wgid / nig, fm = gid * WGM, gsz = (nM - fm) < WGM ? (nM - fm) : WGM;
        u.pm = fm + ((wgid % nig) % gsz); u.pn = (wgid % nig) / gsz; return true;
    }
    __device__ __forceinline__ void a_ready(const Unit&) const {}
    __device__ __forceinline__ void done(const Unit&) const {}
};

__device__ __forceinline__ unsigned cvt_pk_bf16(float lo, float hi) { unsigned r; asm volatile("v_cvt_pk_bf16_f32 %0, %1, %2" : "=v"(r) : "v"(lo), "v"(hi)); return r; }
template <class Epi, class Sched, bool ALIGN_EPI = false, bool SP2 = false>
__device__ __forceinline__ void gemm_phase(PG8_LAS unsigned char* lds, const Gemm g, const Sched& S, const Epi& E, int tid_in) {
    int tid_l = tid_in; asm volatile("" : "+v"(tid_l));
    const int tid = tid_l, wid = __builtin_amdgcn_readfirstlane(tid >> 6), lane = tid & 63, wr = wid >> 2, wc = wid & 3, fr = lane & 15, fq = lane >> 4;
    const int K = g.K, nt = K / BK;
    unsigned voffA[2], voffB[2];
#pragma unroll
    for (int i = 0; i < 2; ++i) { int R, C; stage_rc(tid * 16 + i * 8192, R, C); const int Rb = Epi::PERM ? ((R & ~31) + perm32(R & 31)) : R;
        voffA[i] = (unsigned)(R * K + C) * 2u; voffB[i] = (unsigned)(Rb * K + C) * 2u; }
    const size_t kstep = (size_t)(BK * 2);
    const size_t hstep = (size_t)HALF * K * 2;
    const size_t tstep = 2 * hstep;
    const unsigned ldsw = (unsigned)wid * 1024u;
    const int aoff = lds_byte(wr * 64 + fr, fq * 8), boff = lds_byte(wc * 32 + fr, fq * 8);
#define PG8_SA(b, h) (((b) * 2 + (h)) * HTB)
#define PG8_SB(b, h) ((4 + (b) * 2 + (h)) * HTB)
#define PG8_STAGE(bufoff, gbase, voff) do { _Pragma("unroll") for (int _i = 0; _i < 2; ++_i) \
        __builtin_amdgcn_global_load_lds((const unsigned*)((const char*)(gbase) + (voff)[_i]), (PG8_LAS unsigned*)(lds + (bufoff) + ldsw + _i * 8192), 16, 0, 0); } while (0)
#define PG8_LDA(dst, b, h) do { _Pragma("unroll") for (int m = 0; m < 4; ++m) _Pragma("unroll") for (int k = 0; k < 2; ++k) dst[m][k] = *(const PG8_LAS bf16x8*)(lds + PG8_SA(b, h) + aoff + m * 2048 + k * 1024); } while (0)
#define PG8_LDB(dst, b, h) do { _Pragma("unroll") for (int n = 0; n < 2; ++n) _Pragma("unroll") for (int k = 0; k < 2; ++k) dst[n][k] = *(const PG8_LAS bf16x8*)(lds + PG8_SB(b, h) + boff + n * 2048 + k * 1024); } while (0)
#define PG8_MMA(ai, bj, At, Bt) do { __builtin_amdgcn_s_setprio(1); _Pragma("unroll") for (int m = 0; m < 4; ++m) _Pragma("unroll") for (int n = 0; n < 2; ++n) _Pragma("unroll") for (int k = 0; k < 2; ++k) \
        acc[ai][bj][m][n] = __builtin_amdgcn_mfma_f32_16x16x32_bf16(Bt[n][k], At[m][k], acc[ai][bj][m][n], 0, 0, 0); __builtin_amdgcn_s_setprio(0); } while (0)
#define PG8_WAIT_V(n) asm volatile("s_waitcnt vmcnt(" #n ")" ::: "memory")
#define PG8_WAIT_L(n) asm volatile("s_waitcnt lgkmcnt(" #n ")" ::: "memory")
#define PG8_BAR __builtin_amdgcn_s_barrier()
#define PG8_SCHED __builtin_amdgcn_sched_barrier(0)
    Unit cur, nxt; int ui = 0;
    if (!S.next(0, cur)) return;
    f32x4 acc[2][2][4][2];
#pragma unroll
    for (int a = 0; a < 2; ++a)
#pragma unroll
        for (int b = 0; b < 2; ++b)
#pragma unroll
            for (int m = 0; m < 4; ++m)
#pragma unroll
                for (int n = 0; n < 2; ++n) acc[a][b][m][n] = (f32x4){0.f, 0.f, 0.f, 0.f};
    bf16x8 At[4][2], B0[2][2], B1[2][2];
    const char* cA = (const char*)g.A + (size_t)cur.pm * tstep; const char* cB = (const char*)g.Bt + (size_t)cur.pn * tstep;
    S.a_ready(cur);
    if constexpr (SP2) {
        PG8_STAGE(PG8_SB(0, 0), cB, voffB); PG8_STAGE(PG8_SB(0, 1), cB + hstep, voffB); PG8_STAGE(PG8_SA(0, 0), cA, voffA); PG8_STAGE(PG8_SA(0, 1), cA + hstep, voffA);
        if (wr == 1) PG8_BAR;
        PG8_WAIT_V(2); PG8_BAR;
        PG8_STAGE(PG8_SB(1, 0), cB + kstep, voffB); PG8_STAGE(PG8_SA(1, 0), cA + kstep, voffA); PG8_STAGE(PG8_SB(1, 1), cB + hstep + kstep, voffB);
        PG8_WAIT_V(6); PG8_BAR;
    } else {
        PG8_STAGE(PG8_SB(0, 0), cB, voffB); PG8_STAGE(PG8_SA(0, 0), cA, voffA); PG8_STAGE(PG8_SB(0, 1), cB + hstep, voffB); PG8_STAGE(PG8_SA(0, 1), cA + hstep, voffA);
        if (wr == 1) PG8_BAR;
        PG8_WAIT_V(4); PG8_BAR;
        PG8_STAGE(PG8_SB(1, 0), cB + kstep, voffB); PG8_STAGE(PG8_SA(1, 0), cA + kstep, voffA); PG8_STAGE(PG8_SB(1, 1), cB + hstep + kstep, voffB);
        PG8_WAIT_V(6); PG8_BAR;
    }
    for (;;) {
        const bool has_next = S.next(ui + 1, nxt);
        const char* nA = has_next ? (const char*)g.A + (size_t)nxt.pm * tstep : cA; const char* nB = has_next ? (const char*)g.Bt + (size_t)nxt.pn * tstep : cB;
        for (int t = 0; t < nt; t += 2) {
            const bool last = (t == nt - 2);
            const char* a1 = cA + (size_t)(t + 1) * kstep;
            const char* a2 = last ? nA : cA + (size_t)(t + 2) * kstep; const char* b2 = last ? nB : cB + (size_t)(t + 2) * kstep;
            const char* a3 = a2 + kstep; const char* b3 = b2 + kstep;
            if (last && has_next) S.a_ready(nxt);
            if constexpr (SP2) {
            PG8_LDB(B0, 0, 0); PG8_LDB(B1, 0, 1); PG8_SCHED; PG8_LDA(At, 0, 0); PG8_STAGE(PG8_SA(1, 1), a1 + hstep, voffA);
            PG8_WAIT_V(8); PG8_WAIT_L(0); PG8_BAR; PG8_MMA(0, 0, At, B0); PG8_MMA(0, 1, At, B1); PG8_BAR; PG8_SCHED;
            PG8_LDA(At, 0, 1); PG8_STAGE(PG8_SB(0, 0), b2, voffB); PG8_STAGE(PG8_SB(0, 1), b2 + hstep, voffB); PG8_STAGE(PG8_SA(0, 0), a2, voffA);
            PG8_WAIT_V(8); PG8_WAIT_L(0); PG8_BAR; PG8_MMA(1, 0, At, B0); PG8_MMA(1, 1, At, B1); PG8_BAR; PG8_SCHED;
            PG8_LDB(B0, 1, 0); PG8_LDB(B1, 1, 1); PG8_SCHED; PG8_LDA(At, 1, 0); PG8_STAGE(PG8_SA(0, 1), a2 + hstep, voffA);
            PG8_WAIT_V(8); PG8_WAIT_L(0); PG8_BAR; PG8_MMA(0, 0, At, B0); PG8_MMA(0, 1, At, B1); PG8_BAR; PG8_SCHED;
            PG8_LDA(At, 1, 1); PG8_STAGE(PG8_SB(1, 0), b3, voffB); PG8_STAGE(PG8_SB(1, 1), b3 + hstep, voffB); PG8_STAGE(PG8_SA(1, 0), a3, voffA);
            PG8_WAIT_V(8); PG8_WAIT_L(0); PG8_BAR; PG8_MMA(1, 0, At, B0); PG8_MMA(1, 1, At, B1); PG8_BAR; PG8_SCHED;
            } else {
            PG8_LDB(B0, 0, 0); PG8_SCHED; PG8_LDA(At, 0, 0); PG8_STAGE(PG8_SA(1, 1), a1 + hstep, voffA);
            PG8_WAIT_L(8); PG8_BAR; PG8_WAIT_L(0); PG8_MMA(0, 0, At, B0); PG8_BAR; PG8_SCHED;
            PG8_LDB(B1, 0, 1); PG8_STAGE(PG8_SB(0, 0), b2, voffB);
            PG8_BAR; PG8_WAIT_L(0); PG8_MMA(0, 1, At, B1); PG8_BAR;
            PG8_LDA(At, 0, 1); PG8_STAGE(PG8_SA(0, 0), a2, voffA);
            PG8_BAR; PG8_WAIT_L(0); PG8_MMA(1, 0, At, B0); PG8_BAR; PG8_SCHED;
            PG8_STAGE(PG8_SB(0, 1), b2 + hstep, voffB);
            PG8_WAIT_V(6); PG8_BAR; PG8_MMA(1, 1, At, B1); PG8_BAR;
            PG8_LDB(B0, 1, 0); PG8_SCHED; PG8_LDA(At, 1, 0); PG8_STAGE(PG8_SA(0, 1), a2 + hstep, voffA);
            PG8_WAIT_L(8); PG8_BAR; PG8_WAIT_L(0); PG8_MMA(0, 0, At, B0); PG8_BAR; PG8_SCHED;
            PG8_LDB(B1, 1, 1); PG8_STAGE(PG8_SB(1, 0), b3, voffB);
            PG8_BAR; PG8_WAIT_L(0); PG8_MMA(0, 1, At, B1); PG8_BAR;
            PG8_LDA(At, 1, 1); PG8_STAGE(PG8_SA(1, 0), a3, voffA);
            PG8_BAR; PG8_WAIT_L(0); PG8_MMA(1, 0, At, B0); PG8_BAR; PG8_SCHED;
            PG8_STAGE(PG8_SB(1, 1), b3 + hstep, voffB);
            PG8_WAIT_V(6); PG8_BAR; PG8_MMA(1, 1, At, B1); PG8_BAR;
            }
        }
        if constexpr (ALIGN_EPI) { if (wr == 0) PG8_BAR; }
        if constexpr (!Epi::AFTER_DRAIN) { E(acc, cur, wr, wc, fr, fq); S.done(cur); }
        if (!has_next) break;
#pragma unroll
        for (int a = 0; a < 2; ++a)
#pragma unroll
            for (int b = 0; b < 2; ++b)
#pragma unroll
                for (int m = 0; m < 4; ++m)
#pragma unroll
                    for (int n = 0; n < 2; ++n) acc[a][b][m][n] = (f32x4){0.f, 0.f, 0.f, 0.f};
        cur = nxt; cA = nA; cB = nB; ++ui;
        if constexpr (ALIGN_EPI) { if (wr == 1) PG8_BAR; }
    }
    PG8_WAIT_V(0);
    if constexpr (!ALIGN_EPI) { if (wr == 0) PG8_BAR; }
    PG8_BAR;
    if constexpr (Epi::AFTER_DRAIN) { E.fused(acc, cur, wr, wc, fr, fq, lds, wid, lane); S.done(cur); }
#undef PG8_SA
#undef PG8_SB
#undef PG8_STAGE
#undef PG8_LDA
#undef PG8_LDB
#undef PG8_MMA
#undef PG8_WAIT_V
#undef PG8_WAIT_L
#undef PG8_BAR
#undef PG8_SCHED
}
}
#define PROBE_PH -1
#define PROBE_SUB 0

#define LAS __attribute__((address_space(3)))
typedef unsigned short bf16_t;
typedef short bf16x8 __attribute__((ext_vector_type(8)));
typedef float f32x4 __attribute__((ext_vector_type(4)));
typedef float f32x16 __attribute__((ext_vector_type(16)));
typedef unsigned u32x4 __attribute__((ext_vector_type(4)));
typedef unsigned u32x2 __attribute__((ext_vector_type(2)));
using pg8::cvt_pk_bf16;

constexpr int NWAVES = 8, NTHREADS = 512;
constexpr int BATCH = 4, SEQ = 4096, DM = 1024, MTOK = BATCH * SEQ, NZ = 3072, FF = 2816, NGU = 2 * FF, NLAYER = 2, INC = 2884;
constexpr float C2 = 0.125f * 1.4426950408889634f;
constexpr float NEGF = -1e30f;
constexpr int LDS_BYTES = 153600;
constexpr int NPHASE = 14;

constexpr size_t MiB = 1u << 20;
constexpr size_t WS_WIN = 0, WS_WOUT = 12 * MiB, WS_WGU = 16 * MiB, WS_WDN = 38 * MiB, WS_ROPE = 49 * MiB, WS_SSQA = 50 * MiB, WS_SSQB = 51 * MiB,
                 WS_MASK = 52 * MiB, WS_VB = 60 * MiB, WS_XB = 68 * MiB, WS_Y = 100 * MiB, WS_Z = 132 * MiB, WS_KB = 228 * MiB, WS_KI = 236 * MiB, WS_CTL = 250 * MiB, WS_END = 251 * MiB;
constexpr size_t CTL_BYTES = 40960;
constexpr int CW_ITEM = 8192;
constexpr int CW_PANEL = 4096;
constexpr int LDS_BAR_OFF = LDS_BYTES - 64;
constexpr size_t WIN_L = (size_t)NZ * DM, WOUT_L = (size_t)DM * DM, WGU_L = (size_t)NGU * DM, WDN_L = (size_t)DM * FF;

__device__ const double INVF[32] = {1, 0.74989420933245587, 0.56234132519034907, 0.42169650342858223, 0.31622776601683794, 0.23713737056616552, 0.17782794100389229, 0.1333521432163324,
    0.10000000000000001, 0.074989420933245579, 0.056234132519034911, 0.042169650342858224, 0.031622776601683791, 0.023713737056616554, 0.017782794100389229, 0.013335214321633241,
    0.01, 0.0074989420933245579, 0.005623413251903491, 0.0042169650342858229, 0.0031622776601683794, 0.0023713737056616554, 0.0017782794100389228, 0.0013335214321633241,
    0.001, 0.00074989420933245586, 0.0005623413251903491, 0.00042169650342858224, 0.00031622776601683794, 0.00023713737056616554, 0.00017782794100389227, 0.0001333521432163324};

#define LDS_WAIT() asm volatile("s_waitcnt lgkmcnt(0)" ::: "memory")
__device__ __forceinline__ float bf2f(unsigned short h) { return __uint_as_float((unsigned)h << 16); }
__device__ __forceinline__ float bflo(unsigned w) { return __uint_as_float(w << 16); }
__device__ __forceinline__ float bfhi(unsigned w) { return __uint_as_float(w & 0xffff0000u); }
#define DPPF(v, ctrl, rm) __int_as_float(__builtin_amdgcn_update_dpp(0, __float_as_int(v), ctrl, rm, 0xf, false))
__device__ __forceinline__ float wave_sum(float v) {
    v += DPPF(v, 0x111, 0xf); v += DPPF(v, 0x112, 0xf); v += DPPF(v, 0x114, 0xf); v += DPPF(v, 0x118, 0xf);
    v += DPPF(v, 0x142, 0xa); v += DPPF(v, 0x143, 0xc);
    return __int_as_float(__builtin_amdgcn_readlane(__float_as_int(v), 63));
}
__device__ __forceinline__ unsigned wave_umax(unsigned v) {
#define DPPU(v, ctrl, rm) (unsigned)__builtin_amdgcn_update_dpp(0, (int)(v), ctrl, rm, 0xf, false)
    v = max(v, DPPU(v, 0x111, 0xf)); v = max(v, DPPU(v, 0x112, 0xf)); v = max(v, DPPU(v, 0x114, 0xf)); v = max(v, DPPU(v, 0x118, 0xf));
    v = max(v, DPPU(v, 0x142, 0xa)); v = max(v, DPPU(v, 0x143, 0xc));
    return (unsigned)__builtin_amdgcn_readlane((int)v, 63);
#undef DPPU
}
__device__ __forceinline__ float swap32(float v, int hi) { auto rr = __builtin_amdgcn_permlane32_swap(__float_as_uint(v), __float_as_uint(v), false, false); return hi ? __uint_as_float(rr[0]) : __uint_as_float(rr[1]); }
__device__ __forceinline__ float row_rs(const float* ssq, int r) {
    const f32x4* p = (const f32x4*)(ssq + (size_t)r * 16); const f32x4 a = p[0], b = p[1], c = p[2], d = p[3];
    const float s = (((a.x + a.y) + (a.z + a.w)) + ((b.x + b.y) + (b.z + b.w))) + (((c.x + c.y) + (c.z + c.w)) + ((d.x + d.y) + (d.z + d.w)));
    return __builtin_amdgcn_rsqf(s * (1.f / 1024.f) + 1e-6f);
}
__device__ __forceinline__ float xor16_add(float v) { auto rr = __builtin_amdgcn_permlane16_swap(__float_as_uint(v), __float_as_uint(v), false, false); return __uint_as_float(rr[0]) + __uint_as_float(rr[1]); }
__device__ __forceinline__ float xor32_add(float v) { auto rr = __builtin_amdgcn_permlane32_swap(__float_as_uint(v), __float_as_uint(v), false, false); return __uint_as_float(rr[0]) + __uint_as_float(rr[1]); }
__device__ __forceinline__ void row_rs8(const float* ssq, int rbase  , int fq, float (&rs)[8]) {
    f32x4 p[8];
#pragma unroll
    for (int i = 0; i < 8; ++i) p[i] = *(const f32x4*)(ssq + (size_t)(rbase + (i >> 2) * 128 + (i & 3) * 16) * 16 + fq * 4);
#pragma unroll
    for (int i = 0; i < 8; ++i) { float s = (p[i].x + p[i].y) + (p[i].z + p[i].w); s = xor16_add(s); s = xor32_add(s); rs[i] = __builtin_amdgcn_rsqf(s * (1.f / 1024.f) + 1e-6f); }
}
__device__ __forceinline__ float sigmoidf_(float x) { return __builtin_amdgcn_rcpf(1.f + __expf(-x)); }

struct EpiZ {
    static constexpr bool PERM = true, AFTER_DRAIN = false;
    bf16_t* Z; bf16_t* Vb; bf16_t* Kb; bf16_t* KIb; const float* ssq; const float* ropec; const float* ropes;
    __device__ __forceinline__ void operator()(const f32x4 (&acc)[2][2][4][2], const pg8::Unit& u, int wr, int wc, int fr, int fq) const {
        const int pn = u.pn; const bool rope_tile = (pn == 5) || (pn == 6) || (pn == 8) || (pn == 11);
        float rs8[8]; row_rs8(ssq, u.pm * 256 + wr * 64 + fr, fq, rs8);
#pragma unroll
        for (int ai = 0; ai < 2; ++ai)
        {
            f32x4 rc[4], rsn[4]; const int ri0 = ((wc * 32 + fq * 8) & 63) >> 1;
            if (rope_tile) {
#pragma unroll
                for (int m = 0; m < 4; ++m) { const int pos_ = (u.pm * 256 + ai * 128 + wr * 64 + m * 16 + fr) & (SEQ - 1); rc[m] = *(const f32x4*)(ropec + pos_ * 32 + ri0); rsn[m] = *(const f32x4*)(ropes + pos_ * 32 + ri0); }
            }
#pragma unroll
            for (int m = 0; m < 4; ++m) {
                const int r = u.pm * 256 + ai * 128 + wr * 64 + m * 16 + fr; const float rs = rs8[ai * 4 + m]; const int pos = r & (SEQ - 1);
#pragma unroll
                for (int bj = 0; bj < 2; ++bj) {
                    const int cl = bj * 128 + wc * 32 + fq * 8;
                    f32x4 v0 = acc[ai][bj][m][0] * rs, v1 = acc[ai][bj][m][1] * rs;
                    if (rope_tile && (pn != 11 || cl < 64)) {
                        const f32x4 c4 = rc[m], s4 = rsn[m];
                        float a, b;
                        a = v0[0]; b = v0[1]; v0[0] = a * c4[0] - b * s4[0]; v0[1] = b * c4[0] + a * s4[0];
                        a = v0[2]; b = v0[3]; v0[2] = a * c4[1] - b * s4[1]; v0[3] = b * c4[1] + a * s4[1];
                        a = v1[0]; b = v1[1]; v1[0] = a * c4[2] - b * s4[2]; v1[1] = b * c4[2] + a * s4[2];
                        a = v1[2]; b = v1[3]; v1[2] = a * c4[3] - b * s4[3]; v1[3] = b * c4[3] + a * s4[3];
                    }
                    u32x4 w; w.x = cvt_pk_bf16(v0[0], v0[1]); w.y = cvt_pk_bf16(v0[2], v0[3]); w.z = cvt_pk_bf16(v1[0], v1[1]); w.w = cvt_pk_bf16(v1[2], v1[3]);
                    const int b = r >> 12;
                    if (pn == 7) {
                        const int hh = cl >> 6, d0 = cl & 63, kt = pos >> 5, k32 = pos & 31, c = k32 >> 4, kk = k32 & 15, vh = (kk >> 2) & 1, e = (kk & 3) + 4 * (kk >> 3);
                        bf16_t* vp = Vb + ((((size_t)((b * 4 + hh) * 128 + kt) * 2 + (d0 >> 5)) * 2 + c) * 32 + (d0 & 31)) * 16 + vh * 8 + e;
                        vp[0 * 16] = (bf16_t)(w.x & 0xffffu); vp[1 * 16] = (bf16_t)(w.x >> 16); vp[2 * 16] = (bf16_t)(w.y & 0xffffu); vp[3 * 16] = (bf16_t)(w.y >> 16);
                        vp[4 * 16] = (bf16_t)(w.z & 0xffffu); vp[5 * 16] = (bf16_t)(w.z >> 16); vp[6 * 16] = (bf16_t)(w.w & 0xffffu); vp[7 * 16] = (bf16_t)(w.w >> 16);
                    } else if (pn == 6) {
                        const int hh = cl >> 6, c = (cl >> 4) & 3, kh = (cl >> 3) & 1;
                        *(u32x4*)(Kb + ((((size_t)((b * 4 + hh) * 128 + (pos >> 5)) * 4 + c) * 32 + (pos & 31)) * 16 + kh * 8)) = w;
                    } else if (pn == 11) {
                        if (cl < 64) *(u32x4*)(KIb + ((((size_t)(b * 256 + (pos >> 4)) * 2 + (cl >> 5)) * 16 + (pos & 15)) * 32 + ((cl >> 3) & 3) * 8)) = w;
                        else if (cl == 64) *(u32x4*)(Z + (size_t)r * NZ + pn * 256 + cl) = w;
                    } else {
                        *(u32x4*)(Z + (size_t)r * NZ + pn * 256 + cl) = w;
                    }
                }
                asm volatile("" ::: "memory");
            }
        }
    }
};
#ifndef RES_LO
#define RES_LO 0
#endif
struct XL2 { bf16_t* a; bf16_t* b; };
__device__ __forceinline__ bf16_t* xl_row(const XL2& x, int r) { return r < 8192 ? x.a + (size_t)r * DM : x.b + (size_t)(r - 8192) * DM; }
__device__ __forceinline__ void split_hilo(const f32x4& v0, const f32x4& v1, u32x4& hi, u32x4& lo) {
    hi.x = cvt_pk_bf16(v0[0], v0[1]); hi.y = cvt_pk_bf16(v0[2], v0[3]); hi.z = cvt_pk_bf16(v1[0], v1[1]); hi.w = cvt_pk_bf16(v1[2], v1[3]);
    lo.x = cvt_pk_bf16(v0[0] - bflo(hi.x), v0[1] - bfhi(hi.x)); lo.y = cvt_pk_bf16(v0[2] - bflo(hi.y), v0[3] - bfhi(hi.y));
    lo.z = cvt_pk_bf16(v1[0] - bflo(hi.z), v1[1] - bfhi(hi.z)); lo.w = cvt_pk_bf16(v1[2] - bflo(hi.w), v1[3] - bfhi(hi.w));
}
__device__ __forceinline__ void join_hilo(const u32x4& hi, const u32x4& lo, f32x4& v0, f32x4& v1) {
    v0[0] = bflo(hi.x) + bflo(lo.x); v0[1] = bfhi(hi.x) + bfhi(lo.x); v0[2] = bflo(hi.y) + bflo(lo.y); v0[3] = bfhi(hi.y) + bfhi(lo.y);
    v1[0] = bflo(hi.z) + bflo(lo.z); v1[1] = bfhi(hi.z) + bfhi(lo.z); v1[2] = bflo(hi.w) + bflo(lo.w); v1[3] = bfhi(hi.w) + bfhi(lo.w);
}
template <bool BASE_F32> struct EpiRes {
    static constexpr bool PERM = true, AFTER_DRAIN = false;
    const float* basef; XL2 xlin; XL2 xlout; bf16_t* xb; float* ssq;
    __device__ __forceinline__ void operator()(const f32x4 (&acc)[2][2][4][2], const pg8::Unit& u, int wr, int wc, int fr, int fq) const {
#pragma unroll
        for (int ai = 0; ai < 2; ++ai)
#pragma unroll
            for (int m = 0; m < 4; ++m) {
                const int r = u.pm * 256 + ai * 128 + wr * 64 + m * 16 + fr; float sq = 0.f;
#pragma unroll
                for (int bj = 0; bj < 2; ++bj) {
                    const int col = u.pn * 256 + bj * 128 + wc * 32 + fq * 8; const size_t off = (size_t)r * DM + col;
                    f32x4 b0, b1;
                    if (BASE_F32) { b0 = *(const f32x4*)(basef + off); b1 = *(const f32x4*)(basef + off + 4); }
                    else { const u32x4 hi_in = *(const u32x4*)(xb + off); u32x4 lo_in = {0u, 0u, 0u, 0u}; if (RES_LO) lo_in = *(const u32x4*)(xl_row(xlin, r) + col); join_hilo(hi_in, lo_in, b0, b1); }
                    const f32x4 v0 = acc[ai][bj][m][0] + b0, v1 = acc[ai][bj][m][1] + b1;
                    u32x4 hi, lo; split_hilo(v0, v1, hi, lo);
                    *(u32x4*)(xb + off) = hi; if (RES_LO) *(u32x4*)(xl_row(xlout, r) + col) = lo;
                    sq += ((v0[0] * v0[0] + v0[1] * v0[1]) + (v0[2] * v0[2] + v0[3] * v0[3])) + ((v1[0] * v1[0] + v1[1] * v1[1]) + (v1[2] * v1[2] + v1[3] * v1[3]));
                }
                sq = xor16_add(sq); sq = xor32_add(sq);
                if (fq == 0) ssq[(size_t)r * 16 + u.pn * 4 + wc] = sq;
                if (m == 3) asm volatile("" ::: "memory");
            }
    }
};
struct EpiFinal {
    static constexpr bool PERM = true, AFTER_DRAIN = true;
    const bf16_t* xb; XL2 xlin; float* out; const float* gfin; float* xbuf; unsigned* cnt;
    __device__ __forceinline__ void fused(f32x4 (&acc)[2][2][4][2], const pg8::Unit& u, int wr, int wc, int fr, int fq, LAS unsigned char* lds, int wid, int lane) const {
        LAS float* P = (LAS float*)lds;
        LAS float* S = (LAS float*)(lds + 4096);
#pragma unroll
        for (int ai = 0; ai < 2; ++ai)
#pragma unroll
            for (int m = 0; m < 4; ++m) {
                const int rl = ai * 128 + wr * 64 + m * 16 + fr; float sq = 0.f;
#pragma unroll
                for (int bj = 0; bj < 2; ++bj) {
                    const size_t off = (size_t)(u.pm * 256 + rl) * DM + u.pn * 256 + bj * 128 + wc * 32 + fq * 8;
                    f32x4 b0, b1; { const u32x4 hi_in = *(const u32x4*)(xb + off); u32x4 lo_in = {0u, 0u, 0u, 0u}; if (RES_LO) lo_in = *(const u32x4*)(xl_row(xlin, u.pm * 256 + rl) + (off - (size_t)(u.pm * 256 + rl) * DM)); join_hilo(hi_in, lo_in, b0, b1); }
                    const f32x4 v0 = acc[ai][bj][m][0] + b0, v1 = acc[ai][bj][m][1] + b1;
                    acc[ai][bj][m][0] = v0; acc[ai][bj][m][1] = v1;
                    sq += ((v0[0] * v0[0] + v0[1] * v0[1]) + (v0[2] * v0[2] + v0[3] * v0[3])) + ((v1[0] * v1[0] + v1[1] * v1[1]) + (v1[2] * v1[2] + v1[3] * v1[3]));
                }
                sq = xor16_add(sq); sq = xor32_add(sq);
                if (fq == 0) P[rl * 4 + wc] = sq;
                if (m == 3) asm volatile("" ::: "memory");
            }
        asm volatile("s_waitcnt lgkmcnt(0)" ::: "memory"); __builtin_amdgcn_s_barrier(); asm volatile("" ::: "memory");
        const int tid = wid * 64 + lane;
        if (tid < 256) {
            const float s = (P[tid * 4 + 0] + P[tid * 4 + 1]) + (P[tid * 4 + 2] + P[tid * 4 + 3]);
            __hip_atomic_store(xbuf + (size_t)(u.pm * 256 + tid) * 4 + u.pn, s, __ATOMIC_RELAXED, __HIP_MEMORY_SCOPE_AGENT);
        }
        asm volatile("s_waitcnt vmcnt(0)" ::: "memory");
        if (lane == 0) __hip_atomic_fetch_add(cnt + 64 * u.pm, 1u, __ATOMIC_RELAXED, __HIP_MEMORY_SCOPE_AGENT);
        if (wid == 0) {
            unsigned spins = 0;
            while ((unsigned)__builtin_amdgcn_readfirstlane(__hip_atomic_load(cnt + 64 * u.pm, __ATOMIC_RELAXED, __HIP_MEMORY_SCOPE_AGENT)) < 32u) { __builtin_amdgcn_s_sleep(2); if (++spins > (1u << 22)) break; }
            __builtin_amdgcn_fence(__ATOMIC_ACQUIRE, "agent");
        }
        asm volatile("s_waitcnt vmcnt(0) lgkmcnt(0)" ::: "memory"); __builtin_amdgcn_s_barrier(); asm volatile("" ::: "memory");
        if (tid < 256) {
            const float* xp = xbuf + (size_t)(u.pm * 256 + tid) * 4;
            const float a = __hip_atomic_load(xp + 0, __ATOMIC_RELAXED, __HIP_MEMORY_SCOPE_AGENT), b = __hip_atomic_load(xp + 1, __ATOMIC_RELAXED, __HIP_MEMORY_SCOPE_AGENT),
                        c = __hip_atomic_load(xp + 2, __ATOMIC_RELAXED, __HIP_MEMORY_SCOPE_AGENT), d = __hip_atomic_load(xp + 3, __ATOMIC_RELAXED, __HIP_MEMORY_SCOPE_AGENT);
            S[tid] = __builtin_amdgcn_rsqf(((a + b) + (c + d)) * (1.f / 1024.f) + 1e-6f);
        }
        asm volatile("s_waitcnt vmcnt(0) lgkmcnt(0)" ::: "memory"); __builtin_amdgcn_s_barrier(); asm volatile("" ::: "memory");
#pragma unroll
        for (int ai = 0; ai < 2; ++ai)
#pragma unroll
            for (int m = 0; m < 4; ++m) {
                const int rl = ai * 128 + wr * 64 + m * 16 + fr; const float rs = S[rl];
#pragma unroll
                for (int bj = 0; bj < 2; ++bj) {
                    const int col = u.pn * 256 + bj * 128 + wc * 32 + fq * 8; const size_t off = (size_t)(u.pm * 256 + rl) * DM + col;
                    *(f32x4*)(out + off) = acc[ai][bj][m][0] * rs * *(const f32x4*)(gfin + col); *(f32x4*)(out + off + 4) = acc[ai][bj][m][1] * rs * *(const f32x4*)(gfin + col + 4);
                }
            }
    }
};
struct EpiGU {
    static constexpr bool PERM = true, AFTER_DRAIN = false;
    bf16_t* H; const float* ssq;
    __device__ __forceinline__ void operator()(const f32x4 (&acc)[2][2][4][2], const pg8::Unit& u, int wr, int wc, int fr, int fq) const {
        float rs8[8]; row_rs8(ssq, u.pm * 256 + wr * 64 + fr, fq, rs8);
#pragma unroll
        for (int ai = 0; ai < 2; ++ai)
#pragma unroll
            for (int m = 0; m < 4; ++m) {
                const int r = u.pm * 256 + ai * 128 + wr * 64 + m * 16 + fr; const float rs = rs8[ai * 4 + m];
                u32x4 w;
#pragma unroll
                for (int n = 0; n < 2; ++n) {
                    const f32x4 g = acc[ai][0][m][n] * rs, up = acc[ai][1][m][n] * rs;
                    const float h0 = g[0] * sigmoidf_(g[0]) * up[0], h1 = g[1] * sigmoidf_(g[1]) * up[1], h2 = g[2] * sigmoidf_(g[2]) * up[2], h3 = g[3] * sigmoidf_(g[3]) * up[3];
                    if (n == 0) { w.x = cvt_pk_bf16(h0, h1); w.y = cvt_pk_bf16(h2, h3); } else { w.z = cvt_pk_bf16(h0, h1); w.w = cvt_pk_bf16(h2, h3); }
                }
                *(u32x4*)(H + (size_t)r * FF + u.pn * 128 + wc * 32 + fq * 8) = w;
            }
    }
};

__device__ __forceinline__ int il64(int p) { return (p & 1) ? (p >> 1) + 32 : (p >> 1); }
__device__ __forceinline__ void conv_item(const float* src, int ld, float cs, const float* gk, int K, bf16_t* WT, int n0, int k0, LAS float* scr, int lane) {
    float v[32];
    const float* sp = src + (size_t)(k0 + (lane >> 5)) * ld;
#pragma unroll
    for (int i = 0; i < 32; ++i) v[i] = sp[(size_t)(2 * i) * ld];
    if (gk) {
        float g[32];
#pragma unroll
        for (int i = 0; i < 32; ++i) g[i] = gk[k0 + 2 * i + (lane >> 5)];
#pragma unroll
        for (int i = 0; i < 32; ++i) v[i] *= g[i];
    }
#pragma unroll
    for (int i = 0; i < 32; ++i) scr[(2 * i + (lane >> 5)) * 33 + (lane & 31)] = v[i] * cs;
    LDS_WAIT();
    const int c = lane & 7;
#pragma unroll
    for (int j = 0; j < 4; ++j) {
        const int n = (lane >> 3) + 8 * j; const LAS float* s = scr + (8 * c) * 33 + n;
        u32x4 o; o.x = cvt_pk_bf16(s[0 * 33], s[1 * 33]); o.y = cvt_pk_bf16(s[2 * 33], s[3 * 33]); o.z = cvt_pk_bf16(s[4 * 33], s[5 * 33]); o.w = cvt_pk_bf16(s[6 * 33], s[7 * 33]);
        *(u32x4*)(WT + (size_t)(n0 + n) * K + k0 + 8 * c) = o;
    }
    LDS_WAIT();
}

struct Args { const float* in[18]; float* out; unsigned char* ws; int ph_lo, ph_hi; };
typedef const Args __attribute__((address_space(4)))* KArgs;
__device__ __forceinline__ KArgs kargs() { KArgs p = (KArgs)__builtin_amdgcn_kernarg_segment_ptr(); asm volatile("" : "+s"(p)); return p; }

constexpr int CV_I_IN = 16 * 96, CV_I_OUT = 16 * 32, CV_I_GU = 16 * 176, CV_I_DN = 44 * 32, CV_I_L = CV_I_IN + CV_I_OUT + CV_I_GU + CV_I_DN;
__device__ __forceinline__ void convert_weights(KArgs A, unsigned char* ws, LAS unsigned char* lds, int wave, int lane, int it_lo, int it_hi, int gw, int NGW) {
    LAS float* scr = (LAS float*)(lds + wave * 16384);
    constexpr int I_IN = CV_I_IN, I_OUT = CV_I_OUT, I_GU = CV_I_GU, I_L = CV_I_L;
    for (int it = it_lo + gw; it < it_hi; it += NGW) {
        const int l = it / I_L; int r = it % I_L;
        if (r < I_IN) {
            const int kb = r / 96, nb = r % 96, n = nb * 32 + (lane & 31), tile = n >> 8, c = n & 255;
            int src; float cs = 1.f;
            if (tile <= 4) src = n;
            else if (tile == 5) { src = 1280 + (c & ~63) + il64(c & 63); cs = C2; }
            else if (tile == 6) src = 1536 + (c & ~63) + il64(c & 63);
            else if (tile == 7) src = 1792 + c;
            else if (tile == 8) src = 2048 + (c & ~63) + il64(c & 63);
            else if (tile == 9) src = 2372 + c;
            else if (tile == 10) src = 2628 + c;
            else { if (c < 64) src = 2304 + il64(c); else if (c < 68) { src = 2368 + (c - 64); cs = 0.0625f; } else { src = 0; cs = 0.f; } }
            const float* wl = A->in[2] + (size_t)l * DM * INC;
            conv_item(wl + src, INC, cs, A->in[1] + l * DM, DM, (bf16_t*)(ws + WS_WIN) + l * WIN_L, nb * 32, kb * 64, scr, lane);
            continue;
        }
        r -= I_IN;
        if (r < I_OUT) {
            const int kb = r / 32, nb = r % 32;
            conv_item(A->in[12] + (size_t)l * DM * DM + nb * 32 + (lane & 31), DM, 1.f, nullptr, DM, (bf16_t*)(ws + WS_WOUT) + l * WOUT_L, nb * 32, kb * 64, scr, lane);
            continue;
        }
        r -= I_OUT;
        if (r < I_GU) {
            const int kb = r / 176, nb = r % 176, n = nb * 32 + (lane & 31), c = n & 255, col = (n >> 8) * 128 + (c & 127);
            const float* wsrc = (c < 128 ? A->in[14] : A->in[15]) + (size_t)l * DM * FF + col;
            conv_item(wsrc, FF, 1.f, A->in[13] + l * DM, DM, (bf16_t*)(ws + WS_WGU) + l * WGU_L, nb * 32, kb * 64, scr, lane);
            continue;
        }
        r -= I_GU;
        { const int kb = r / 32, nb = r % 32;
          conv_item(A->in[16] + (size_t)l * FF * DM + nb * 32 + (lane & 31), DM, 1.f, nullptr, FF, (bf16_t*)(ws + WS_WDN) + l * WDN_L, nb * 32, kb * 64, scr, lane); }
    }
}
__device__ __forceinline__ void prologue(KArgs A, unsigned char* ws, LAS unsigned char* lds, int tid, int wave, int lane, int bid, int G, int sub) {
    const int gw = bid * NWAVES + wave, NGW = G * NWAVES;
    if (sub == 0 || sub == 1) convert_weights(A, ws, lds, wave, lane, 0, CV_I_L - CV_I_DN, gw, NGW);
    float* ropec = (float*)(ws + WS_ROPE); float* ropes = ropec + SEQ * 32;
    if (sub == 0 || sub == 2) for (int idx = bid * NTHREADS + tid; idx < SEQ * 32; idx += G * NTHREADS) {
        const int pos = idx >> 5, i = idx & 31;
        const double ang = (double)pos * INVF[i];
        const double nn = rint(ang * 0.15915494309189535);
        const double x = ang - nn * 6.283185307179586477, x2 = x * x;
        double c = 1.0, s = 1.0, tc = 1.0, ts = 1.0;
#pragma unroll
        for (int k = 1; k <= 15; ++k) { tc *= -x2 * (1.0 / (double)((2 * k - 1) * (2 * k))); c += tc; ts *= -x2 * (1.0 / (double)((2 * k) * (2 * k + 1))); s += ts; }
        ropec[idx] = (float)c; ropes[idx] = (float)(s * x);
    }
    const float* x = A->in[0]; bf16_t* XB = (bf16_t*)(ws + WS_XB); float* ssqA = (float*)(ws + WS_SSQA);
    if (sub == 0 || sub == 3) for (int row0 = gw; row0 < MTOK; row0 += 4 * NGW) {
        f32x4 v[4][4];
#pragma unroll
        for (int rr = 0; rr < 4; ++rr) { const int row = min(row0 + rr * NGW, MTOK - 1); const f32x4* xr = (const f32x4*)(x + (size_t)row * DM) + lane;
#pragma unroll
            for (int j = 0; j < 4; ++j) v[rr][j] = xr[64 * j]; }
#pragma unroll
        for (int rr = 0; rr < 4; ++rr) { const int row = row0 + rr * NGW; if (row < MTOK) { u32x2* d = (u32x2*)(XB + (size_t)row * DM) + lane; float s = 0.f;
#pragma unroll
            for (int j = 0; j < 4; ++j) { const f32x4 t = v[rr][j]; s += (t.x * t.x + t.y * t.y) + (t.z * t.z + t.w * t.w); u32x2 o; o.x = cvt_pk_bf16(t.x, t.y); o.y = cvt_pk_bf16(t.z, t.w); d[64 * j] = o; }
            s = wave_sum(s);
            if (lane < 16) ssqA[(size_t)row * 16 + lane] = lane == 0 ? s : 0.f; } }
    }
}

__device__ __forceinline__ int wave_isum(int v) {
    v += __builtin_amdgcn_update_dpp(0, v, 0x111, 0xf, 0xf, false);
    v += __builtin_amdgcn_update_dpp(0, v, 0x112, 0xf, 0xf, false);
    v += __builtin_amdgcn_update_dpp(0, v, 0x114, 0xf, 0xf, false);
    v += __builtin_amdgcn_update_dpp(0, v, 0x118, 0xf, 0xf, false);
    v += __builtin_amdgcn_update_dpp(0, v, 0x142, 0xa, 0xf, false);
    v += __builtin_amdgcn_update_dpp(0, v, 0x143, 0xc, 0xf, false);
    return __builtin_amdgcn_readlane(v, 63);
}
#define CNT4(c0, c1, t, x0, x1, x2, x3) do { unsigned long long m0_, m1_, m2_, m3_, j0_, j1_; \
    asm("v_cmp_le_u32_e64 %[m0], %[tt], %[a0]\n\tv_cmp_le_u32_e64 %[m1], %[tt], %[a1]\n\tv_cmp_le_u32_e64 %[m2], %[tt], %[a2]\n\tv_cmp_le_u32_e64 %[m3], %[tt], %[a3]\n\t" \
        "v_addc_co_u32_e64 %[k0], %[j0], 0, %[k0], %[m0]\n\tv_addc_co_u32_e64 %[k1], %[j1], 0, %[k1], %[m1]\n\t" \
        "v_addc_co_u32_e64 %[k0], %[j0], 0, %[k0], %[m2]\n\tv_addc_co_u32_e64 %[k1], %[j1], 0, %[k1], %[m3]" \
        : [k0] "+v"(c0), [k1] "+v"(c1), [m0] "=&s"(m0_), [m1] "=&s"(m1_), [m2] "=&s"(m2_), [m3] "=&s"(m3_), [j0] "=&s"(j0_), [j1] "=&s"(j1_) \
        : [tt] "s"(t), [a0] "v"(x0), [a1] "v"(x1), [a2] "v"(x2), [a3] "v"(x3)); } while (0)
#define BIT4(w, t, x0, x1, x2, x3) do { unsigned long long m0_, m1_, m2_, m3_, j0_; \
    asm("v_cmp_gt_u32_e64 %[m0], %[a0], %[tt]\n\tv_cmp_gt_u32_e64 %[m1], %[a1], %[tt]\n\tv_cmp_gt_u32_e64 %[m2], %[a2], %[tt]\n\tv_cmp_gt_u32_e64 %[m3], %[a3], %[tt]\n\t" \
        "v_addc_co_u32_e64 %[k0], %[j0], %[k0], %[k0], %[m0]\n\tv_addc_co_u32_e64 %[k0], %[j0], %[k0], %[k0], %[m1]\n\t" \
        "v_addc_co_u32_e64 %[k0], %[j0], %[k0], %[k0], %[m2]\n\tv_addc_co_u32_e64 %[k0], %[j0], %[k0], %[k0], %[m3]" \
        : [k0] "+v"(w), [m0] "=&s"(m0_), [m1] "=&s"(m1_), [m2] "=&s"(m2_), [m3] "=&s"(m3_), [j0] "=&s"(j0_) \
        : [tt] "s"(t), [a0] "v"(x0), [a1] "v"(x1), [a2] "v"(x2), [a3] "v"(x3)); } while (0)
__device__ __forceinline__ int count_ge(const unsigned (&u)[64], unsigned cand, int nblk) {
    int c0 = 0, c1 = 0;
    const unsigned ts = __builtin_amdgcn_readfirstlane(cand);
#pragma unroll
    for (int B = 0; B < 2; ++B) {
        if (B < nblk) {
#pragma unroll
            for (int i = 0; i < 32; i += 4) CNT4(c0, c1, ts, u[B * 32 + i], u[B * 32 + i + 1], u[B * 32 + i + 2], u[B * 32 + i + 3]);
        }
    }
    return wave_isum(c0 + c1);
}
__device__ __forceinline__ float keyval(unsigned k) { return __uint_as_float((k & 0x80000000u) ? (k ^ 0x80000000u) : ~k); }
__device__ __forceinline__ unsigned valkey(float f) { const unsigned b = __float_as_uint(f); return b ^ ((unsigned)((int)b >> 31) | 0x80000000u); }
__device__ __forceinline__ void select_query(const unsigned (&u)[64], unsigned vmax, int q, int b, int lane, unsigned* MASKb) {
    const int n = q + 1, nblk = (n + 2047) >> 11;
    unsigned T = 0u, TG = 0u; int rrem = 0;
    if (n > 256) {
        const unsigned kmax = wave_umax(vmax);
        const unsigned K0 = 0x80000000u;
        bool exact = false, done = false;
        unsigned lo = 0u, hi = 0u; float Llo = 1.f, Lhi = 1.f;
        const float L256 = 8.0028150156f;
        const int cpos = count_ge(u, K0 + 1u, nblk);
        if (cpos == 256) { T = K0 + 1u; exact = true; done = true; }
        else if (cpos > 256) { lo = K0 + 1u; Llo = __log2f((float)cpos) - L256; hi = kmax + 1u; Lhi = L256 + 1.f; }
        else {
            const int c0 = count_ge(u, K0, nblk);
            if (c0 >= 256) { T = K0; exact = (c0 == 256); done = true; }
            else {
                unsigned vmin = 0xffffffffu;
#pragma unroll
                for (int i = 0; i < 64; ++i) vmin = min(vmin, u[i] - 1u);
                lo = ~wave_umax(~vmin) + 1u; Llo = __log2f((float)n) - L256; hi = K0; Lhi = L256 - __log2f(fmaxf((float)c0, 0.5f));
            }
        }
        int it = 0, last = 0;
        while (!done) {
            if (hi - lo <= 1u) { T = lo; exact = false; break; }
            const float vlo = keyval(lo), vhi = keyval(hi);
            const float frac = (it >= 9 && (it & 1)) ? 0.5f : Llo * __builtin_amdgcn_rcpf(Llo + Lhi);
            unsigned mid = valkey(vlo + frac * (vhi - vlo));
            if (mid <= lo) mid = lo + 1u;
            if (mid >= hi) mid = hi - 1u;
            mid = __builtin_amdgcn_readfirstlane(mid);
            const int c = count_ge(u, mid, nblk);
            if (c == 256) { T = mid; exact = true; break; }
            if (c > 256) { lo = mid; Llo = __log2f((float)c) - L256; if (last == 1) Lhi *= 0.5f; last = 1; }
            else { hi = mid; Lhi = L256 - __log2f(fmaxf((float)c, 0.5f)); if (last == 2) Llo *= 0.5f; last = 2; }
            ++it;
        }
        if (exact) TG = T - 1u; else { TG = T; rrem = 256 - count_ge(u, T + 1u, nblk); }
    }
    int tbase = 0;
#pragma unroll
    for (int B = 0; B < 2; ++B) {
        if (B < nblk) {
            unsigned w = 0u; const unsigned tgs = __builtin_amdgcn_readfirstlane(TG);
#pragma unroll
            for (int e = 31; e >= 3; e -= 4) BIT4(w, tgs, u[B * 32 + e], u[B * 32 + e - 1], u[B * 32 + e - 2], u[B * 32 + e - 3]);
            if (rrem > 0) {
                int ec = 0;
#pragma unroll
                for (int e = 0; e < 32; ++e) ec += (u[B * 32 + e] == T) ? 1 : 0;
                int incl = ec;
#pragma unroll
                for (int o = 1; o < 64; o <<= 1) { const int t = __shfl_up(incl, o); if (lane >= o) incl += t; }
                const int total = __builtin_amdgcn_readlane(incl, 63);
                const int quota = rrem - tbase - (incl - ec);
                int taken = 0;
#pragma unroll
                for (int e = 0; e < 32; ++e) { const bool is = (u[B * 32 + e] == T) && (taken < quota); w |= is ? (1u << e) : 0u; taken += is ? 1 : 0; }
                tbase += total;
            }
            if (64 * B + lane <= (q >> 5)) __hip_atomic_store(MASKb + ((size_t)(b * 128 + (q >> 5)) * 128 + 64 * B + lane) * 32 + (q & 31), w, __ATOMIC_RELAXED, __HIP_MEMORY_SCOPE_AGENT);
        }
    }
}
__device__ __forceinline__ void select_phase(const bf16_t* Z, const bf16_t* KIb, unsigned* MASKb, unsigned* itemcnt, LAS unsigned char* lds, int wave_in, int lane_in, int bid, int G, int sub) {
    constexpr int SCS = 2312;
    LAS float* sc = (LAS float*)lds;
    const int nrounds = (1024 + G - 1) / G;
    bf16x8 qf[4][2]; u32x2 wraw;
#define SEL_LOADQ(idx_) do { const int i_ = (idx_) < 1023 ? (idx_) : 1023; const bf16_t* zq_ = Z + ((size_t)(i_ & 3) * SEQ + (i_ >> 2) * 16 + (lane_in & 15)) * NZ; \
        _Pragma("unroll") for (int j = 0; j < 4; ++j) _Pragma("unroll") for (int ks = 0; ks < 2; ++ks) qf[j][ks] = *(const bf16x8*)(zq_ + 2048 + j * 64 + ks * 32 + (lane_in >> 4) * 8); \
        wraw = *(const u32x2*)(zq_ + 2816 + 64); } while (0)
    { const int r0 = nrounds - 1; int i0_ = r0 * G + ((r0 & 1) ? (G - 1 - bid) : bid); SEL_LOADQ(i0_); }
    for (int rd = 0; rd < nrounds; ++rd) {
        const int rr_ = nrounds - 1 - rd, rn_ = rr_ > 0 ? rr_ - 1 : 0;
        const int idx = rr_ * G + ((rr_ & 1) ? (G - 1 - bid) : bid);
        const int idxn = rn_ * G + ((rn_ & 1) ? (G - 1 - bid) : bid);
        if (idx >= 1024) continue;
        const int b = idx & 3, q0 = (idx >> 2) * 16;
        int wave = wave_in, lane = lane_in; asm volatile("" : "+s"(wave), "+v"(lane));
        const int fr = lane & 15, fq = lane >> 4;
        const float w0 = bflo(wraw.x), w1 = bfhi(wraw.x), w2 = bflo(wraw.y), w3 = bfhi(wraw.y);
        const int nkt = (q0 >> 4) + 1, nch = (nkt + 127) >> 7;
        const bf16_t* kib = KIb + (size_t)b * 256 * 1024 + fr * 32 + fq * 8;
        const int qa = q0 + 2 * wave, qb = qa + 1;
        unsigned ua[64], ub[64]; unsigned vmaxa = 0u, vmaxb = 0u;
#pragma unroll
        for (int c = 0; c < 2; ++c) {
            if (c < nch) {
                const int ktlo = 128 * c, kthi = min(nkt, ktlo + 128);
                bf16x8 ka[2][2], kb2[2][2];
#define KI_LOAD(dst, i0) do { _Pragma("unroll") for (int t_ = 0; t_ < 2; ++t_) { int kt_ = ktlo + wave + 8 * ((i0) + t_); kt_ = kt_ < kthi ? kt_ : kthi - 1; \
                dst[t_][0] = *(const bf16x8*)(kib + (size_t)kt_ * 1024); dst[t_][1] = *(const bf16x8*)(kib + (size_t)kt_ * 1024 + 512); } } while (0)
#define KI_COMP(src, i0) do { _Pragma("unroll") for (int t_ = 0; t_ < 2; ++t_) { int kt_ = ktlo + wave + 8 * ((i0) + t_); kt_ = (kt_ < kthi ? kt_ : kthi - 1) - ktlo; \
                f32x4 s4 = {0.f, 0.f, 0.f, 0.f}; \
                _Pragma("unroll") for (int j = 0; j < 4; ++j) { \
                    f32x4 a = __builtin_amdgcn_mfma_f32_16x16x32_bf16(src[t_][0], qf[j][0], (f32x4){0.f, 0.f, 0.f, 0.f}, 0, 0, 0); \
                    a = __builtin_amdgcn_mfma_f32_16x16x32_bf16(src[t_][1], qf[j][1], a, 0, 0, 0); \
                    const float wj = j == 0 ? w0 : j == 1 ? w1 : j == 2 ? w2 : w3; \
                    _Pragma("unroll") for (int i = 0; i < 4; ++i) s4[i] = fmaf(__int_as_float(max(__float_as_int(a[i]), 0)), wj, s4[i]); } \
                *(LAS f32x4*)(sc + fr * SCS + kt_ * 16 + (kt_ >> 1) * 4 + fq * 4) = s4; } } while (0)
                KI_LOAD(ka, 0);
                for (int i0 = 0; ktlo + wave + 8 * i0 < kthi; i0 += 4) { KI_LOAD(kb2, i0 + 2); KI_COMP(ka, i0); KI_LOAD(ka, i0 + 4); KI_COMP(kb2, i0 + 2); }
#undef KI_LOAD
#undef KI_COMP
                __syncthreads();
                if (c + 1 == nch) SEL_LOADQ(idxn);
                const LAS float* srow = sc + (2 * wave) * SCS + 36 * lane;
                const int ema = qa - 2048 * c - 32 * lane, emb = ema + 1;
                const int adma = (int)(ema >= 31 ? 0xffffffffu : ema < 0 ? 0u : ((2u << ema) - 1u)), admb = (int)(emb >= 31 ? 0xffffffffu : emb < 0 ? 0u : ((2u << emb) - 1u));
#pragma unroll
                for (int e4 = 0; e4 < 8; ++e4) {
                    const f32x4 va = *(const LAS f32x4*)(srow + 4 * e4), vb = *(const LAS f32x4*)(srow + SCS + 4 * e4);
#pragma unroll
                    for (int e = 0; e < 4; ++e) {
                        const int ii = c * 32 + e4 * 4 + e;
                        const unsigned ba = __float_as_uint(va[e]), bb = __float_as_uint(vb[e]);
                        ua[ii] = (ba ^ ((unsigned)((int)ba >> 31) | 0x80000000u)) & (unsigned)__builtin_amdgcn_sbfe(adma, e4 * 4 + e, 1);
                        ub[ii] = (bb ^ ((unsigned)((int)bb >> 31) | 0x80000000u)) & (unsigned)__builtin_amdgcn_sbfe(admb, e4 * 4 + e, 1);
                        vmaxa = max(vmaxa, ua[ii]); vmaxb = max(vmaxb, ub[ii]);
                    }
                }
                asm volatile("s_waitcnt lgkmcnt(0)" ::: "memory");
                __syncthreads();
            } else {
#pragma unroll
                for (int e = 0; e < 32; ++e) { ua[c * 32 + e] = 0u; ub[c * 32 + e] = 0u; }
            }
        }
        if (sub != 3) {
            select_query(ua, vmaxa, qa, b, lane, MASKb);
            select_query(ub, vmaxb, qb, b, lane, MASKb);
            asm volatile("s_waitcnt vmcnt(0)" ::: "memory");
            if (lane == 0) __hip_atomic_fetch_add(itemcnt + idx, 1u, __ATOMIC_RELAXED, __HIP_MEMORY_SCOPE_AGENT);
        }
    }
    __syncthreads();
#undef SEL_LOADQ
}

__device__ __forceinline__ void mixer_a(const bf16_t* __restrict__ Z, bf16_t* __restrict__ Y, const float* __restrict__ wc, int gtid, int NGT) {
#pragma unroll 2
    for (int it = gtid; it < MTOK * 32; it += NGT) {
        const int row = it >> 5, c8 = (it & 31) * 8, pos = row & (SEQ - 1);
        const bf16_t* zr = Z + (size_t)row * NZ;
        float acc[8];
#pragma unroll
        for (int i = 0; i < 8; ++i) acc[i] = 0.f;
#pragma unroll
        for (int j = 0; j < 3; ++j) {
            const int d = 2 - j; const float ok = (pos >= d) ? 1.f : 0.f;
            {
                const bf16_t* zz = zr - (size_t)((pos >= d) ? d : 0) * NZ;
                const u32x4 cc = *(const u32x4*)(zz + 256 + c8), hh = *(const u32x4*)(zz + 512 + c8);
                const f32x4 wa = *(const f32x4*)(wc + j * 256 + c8) * ok, wb = *(const f32x4*)(wc + j * 256 + c8 + 4) * ok;
                acc[0] += wa[0] * (bflo(cc.x) * bflo(hh.x)); acc[1] += wa[1] * (bfhi(cc.x) * bfhi(hh.x));
                acc[2] += wa[2] * (bflo(cc.y) * bflo(hh.y)); acc[3] += wa[3] * (bfhi(cc.y) * bfhi(hh.y));
                acc[4] += wb[0] * (bflo(cc.z) * bflo(hh.z)); acc[5] += wb[1] * (bfhi(cc.z) * bfhi(hh.z));
                acc[6] += wb[2] * (bflo(cc.w) * bflo(hh.w)); acc[7] += wb[3] * (bfhi(cc.w) * bfhi(hh.w));
            }
        }
        const u32x4 ab = *(const u32x4*)(zr + c8);
        u32x4 o;
        o.x = cvt_pk_bf16(bflo(ab.x) * acc[0], bfhi(ab.x) * acc[1]); o.y = cvt_pk_bf16(bflo(ab.y) * acc[2], bfhi(ab.y) * acc[3]);
        o.z = cvt_pk_bf16(bflo(ab.z) * acc[4], bfhi(ab.z) * acc[5]); o.w = cvt_pk_bf16(bflo(ab.w) * acc[6], bfhi(ab.w) * acc[7]);
        *(u32x4*)(Y + (size_t)row * DM + c8) = o;
    }
}

__device__ __forceinline__ void mixer_b(const bf16_t* __restrict__ Z, bf16_t* __restrict__ Y, const float* __restrict__ lng, const float* __restrict__ lnb, const float* __restrict__ wsp, const float* __restrict__ bsp,
                                        LAS unsigned char* lds, int wave, int lane, int bid, int G) {
    constexpr int VP = 132;
    LAS bf16_t* vt = (LAS bf16_t*)lds;
    const int fr = lane & 15, fq = lane >> 4;
    for (int un = bid; un < 256; un += G) {
        const int chunk = un >> 1, hf = un & 1; const size_t row0 = (size_t)chunk * 128;
#pragma unroll 8
        for (int k = 0; k < 16; ++k) {
            const int s = wave * 16 + k; const bf16_t* zr = Z + (row0 + s) * NZ + 4 * 256;
            const float v0 = bf2f(zr[lane]), v1 = bf2f(zr[lane + 64]), v2 = bf2f(zr[lane + 128]), v3 = bf2f(zr[lane + 192]);
            const float mean = wave_sum((v0 + v1) + (v2 + v3)) * (1.f / 256.f);
            const float d0 = v0 - mean, d1 = v1 - mean, d2 = v2 - mean, d3 = v3 - mean;
            const float var = wave_sum((d0 * d0 + d1 * d1) + (d2 * d2 + d3 * d3)) * (1.f / 256.f);
            const float rstd = __builtin_amdgcn_rsqf(var + 1e-5f);
            const int ca = hf * 128 + lane, cb = ca + 64;
            const float a = (hf ? d2 : d0) * rstd * lng[ca] + lnb[ca], b = (hf ? d3 : d1) * rstd * lng[cb] + lnb[cb];
            const unsigned pk = cvt_pk_bf16(a, b);
            vt[lane * VP + s] = (bf16_t)(pk & 0xffffu); vt[(lane + 64) * VP + s] = (bf16_t)(pk >> 16);
        }
        __syncthreads();
        const int t = wave * 16 + fr;
#pragma unroll
        for (int hh = 0; hh < 2; ++hh) {
            const int h = hf * 2 + hh; const float* W = wsp + (size_t)h * 128 * 128 + (size_t)t * 128;
            f32x4 acc[4];
#pragma unroll
            for (int nt = 0; nt < 4; ++nt) acc[nt] = (f32x4){0.f, 0.f, 0.f, 0.f};
#pragma unroll
            for (int ks = 0; ks < 4; ++ks) {
                const int s0 = ks * 32 + fq * 8;
                f32x4 wa = *(const f32x4*)(W + s0), wb = *(const f32x4*)(W + s0 + 4);
#pragma unroll
                for (int j = 0; j < 4; ++j) { if (s0 + j > t) wa[j] = 0.f; if (s0 + 4 + j > t) wb[j] = 0.f; }
                u32x4 wp; wp.x = cvt_pk_bf16(wa[0], wa[1]); wp.y = cvt_pk_bf16(wa[2], wa[3]); wp.z = cvt_pk_bf16(wb[0], wb[1]); wp.w = cvt_pk_bf16(wb[2], wb[3]);
                const bf16x8 wf = __builtin_bit_cast(bf16x8, wp);
#pragma unroll
                for (int nt = 0; nt < 4; ++nt) {
                    const LAS bf16_t* vp = vt + (hh * 64 + nt * 16 + fr) * VP + s0;
                    const u32x2 lo = *(const LAS u32x2*)vp, hi2 = *(const LAS u32x2*)(vp + 4);
                    u32x4 vv; vv.x = lo.x; vv.y = lo.y; vv.z = hi2.x; vv.w = hi2.y;
                    acc[nt] = __builtin_amdgcn_mfma_f32_16x16x32_bf16(__builtin_bit_cast(bf16x8, vv), wf, acc[nt], 0, 0, 0);
                }
            }
            const float bias = bsp[h * 128 + t]; const size_t row = row0 + t;
#pragma unroll
            for (int nt = 0; nt < 4; ++nt) {
                const int col = h * 64 + nt * 16 + fq * 4;
                const u32x2 uu = *(const u32x2*)(Z + row * NZ + 3 * 256 + col);
                u32x2 o; o.x = cvt_pk_bf16((acc[nt][0] + bias) * bflo(uu.x), (acc[nt][1] + bias) * bfhi(uu.x)); o.y = cvt_pk_bf16((acc[nt][2] + bias) * bflo(uu.y), (acc[nt][3] + bias) * bfhi(uu.y));
                *(u32x2*)(Y + row * DM + 256 + col) = o;
            }
        }
        __syncthreads();
    }
}

__device__ __forceinline__ void mixer_d(const bf16_t* Z, bf16_t* Y, const float* wcf, const float* bcf, const float* lng, const float* lnb,
                                        LAS unsigned char* lds, int tid, int wave, int lane, int bid, int G) {
    LAS float* yl = (LAS float*)lds;
    LAS float* cv = (LAS float*)(lds + 62 * 256 * 4);
    const int c = tid & 255, half = tid >> 8;
    float w[31];
#pragma unroll
    for (int j = 0; j < 31; ++j) w[j] = wcf[j * 256 + c];
    const float bias = bcf[c];
    const f32x4 g4 = *(const f32x4*)(lng + lane * 4), b4 = *(const f32x4*)(lnb + lane * 4);
    for (int un = bid; un < MTOK / 32; un += G) {
        const int row0 = un * 32, pos0 = row0 & (SEQ - 1);
#pragma unroll
        for (int i4 = 0; i4 < 4; ++i4) {
            const int it0 = tid + i4 * NTHREADS, it = it0 < 62 * 32 ? it0 : 62 * 32 - 1;
            const int rr = it >> 5, c8 = (it & 31) * 8, p = pos0 - 30 + rr;
            f32x4 o0, o1; const float ok = (p >= 0) ? 1.f : 0.f;
            {
                const bf16_t* zr = Z + (size_t)(row0 + ((p >= 0) ? rr - 30 : 0)) * NZ;
                const u32x4 a = *(const u32x4*)(zr + 9 * 256 + c8), gg = *(const u32x4*)(zr + 10 * 256 + c8);
                o0[0] = bflo(a.x) * sigmoidf_(bflo(gg.x)); o0[1] = bfhi(a.x) * sigmoidf_(bfhi(gg.x)); o0[2] = bflo(a.y) * sigmoidf_(bflo(gg.y)); o0[3] = bfhi(a.y) * sigmoidf_(bfhi(gg.y));
                o1[0] = bflo(a.z) * sigmoidf_(bflo(gg.z)); o1[1] = bfhi(a.z) * sigmoidf_(bfhi(gg.z)); o1[2] = bflo(a.w) * sigmoidf_(bflo(gg.w)); o1[3] = bfhi(a.w) * sigmoidf_(bfhi(gg.w));
            }
            *(LAS f32x4*)(yl + rr * 256 + c8) = o0 * ok; *(LAS f32x4*)(yl + rr * 256 + c8 + 4) = o1 * ok;
        }
        __syncthreads();
#pragma unroll
        for (int blk = 0; blk < 2; ++blk) {
            const int tb = half * 16 + blk * 8;
            float acc[8];
#pragma unroll
            for (int o = 0; o < 8; ++o) acc[o] = bias;
#pragma unroll
            for (int jj = 0; jj < 38; ++jj) {
                const float v = yl[(tb + jj) * 256 + c];
#pragma unroll
                for (int o = 0; o < 8; ++o) { const int j = jj - o; if (j >= 0 && j < 31) acc[o] += w[j] * v; }
            }
#pragma unroll
            for (int o = 0; o < 8; ++o) cv[(tb + o) * 256 + c] = acc[o];
        }
        __syncthreads();
#pragma unroll
        for (int k = 0; k < 4; ++k) {
            const int tt = wave * 4 + k;
            const f32x4 v = *(const LAS f32x4*)(cv + tt * 256 + lane * 4);
            const float mean = wave_sum((v[0] + v[1]) + (v[2] + v[3])) * (1.f / 256.f);
            const f32x4 d = v - mean;
            const float var = wave_sum((d[0] * d[0] + d[1] * d[1]) + (d[2] * d[2] + d[3] * d[3])) * (1.f / 256.f);
            const float rstd = __builtin_amdgcn_rsqf(var + 1e-5f);
            const f32x4 y = d * rstd * g4 + b4;
            u32x2 o; o.x = cvt_pk_bf16(y[0] * sigmoidf_(y[0]), y[1] * sigmoidf_(y[1])); o.y = cvt_pk_bf16(y[2] * sigmoidf_(y[2]), y[3] * sigmoidf_(y[3]));
            *(u32x2*)(Y + (size_t)(row0 + tt) * DM + 768 + lane * 4) = o;
        }
        __syncthreads();
    }
}

__device__ __forceinline__ void mixer_bd(const bf16_t* __restrict__ Z, bf16_t* __restrict__ Y, const float* __restrict__ lng, const float* __restrict__ lnb, const float* __restrict__ wsp, const float* __restrict__ bsp,
                                         const float* __restrict__ wcf, const float* __restrict__ bcf, const float* __restrict__ dlng, const float* __restrict__ dlnb,
                                         LAS unsigned char* lds, int tid, int wave, int lane, int bid, int G) {
    constexpr int VP = 132;
    LAS bf16_t* vt = (LAS bf16_t*)lds;
    LAS float* yl = (LAS float*)(lds + 36864);
    LAS float* cv = (LAS float*)(lds + 100352);
    const int fr = lane & 15, fq = lane >> 4;
    const int c = tid & 255, half = tid >> 8;
    float w[31];
#pragma unroll
    for (int j = 0; j < 31; ++j) w[j] = wcf[j * 256 + c];
    const float dbias = bcf[c];
    const f32x4 g4 = *(const f32x4*)(dlng + lane * 4), b4 = *(const f32x4*)(dlnb + lane * 4);
#define MD_GLU(dun) do { const int row0_ = (dun) * 32, pos0_ = row0_ & (SEQ - 1); \
        _Pragma("unroll") for (int i4 = 0; i4 < 4; ++i4) { \
            const int it0 = tid + i4 * NTHREADS, it = it0 < 62 * 32 ? it0 : 62 * 32 - 1; \
            const int rr = it >> 5, c8 = (it & 31) * 8, p = pos0_ - 30 + rr; \
            f32x4 o0, o1; const float ok = (p >= 0) ? 1.f : 0.f; \
            const bf16_t* zr = Z + (size_t)(row0_ + ((p >= 0) ? rr - 30 : 0)) * NZ; \
            const u32x4 a = *(const u32x4*)(zr + 9 * 256 + c8), gg = *(const u32x4*)(zr + 10 * 256 + c8); \
            o0[0] = bflo(a.x) * sigmoidf_(bflo(gg.x)); o0[1] = bfhi(a.x) * sigmoidf_(bfhi(gg.x)); o0[2] = bflo(a.y) * sigmoidf_(bflo(gg.y)); o0[3] = bfhi(a.y) * sigmoidf_(bfhi(gg.y)); \
            o1[0] = bflo(a.z) * sigmoidf_(bflo(gg.z)); o1[1] = bfhi(a.z) * sigmoidf_(bfhi(gg.z)); o1[2] = bflo(a.w) * sigmoidf_(bflo(gg.w)); o1[3] = bfhi(a.w) * sigmoidf_(bfhi(gg.w)); \
            *(LAS f32x4*)(yl + rr * 256 + c8) = o0 * ok; *(LAS f32x4*)(yl + rr * 256 + c8 + 4) = o1 * ok; } } while (0)
#define MD_CONV() do { _Pragma("unroll") for (int blk = 0; blk < 2; ++blk) { const int tb = half * 16 + blk * 8; float acc_[8]; \
            _Pragma("unroll") for (int o = 0; o < 8; ++o) acc_[o] = dbias; \
            _Pragma("unroll") for (int jj = 0; jj < 38; ++jj) { const float v = yl[(tb + jj) * 256 + c]; \
                _Pragma("unroll") for (int o = 0; o < 8; ++o) { const int j = jj - o; if (j >= 0 && j < 31) acc_[o] += w[j] * v; } } \
            _Pragma("unroll") for (int o = 0; o < 8; ++o) cv[(tb + o) * 256 + c] = acc_[o]; } } while (0)
#define MD_LN(dun) do { const int row0_ = (dun) * 32; _Pragma("unroll") for (int k = 0; k < 4; ++k) { const int tt = wave * 4 + k; \
            const f32x4 v = *(const LAS f32x4*)(cv + tt * 256 + lane * 4); \
            const float mean = wave_sum((v[0] + v[1]) + (v[2] + v[3])) * (1.f / 256.f); const f32x4 d = v - mean; \
            const float var = wave_sum((d[0] * d[0] + d[1] * d[1]) + (d[2] * d[2] + d[3] * d[3])) * (1.f / 256.f); const float rstd = __builtin_amdgcn_rsqf(var + 1e-5f); \
            const f32x4 y = d * rstd * g4 + b4; \
            u32x2 o; o.x = cvt_pk_bf16(y[0] * sigmoidf_(y[0]), y[1] * sigmoidf_(y[1])); o.y = cvt_pk_bf16(y[2] * sigmoidf_(y[2]), y[3] * sigmoidf_(y[3])); \
            *(u32x2*)(Y + (size_t)(row0_ + tt) * DM + 768 + lane * 4) = o; } } while (0)
    for (int un = bid; un < 256; un += G) {
        const int chunk = un >> 1, hf = un & 1; const size_t row0 = (size_t)chunk * 128;
        const int t = wave * 16 + fr; const size_t row = row0 + t;
        bf16x8 wf[2][4]; u32x2 uu[2][4]; float bias[2];
#pragma unroll
        for (int hh = 0; hh < 2; ++hh) {
            const int h = hf * 2 + hh; const float* W = wsp + (size_t)h * 128 * 128 + (size_t)t * 128;
            f32x4 wa[4], wb[4];
#pragma unroll
            for (int ks = 0; ks < 4; ++ks) { wa[ks] = *(const f32x4*)(W + ks * 32 + fq * 8); wb[ks] = *(const f32x4*)(W + ks * 32 + fq * 8 + 4); }
#pragma unroll
            for (int nt = 0; nt < 4; ++nt) uu[hh][nt] = *(const u32x2*)(Z + row * NZ + 3 * 256 + h * 64 + nt * 16 + fq * 4);
            bias[hh] = bsp[h * 128 + t];
#pragma unroll
            for (int ks = 0; ks < 4; ++ks) {
                const int s0 = ks * 32 + fq * 8;
#pragma unroll
                for (int j = 0; j < 4; ++j) { if (s0 + j > t) wa[ks][j] = 0.f; if (s0 + 4 + j > t) wb[ks][j] = 0.f; }
                u32x4 wp; wp.x = cvt_pk_bf16(wa[ks][0], wa[ks][1]); wp.y = cvt_pk_bf16(wa[ks][2], wa[ks][3]); wp.z = cvt_pk_bf16(wb[ks][0], wb[ks][1]); wp.w = cvt_pk_bf16(wb[ks][2], wb[ks][3]);
                wf[hh][ks] = __builtin_bit_cast(bf16x8, wp);
            }
        }
#pragma unroll 8
        for (int k = 0; k < 16; ++k) {
            const int s = wave * 16 + k; const bf16_t* zr = Z + (row0 + s) * NZ + 4 * 256;
            const float v0 = bf2f(zr[lane]), v1 = bf2f(zr[lane + 64]), v2 = bf2f(zr[lane + 128]), v3 = bf2f(zr[lane + 192]);
            const float mean = wave_sum((v0 + v1) + (v2 + v3)) * (1.f / 256.f);
            const float d0 = v0 - mean, d1 = v1 - mean, d2 = v2 - mean, d3 = v3 - mean;
            const float var = wave_sum((d0 * d0 + d1 * d1) + (d2 * d2 + d3 * d3)) * (1.f / 256.f);
            const float rstd = __builtin_amdgcn_rsqf(var + 1e-5f);
            const int ca = hf * 128 + lane, cb = ca + 64;
            const float a = (hf ? d2 : d0) * rstd * lng[ca] + lnb[ca], b = (hf ? d3 : d1) * rstd * lng[cb] + lnb[cb];
            const unsigned pk = cvt_pk_bf16(a, b);
            vt[lane * VP + s] = (bf16_t)(pk & 0xffffu); vt[(lane + 64) * VP + s] = (bf16_t)(pk >> 16);
        }
        MD_GLU(2 * un);
        __syncthreads();
#pragma unroll
        for (int hh = 0; hh < 2; ++hh) {
            const int h = hf * 2 + hh;
            f32x4 acc[4];
#pragma unroll
            for (int nt = 0; nt < 4; ++nt) acc[nt] = (f32x4){0.f, 0.f, 0.f, 0.f};
#pragma unroll
            for (int ks = 0; ks < 4; ++ks) {
                const int s0 = ks * 32 + fq * 8;
#pragma unroll
                for (int nt = 0; nt < 4; ++nt) {
                    const LAS bf16_t* vp = vt + (hh * 64 + nt * 16 + fr) * VP + s0;
                    const u32x2 lo = *(const LAS u32x2*)vp, hi2 = *(const LAS u32x2*)(vp + 4);
                    u32x4 vv; vv.x = lo.x; vv.y = lo.y; vv.z = hi2.x; vv.w = hi2.y;
                    acc[nt] = __builtin_amdgcn_mfma_f32_16x16x32_bf16(__builtin_bit_cast(bf16x8, vv), wf[hh][ks], acc[nt], 0, 0, 0);
                }
            }
#pragma unroll
            for (int nt = 0; nt < 4; ++nt) {
                const int col = h * 64 + nt * 16 + fq * 4; const u32x2 u2 = uu[hh][nt]; const float bs_ = bias[hh];
                u32x2 o; o.x = cvt_pk_bf16((acc[nt][0] + bs_) * bflo(u2.x), (acc[nt][1] + bs_) * bfhi(u2.x)); o.y = cvt_pk_bf16((acc[nt][2] + bs_) * bflo(u2.y), (acc[nt][3] + bs_) * bfhi(u2.y));
                *(u32x2*)(Y + row * DM + 256 + col) = o;
            }
        }
        MD_CONV();
        __syncthreads();
        MD_LN(2 * un);
        MD_GLU(2 * un + 1);
        __syncthreads();
        MD_CONV();
        __syncthreads();
        MD_LN(2 * un + 1);
        __syncthreads();
    }
#undef MD_GLU
#undef MD_CONV
#undef MD_LN
}

__device__ __forceinline__ void attn_phase(const bf16_t* Z, const bf16_t* Kb, const bf16_t* Vb, unsigned* MASKb, unsigned* itemcnt, bf16_t* Y, LAS unsigned char* lds, int wave, int lane, int bid, int G) {
    const int h = wave & 3, half = wave >> 2, ql = lane & 31, hi = lane >> 5;
    LAS float* mo = (LAS float*)lds + h * 2048;
    LAS float* mml = (LAS float*)(lds + 32768) + h * 128;
    LAS bf16_t* ost = (LAS bf16_t*)(lds + 36864) + h * (32 * 72);
    const unsigned NEGB = __float_as_uint(NEGF);
    for (int pu = bid; pu < 256; pu += G) {
        const int b = pu & 3, jj = pu >> 2;
        for (int rep = 0; rep < 2; ++rep) {
            const int qb = rep ? jj : 127 - jj;
            const int NT = qb + 1, n0 = (NT + 1) >> 1, tb = half ? n0 : 0, te = half ? NT : n0;
            if (wave == 0) {
                unsigned* c0 = itemcnt + (2 * qb) * 4 + b; unsigned* c1 = c0 + 4; unsigned spins = 0;
                while ((unsigned)__builtin_amdgcn_readfirstlane(__hip_atomic_load(c0, __ATOMIC_RELAXED, __HIP_MEMORY_SCOPE_AGENT)) < 8u ||
                       (unsigned)__builtin_amdgcn_readfirstlane(__hip_atomic_load(c1, __ATOMIC_RELAXED, __HIP_MEMORY_SCOPE_AGENT)) < 8u) { __builtin_amdgcn_s_sleep(4); if (++spins > (1u << 22)) break; }
                __builtin_amdgcn_fence(__ATOMIC_ACQUIRE, "agent");
            }
            __syncthreads();
            const size_t rowq = (size_t)b * SEQ + qb * 32 + ql;
            const bf16_t* zq = Z + rowq * NZ + 1280 + h * 64 + hi * 8;
            bf16x8 qf[4];
#pragma unroll
            for (int c = 0; c < 4; ++c) qf[c] = *(const bf16x8*)(zq + 16 * c);
            unsigned* mrow = MASKb + ((size_t)(b * 128 + qb) * 128) * 32 + ql;
            const bf16_t* kb = Kb + ((size_t)(b * 4 + h) * 128) * 2048 + ql * 16 + hi * 8;
            const bf16_t* vb = Vb + ((size_t)(b * 4 + h) * 128) * 2048 + ql * 16 + hi * 8;
            f32x16 o0, o1;
#pragma unroll
            for (int r = 0; r < 16; ++r) { o0[r] = 0.f; o1[r] = 0.f; }
            float m = NEGF, l = 0.f;
            bf16x8 kA[4], kB[4]; bf16x8 vA[2][2], vB[2][2]; unsigned mA = 0u, mB = 0u;
#define ATT_LOAD(KF, VR, MW, kt_) do { const bf16_t* kp_ = kb + (size_t)(kt_) * 2048; const bf16_t* vp_ = vb + (size_t)(kt_) * 2048; _Pragma("unroll") for (int c = 0; c < 4; ++c) KF[c] = *(const bf16x8*)(kp_ + c * 512); \
        _Pragma("unroll") for (int mt = 0; mt < 2; ++mt) _Pragma("unroll") for (int c = 0; c < 2; ++c) VR[mt][c] = *(const bf16x8*)(vp_ + (mt * 2 + c) * 512); \
        MW = __hip_atomic_load(mrow + (kt_) * 32, __ATOMIC_RELAXED, __HIP_MEMORY_SCOPE_AGENT); } while (0)
#define ATT_COMP(KF, VR, MW) do { \
        f32x16 s; \
        _Pragma("unroll") for (int r = 0; r < 16; ++r) s[r] = 0.f; \
        __builtin_amdgcn_s_setprio(1); \
        _Pragma("unroll") for (int c = 0; c < 4; ++c) s = __builtin_amdgcn_mfma_f32_32x32x16_bf16(KF[c], qf[c], s, 0, 0, 0); \
        __builtin_amdgcn_s_setprio(0); \
        const int mws = (int)(MW >> (4 * hi)); \
        float rm = NEGF; \
        _Pragma("unroll") for (int r = 0; r < 16; ++r) { \
            const unsigned sel = (unsigned)__builtin_amdgcn_sbfe(mws, (r & 3) + 8 * (r >> 2), 1); \
            s[r] = __uint_as_float((__float_as_uint(s[r]) & sel) | (NEGB & ~sel)); \
            rm = fmaxf(rm, s[r]); } \
        rm = fmaxf(rm, swap32(rm, hi)); \
        const float mn = fmaxf(m, rm); \
        if (__any(mn > m)) { \
            const float al = __builtin_amdgcn_exp2f(m - mn); l *= al; \
            _Pragma("unroll") for (int r = 0; r < 16; ++r) { o0[r] *= al; o1[r] *= al; } \
            m = mn; } \
        float ps = 0.f; \
        _Pragma("unroll") for (int r = 0; r < 16; ++r) { s[r] = __builtin_amdgcn_exp2f(s[r] - m); ps += s[r]; } \
        l += ps; \
        u32x4 p0, p1; \
        p0.x = cvt_pk_bf16(s[0], s[1]); p0.y = cvt_pk_bf16(s[2], s[3]); p0.z = cvt_pk_bf16(s[4], s[5]); p0.w = cvt_pk_bf16(s[6], s[7]); \
        p1.x = cvt_pk_bf16(s[8], s[9]); p1.y = cvt_pk_bf16(s[10], s[11]); p1.z = cvt_pk_bf16(s[12], s[13]); p1.w = cvt_pk_bf16(s[14], s[15]); \
        const bf16x8 pf0 = __builtin_bit_cast(bf16x8, p0), pf1 = __builtin_bit_cast(bf16x8, p1); \
        __builtin_amdgcn_s_setprio(1); \
        o0 = __builtin_amdgcn_mfma_f32_32x32x16_bf16(VR[0][0], pf0, o0, 0, 0, 0); o1 = __builtin_amdgcn_mfma_f32_32x32x16_bf16(VR[1][0], pf0, o1, 0, 0, 0); \
        o0 = __builtin_amdgcn_mfma_f32_32x32x16_bf16(VR[0][1], pf1, o0, 0, 0, 0); o1 = __builtin_amdgcn_mfma_f32_32x32x16_bf16(VR[1][1], pf1, o1, 0, 0, 0); \
        __builtin_amdgcn_s_setprio(0); } while (0)
            if (tb < te) ATT_LOAD(kA, vA, mA, tb);
            for (int kt = tb; kt < te; kt += 2) {
                { const int k1 = (kt + 1 < te) ? kt + 1 : kt; ATT_LOAD(kB, vB, mB, k1); }
                ATT_COMP(kA, vA, mA);
                { const int k2 = (kt + 2 < te) ? kt + 2 : te - 1; ATT_LOAD(kA, vA, mA, k2); }
                if (kt + 1 < te) ATT_COMP(kB, vB, mB);
            }
#undef ATT_COMP
#undef ATT_LOAD
            const float lt = l + swap32(l, hi);
            if (half == 1) {
#pragma unroll
                for (int r = 0; r < 16; ++r) { mo[r * 64 + lane] = o0[r]; mo[(16 + r) * 64 + lane] = o1[r]; }
                mml[lane] = m; mml[64 + lane] = lt;
            }
            __syncthreads();
            if (half == 0) {
                const float m1 = mml[lane], l1 = mml[64 + lane];
                const float mn = fmaxf(m, m1), a0 = __builtin_amdgcn_exp2f(m - mn), a1 = __builtin_amdgcn_exp2f(m1 - mn);
                const float inv = __builtin_amdgcn_rcpf(lt * a0 + l1 * a1), f0 = a0 * inv, f1 = a1 * inv;
#pragma unroll
                for (int r = 0; r < 16; ++r) { o0[r] = o0[r] * f0 + mo[r * 64 + lane] * f1; o1[r] = o1[r] * f0 + mo[(16 + r) * 64 + lane] * f1; }
#pragma unroll
                for (int r = 0; r < 16; r += 2) {
                    const int d = (r & 3) + 8 * (r >> 2) + 4 * hi;
                    *(LAS unsigned*)(ost + ql * 72 + d) = cvt_pk_bf16(o0[r], o0[r + 1]);
                    *(LAS unsigned*)(ost + ql * 72 + 32 + d) = cvt_pk_bf16(o1[r], o1[r + 1]);
                }
                LDS_WAIT();
                bf16_t* yo = Y + ((size_t)b * SEQ + qb * 32 + (lane >> 1)) * DM + 512 + h * 64 + (lane & 1) * 32;
#pragma unroll
                for (int k = 0; k < 4; ++k) { const u32x4 v = *(const LAS u32x4*)(ost + (lane >> 1) * 72 + (lane & 1) * 32 + k * 8); *(u32x4*)(yo + k * 8) = v; }
            }
            __syncthreads();
        }
    }
}

#define RLX_AGENT __ATOMIC_RELAXED, __HIP_MEMORY_SCOPE_AGENT
#define XB_TMO      128
#define XB_XCNT(j)  (256  + 64 * (j))
#define XB_XSUB(j)  (1280 + 64 * (j))
#define XB_XGEN(j)  (2304 + 64 * (j))
#define XB_TOP      3328
#define XB_TOPGEN   3392
#define XCD_BAR_WORDS 3456
#define XB_SPIN_CAP (1u << 18)

__device__ __forceinline__ unsigned xb_ld(unsigned* p)              { return __hip_atomic_load(p, __ATOMIC_RELAXED, __HIP_MEMORY_SCOPE_AGENT); }
__device__ __forceinline__ unsigned xb_add(unsigned* p, unsigned v) { return __hip_atomic_fetch_add(p, v, __ATOMIC_RELAXED, __HIP_MEMORY_SCOPE_AGENT); }
__device__ __forceinline__ unsigned xb_xcc_id() { return (unsigned)__builtin_amdgcn_s_getreg((3 << 11) | 20) & 0xFu; }
#define XB_SPIN(cond, bar) do { unsigned _sp = 0; while (cond) { __builtin_amdgcn_s_sleep(1); \
    if ((++_sp & 255u) == 0u) { if (xb_ld(&(bar)[XB_TMO])) break; if (_sp > XB_SPIN_CAP) { atomicAdd(&(bar)[XB_TMO], 1u); break; } } } } while (0)

struct XcdBarrier {
    unsigned* bar; unsigned x;
    volatile LAS unsigned* st;
};

__device__ __forceinline__ XcdBarrier xcd_barrier_post(unsigned* bar, volatile LAS unsigned* st, int tid) {
    XcdBarrier b; b.bar = bar; b.x = xb_xcc_id(); b.st = st;
    if (tid == 0) (void)xb_add(&bar[XB_XCNT(b.x)], 1u);
    return b;
}
__device__ __forceinline__ void xcd_barrier_complete(unsigned* bar, unsigned x, unsigned& nloc, unsigned& nx) {
    const unsigned G = gridDim.x * gridDim.y * gridDim.z;
    unsigned sum, cnt, mine, sp = 0u;
    for (;;) {
        sum = 0u; cnt = 0u; mine = 0u;
#pragma unroll
        for (unsigned j = 0; j < 16; ++j) { const unsigned c = xb_ld(&bar[XB_XCNT(j)]); sum += c; cnt += (c > 0u) ? 1u : 0u; mine = (j == x) ? c : mine; }
        if (sum == G) break;
        __builtin_amdgcn_s_sleep(1);
        if ((++sp & 255u) == 0u) { if (xb_ld(&bar[XB_TMO])) break; if (sp > XB_SPIN_CAP) { atomicAdd(&bar[XB_TMO], 1u); break; } }
    }
    nloc = mine > 0u ? mine : 1u; nx = cnt > 0u ? cnt : 1u;
}

__device__ __forceinline__ void xcd_barrier(const XcdBarrier& b, int tid) {
    asm volatile("s_waitcnt vmcnt(0)" ::: "memory");
    __syncthreads();
    if (tid == 0) {
        unsigned* bar = b.bar;
        __builtin_amdgcn_s_waitcnt(0);
        unsigned nloc = b.st[0], nx = b.st[1];
        if (nloc == 0u) { xcd_barrier_complete(bar, b.x, nloc, nx); b.st[0] = nloc; b.st[1] = nx; }
        const unsigned old = xb_add(&bar[XB_XSUB(b.x)], 1u);
        const unsigned gen = old / nloc;
        if (old + 1u == (gen + 1u) * nloc) {
            __builtin_amdgcn_fence(__ATOMIC_RELEASE, "agent");
            asm volatile("s_waitcnt vmcnt(0)" ::: "memory");
            const unsigned og = xb_add(&bar[XB_TOP], 1u);
            const unsigned tg = og / nx, target = (tg + 1u) * nx;
            if (og + 1u != target) XB_SPIN(xb_ld(&bar[XB_TOP]) < target, bar);
            __builtin_amdgcn_fence(__ATOMIC_ACQUIRE, "agent");
            xb_add(&bar[XB_XGEN(b.x)], 1u);
            asm volatile("s_waitcnt vmcnt(0)" ::: "memory");
        } else {
            XB_SPIN(xb_ld(&bar[XB_XGEN(b.x)]) == gen, bar);
            __builtin_amdgcn_fence(__ATOMIC_ACQUIRE, "agent");
            asm volatile("s_waitcnt vmcnt(0)" ::: "memory");
        }
    }
    __syncthreads();
}

#ifndef PROBE_PH
#define PROBE_PH -1
#endif
#ifndef PROBE_SUB
#define PROBE_SUB 0
#endif
__global__ void __launch_bounds__(NTHREADS, 2) mega_fwd(Args A_unused) {
    extern __shared__ __attribute__((aligned(16))) unsigned char lds_raw[];
    LAS unsigned char* lds = (LAS unsigned char*)lds_raw;
    cg::grid_group grid = cg::this_grid();
    const int ph_lo = kargs()->ph_lo, ph_hi = kargs()->ph_hi;
    const int wave0 = __builtin_amdgcn_readfirstlane((int)(threadIdx.x >> 6));
    if (threadIdx.x < 16) ((volatile LAS unsigned*)(lds + LDS_BAR_OFF))[threadIdx.x] = 0u;
    __syncthreads();
    if (ph_hi - ph_lo > 1) { (void)xcd_barrier_post((unsigned*)(kargs()->ws + WS_CTL), (volatile LAS unsigned*)(lds + LDS_BAR_OFF), (int)threadIdx.x); }
    const int st_hi = (PROBE_PH >= 0) ? ph_hi + 1 : ph_hi;
    for (int st = ph_lo; st < st_hi; ++st) {
        const int ph = (PROBE_PH >= 0 && st > PROBE_PH) ? st - 1 : st;
        const int sub = (PROBE_PH >= 0 && st == PROBE_PH + 1) ? PROBE_SUB : 0;
        KArgs A = kargs();
        int G = gridDim.x; asm volatile("" : "+s"(G));
        unsigned char* ws = A->ws;
        bf16_t* XB = (bf16_t*)(ws + WS_XB); bf16_t* Yb = (bf16_t*)(ws + WS_Y); bf16_t* Zb = (bf16_t*)(ws + WS_Z); bf16_t* HID = Zb; bf16_t* Vb = (bf16_t*)(ws + WS_VB); bf16_t* Kb = (bf16_t*)(ws + WS_KB); bf16_t* KIb = (bf16_t*)(ws + WS_KI);
        float* ssqA = (float*)(ws + WS_SSQA); float* ssqB = (float*)(ws + WS_SSQB);
        float* ropec = (float*)(ws + WS_ROPE); float* ropes = ropec + SEQ * 32;
        unsigned* MASKb = (unsigned*)(ws + WS_MASK);
        int bid = blockIdx.x, wave = wave0; asm volatile("" : "+s"(bid), "+s"(wave));
        int lane = (int)__builtin_amdgcn_mbcnt_hi(~0u, __builtin_amdgcn_mbcnt_lo(~0u, 0u)); asm volatile("" : "+v"(lane));
        const int tid = wave * 64 + lane;
        if (ph == 0) {
#ifndef NO_PRO
            prologue(A, ws, lds, tid, wave, lane, bid, G, sub);
#endif
        } else if (ph == NPHASE - 1) {
            const float* gfin = A->in[17];
            if (G != 256) for (int row = bid * NWAVES + wave; row < MTOK; row += G * NWAVES) {
                const XL2 XLS{(bf16_t*)(ws + WS_MASK), (bf16_t*)(ws + WS_KB)};
                const float rs = row_rs(ssqA, row); f32x4* p = (f32x4*)(A->out + (size_t)row * DM) + lane; const f32x4* g = (const f32x4*)gfin + lane;
                const u32x2* ph_ = (const u32x2*)(XB + (size_t)row * DM) + lane; const u32x2* pl_ = (const u32x2*)xl_row(XLS, row) + lane;
#pragma unroll
                for (int j = 0; j < 4; ++j) { const u32x2 h2 = ph_[64 * j]; u32x2 l2 = {0u, 0u}; if (RES_LO) l2 = pl_[64 * j]; f32x4 v; v[0] = bflo(h2.x) + bflo(l2.x); v[1] = bfhi(h2.x) + bfhi(l2.x); v[2] = bflo(h2.y) + bflo(l2.y); v[3] = bfhi(h2.y) + bfhi(l2.y); p[64 * j] = v * rs * g[64 * j]; }
            }
        } else {
            const int l = (ph - 1) / 6, k = (ph - 1) % 6;
            if (k == 0) {
                pg8::Gemm g{XB, (bf16_t*)(ws + WS_WIN) + l * WIN_L, MTOK, NZ, DM}; pg8::StaticOrder S; S.init(MTOK, NZ, G, bid);
                EpiZ E{Zb, Vb, Kb, KIb, ssqA, ropec, ropes};
#ifndef NO_G0
                pg8::gemm_phase<EpiZ, pg8::StaticOrder, true, true>(lds, g, S, E, tid);
#endif
            } else if (k == 1) {
#ifndef NO_SEL
                if (sub != 2 && sub < 6) select_phase(Zb, KIb, MASKb, (unsigned*)(ws + WS_CTL) + CW_ITEM + l * 1024, lds, wave, lane, bid, G, sub);
#endif
#ifndef NO_MA
                if (sub == 0 || sub == 2 || sub == 8) mixer_a(Zb, Yb, A->in[3] + l * 3 * 256, bid * NTHREADS + tid, G * NTHREADS);
#endif
#ifndef NO_MB
                if (sub == 0 || sub == 2 || sub == 6 || sub == 7) mixer_bd(Zb, Yb, A->in[4] + l * 256, A->in[5] + l * 256, A->in[6] + (size_t)l * 4 * 128 * 128, A->in[7] + l * 4 * 128,
                                                                      A->in[8] + l * 31 * 256, A->in[9] + l * 256, A->in[10] + l * 256, A->in[11] + l * 256, lds, tid, wave, lane, bid, G);
#endif
            } else if (k == 2) {
#ifndef NO_ATT
                attn_phase(Zb, Kb, Vb, MASKb, (unsigned*)(ws + WS_CTL) + CW_ITEM + l * 1024, Yb, lds, wave, lane, bid, G);
#endif
            } else if (k == 3 || k == 5) {
                const XL2 XLD{(bf16_t*)A->out, (bf16_t*)A->out + (size_t)8192 * DM}, XLS{(bf16_t*)(ws + WS_MASK), (bf16_t*)(ws + WS_KB)};
                const bool last = (l == NLAYER - 1);
                pg8::Gemm g{k == 3 ? Yb : HID, k == 3 ? (bf16_t*)(ws + WS_WOUT) + l * WOUT_L : (bf16_t*)(ws + WS_WDN) + l * WDN_L, MTOK, DM, k == 3 ? DM : FF}; pg8::StaticOrder S; S.init(MTOK, DM, G, bid);
                if (k == 3 && l == 0) {
                    EpiRes<true> E{A->in[0], XLD, last ? XLS : XLD, XB, ssqB};
                    pg8::gemm_phase<EpiRes<true>, pg8::StaticOrder, true, true>(lds, g, S, E, tid);
                } else if (k == 5 && last && G == 256) {
                    EpiFinal E{XB, XLS, A->out, A->in[17], ssqB, (unsigned*)(ws + WS_CTL) + CW_PANEL};
                    pg8::gemm_phase<EpiFinal, pg8::StaticOrder, false, true>(lds, g, S, E, tid);
                } else {
                    EpiRes<false> E{nullptr, (k == 5 && last) ? XLS : XLD, last ? XLS : XLD, XB, k == 3 ? ssqB : ssqA};
                    pg8::gemm_phase<EpiRes<false>, pg8::StaticOrder, true, true>(lds, g, S, E, tid);
                }
            } else if (k == 4) {
                pg8::Gemm g{XB, (bf16_t*)(ws + WS_WGU) + l * WGU_L, MTOK, NGU, DM}; pg8::StaticOrder S; S.init(MTOK, NGU, G, bid);
                EpiGU E{HID, ssqB};
#ifndef NO_G2
                pg8::gemm_phase<EpiGU, pg8::StaticOrder, true, true>(lds, g, S, E, tid);
#endif
                if (l == 0) {
                    const int nwg = (MTOK / 256) * (NGU / 256), rem = nwg % G;
                    if (rem == 0) convert_weights(A, ws, lds, wave, lane, CV_I_L - CV_I_DN, NLAYER * CV_I_L, bid * NWAVES + wave, G * NWAVES);
                    else if (bid >= rem) convert_weights(A, ws, lds, wave, lane, CV_I_L - CV_I_DN, NLAYER * CV_I_L, (bid - rem) * NWAVES + wave, (G - rem) * NWAVES);
                }
            }
        }
        const bool flag_seam = (PROBE_PH < 0) && ph >= 1 && ph <= 12 && ((ph - 1) % 6) == 1;
        if (st + 1 < st_hi && !flag_seam) {
            if (ph_hi > 100000) grid.sync();
            XcdBarrier xb; xb.bar = (unsigned*)(ws + WS_CTL); xb.x = xb_xcc_id(); xb.st = (volatile LAS unsigned*)(lds + LDS_BAR_OFF);
            xcd_barrier(xb, tid);
        }
    }
}

#ifndef MK_COOP
#define MK_COOP 1
#endif
extern "C" void kernel_launch(void* const* d_in, const int* in_sizes, int n_in, void* d_out, int out_size, void* d_ws, size_t ws_size, hipStream_t stream) {
    static int grid = 0;
    if (grid == 0) {
        if (n_in != 18 || out_size != MTOK * DM || ws_size < WS_END) { fprintf(stderr, "kernel_launch: unexpected shapes (n_in %d out %d ws %zu)\n", n_in, out_size, ws_size); grid = -1; return; }
        int dev = 0, cus = 0, per_cu = 0;
        if (hipGetDevice(&dev) != hipSuccess || hipDeviceGetAttribute(&cus, hipDeviceAttributeMultiprocessorCount, dev) != hipSuccess) { grid = -1; return; }
        if (hipFuncSetAttribute((const void*)mega_fwd, hipFuncAttributeMaxDynamicSharedMemorySize, LDS_BYTES) != hipSuccess) { fprintf(stderr, "kernel_launch: hipFuncSetAttribute failed\n"); grid = -1; return; }
        if (hipOccupancyMaxActiveBlocksPerMultiprocessor(&per_cu, (const void*)mega_fwd, NTHREADS, LDS_BYTES) != hipSuccess || per_cu < 1) { fprintf(stderr, "kernel_launch: occupancy query says %d\n", per_cu); (void)hipGetLastError(); }
        grid = cus;
    }
    if (grid < 0) return;
    if (hipMemsetAsync((char*)d_ws + WS_CTL, 0, CTL_BYTES, stream) != hipSuccess) { fprintf(stderr, "kernel_launch: memset failed\n"); return; }
    Args a{};
    for (int i = 0; i < 18; ++i) a.in[i] = (const float*)d_in[i];
    a.out = (float*)d_out; a.ws = (unsigned char*)d_ws;
#if MK_COOP
    a.ph_lo = 0; a.ph_hi = (grid == 256) ? NPHASE - 1 : NPHASE;
    void* args[] = {&a};
    hipError_t e = hipLaunchCooperativeKernel((const void*)mega_fwd, dim3(grid), dim3(NTHREADS), args, LDS_BYTES, stream);
    if (e != hipSuccess) fprintf(stderr, "cooperative launch failed: %s (grid %d)\n", hipGetErrorString(e), grid);
#else
    for (int ph = 0; ph < NPHASE; ++ph) {
        a.ph_lo = ph; a.ph_hi = ph + 1;
        hipLaunchKernelGGL(mega_fwd, dim3(grid), dim3(NTHREADS), LDS_BYTES, stream, a);
    }
#endif
}
```

```cpp
#include <hip/hip_runtime.h>
#include <hip/hip_cooperative_groups.h>
#include <cstdio>
#include <cstdint>
namespace cg = cooperative_groups;
namespace pg8 {
#define PG8_LAS __attribute__((address_space(3)))
typedef unsigned short bf16_t;
typedef short bf16x8 __attribute__((ext_vector_type(8)));
typedef float f32x4 __attribute__((ext_vector_type(4)));
typedef unsigned u32x4 __attribute__((ext_vector_type(4)));
constexpr int BM = 256, BK = 64, HALF = 128, HTB = HALF * BK * 2  , STAGE_BYTES = 8 * HTB, NXCD = 8, WGM = 8;

__host__ __device__ __forceinline__ int lds_byte(int r, int c) { const int st = (r >> 4) * 2 + (c >> 5), rr = r & 15, cc = c & 31, ob = rr * 64 + cc * 2; return st * 1024 + (ob ^ (((ob >> 9) & 1) << 5)); }
__host__ __device__ __forceinline__ void stage_rc(int b, int& R, int& C) { const int st = b / 1024, sb = b % 1024, swz = sb ^ (((sb >> 9) & 1) << 5); R = (st >> 1) * 16 + swz / 64; C = (st & 1) * 32 + (swz % 64) / 2; }
__host__ __device__ __forceinline__ int perm32(int rho) { const int n = rho >> 4, i = rho & 15; return 8 * (i >> 2) + 4 * n + (i & 3); }

struct Unit { int pm, pn; };
struct Gemm { const bf16_t* A; const bf16_t* Bt; int M, N, K; };

struct StaticOrder {
    int nM, nN, nwg, G, c;
    __host__ __device__ void init(int M, int N, int G_, int c_) { nM = M / BM; nN = N / BM; nwg = nM * nN; G = G_; c = c_; }
    __host__ __device__ bool next(int i, Unit& u) const {
        const long L = (long)i * G + c; if (L >= nwg) return false;
        int wgid = (int)L; { const int q = nwg / NXCD, r = nwg % NXCD, xcd = wgid % NXCD, off = wgid / NXCD; wgid = (xcd < r ? xcd * (q + 1) : r * (q + 1) + (xcd - r) * q) + off; }
        const int nig = WGM * nN, gid = wgid / nig, fm = gid * WGM, gsz = (nM - fm) < WGM ? (nM - fm) : WGM;
        u.pm = fm + ((wgid % nig) % gsz); u.pn = (wgid % nig) / gsz; return true;
    }
    __device__ __forceinline__ void a_ready(const Unit&) const {}
    __device__ __forceinline__ void done(const Unit&) const {}
};

__device__ __forceinline__ unsigned cvt_pk_bf16(float lo, float hi) { unsigned r; asm volatile("v_cvt_pk_bf16_f32 %0, %1, %2" : "=v"(r) : "v"(lo), "v"(hi)); return r; }
template <class Epi, class Sched, bool ALIGN_EPI = false, bool SP2 = false>
__device__ __forceinline__ void gemm_phase(PG8_LAS unsigned char* lds, const Gemm g, const Sched& S, const Epi& E, int tid_in) {
    int tid_l = tid_in; asm volatile("" : "+v"(tid_l));
    const int tid = tid_l, wid = __builtin_amdgcn_readfirstlane(tid >> 6), lane = tid & 63, wr = wid >> 2, wc = wid & 3, fr = lane & 15, fq = lane >> 4;
    const int K = g.K, nt = K / BK;
    unsigned voffA[2], voffB[2];
#pragma unroll
    for (int i = 0; i < 2; ++i) { int R, C; stage_rc(tid * 16 + i * 8192, R, C); const int Rb = Epi::PERM ? ((R & ~31) + perm32(R & 31)) : R;
        voffA[i] = (unsigned)(R * K + C) * 2u; voffB[i] = (unsigned)(Rb * K + C) * 2u; }
    const size_t kstep = (size_t)(BK * 2);
    const size_t hstep = (size_t)HALF * K * 2;
    const size_t tstep = 2 * hstep;
    const unsigned ldsw = (unsigned)wid * 1024u;
    const int aoff = lds_byte(wr * 64 + fr, fq * 8), boff = lds_byte(wc * 32 + fr, fq * 8);
#define PG8_SA(b, h) (((b) * 2 + (h)) * HTB)
#define PG8_SB(b, h) ((4 + (b) * 2 + (h)) * HTB)
#define PG8_STAGE(bufoff, gbase, voff) do { _Pragma("unroll") for (int _i = 0; _i < 2; ++_i) \
        __builtin_amdgcn_global_load_lds((const unsigned*)((const char*)(gbase) + (voff)[_i]), (PG8_LAS unsigned*)(lds + (bufoff) + ldsw + _i * 8192), 16, 0, 0); } while (0)
#define PG8_LDA(dst, b, h) do { _Pragma("unroll") for (int m = 0; m < 4; ++m) _Pragma("unroll") for (int k = 0; k < 2; ++k) dst[m][k] = *(const PG8_LAS bf16x8*)(lds + PG8_SA(b, h) + aoff + m * 2048 + k * 1024); } while (0)
#define PG8_LDB(dst, b, h) do { _Pragma("unroll") for (int n = 0; n < 2; ++n) _Pragma("unroll") for (int k = 0; k < 2; ++k) dst[n][k] = *(const PG8_LAS bf16x8*)(lds + PG8_SB(b, h) + boff + n * 2048 + k * 1024); } while (0)
#define PG8_MMA(ai, bj, At, Bt) do { __builtin_amdgcn_s_setprio(1); _Pragma("unroll") for (int m = 0; m < 4; ++m) _Pragma("unroll") for (int n = 0; n < 2; ++n) _Pragma("unroll") for (int k = 0; k < 2; ++k) \
        acc[ai][bj][m][n] = __builtin_amdgcn_mfma_f32_16x16x32_bf16(Bt[n][k], At[m][k], acc[ai][bj][m][n], 0, 0, 0); __builtin_amdgcn_s_setprio(0); } while (0)
#define PG8_WAIT_V(n) asm volatile("s_waitcnt vmcnt(" #n ")" ::: "memory")
#define PG8_WAIT_L(n) asm volatile("s_waitcnt lgkmcnt(" #n ")" ::: "memory")
#define PG8_BAR __builtin_amdgcn_s_barrier()
#define PG8_SCHED __builtin_amdgcn_sched_barrier(0)
    Unit cur, nxt; int ui = 0;
    if (!S.next(0, cur)) return;
    f32x4 acc[2][2][4][2];
#pragma unroll
    for (int a = 0; a < 2; ++a)
#pragma unroll
        for (int b = 0; b < 2; ++b)
#pragma unroll
            for (int m = 0; m < 4; ++m)
#pragma unroll
                for (int n = 0; n < 2; ++n) acc[a][b][m][n] = (f32x4){0.f, 0.f, 0.f, 0.f};
    bf16x8 At[4][2], B0[2][2], B1[2][2];
    const char* cA = (const char*)g.A + (size_t)cur.pm * tstep; const char* cB = (const char*)g.Bt + (size_t)cur.pn * tstep;
    S.a_ready(cur);
    if constexpr (SP2) {
        PG8_STAGE(PG8_SB(0, 0), cB, voffB); PG8_STAGE(PG8_SB(0, 1), cB + hstep, voffB); PG8_STAGE(PG8_SA(0, 0), cA, voffA); PG8_STAGE(PG8_SA(0, 1), cA + hstep, voffA);
        if (wr == 1) PG8_BAR;
        PG8_WAIT_V(2); PG8_BAR;
        PG8_STAGE(PG8_SB(1, 0), cB + kstep, voffB); PG8_STAGE(PG8_SA(1, 0), cA + kstep, voffA); PG8_STAGE(PG8_SB(1, 1), cB + hstep + kstep, voffB);
        PG8_WAIT_V(6); PG8_BAR;
    } else {
        PG8_STAGE(PG8_SB(0, 0), cB, voffB); PG8_STAGE(PG8_SA(0, 0), cA, voffA); PG8_STAGE(PG8_SB(0, 1), cB + hstep, voffB); PG8_STAGE(PG8_SA(0, 1), cA + hstep, voffA);
        if (wr == 1) PG8_BAR;
        PG8_WAIT_V(4); PG8_BAR;
        PG8_STAGE(PG8_SB(1, 0), cB + kstep, voffB); PG8_STAGE(PG8_SA(1, 0), cA + kstep, voffA); PG8_STAGE(PG8_SB(1, 1), cB + hstep + kstep, voffB);
        PG8_WAIT_V(6); PG8_BAR;
    }
    for (;;) {
        const bool has_next = S.next(ui + 1, nxt);
        const char* nA = has_next ? (const char*)g.A + (size_t)nxt.pm * tstep : cA; const char* nB = has_next ? (const char*)g.Bt + (size_t)nxt.pn * tstep : cB;
        for (int t = 0; t < nt; t += 2) {
            const bool last = (t == nt - 2);
            const char* a1 = cA + (size_t)(t + 1) * kstep;
            const char* a2 = last ? nA : cA + (size_t)(t + 2) * kstep; const char* b2 = last ? nB : cB + (size_t)(t + 2) * kstep;
            const char* a3 = a2 + kstep; const char* b3 = b2 + kstep;
            if (last && has_next) S.a_ready(nxt);
            if constexpr (SP2) {
            PG8_LDB(B0, 0, 0); PG8_LDB(B1, 0, 1); PG8_SCHED; PG8_LDA(At, 0, 0); PG8_STAGE(PG8_SA(1, 1), a1 + hstep, voffA);
            PG8_WAIT_V(8); PG8_WAIT_L(0); PG8_BAR; PG8_MMA(0, 0, At, B0); PG8_MMA(0, 1, At, B1); PG8_BAR; PG8_SCHED;
            PG8_LDA(At, 0, 1); PG8_STAGE(PG8_SB(0, 0), b2, voffB); PG8_STAGE(PG8_SB(0, 1), b2 + hstep, voffB); PG8_STAGE(PG8_SA(0, 0), a2, voffA);
            PG8_WAIT_V(8); PG8_WAIT_L(0); PG8_BAR; PG8_MMA(1, 0, At, B0); PG8_MMA(1, 1, At, B1); PG8_BAR; PG8_SCHED;
            PG8_LDB(B0, 1, 0); PG8_LDB(B1, 1, 1); PG8_SCHED; PG8_LDA(At, 1, 0); PG8_STAGE(PG8_SA(0, 1), a2 + hstep, voffA);
            PG8_WAIT_V(8); PG8_WAIT_L(0); PG8_BAR; PG8_MMA(0, 0, At, B0); PG8_MMA(0, 1, At, B1); PG8_BAR; PG8_SCHED;
            PG8_LDA(At, 1, 1); PG8_STAGE(PG8_SB(1, 0), b3, voffB); PG8_STAGE(PG8_SB(1, 1), b3 + hstep, voffB); PG8_STAGE(PG8_SA(1, 0), a3, voffA);
            PG8_WAIT_V(8); PG8_WAIT_L(0); PG8_BAR; PG8_MMA(1, 0, At, B0); PG8_MMA(1, 1, At, B1); PG8_BAR; PG8_SCHED;
            } else {
            PG8_LDB(B0, 0, 0); PG8_SCHED; PG8_LDA(At, 0, 0); PG8_STAGE(PG8_SA(1, 1), a1 + hstep, voffA);
            PG8_WAIT_L(8); PG8_BAR; PG8_WAIT_L(0); PG8_MMA(0, 0, At, B0); PG8_BAR; PG8_SCHED;
            PG8_LDB(B1, 0, 1); PG8_STAGE(PG8_SB(0, 0), b2, voffB);
            PG8_BAR; PG8_WAIT_L(0); PG8_MMA(0, 1, At, B1); PG8_BAR;
            PG8_LDA(At, 0, 1); PG8_STAGE(PG8_SA(0, 0), a2, voffA);
            PG8_BAR; PG8_WAIT_L(0); PG8_MMA(1, 0, At, B0); PG8_BAR; PG8_SCHED;
            PG8_STAGE(PG8_SB(0, 1), b2 + hstep, voffB);
            PG8_WAIT_V(6); PG8_BAR; PG8_MMA(1, 1, At, B1); PG8_BAR;
            PG8_LDB(B0, 1, 0); PG8_SCHED; PG8_LDA(At, 1, 0); PG8_STAGE(PG8_SA(0, 1), a2 + hstep, voffA);
            PG8_WAIT_L(8); PG8_BAR; PG8_WAIT_L(0); PG8_MMA(0, 0, At, B0); PG8_BAR; PG8_SCHED;
            PG8_LDB(B1, 1, 1); PG8_STAGE(PG8_SB(1, 0), b3, voffB);
            PG8_BAR; PG8_WAIT_L(0); PG8_MMA(0, 1, At, B1); PG8_BAR;
            PG8_LDA(At, 1, 1); PG8_STAGE(PG8_SA(1, 0), a3, voffA);
            PG8_BAR; PG8_WAIT_L(0); PG8_MMA(1, 0, At, B0); PG8_BAR; PG8_SCHED;
            PG8_STAGE(PG8_SB(1, 1), b3 + hstep, voffB);
            PG8_WAIT_V(6); PG8_BAR; PG8_MMA(1, 1, At, B1); PG8_BAR;
            }
        }
        if constexpr (ALIGN_EPI) { if (wr == 0) PG8_BAR; }
        if constexpr (!Epi::AFTER_DRAIN) { E(acc, cur, wr, wc, fr, fq); S.done(cur); }
        if (!has_next) break;
#pragma unroll
        for (int a = 0; a < 2; ++a)
#pragma unroll
            for (int b = 0; b < 2; ++b)
#pragma unroll
                for (int m = 0; m < 4; ++m)
#pragma unroll
                    for (int n = 0; n < 2; ++n) acc[a][b][m][n] = (f32x4){0.f, 0.f, 0.f, 0.f};
        cur = nxt; cA = nA; cB = nB; ++ui;
        if constexpr (ALIGN_EPI) { if (wr == 1) PG8_BAR; }
    }
    PG8_WAIT_V(0);
    if constexpr (!ALIGN_EPI) { if (wr == 0) PG8_BAR; }
    PG8_BAR;
    if constexpr (Epi::AFTER_DRAIN) { E.fused(acc, cur, wr, wc, fr, fq, lds, wid, lane); S.done(cur); }
#undef PG8_SA
#undef PG8_SB
#undef PG8_STAGE
#undef PG8_LDA
#undef PG8_LDB
#undef PG8_MMA
#undef PG8_WAIT_V
#undef PG8_WAIT_L
#undef PG8_BAR
#undef PG8_SCHED
}
}
#define PROBE_PH -1
#define PROBE_SUB 0

#define LAS __attribute__((address_space(3)))
typedef unsigned short bf16_t;
typedef short bf16x8 __attribute__((ext_vector_type(8)));
typedef float f32x4 __attribute__((ext_vector_type(4)));
typedef float f32x16 __attribute__((ext_vector_type(16)));
typedef unsigned u32x4 __attribute__((ext_vector_type(4)));
typedef unsigned u32x2 __attribute__((ext_vector_type(2)));
using pg8::cvt_pk_bf16;

constexpr int NWAVES = 8, NTHREADS = 512;
constexpr int BATCH = 4, SEQ = 4096, DM = 1024, MTOK = BATCH * SEQ, NZ = 3072, FF = 2816, NGU = 2 * FF, NLAYER = 2, INC = 2884;
constexpr float C2 = 0.125f * 1.4426950408889634f;
constexpr float NEGF = -1e30f;
constexpr int LDS_BYTES = 153600;
constexpr int NPHASE = 14;

constexpr size_t MiB = 1u << 20;
constexpr size_t WS_WIN = 0, WS_WOUT = 12 * MiB, WS_WGU = 16 * MiB, WS_WDN = 38 * MiB, WS_ROPE = 49 * MiB, WS_SSQA = 50 * MiB, WS_SSQB = 51 * MiB,
                 WS_MASK = 52 * MiB, WS_VB = 60 * MiB, WS_XB = 68 * MiB, WS_Y = 100 * MiB, WS_Z = 132 * MiB, WS_KB = 228 * MiB, WS_KI = 236 * MiB, WS_CTL = 250 * MiB, WS_END = 251 * MiB;
constexpr size_t CTL_BYTES = 40960;
constexpr int CW_ITEM = 8192;
constexpr int CW_PANEL = 4096;
constexpr int LDS_BAR_OFF = LDS_BYTES - 64;
constexpr size_t WIN_L = (size_t)NZ * DM, WOUT_L = (size_t)DM * DM, WGU_L = (size_t)NGU * DM, WDN_L = (size_t)DM * FF;

__device__ const double INVF[32] = {1, 0.74989420933245587, 0.56234132519034907, 0.42169650342858223, 0.31622776601683794, 0.23713737056616552, 0.17782794100389229, 0.1333521432163324,
    0.10000000000000001, 0.074989420933245579, 0.056234132519034911, 0.042169650342858224, 0.031622776601683791, 0.023713737056616554, 0.017782794100389229, 0.013335214321633241,
    0.01, 0.0074989420933245579, 0.005623413251903491, 0.0042169650342858229, 0.0031622776601683794, 0.0023713737056616554, 0.0017782794100389228, 0.0013335214321633241,
    0.001, 0.00074989420933245586, 0.0005623413251903491, 0.00042169650342858224, 0.00031622776601683794, 0.00023713737056616554, 0.00017782794100389227, 0.0001333521432163324};

#define LDS_WAIT() asm volatile("s_waitcnt lgkmcnt(0)" ::: "memory")
__device__ __forceinline__ float bf2f(unsigned short h) { return __uint_as_float((unsigned)h << 16); }
__device__ __forceinline__ float bflo(unsigned w) { return __uint_as_float(w << 16); }
__device__ __forceinline__ float bfhi(unsigned w) { return __uint_as_float(w & 0xffff0000u); }
#define DPPF(v, ctrl, rm) __int_as_float(__builtin_amdgcn_update_dpp(0, __float_as_int(v), ctrl, rm, 0xf, false))
__device__ __forceinline__ float wave_sum(float v) {
    v += DPPF(v, 0x111, 0xf); v += DPPF(v, 0x112, 0xf); v += DPPF(v, 0x114, 0xf); v += DPPF(v, 0x118, 0xf);
    v += DPPF(v, 0x142, 0xa); v += DPPF(v, 0x143, 0xc);
    return __int_as_float(__builtin_amdgcn_readlane(__float_as_int(v), 63));
}
__device__ __forceinline__ unsigned wave_umax(unsigned v) {
#define DPPU(v, ctrl, rm) (unsigned)__builtin_amdgcn_update_dpp(0, (int)(v), ctrl, rm, 0xf, false)
    v = max(v, DPPU(v, 0x111, 0xf)); v = max(v, DPPU(v, 0x112, 0xf)); v = max(v, DPPU(v, 0x114, 0xf)); v = max(v, DPPU(v, 0x118, 0xf));
    v = max(v, DPPU(v, 0x142, 0xa)); v = max(v, DPPU(v, 0x143, 0xc));
    return (unsigned)__builtin_amdgcn_readlane((int)v, 63);
#undef DPPU
}
__device__ __forceinline__ float swap32(float v, int hi) { auto rr = __builtin_amdgcn_permlane32_swap(__float_as_uint(v), __float_as_uint(v), false, false); return hi ? __uint_as_float(rr[0]) : __uint_as_float(rr[1]); }
__device__ __forceinline__ float row_rs(const float* ssq, int r) {
    const f32x4* p = (const f32x4*)(ssq + (size_t)r * 16); const f32x4 a = p[0], b = p[1], c = p[2], d = p[3];
    const float s = (((a.x + a.y) + (a.z + a.w)) + ((b.x + b.y) + (b.z + b.w))) + (((c.x + c.y) + (c.z + c.w)) + ((d.x + d.y) + (d.z + d.w)));
    return __builtin_amdgcn_rsqf(s * (1.f / 1024.f) + 1e-6f);
}
__device__ __forceinline__ float xor16_add(float v) { auto rr = __builtin_amdgcn_permlane16_swap(__float_as_uint(v), __float_as_uint(v), false, false); return __uint_as_float(rr[0]) + __uint_as_float(rr[1]); }
__device__ __forceinline__ float xor32_add(float v) { auto rr = __builtin_amdgcn_permlane32_swap(__float_as_uint(v), __float_as_uint(v), false, false); return __uint_as_float(rr[0]) + __uint_as_float(rr[1]); }
__device__ __forceinline__ void row_rs8(const float* ssq, int rbase  , int fq, float (&rs)[8]) {
    f32x4 p[8];
#pragma unroll
    for (int i = 0; i < 8; ++i) p[i] = *(const f32x4*)(ssq + (size_t)(rbase + (i >> 2) * 128 + (i & 3) * 16) * 16 + fq * 4);
#pragma unroll
    for (int i = 0; i < 8; ++i) { float s = (p[i].x + p[i].y) + (p[i].z + p[i].w); s = xor16_add(s); s = xor32_add(s); rs[i] = __builtin_amdgcn_rsqf(s * (1.f / 1024.f) + 1e-6f); }
}
__device__ __forceinline__ float sigmoidf_(float x) { return __builtin_amdgcn_rcpf(1.f + __expf(-x)); }

struct EpiZ {
    static constexpr bool PERM = true, AFTER_DRAIN = false;
    bf16_t* Z; bf16_t* Vb; bf16_t* Kb; bf16_t* KIb; const float* ssq; const float* ropec; const float* ropes;
    __device__ __forceinline__ void operator()(const f32x4 (&acc)[2][2][4][2], const pg8::Unit& u, int wr, int wc, int fr, int fq) const {
        const int pn = u.pn; const bool rope_tile = (pn == 5) || (pn == 6) || (pn == 8) || (pn == 11);
        float rs8[8]; row_rs8(ssq, u.pm * 256 + wr * 64 + fr, fq, rs8);
#pragma unroll
        for (int ai = 0; ai < 2; ++ai)
        {
            f32x4 rc[4], rsn[4]; const int ri0 = ((wc * 32 + fq * 8) & 63) >> 1;
            if (rope_tile) {
#pragma unroll
                for (int m = 0; m < 4; ++m) { const int pos_ = (u.pm * 256 + ai * 128 + wr * 64 + m * 16 + fr) & (SEQ - 1); rc[m] = *(const f32x4*)(ropec + pos_ * 32 + ri0); rsn[m] = *(const f32x4*)(ropes + pos_ * 32 + ri0); }
            }
#pragma unroll
            for (int m = 0; m < 4; ++m) {
                const int r = u.pm * 256 + ai * 128 + wr * 64 + m * 16 + fr; const float rs = rs8[ai * 4 + m]; const int pos = r & (SEQ - 1);
#pragma unroll
                for (int bj = 0; bj < 2; ++bj) {
                    const int cl = bj * 128 + wc * 32 + fq * 8;
                    f32x4 v0 = acc[ai][bj][m][0] * rs, v1 = acc[ai][bj][m][1] * rs;
                    if (rope_tile && (pn != 11 || cl < 64)) {
                        const f32x4 c4 = rc[m], s4 = rsn[m];
                        float a, b;
                        a = v0[0]; b = v0[1]; v0[0] = a * c4[0] - b * s4[0]; v0[1] = b * c4[0] + a * s4[0];
                        a = v0[2]; b = v0[3]; v0[2] = a * c4[1] - b * s4[1]; v0[3] = b * c4[1] + a * s4[1];
                        a = v1[0]; b = v1[1]; v1[0] = a * c4[2] - b * s4[2]; v1[1] = b * c4[2] + a * s4[2];
                        a = v1[2]; b = v1[3]; v1[2] = a * c4[3] - b * s4[3]; v1[3] = b * c4[3] + a * s4[3];
                    }
                    u32x4 w; w.x = cvt_pk_bf16(v0[0], v0[1]); w.y = cvt_pk_bf16(v0[2], v0[3]); w.z = cvt_pk_bf16(v1[0], v1[1]); w.w = cvt_pk_bf16(v1[2], v1[3]);
                    const int b = r >> 12;
                    if (pn == 7) {
                        const int hh = cl >> 6, d0 = cl & 63, kt = pos >> 5, k32 = pos & 31, c = k32 >> 4, kk = k32 & 15, vh = (kk >> 2) & 1, e = (kk & 3) + 4 * (kk >> 3);
                        bf16_t* vp = Vb + ((((size_t)((b * 4 + hh) * 128 + kt) * 2 + (d0 >> 5)) * 2 + c) * 32 + (d0 & 31)) * 16 + vh * 8 + e;
                        vp[0 * 16] = (bf16_t)(w.x & 0xffffu); vp[1 * 16] = (bf16_t)(w.x >> 16); vp[2 * 16] = (bf16_t)(w.y & 0xffffu); vp[3 * 16] = (bf16_t)(w.y >> 16);
                        vp[4 * 16] = (bf16_t)(w.z & 0xffffu); vp[5 * 16] = (bf16_t)(w.z >> 16); vp[6 * 16] = (bf16_t)(w.w & 0xffffu); vp[7 * 16] = (bf16_t)(w.w >> 16);
                    } else if (pn == 6) {
                        const int hh = cl >> 6, c = (cl >> 4) & 3, kh = (cl >> 3) & 1;
                        *(u32x4*)(Kb + ((((size_t)((b * 4 + hh) * 128 + (pos >> 5)) * 4 + c) * 32 + (pos & 31)) * 16 + kh * 8)) = w;
                    } else if (pn == 11) {
                        if (cl < 64) *(u32x4*)(KIb + ((((size_t)(b * 256 + (pos >> 4)) * 2 + (cl >> 5)) * 16 + (pos & 15)) * 32 + ((cl >> 3) & 3) * 8)) = w;
                        else if (cl == 64) *(u32x4*)(Z + (size_t)r * NZ + pn * 256 + cl) = w;
                    } else {
                        *(u32x4*)(Z + (size_t)r * NZ + pn * 256 + cl) = w;
                    }
                }
                asm volatile("" ::: "memory");
            }
        }
    }
};
#ifndef RES_LO
#define RES_LO 0
#endif
struct XL2 { bf16_t* a; bf16_t* b; };
__device__ __forceinline__ bf16_t* xl_row(const XL2& x, int r) { return r < 8192 ? x.a + (size_t)r * DM : x.b + (size_t)(r - 8192) * DM; }
__device__ __forceinline__ void split_hilo(const f32x4& v0, const f32x4& v1, u32x4& hi, u32x4& lo) {
    hi.x = cvt_pk_bf16(v0[0], v0[1]); hi.y = cvt_pk_bf16(v0[2], v0[3]); hi.z = cvt_pk_bf16(v1[0], v1[1]); hi.w = cvt_pk_bf16(v1[2], v1[3]);
    lo.x = cvt_pk_bf16(v0[0] - bflo(hi.x), v0[1] - bfhi(hi.x)); lo.y = cvt_pk_bf16(v0[2] - bflo(hi.y), v0[3] - bfhi(hi.y));
    lo.z = cvt_pk_bf16(v1[0] - bflo(hi.z), v1[1] - bfhi(hi.z)); lo.w = cvt_pk_bf16(v1[2] - bflo(hi.w), v1[3] - bfhi(hi.w));
}
__device__ __forceinline__ void join_hilo(const u32x4& hi, const u32x4& lo, f32x4& v0, f32x4& v1) {
    v0[0] = bflo(hi.x) + bflo(lo.x); v0[1] = bfhi(hi.x) + bfhi(lo.x); v0[2] = bflo(hi.y) + bflo(lo.y); v0[3] = bfhi(hi.y) + bfhi(lo.y);
    v1[0] = bflo(hi.z) + bflo(lo.z); v1[1] = bfhi(hi.z) + bfhi(lo.z); v1[2] = bflo(hi.w) + bflo(lo.w); v1[3] = bfhi(hi.w) + bfhi(lo.w);
}
template <bool BASE_F32> struct EpiRes {
    static constexpr bool PERM = true, AFTER_DRAIN = false;
    const float* basef; XL2 xlin; XL2 xlout; bf16_t* xb; float* ssq;
    __device__ __forceinline__ void operator()(const f32x4 (&acc)[2][2][4][2], const pg8::Unit& u, int wr, int wc, int fr, int fq) const {
#pragma unroll
        for (int ai = 0; ai < 2; ++ai)
#pragma unroll
            for (int m = 0; m < 4; ++m) {
                const int r = u.pm * 256 + ai * 128 + wr * 64 + m * 16 + fr; float sq = 0.f;
#pragma unroll
                for (int bj = 0; bj < 2; ++bj) {
                    const int col = u.pn * 256 + bj * 128 + wc * 32 + fq * 8; const size_t off = (size_t)r * DM + col;
                    f32x4 b0, b1;
                    if (BASE_F32) { b0 = *(const f32x4*)(basef + off); b1 = *(const f32x4*)(basef + off + 4); }
                    else { const u32x4 hi_in = *(const u32x4*)(xb + off); u32x4 lo_in = {0u, 0u, 0u, 0u}; if (RES_LO) lo_in = *(const u32x4*)(xl_row(xlin, r) + col); join_hilo(hi_in, lo_in, b0, b1); }
                    const f32x4 v0 = acc[ai][bj][m][0] + b0, v1 = acc[ai][bj][m][1] + b1;
                    u32x4 hi, lo; split_hilo(v0, v1, hi, lo);
                    *(u32x4*)(xb + off) = hi; if (RES_LO) *(u32x4*)(xl_row(xlout, r) + col) = lo;
                    sq += ((v0[0] * v0[0] + v0[1] * v0[1]) + (v0[2] * v0[2] + v0[3] * v0[3])) + ((v1[0] * v1[0] + v1[1] * v1[1]) + (v1[2] * v1[2] + v1[3] * v1[3]));
                }
                sq = xor16_add(sq); sq = xor32_add(sq);
                if (fq == 0) ssq[(size_t)r * 16 + u.pn * 4 + wc] = sq;
                if (m == 3) asm volatile("" ::: "memory");
            }
    }
};
struct EpiFinal {
    static constexpr bool PERM = true, AFTER_DRAIN = true;
    const bf16_t* xb; XL2 xlin; float* out; const float* gfin; float* xbuf; unsigned* cnt;
    __device__ __forceinline__ void fused(f32x4 (&acc)[2][2][4][2], const pg8::Unit& u, int wr, int wc, int fr, int fq, LAS unsigned char* lds, int wid, int lane) const {
        LAS float* P = (LAS float*)lds;
        LAS float* S = (LAS float*)(lds + 4096);
#pragma unroll
        for (int ai = 0; ai < 2; ++ai)
#pragma unroll
            for (int m = 0; m < 4; ++m) {
                const int rl = ai * 128 + wr * 64 + m * 16 + fr; float sq = 0.f;
#pragma unroll
                for (int bj = 0; bj < 2; ++bj) {
                    const size_t off = (size_t)(u.pm * 256 + rl) * DM + u.pn * 256 + bj * 128 + wc * 32 + fq * 8;
                    f32x4 b0, b1; { const u32x4 hi_in = *(const u32x4*)(xb + off); u32x4 lo_in = {0u, 0u, 0u, 0u}; if (RES_LO) lo_in = *(const u32x4*)(xl_row(xlin, u.pm * 256 + rl) + (off - (size_t)(u.pm * 256 + rl) * DM)); join_hilo(hi_in, lo_in, b0, b1); }
                    const f32x4 v0 = acc[ai][bj][m][0] + b0, v1 = acc[ai][bj][m][1] + b1;
                    acc[ai][bj][m][0] = v0; acc[ai][bj][m][1] = v1;
                    sq += ((v0[0] * v0[0] + v0[1] * v0[1]) + (v0[2] * v0[2] + v0[3] * v0[3])) + ((v1[0] * v1[0] + v1[1] * v1[1]) + (v1[2] * v1[2] + v1[3] * v1[3]));
                }
                sq = xor16_add(sq); sq = xor32_add(sq);
                if (fq == 0) P[rl * 4 + wc] = sq;
                if (m == 3) asm volatile("" ::: "memory");
            }
        asm volatile("s_waitcnt lgkmcnt(0)" ::: "memory"); __builtin_amdgcn_s_barrier(); asm volatile("" ::: "memory");
        const int tid = wid * 64 + lane;
        if (tid < 256) {
            const float s = (P[tid * 4 + 0] + P[tid * 4 + 1]) + (P[tid * 4 + 2] + P[tid * 4 + 3]);
            __hip_atomic_store(xbuf + (size_t)(u.pm * 256 + tid) * 4 + u.pn, s, __ATOMIC_RELAXED, __HIP_MEMORY_SCOPE_AGENT);
        }
        asm volatile("s_waitcnt vmcnt(0)" ::: "memory");
        if (lane == 0) __hip_atomic_fetch_add(cnt + 64 * u.pm, 1u, __ATOMIC_RELAXED, __HIP_MEMORY_SCOPE_AGENT);
        if (wid == 0) {
            unsigned spins = 0;
            while ((unsigned)__builtin_amdgcn_readfirstlane(__hip_atomic_load(cnt + 64 * u.pm, __ATOMIC_RELAXED, __HIP_MEMORY_SCOPE_AGENT)) < 32u) { __builtin_amdgcn_s_sleep(2); if (++spins > (1u << 22)) break; }
            __builtin_amdgcn_fence(__ATOMIC_ACQUIRE, "agent");
        }
        asm volatile("s_waitcnt vmcnt(0) lgkmcnt(0)" ::: "memory"); __builtin_amdgcn_s_barrier(); asm volatile("" ::: "memory");
        if (tid < 256) {
            const float* xp = xbuf + (size_t)(u.pm * 256 + tid) * 4;
            const float a = __hip_atomic_load(xp + 0, __ATOMIC_RELAXED, __HIP_MEMORY_SCOPE_AGENT), b = __hip_atomic_load(xp + 1, __ATOMIC_RELAXED, __HIP_MEMORY_SCOPE_AGENT),
                        c = __hip_atomic_load(xp + 2, __ATOMIC_RELAXED, __HIP_MEMORY_SCOPE_AGENT), d = __hip_atomic_load(xp + 3, __ATOMIC_RELAXED, __HIP_MEMORY_SCOPE_AGENT);
            S[tid] = __builtin_amdgcn_rsqf(((a + b) + (c + d)) * (1.f / 1024.f) + 1e-6f);
        }
        asm volatile("s_waitcnt vmcnt(0) lgkmcnt(0)" ::: "memory"); __builtin_amdgcn_s_barrier(); asm volatile("" ::: "memory");
#pragma unroll
        for (int ai = 0; ai < 2; ++ai)
#pragma unroll
            for (int m = 0; m < 4; ++m) {
                const int rl = ai * 128 + wr * 64 + m * 16 + fr; const float rs = S[rl];
#pragma unroll
                for (int bj = 0; bj < 2; ++bj) {
                    const int col = u.pn * 256 + bj * 128 + wc * 32 + fq * 8; const size_t off = (size_t)(u.pm * 256 + rl) * DM + col;
                    *(f32x4*)(out + off) = acc[ai][bj][m][0] * rs * *(const f32x4*)(gfin + col); *(f32x4*)(out + off + 4) = acc[ai][bj][m][1] * rs * *(const f32x4*)(gfin + col + 4);
                }
            }
    }
};
struct EpiGU {
    static constexpr bool PERM = true, AFTER_DRAIN = false;
    bf16_t* H; const float* ssq;
    __device__ __forceinline__ void operator()(const f32x4 (&acc)[2][2][4][2], const pg8::Unit& u, int wr, int wc, int fr, int fq) const {
        float rs8[8]; row_rs8(ssq, u.pm * 256 + wr * 64 + fr, fq, rs8);
#pragma unroll
        for (int ai = 0; ai < 2; ++ai)
#pragma unroll
            for (int m = 0; m < 4; ++m) {
                const int r = u.pm * 256 + ai * 128 + wr * 64 + m * 16 + fr; const float rs = rs8[ai * 4 + m];
                u32x4 w;
#pragma unroll
                for (int n = 0; n < 2; ++n) {
                    const f32x4 g = acc[ai][0][m][n] * rs, up = acc[ai][1][m][n] * rs;
                    const float h0 = g[0] * sigmoidf_(g[0]) * up[0], h1 = g[1] * sigmoidf_(g[1]) * up[1], h2 = g[2] * sigmoidf_(g[2]) * up[2], h3 = g[3] * sigmoidf_(g[3]) * up[3];
                    if (n == 0) { w.x = cvt_pk_bf16(h0, h1); w.y = cvt_pk_bf16(h2, h3); } else { w.z = cvt_pk_bf16(h0, h1); w.w = cvt_pk_bf16(h2, h3); }
                }
                *(u32x4*)(H + (size_t)r * FF + u.pn * 128 + wc * 32 + fq * 8) = w;
            }
    }
};

__device__ __forceinline__ int il64(int p) { return (p & 1) ? (p >> 1) + 32 : (p >> 1); }
__device__ __forceinline__ void conv_item(const float* src, int ld, float cs, const float* gk, int K, bf16_t* WT, int n0, int k0, LAS float* scr, int lane) {
    float v[32];
    const float* sp = src + (size_t)(k0 + (lane >> 5)) * ld;
#pragma unroll
    for (int i = 0; i < 32; ++i) v[i] = sp[(size_t)(2 * i) * ld];
    if (gk) {
        float g[32];
#pragma unroll
        for (int i = 0; i < 32; ++i) g[i] = gk[k0 + 2 * i + (lane >> 5)];
#pragma unroll
        for (int i = 0; i < 32; ++i) v[i] *= g[i];
    }
#pragma unroll
    for (int i = 0; i < 32; ++i) scr[(2 * i + (lane >> 5)) * 33 + (lane & 31)] = v[i] * cs;
    LDS_WAIT();
    const int c = lane & 7;
#pragma unroll
    for (int j = 0; j < 4; ++j) {
        const int n = (lane >> 3) + 8 * j; const LAS float* s = scr + (8 * c) * 33 + n;
        u32x4 o; o.x = cvt_pk_bf16(s[0 * 33], s[1 * 33]); o.y = cvt_pk_bf16(s[2 * 33], s[3 * 33]); o.z = cvt_pk_bf16(s[4 * 33], s[5 * 33]); o.w = cvt_pk_bf16(s[6 * 33], s[7 * 33]);
        *(u32x4*)(WT + (size_t)(n0 + n) * K + k0 + 8 * c) = o;
    }
    LDS_WAIT();
}

struct Args { const float* in[18]; float* out; unsigned char* ws; int ph_lo, ph_hi; };
typedef const Args __attribute__((address_space(4)))* KArgs;
__device__ __forceinline__ KArgs kargs() { KArgs p = (KArgs)__builtin_amdgcn_kernarg_segment_ptr(); asm volatile("" : "+s"(p)); return p; }

constexpr int CV_I_IN = 16 * 96, CV_I_OUT = 16 * 32, CV_I_GU = 16 * 176, CV_I_DN = 44 * 32, CV_I_L = CV_I_IN + CV_I_OUT + CV_I_GU + CV_I_DN;
__device__ __forceinline__ void convert_weights(KArgs A, unsigned char* ws, LAS unsigned char* lds, int wave, int lane, int it_lo, int it_hi, int gw, int NGW) {
    LAS float* scr = (LAS float*)(lds + wave * 16384);
    constexpr int I_IN = CV_I_IN, I_OUT = CV_I_OUT, I_GU = CV_I_GU, I_L = CV_I_L;
    for (int it = it_lo + gw; it < it_hi; it += NGW) {
        const int l = it / I_L; int r = it % I_L;
        if (r < I_IN) {
            const int kb = r / 96, nb = r % 96, n = nb * 32 + (lane & 31), tile = n >> 8, c = n & 255;
            int src; float cs = 1.f;
            if (tile <= 4) src = n;
            else if (tile == 5) { src = 1280 + (c & ~63) + il64(c & 63); cs = C2; }
            else if (tile == 6) src = 1536 + (c & ~63) + il64(c & 63);
            else if (tile == 7) src = 1792 + c;
            else if (tile == 8) src = 2048 + (c & ~63) + il64(c & 63);
            else if (tile == 9) src = 2372 + c;
            else if (tile == 10) src = 2628 + c;
            else { if (c < 64) src = 2304 + il64(c); else if (c < 68) { src = 2368 + (c - 64); cs = 0.0625f; } else { src = 0; cs = 0.f; } }
            const float* wl = A->in[2] + (size_t)l * DM * INC;
            conv_item(wl + src, INC, cs, A->in[1] + l * DM, DM, (bf16_t*)(ws + WS_WIN) + l * WIN_L, nb * 32, kb * 64, scr, lane);
            continue;
        }
        r -= I_IN;
        if (r < I_OUT) {
            const int kb = r / 32, nb = r % 32;
            conv_item(A->in[12] + (size_t)l * DM * DM + nb * 32 + (lane & 31), DM, 1.f, nullptr, DM, (bf16_t*)(ws + WS_WOUT) + l * WOUT_L, nb * 32, kb * 64, scr, lane);
            continue;
        }
        r -= I_OUT;
        if (r < I_GU) {
            const int kb = r / 176, nb = r % 176, n = nb * 32 + (lane & 31), c = n & 255, col = (n >> 8) * 128 + (c & 127);
            const float* wsrc = (c < 128 ? A->in[14] : A->in[15]) + (size_t)l * DM * FF + col;
            conv_item(wsrc, FF, 1.f, A->in[13] + l * DM, DM, (bf16_t*)(ws + WS_WGU) + l * WGU_L, nb * 32, kb * 64, scr, lane);
            continue;
        }
        r -= I_GU;
        { const int kb = r / 32, nb = r % 32;
          conv_item(A->in[16] + (size_t)l * FF * DM + nb * 32 + (lane & 31), DM, 1.f, nullptr, FF, (bf16_t*)(ws + WS_WDN) + l * WDN_L, nb * 32, kb * 64, scr, lane); }
    }
}
__device__ __forceinline__ void prologue(KArgs A, unsigned char* ws, LAS unsigned char* lds, int tid, int wave, int lane, int bid, int G, int sub) {
    const int gw = bid * NWAVES + wave, NGW = G * NWAVES;
    if (sub == 0 || sub == 1) convert_weights(A, ws, lds, wave, lane, 0, CV_I_L - CV_I_DN, gw, NGW);
    float* ropec = (float*)(ws + WS_ROPE); float* ropes = ropec + SEQ * 32;
    if (sub == 0 || sub == 2) for (int idx = bid * NTHREADS + tid; idx < SEQ * 32; idx += G * NTHREADS) {
        const int pos = idx >> 5, i = idx & 31;
        const double ang = (double)pos * INVF[i];
        const double nn = rint(ang * 0.15915494309189535);
        const double x = ang - nn * 6.283185307179586477, x2 = x * x;
        double c = 1.0, s = 1.0, tc = 1.0, ts = 1.0;
#pragma unroll
        for (int k = 1; k <= 15; ++k) { tc *= -x2 * (1.0 / (double)((2 * k - 1) * (2 * k))); c += tc; ts *= -x2 * (1.0 / (double)((2 * k) * (2 * k + 1))); s += ts; }
        ropec[idx] = (float)c; ropes[idx] = (float)(s * x);
    }
    const float* x = A->in[0]; bf16_t* XB = (bf16_t*)(ws + WS_XB); float* ssqA = (float*)(ws + WS_SSQA);
    if (sub == 0 || sub == 3) for (int row0 = gw; row0 < MTOK; row0 += 4 * NGW) {
        f32x4 v[4][4];
#pragma unroll
        for (int rr = 0; rr < 4; ++rr) { const int row = min(row0 + rr * NGW, MTOK - 1); const f32x4* xr = (const f32x4*)(x + (size_t)row * DM) + lane;
#pragma unroll
            for (int j = 0; j < 4; ++j) v[rr][j] = __builtin_nontemporal_load(xr + 64 * j); }
#pragma unroll
        for (int rr = 0; rr < 4; ++rr) { const int row = row0 + rr * NGW; if (row < MTOK) { u32x2* d = (u32x2*)(XB + (size_t)row * DM) + lane; float s = 0.f;
#pragma unroll
            for (int j = 0; j < 4; ++j) { const f32x4 t = v[rr][j]; s += (t.x * t.x + t.y * t.y) + (t.z * t.z + t.w * t.w); u32x2 o; o.x = cvt_pk_bf16(t.x, t.y); o.y = cvt_pk_bf16(t.z, t.w); d[64 * j] = o; }
            s = wave_sum(s);
            if (lane < 16) ssqA[(size_t)row * 16 + lane] = lane == 0 ? s : 0.f; } }
    }
}

__device__ __forceinline__ int wave_isum(int v) {
    v += __builtin_amdgcn_update_dpp(0, v, 0x111, 0xf, 0xf, false);
    v += __builtin_amdgcn_update_dpp(0, v, 0x112, 0xf, 0xf, false);
    v += __builtin_amdgcn_update_dpp(0, v, 0x114, 0xf, 0xf, false);
    v += __builtin_amdgcn_update_dpp(0, v, 0x118, 0xf, 0xf, false);
    v += __builtin_amdgcn_update_dpp(0, v, 0x142, 0xa, 0xf, false);
    v += __builtin_amdgcn_update_dpp(0, v, 0x143, 0xc, 0xf, false);
    return __builtin_amdgcn_readlane(v, 63);
}
#define CNT4(c0, c1, t, x0, x1, x2, x3) do { unsigned long long m0_, m1_, m2_, m3_, j0_, j1_; \
    asm("v_cmp_le_u32_e64 %[m0], %[tt], %[a0]\n\tv_cmp_le_u32_e64 %[m1], %[tt], %[a1]\n\tv_cmp_le_u32_e64 %[m2], %[tt], %[a2]\n\tv_cmp_le_u32_e64 %[m3], %[tt], %[a3]\n\t" \
        "v_addc_co_u32_e64 %[k0], %[j0], 0, %[k0], %[m0]\n\tv_addc_co_u32_e64 %[k1], %[j1], 0, %[k1], %[m1]\n\t" \
        "v_addc_co_u32_e64 %[k0], %[j0], 0, %[k0], %[m2]\n\tv_addc_co_u32_e64 %[k1], %[j1], 0, %[k1], %[m3]" \
        : [k0] "+v"(c0), [k1] "+v"(c1), [m0] "=&s"(m0_), [m1] "=&s"(m1_), [m2] "=&s"(m2_), [m3] "=&s"(m3_), [j0] "=&s"(j0_), [j1] "=&s"(j1_) \
        : [tt] "s"(t), [a0] "v"(x0), [a1] "v"(x1), [a2] "v"(x2), [a3] "v"(x3)); } while (0)
#define BIT4(w, t, x0, x1, x2, x3) do { unsigned long long m0_, m1_, m2_, m3_, j0_; \
    asm("v_cmp_gt_u32_e64 %[m0], %[a0], %[tt]\n\tv_cmp_gt_u32_e64 %[m1], %[a1], %[tt]\n\tv_cmp_gt_u32_e64 %[m2], %[a2], %[tt]\n\tv_cmp_gt_u32_e64 %[m3], %[a3], %[tt]\n\t" \
        "v_addc_co_u32_e64 %[k0], %[j0], %[k0], %[k0], %[m0]\n\tv_addc_co_u32_e64 %[k0], %[j0], %[k0], %[k0], %[m1]\n\t" \
        "v_addc_co_u32_e64 %[k0], %[j0], %[k0], %[k0], %[m2]\n\tv_addc_co_u32_e64 %[k0], %[j0], %[k0], %[k0], %[m3]" \
        : [k0] "+v"(w), [m0] "=&s"(m0_), [m1] "=&s"(m1_), [m2] "=&s"(m2_), [m3] "=&s"(m3_), [j0] "=&s"(j0_) \
        : [tt] "s"(t), [a0] "v"(x0), [a1] "v"(x1), [a2] "v"(x2), [a3] "v"(x3)); } while (0)
__device__ __forceinline__ int count_ge(const unsigned (&u)[64], unsigned cand, int nblk) {
    int c0 = 0, c1 = 0;
    const unsigned ts = __builtin_amdgcn_readfirstlane(cand);
#pragma unroll
    for (int B = 0; B < 2; ++B) {
        if (B < nblk) {
#pragma unroll
            for (int i = 0; i < 32; i += 4) CNT4(c0, c1, ts, u[B * 32 + i], u[B * 32 + i + 1], u[B * 32 + i + 2], u[B * 32 + i + 3]);
        }
    }
    return wave_isum(c0 + c1);
}
__device__ __forceinline__ float keyval(unsigned k) { return __uint_as_float((k & 0x80000000u) ? (k ^ 0x80000000u) : ~k); }
__device__ __forceinline__ unsigned valkey(float f) { const unsigned b = __float_as_uint(f); return b ^ ((unsigned)((int)b >> 31) | 0x80000000u); }
__device__ __forceinline__ void select_query(const unsigned (&u)[64], unsigned vmax, int q, int b, int lane, unsigned* MASKb) {
    const int n = q + 1, nblk = (n + 2047) >> 11;
    unsigned T = 0u, TG = 0u; int rrem = 0;
    if (n > 256) {
        const unsigned kmax = wave_umax(vmax);
        const unsigned K0 = 0x80000000u;
        bool exact = false, done = false;
        unsigned lo = 0u, hi = 0u; float Llo = 1.f, Lhi = 1.f;
        const float L256 = 8.0028150156f;
        const int cpos = count_ge(u, K0 + 1u, nblk);
        if (cpos == 256) { T = K0 + 1u; exact = true; done = true; }
        else if (cpos > 256) { lo = K0 + 1u; Llo = __log2f((float)cpos) - L256; hi = kmax + 1u; Lhi = L256 + 1.f; }
        else {
            const int c0 = count_ge(u, K0, nblk);
            if (c0 >= 256) { T = K0; exact = (c0 == 256); done = true; }
            else {
                unsigned vmin = 0xffffffffu;
#pragma unroll
                for (int i = 0; i < 64; ++i) vmin = min(vmin, u[i] - 1u);
                lo = ~wave_umax(~vmin) + 1u; Llo = __log2f((float)n) - L256; hi = K0; Lhi = L256 - __log2f(fmaxf((float)c0, 0.5f));
            }
        }
        int it = 0, last = 0;
        while (!done) {
            if (hi - lo <= 1u) { T = lo; exact = false; break; }
            const float vlo = keyval(lo), vhi = keyval(hi);
            const float frac = (it >= 9 && (it & 1)) ? 0.5f : Llo * __builtin_amdgcn_rcpf(Llo + Lhi);
            unsigned mid = valkey(vlo + frac * (vhi - vlo));
            if (mid <= lo) mid = lo + 1u;
            if (mid >= hi) mid = hi - 1u;
            mid = __builtin_amdgcn_readfirstlane(mid);
            const int c = count_ge(u, mid, nblk);
            if (c == 256) { T = mid; exact = true; break; }
            if (c > 256) { lo = mid; Llo = __log2f((float)c) - L256; if (last == 1) Lhi *= 0.5f; last = 1; }
            else { hi = mid; Lhi = L256 - __log2f(fmaxf((float)c, 0.5f)); if (last == 2) Llo *= 0.5f; last = 2; }
            ++it;
        }
        if (exact) TG = T - 1u; else { TG = T; rrem = 256 - count_ge(u, T + 1u, nblk); }
    }
    int tbase = 0;
#pragma unroll
    for (int B = 0; B < 2; ++B) {
        if (B < nblk) {
            unsigned w = 0u; const unsigned tgs = __builtin_amdgcn_readfirstlane(TG);
#pragma unroll
            for (int e = 31; e >= 3; e -= 4) BIT4(w, tgs, u[B * 32 + e], u[B * 32 + e - 1], u[B * 32 + e - 2], u[B * 32 + e - 3]);
            if (rrem > 0) {
                int ec = 0;
#pragma unroll
                for (int e = 0; e < 32; ++e) ec += (u[B * 32 + e] == T) ? 1 : 0;
                int incl = ec;
#pragma unroll
                for (int o = 1; o < 64; o <<= 1) { const int t = __shfl_up(incl, o); if (lane >= o) incl += t; }
                const int total = __builtin_amdgcn_readlane(incl, 63);
                const int quota = rrem - tbase - (incl - ec);
                int taken = 0;
#pragma unroll
                for (int e = 0; e < 32; ++e) { const bool is = (u[B * 32 + e] == T) && (taken < quota); w |= is ? (1u << e) : 0u; taken += is ? 1 : 0; }
                tbase += total;
            }
            if (64 * B + lane <= (q >> 5)) __hip_atomic_store(MASKb + ((size_t)(b * 128 + (q >> 5)) * 128 + 64 * B + lane) * 32 + (q & 31), w, __ATOMIC_RELAXED, __HIP_MEMORY_SCOPE_AGENT);
        }
    }
}
__device__ __forceinline__ void select_phase(const bf16_t* Z, const bf16_t* KIb, unsigned* MASKb, unsigned* itemcnt, LAS unsigned char* lds, int wave_in, int lane_in, int bid, int G, int sub) {
    constexpr int SCS = 2312;
    LAS float* sc = (LAS float*)lds;
    const int nrounds = (1024 + G - 1) / G;
    bf16x8 qf[4][2]; u32x2 wraw;
#define SEL_LOADQ(idx_) do { const int i_ = (idx_) < 1023 ? (idx_) : 1023; const bf16_t* zq_ = Z + ((size_t)(i_ & 3) * SEQ + (i_ >> 2) * 16 + (lane_in & 15)) * NZ; \
        _Pragma("unroll") for (int j = 0; j < 4; ++j) _Pragma("unroll") for (int ks = 0; ks < 2; ++ks) qf[j][ks] = *(const bf16x8*)(zq_ + 2048 + j * 64 + ks * 32 + (lane_in >> 4) * 8); \
        wraw = *(const u32x2*)(zq_ + 2816 + 64); } while (0)
    { const int r0 = nrounds - 1; int i0_ = r0 * G + ((r0 & 1) ? (G - 1 - bid) : bid); SEL_LOADQ(i0_); }
    for (int rd = 0; rd < nrounds; ++rd) {
        const int rr_ = nrounds - 1 - rd, rn_ = rr_ > 0 ? rr_ - 1 : 0;
        const int idx = rr_ * G + ((rr_ & 1) ? (G - 1 - bid) : bid);
        const int idxn = rn_ * G + ((rn_ & 1) ? (G - 1 - bid) : bid);
        if (idx >= 1024) continue;
        const int b = idx & 3, q0 = (idx >> 2) * 16;
        int wave = wave_in, lane = lane_in; asm volatile("" : "+s"(wave), "+v"(lane));
        const int fr = lane & 15, fq = lane >> 4;
        const float w0 = bflo(wraw.x), w1 = bfhi(wraw.x), w2 = bflo(wraw.y), w3 = bfhi(wraw.y);
        const int nkt = (q0 >> 4) + 1, nch = (nkt + 127) >> 7;
        const bf16_t* kib = KIb + (size_t)b * 256 * 1024 + fr * 32 + fq * 8;
        const int qa = q0 + 2 * wave, qb = qa + 1;
        unsigned ua[64], ub[64]; unsigned vmaxa = 0u, vmaxb = 0u;
#pragma unroll
        for (int c = 0; c < 2; ++c) {
            if (c < nch) {
                const int ktlo = 128 * c, kthi = min(nkt, ktlo + 128);
                bf16x8 ka[2][2], kb2[2][2];
#define KI_LOAD(dst, i0) do { _Pragma("unroll") for (int t_ = 0; t_ < 2; ++t_) { int kt_ = ktlo + wave + 8 * ((i0) + t_); kt_ = kt_ < kthi ? kt_ : kthi - 1; \
                dst[t_][0] = *(const bf16x8*)(kib + (size_t)kt_ * 1024); dst[t_][1] = *(const bf16x8*)(kib + (size_t)kt_ * 1024 + 512); } } while (0)
#define KI_COMP(src, i0) do { _Pragma("unroll") for (int t_ = 0; t_ < 2; ++t_) { int kt_ = ktlo + wave + 8 * ((i0) + t_); kt_ = (kt_ < kthi ? kt_ : kthi - 1) - ktlo; \
                f32x4 s4 = {0.f, 0.f, 0.f, 0.f}; \
                _Pragma("unroll") for (int j = 0; j < 4; ++j) { \
                    f32x4 a = __builtin_amdgcn_mfma_f32_16x16x32_bf16(src[t_][0], qf[j][0], (f32x4){0.f, 0.f, 0.f, 0.f}, 0, 0, 0); \
                    a = __builtin_amdgcn_mfma_f32_16x16x32_bf16(src[t_][1], qf[j][1], a, 0, 0, 0); \
                    const float wj = j == 0 ? w0 : j == 1 ? w1 : j == 2 ? w2 : w3; \
                    _Pragma("unroll") for (int i = 0; i < 4; ++i) s4[i] = fmaf(__int_as_float(max(__float_as_int(a[i]), 0)), wj, s4[i]); } \
                *(LAS f32x4*)(sc + fr * SCS + kt_ * 16 + (kt_ >> 1) * 4 + fq * 4) = s4; } } while (0)
                KI_LOAD(ka, 0);
                for (int i0 = 0; ktlo + wave + 8 * i0 < kthi; i0 += 4) { KI_LOAD(kb2, i0 + 2); KI_COMP(ka, i0); KI_LOAD(ka, i0 + 4); KI_COMP(kb2, i0 + 2); }
#undef KI_LOAD
#undef KI_COMP
                __syncthreads();
                if (c + 1 == nch) SEL_LOADQ(idxn);
                const LAS float* srow = sc + (2 * wave) * SCS + 36 * lane;
                const int ema = qa - 2048 * c - 32 * lane, emb = ema + 1;
                const int adma = (int)(ema >= 31 ? 0xffffffffu : ema < 0 ? 0u : ((2u << ema) - 1u)), admb = (int)(emb >= 31 ? 0xffffffffu : emb < 0 ? 0u : ((2u << emb) - 1u));
#pragma unroll
                for (int e4 = 0; e4 < 8; ++e4) {
                    const f32x4 va = *(const LAS f32x4*)(srow + 4 * e4), vb = *(const LAS f32x4*)(srow + SCS + 4 * e4);
#pragma unroll
                    for (int e = 0; e < 4; ++e) {
                        const int ii = c * 32 + e4 * 4 + e;
                        const unsigned ba = __float_as_uint(va[e]), bb = __float_as_uint(vb[e]);
                        ua[ii] = (ba ^ ((unsigned)((int)ba >> 31) | 0x80000000u)) & (unsigned)__builtin_amdgcn_sbfe(adma, e4 * 4 + e, 1);
                        ub[ii] = (bb ^ ((unsigned)((int)bb >> 31) | 0x80000000u)) & (unsigned)__builtin_amdgcn_sbfe(admb, e4 * 4 + e, 1);
                        vmaxa = max(vmaxa, ua[ii]); vmaxb = max(vmaxb, ub[ii]);
                    }
                }
                asm volatile("s_waitcnt lgkmcnt(0)" ::: "memory");
                __syncthreads();
            } else {
#pragma unroll
                for (int e = 0; e < 32; ++e) { ua[c * 32 + e] = 0u; ub[c * 32 + e] = 0u; }
            }
        }
        if (sub != 3) {
            select_query(ua, vmaxa, qa, b, lane, MASKb);
            select_query(ub, vmaxb, qb, b, lane, MASKb);
            asm volatile("s_waitcnt vmcnt(0)" ::: "memory");
            if (lane == 0) __hip_atomic_fetch_add(itemcnt + idx, 1u, __ATOMIC_RELAXED, __HIP_MEMORY_SCOPE_AGENT);
        }
    }
    __syncthreads();
#undef SEL_LOADQ
}

__device__ __forceinline__ void mixer_a(const bf16_t* __restrict__ Z, bf16_t* __restrict__ Y, const float* __restrict__ wc, int gtid, int NGT) {
#pragma unroll 2
    for (int it = gtid; it < MTOK * 32; it += NGT) {
        const int row = it >> 5, c8 = (it & 31) * 8, pos = row & (SEQ - 1);
        const bf16_t* zr = Z + (size_t)row * NZ;
        float acc[8];
#pragma unroll
        for (int i = 0; i < 8; ++i) acc[i] = 0.f;
#pragma unroll
        for (int j = 0; j < 3; ++j) {
            const int d = 2 - j; const float ok = (pos >= d) ? 1.f : 0.f;
            {
                const bf16_t* zz = zr - (size_t)((pos >= d) ? d : 0) * NZ;
                const u32x4 cc = *(const u32x4*)(zz + 256 + c8), hh = *(const u32x4*)(zz + 512 + c8);
                const f32x4 wa = *(const f32x4*)(wc + j * 256 + c8) * ok, wb = *(const f32x4*)(wc + j * 256 + c8 + 4) * ok;
                acc[0] += wa[0] * (bflo(cc.x) * bflo(hh.x)); acc[1] += wa[1] * (bfhi(cc.x) * bfhi(hh.x));
                acc[2] += wa[2] * (bflo(cc.y) * bflo(hh.y)); acc[3] += wa[3] * (bfhi(cc.y) * bfhi(hh.y));
                acc[4] += wb[0] * (bflo(cc.z) * bflo(hh.z)); acc[5] += wb[1] * (bfhi(cc.z) * bfhi(hh.z));
                acc[6] += wb[2] * (bflo(cc.w) * bflo(hh.w)); acc[7] += wb[3] * (bfhi(cc.w) * bfhi(hh.w));
            }
        }
        const u32x4 ab = *(const u32x4*)(zr + c8);
        u32x4 o;
        o.x = cvt_pk_bf16(bflo(ab.x) * acc[0], bfhi(ab.x) * acc[1]); o.y = cvt_pk_bf16(bflo(ab.y) * acc[2], bfhi(ab.y) * acc[3]);
        o.z = cvt_pk_bf16(bflo(ab.z) * acc[4], bfhi(ab.z) * acc[5]); o.w = cvt_pk_bf16(bflo(ab.w) * acc[6], bfhi(ab.w) * acc[7]);
        *(u32x4*)(Y + (size_t)row * DM + c8) = o;
    }
}

__device__ __forceinline__ void mixer_b(const bf16_t* __restrict__ Z, bf16_t* __restrict__ Y, const float* __restrict__ lng, const float* __restrict__ lnb, const float* __restrict__ wsp, const float* __restrict__ bsp,
                                        LAS unsigned char* lds, int wave, int lane, int bid, int G) {
    constexpr int VP = 132;
    LAS bf16_t* vt = (LAS bf16_t*)lds;
    const int fr = lane & 15, fq = lane >> 4;
    for (int un = bid; un < 256; un += G) {
        const int chunk = un >> 1, hf = un & 1; const size_t row0 = (size_t)chunk * 128;
#pragma unroll 8
        for (int k = 0; k < 16; ++k) {
            const int s = wave * 16 + k; const bf16_t* zr = Z + (row0 + s) * NZ + 4 * 256;
            const float v0 = bf2f(zr[lane]), v1 = bf2f(zr[lane + 64]), v2 = bf2f(zr[lane + 128]), v3 = bf2f(zr[lane + 192]);
            const float mean = wave_sum((v0 + v1) + (v2 + v3)) * (1.f / 256.f);
            const float d0 = v0 - mean, d1 = v1 - mean, d2 = v2 - mean, d3 = v3 - mean;
            const float var = wave_sum((d0 * d0 + d1 * d1) + (d2 * d2 + d3 * d3)) * (1.f / 256.f);
            const float rstd = __builtin_amdgcn_rsqf(var + 1e-5f);
            const int ca = hf * 128 + lane, cb = ca + 64;
            const float a = (hf ? d2 : d0) * rstd * lng[ca] + lnb[ca], b = (hf ? d3 : d1) * rstd * lng[cb] + lnb[cb];
            const unsigned pk = cvt_pk_bf16(a, b);
            vt[lane * VP + s] = (bf16_t)(pk & 0xffffu); vt[(lane + 64) * VP + s] = (bf16_t)(pk >> 16);
        }
        __syncthreads();
        const int t = wave * 16 + fr;
#pragma unroll
        for (int hh = 0; hh < 2; ++hh) {
            const int h = hf * 2 + hh; const float* W = wsp + (size_t)h * 128 * 128 + (size_t)t * 128;
            f32x4 acc[4];
#pragma unroll
            for (int nt = 0; nt < 4; ++nt) acc[nt] = (f32x4){0.f, 0.f, 0.f, 0.f};
#pragma unroll
            for (int ks = 0; ks < 4; ++ks) {
                const int s0 = ks * 32 + fq * 8;
                f32x4 wa = *(const f32x4*)(W + s0), wb = *(const f32x4*)(W + s0 + 4);
#pragma unroll
                for (int j = 0; j < 4; ++j) { if (s0 + j > t) wa[j] = 0.f; if (s0 + 4 + j > t) wb[j] = 0.f; }
                u32x4 wp; wp.x = cvt_pk_bf16(wa[0], wa[1]); wp.y = cvt_pk_bf16(wa[2], wa[3]); wp.z = cvt_pk_bf16(wb[0], wb[1]); wp.w = cvt_pk_bf16(wb[2], wb[3]);
                const bf16x8 wf = __builtin_bit_cast(bf16x8, wp);
#pragma unroll
                for (int nt = 0; nt < 4; ++nt) {
                    const LAS bf16_t* vp = vt + (hh * 64 + nt * 16 + fr) * VP + s0;
                    const u32x2 lo = *(const LAS u32x2*)vp, hi2 = *(const LAS u32x2*)(vp + 4);
                    u32x4 vv; vv.x = lo.x; vv.y = lo.y; vv.z = hi2.x; vv.w = hi2.y;
                    acc[nt] = __builtin_amdgcn_mfma_f32_16x16x32_bf16(__builtin_bit_cast(bf16x8, vv), wf, acc[nt], 0, 0, 0);
                }
            }
            const float bias = bsp[h * 128 + t]; const size_t row = row0 + t;
#pragma unroll
            for (int nt = 0; nt < 4; ++nt) {
                const int col = h * 64 + nt * 16 + fq * 4;
                const u32x2 uu = *(const u32x2*)(Z + row * NZ + 3 * 256 + col);
                u32x2 o; o.x = cvt_pk_bf16((acc[nt][0] + bias) * bflo(uu.x), (acc[nt][1] + bias) * bfhi(uu.x)); o.y = cvt_pk_bf16((acc[nt][2] + bias) * bflo(uu.y), (acc[nt][3] + bias) * bfhi(uu.y));
                *(u32x2*)(Y + row * DM + 256 + col) = o;
            }
        }
        __syncthreads();
    }
}

__device__ __forceinline__ void mixer_d(const bf16_t* Z, bf16_t* Y, const float* wcf, const float* bcf, const float* lng, const float* lnb,
                                        LAS unsigned char* lds, int tid, int wave, int lane, int bid, int G) {
    LAS float* yl = (LAS float*)lds;
    LAS float* cv = (LAS float*)(lds + 62 * 256 * 4);
    const int c = tid & 255, half = tid >> 8;
    float w[31];
#pragma unroll
    for (int j = 0; j < 31; ++j) w[j] = wcf[j * 256 + c];
    const float bias = bcf[c];
    const f32x4 g4 = *(const f32x4*)(lng + lane * 4), b4 = *(const f32x4*)(lnb + lane * 4);
    for (int un = bid; un < MTOK / 32; un += G) {
        const int row0 = un * 32, pos0 = row0 & (SEQ - 1);
#pragma unroll
        for (int i4 = 0; i4 < 4; ++i4) {
            const int it0 = tid + i4 * NTHREADS, it = it0 < 62 * 32 ? it0 : 62 * 32 - 1;
            const int rr = it >> 5, c8 = (it & 31) * 8, p = pos0 - 30 + rr;
            f32x4 o0, o1; const float ok = (p >= 0) ? 1.f : 0.f;
            {
                const bf16_t* zr = Z + (size_t)(row0 + ((p >= 0) ? rr - 30 : 0)) * NZ;
                const u32x4 a = *(const u32x4*)(zr + 9 * 256 + c8), gg = *(const u32x4*)(zr + 10 * 256 + c8);
                o0[0] = bflo(a.x) * sigmoidf_(bflo(gg.x)); o0[1] = bfhi(a.x) * sigmoidf_(bfhi(gg.x)); o0[2] = bflo(a.y) * sigmoidf_(bflo(gg.y)); o0[3] = bfhi(a.y) * sigmoidf_(bfhi(gg.y));
                o1[0] = bflo(a.z) * sigmoidf_(bflo(gg.z)); o1[1] = bfhi(a.z) * sigmoidf_(bfhi(gg.z)); o1[2] = bflo(a.w) * sigmoidf_(bflo(gg.w)); o1[3] = bfhi(a.w) * sigmoidf_(bfhi(gg.w));
            }
            *(LAS f32x4*)(yl + rr * 256 + c8) = o0 * ok; *(LAS f32x4*)(yl + rr * 256 + c8 + 4) = o1 * ok;
        }
        __syncthreads();
#pragma unroll
        for (int blk = 0; blk < 2; ++blk) {
            const int tb = half * 16 + blk * 8;
            float acc[8];
#pragma unroll
            for (int o = 0; o < 8; ++o) acc[o] = bias;
#pragma unroll
            for (int jj = 0; jj < 38; ++jj) {
                const float v = yl[(tb + jj) * 256 + c];
#pragma unroll
                for (int o = 0; o < 8; ++o) { const int j = jj - o; if (j >= 0 && j < 31) acc[o] += w[j] * v; }
            }
#pragma unroll
            for (int o = 0; o < 8; ++o) cv[(tb + o) * 256 + c] = acc[o];
        }
        __syncthreads();
#pragma unroll
        for (int k = 0; k < 4; ++k) {
            const int tt = wave * 4 + k;
            const f32x4 v = *(const LAS f32x4*)(cv + tt * 256 + lane * 4);
            const float mean = wave_sum((v[0] + v[1]) + (v[2] + v[3])) * (1.f / 256.f);
            const f32x4 d = v - mean;
            const float var = wave_sum((d[0] * d[0] + d[1] * d[1]) + (d[2] * d[2] + d[3] * d[3])) * (1.f / 256.f);
            const float rstd = __builtin_amdgcn_rsqf(var + 1e-5f);
            const f32x4 y = d * rstd * g4 + b4;
            u32x2 o; o.x = cvt_pk_bf16(y[0] * sigmoidf_(y[0]), y[1] * sigmoidf_(y[1])); o.y = cvt_pk_bf16(y[2] * sigmoidf_(y[2]), y[3] * sigmoidf_(y[3]));
            *(u32x2*)(Y + (size_t)(row0 + tt) * DM + 768 + lane * 4) = o;
        }
        __syncthreads();
    }
}

__device__ __forceinline__ void mixer_bd(const bf16_t* __restrict__ Z, bf16_t* __restrict__ Y, const float* __restrict__ lng, const float* __restrict__ lnb, const float* __restrict__ wsp, const float* __restrict__ bsp,
                                         const float* __restrict__ wcf, const float* __restrict__ bcf, const float* __restrict__ dlng, const float* __restrict__ dlnb,
                                         LAS unsigned char* lds, int tid, int wave, int lane, int bid, int G) {
    constexpr int VP = 132;
    LAS bf16_t* vt = (LAS bf16_t*)lds;
    LAS float* yl = (LAS float*)(lds + 36864);
    LAS float* cv = (LAS float*)(lds + 100352);
    const int fr = lane & 15, fq = lane >> 4;
    const int c = tid & 255, half = tid >> 8;
    float w[31];
#pragma unroll
    for (int j = 0; j < 31; ++j) w[j] = wcf[j * 256 + c];
    const float dbias = bcf[c];
    const f32x4 g4 = *(const f32x4*)(dlng + lane * 4), b4 = *(const f32x4*)(dlnb + lane * 4);
#define MD_GLU(dun) do { const int row0_ = (dun) * 32, pos0_ = row0_ & (SEQ - 1); \
        _Pragma("unroll") for (int i4 = 0; i4 < 4; ++i4) { \
            const int it0 = tid + i4 * NTHREADS, it = it0 < 62 * 32 ? it0 : 62 * 32 - 1; \
            const int rr = it >> 5, c8 = (it & 31) * 8, p = pos0_ - 30 + rr; \
            f32x4 o0, o1; const float ok = (p >= 0) ? 1.f : 0.f; \
            const bf16_t* zr = Z + (size_t)(row0_ + ((p >= 0) ? rr - 30 : 0)) * NZ; \
            const u32x4 a = *(const u32x4*)(zr + 9 * 256 + c8), gg = *(const u32x4*)(zr + 10 * 256 + c8); \
            o0[0] = bflo(a.x) * sigmoidf_(bflo(gg.x)); o0[1] = bfhi(a.x) * sigmoidf_(bfhi(gg.x)); o0[2] = bflo(a.y) * sigmoidf_(bflo(gg.y)); o0[3] = bfhi(a.y) * sigmoidf_(bfhi(gg.y)); \
            o1[0] = bflo(a.z) * sigmoidf_(bflo(gg.z)); o1[1] = bfhi(a.z) * sigmoidf_(bfhi(gg.z)); o1[2] = bflo(a.w) * sigmoidf_(bflo(gg.w)); o1[3] = bfhi(a.w) * sigmoidf_(bfhi(gg.w)); \
            *(LAS f32x4*)(yl + rr * 256 + c8) = o0 * ok; *(LAS f32x4*)(yl + rr * 256 + c8 + 4) = o1 * ok; } } while (0)
#define MD_CONV() do { _Pragma("unroll") for (int blk = 0; blk < 2; ++blk) { const int tb = half * 16 + blk * 8; float acc_[8]; \
            _Pragma("unroll") for (int o = 0; o < 8; ++o) acc_[o] = dbias; \
            _Pragma("unroll") for (int jj = 0; jj < 38; ++jj) { const float v = yl[(tb + jj) * 256 + c]; \
                _Pragma("unroll") for (int o = 0; o < 8; ++o) { const int j = jj - o; if (j >= 0 && j < 31) acc_[o] += w[j] * v; } } \
            _Pragma("unroll") for (int o = 0; o < 8; ++o) cv[(tb + o) * 256 + c] = acc_[o]; } } while (0)
#define MD_LN(dun) do { const int row0_ = (dun) * 32; _Pragma("unroll") for (int k = 0; k < 4; ++k) { const int tt = wave * 4 + k; \
            const f32x4 v = *(const LAS f32x4*)(cv + tt * 256 + lane * 4); \
            const float mean = wave_sum((v[0] + v[1]) + (v[2] + v[3])) * (1.f / 256.f); const f32x4 d = v - mean; \
            const float var = wave_sum((d[0] * d[0] + d[1] * d[1]) + (d[2] * d[2] + d[3] * d[3])) * (1.f / 256.f); const float rstd = __builtin_amdgcn_rsqf(var + 1e-5f); \
            const f32x4 y = d * rstd * g4 + b4; \
            u32x2 o; o.x = cvt_pk_bf16(y[0] * sigmoidf_(y[0]), y[1] * sigmoidf_(y[1])); o.y = cvt_pk_bf16(y[2] * sigmoidf_(y[2]), y[3] * sigmoidf_(y[3])); \
            *(u32x2*)(Y + (size_t)(row0_ + tt) * DM + 768 + lane * 4) = o; } } while (0)
    for (int un = bid; un < 256; un += G) {
        const int chunk = un >> 1, hf = un & 1; const size_t row0 = (size_t)chunk * 128;
        const int t = wave * 16 + fr; const size_t row = row0 + t;
        bf16x8 wf[2][4]; u32x2 uu[2][4]; float bias[2];
#pragma unroll
        for (int hh = 0; hh < 2; ++hh) {
            const int h = hf * 2 + hh; const float* W = wsp + (size_t)h * 128 * 128 + (size_t)t * 128;
            f32x4 wa[4], wb[4];
#pragma unroll
            for (int ks = 0; ks < 4; ++ks) { wa[ks] = *(const f32x4*)(W + ks * 32 + fq * 8); wb[ks] = *(const f32x4*)(W + ks * 32 + fq * 8 + 4); }
#pragma unroll
            for (int nt = 0; nt < 4; ++nt) uu[hh][nt] = *(const u32x2*)(Z + row * NZ + 3 * 256 + h * 64 + nt * 16 + fq * 4);
            bias[hh] = bsp[h * 128 + t];
#pragma unroll
            for (int ks = 0; ks < 4; ++ks) {
                const int s0 = ks * 32 + fq * 8;
#pragma unroll
                for (int j = 0; j < 4; ++j) { if (s0 + j > t) wa[ks][j] = 0.f; if (s0 + 4 + j > t) wb[ks][j] = 0.f; }
                u32x4 wp; wp.x = cvt_pk_bf16(wa[ks][0], wa[ks][1]); wp.y = cvt_pk_bf16(wa[ks][2], wa[ks][3]); wp.z = cvt_pk_bf16(wb[ks][0], wb[ks][1]); wp.w = cvt_pk_bf16(wb[ks][2], wb[ks][3]);
                wf[hh][ks] = __builtin_bit_cast(bf16x8, wp);
            }
        }
#pragma unroll 8
        for (int k = 0; k < 16; ++k) {
            const int s = wave * 16 + k; const bf16_t* zr = Z + (row0 + s) * NZ + 4 * 256;
            const float v0 = bf2f(zr[lane]), v1 = bf2f(zr[lane + 64]), v2 = bf2f(zr[lane + 128]), v3 = bf2f(zr[lane + 192]);
            const float mean = wave_sum((v0 + v1) + (v2 + v3)) * (1.f / 256.f);
            const float d0 = v0 - mean, d1 = v1 - mean, d2 = v2 - mean, d3 = v3 - mean;
            const float var = wave_sum((d0 * d0 + d1 * d1) + (d2 * d2 + d3 * d3)) * (1.f / 256.f);
            const float rstd = __builtin_amdgcn_rsqf(var + 1e-5f);
            const int ca = hf * 128 + lane, cb = ca + 64;
            const float a = (hf ? d2 : d0) * rstd * lng[ca] + lnb[ca], b = (hf ? d3 : d1) * rstd * lng[cb] + lnb[cb];
            const unsigned pk = cvt_pk_bf16(a, b);
            vt[lane * VP + s] = (bf16_t)(pk & 0xffffu); vt[(lane + 64) * VP + s] = (bf16_t)(pk >> 16);
        }
        MD_GLU(2 * un);
        __syncthreads();
#pragma unroll
        for (int hh = 0; hh < 2; ++hh) {
            const int h = hf * 2 + hh;
            f32x4 acc[4];
#pragma unroll
            for (int nt = 0; nt < 4; ++nt) acc[nt] = (f32x4){0.f, 0.f, 0.f, 0.f};
#pragma unroll
            for (int ks = 0; ks < 4; ++ks) {
                const int s0 = ks * 32 + fq * 8;
#pragma unroll
                for (int nt = 0; nt < 4; ++nt) {
                    const LAS bf16_t* vp = vt + (hh * 64 + nt * 16 + fr) * VP + s0;
                    const u32x2 lo = *(const LAS u32x2*)vp, hi2 = *(const LAS u32x2*)(vp + 4);
                    u32x4 vv; vv.x = lo.x; vv.y = lo.y; vv.z = hi2.x; vv.w = hi2.y;
                    acc[nt] = __builtin_amdgcn_mfma_f32_16x16x32_bf16(__builtin_bit_cast(bf16x8, vv), wf[hh][ks], acc[nt], 0, 0, 0);
                }
            }
#pragma unroll
            for (int nt = 0; nt < 4; ++nt) {
                const int col = h * 64 + nt * 16 + fq * 4; const u32x2 u2 = uu[hh][nt]; const float bs_ = bias[hh];
                u32x2 o; o.x = cvt_pk_bf16((acc[nt][0] + bs_) * bflo(u2.x), (acc[nt][1] + bs_) * bfhi(u2.x)); o.y = cvt_pk_bf16((acc[nt][2] + bs_) * bflo(u2.y), (acc[nt][3] + bs_) * bfhi(u2.y));
                *(u32x2*)(Y + row * DM + 256 + col) = o;
            }
        }
        MD_CONV();
        __syncthreads();
        MD_LN(2 * un);
        MD_GLU(2 * un + 1);
        __syncthreads();
        MD_CONV();
        __syncthreads();
        MD_LN(2 * un + 1);
        __syncthreads();
    }
#undef MD_GLU
#undef MD_CONV
#undef MD_LN
}

__device__ __forceinline__ void attn_phase(const bf16_t* Z, const bf16_t* Kb, const bf16_t* Vb, unsigned* MASKb, unsigned* itemcnt, bf16_t* Y, LAS unsigned char* lds, int wave, int lane, int bid, int G) {
    const int h = wave & 3, half = wave >> 2, ql = lane & 31, hi = lane >> 5;
    LAS float* mo = (LAS float*)lds + h * 2048;
    LAS float* mml = (LAS float*)(lds + 32768) + h * 128;
    LAS bf16_t* ost = (LAS bf16_t*)(lds + 36864) + h * (32 * 72);
    const unsigned NEGB = __float_as_uint(NEGF);
    for (int pu = bid; pu < 256; pu += G) {
        const int b = pu & 3, jj = pu >> 2;
        for (int rep = 0; rep < 2; ++rep) {
            const int qb = rep ? jj : 127 - jj;
            const int NT = qb + 1, n0 = (NT + 1) >> 1, tb = half ? n0 : 0, te = half ? NT : n0;
            if (wave == 0) {
                unsigned* c0 = itemcnt + (2 * qb) * 4 + b; unsigned* c1 = c0 + 4; unsigned spins = 0;
                while ((unsigned)__builtin_amdgcn_readfirstlane(__hip_atomic_load(c0, __ATOMIC_RELAXED, __HIP_MEMORY_SCOPE_AGENT)) < 8u ||
                       (unsigned)__builtin_amdgcn_readfirstlane(__hip_atomic_load(c1, __ATOMIC_RELAXED, __HIP_MEMORY_SCOPE_AGENT)) < 8u) { __builtin_amdgcn_s_sleep(4); if (++spins > (1u << 22)) break; }
                __builtin_amdgcn_fence(__ATOMIC_ACQUIRE, "agent");
            }
            __syncthreads();
            const size_t rowq = (size_t)b * SEQ + qb * 32 + ql;
            const bf16_t* zq = Z + rowq * NZ + 1280 + h * 64 + hi * 8;
            bf16x8 qf[4];
#pragma unroll
            for (int c = 0; c < 4; ++c) qf[c] = *(const bf16x8*)(zq + 16 * c);
            unsigned* mrow = MASKb + ((size_t)(b * 128 + qb) * 128) * 32 + ql;
            const bf16_t* kb = Kb + ((size_t)(b * 4 + h) * 128) * 2048 + ql * 16 + hi * 8;
            const bf16_t* vb = Vb + ((size_t)(b * 4 + h) * 128) * 2048 + ql * 16 + hi * 8;
            f32x16 o0, o1;
#pragma unroll
            for (int r = 0; r < 16; ++r) { o0[r] = 0.f; o1[r] = 0.f; }
            float m = NEGF, l = 0.f;
            bf16x8 kA[4], kB[4]; bf16x8 vA[2][2], vB[2][2]; unsigned mA = 0u, mB = 0u;
#define ATT_LOAD(KF, VR, MW, kt_) do { const bf16_t* kp_ = kb + (size_t)(kt_) * 2048; const bf16_t* vp_ = vb + (size_t)(kt_) * 2048; _Pragma("unroll") for (int c = 0; c < 4; ++c) KF[c] = *(const bf16x8*)(kp_ + c * 512); \
        _Pragma("unroll") for (int mt = 0; mt < 2; ++mt) _Pragma("unroll") for (int c = 0; c < 2; ++c) VR[mt][c] = *(const bf16x8*)(vp_ + (mt * 2 + c) * 512); \
        MW = __hip_atomic_load(mrow + (kt_) * 32, __ATOMIC_RELAXED, __HIP_MEMORY_SCOPE_AGENT); } while (0)
#define ATT_COMP(KF, VR, MW) do { \
        f32x16 s; \
        _Pragma("unroll") for (int r = 0; r < 16; ++r) s[r] = 0.f; \
        __builtin_amdgcn_s_setprio(1); \
        _Pragma("unroll") for (int c = 0; c < 4; ++c) s = __builtin_amdgcn_mfma_f32_32x32x16_bf16(KF[c], qf[c], s, 0, 0, 0); \
        __builtin_amdgcn_s_setprio(0); \
        const int mws = (int)(MW >> (4 * hi)); \
        float rm = NEGF; \
        _Pragma("unroll") for (int r = 0; r < 16; ++r) { \
            const unsigned sel = (unsigned)__builtin_amdgcn_sbfe(mws, (r & 3) + 8 * (r >> 2), 1); \
            s[r] = __uint_as_float((__float_as_uint(s[r]) & sel) | (NEGB & ~sel)); \
            rm = fmaxf(rm, s[r]); } \
        rm = fmaxf(rm, swap32(rm, hi)); \
        const float mn = fmaxf(m, rm); \
        if (__any(mn > m)) { \
            const float al = __builtin_amdgcn_exp2f(m - mn); l *= al; \
            _Pragma("unroll") for (int r = 0; r < 16; ++r) { o0[r] *= al; o1[r] *= al; } \
            m = mn; } \
        float ps = 0.f; \
        _Pragma("unroll") for (int r = 0; r < 16; ++r) { s[r] = __builtin_amdgcn_exp2f(s[r] - m); ps += s[r]; } \
        l += ps; \
        u32x4 p0, p1; \
        p0.x = cvt_pk_bf16(s[0], s[1]); p0.y = cvt_pk_bf16(s[2], s[3]); p0.z = cvt_pk_bf16(s[4], s[5]); p0.w = cvt_pk_bf16(s[6], s[7]); \
        p1.x = cvt_pk_bf16(s[8], s[9]); p1.y = cvt_pk_bf16(s[10], s[11]); p1.z = cvt_pk_bf16(s[12], s[13]); p1.w = cvt_pk_bf16(s[14], s[15]); \
        const bf16x8 pf0 = __builtin_bit_cast(bf16x8, p0), pf1 = __builtin_bit_cast(bf16x8, p1); \
        __builtin_amdgcn_s_setprio(1); \
        o0 = __builtin_amdgcn_mfma_f32_32x32x16_bf16(VR[0][0], pf0, o0, 0, 0, 0); o1 = __builtin_amdgcn_mfma_f32_32x32x16_bf16(VR[1][0], pf0, o1, 0, 0, 0); \
        o0 = __builtin_amdgcn_mfma_f32_32x32x16_bf16(VR[0][1], pf1, o0, 0, 0, 0); o1 = __builtin_amdgcn_mfma_f32_32x32x16_bf16(VR[1][1], pf1, o1, 0, 0, 0); \
        __builtin_amdgcn_s_setprio(0); } while (0)
            if (tb < te) ATT_LOAD(kA, vA, mA, tb);
            for (int kt = tb; kt < te; kt += 2) {
                { const int k1 = (kt + 1 < te) ? kt + 1 : kt; ATT_LOAD(kB, vB, mB, k1); }
                ATT_COMP(kA, vA, mA);
                { const int k2 = (kt + 2 < te) ? kt + 2 : te - 1; ATT_LOAD(kA, vA, mA, k2); }
                if (kt + 1 < te) ATT_COMP(kB, vB, mB);
            }
#undef ATT_COMP
#undef ATT_LOAD
            const float lt = l + swap32(l, hi);
            if (half == 1) {
#pragma unroll
                for (int r = 0; r < 16; ++r) { mo[r * 64 + lane] = o0[r]; mo[(16 + r) * 64 + lane] = o1[r]; }
                mml[lane] = m; mml[64 + lane] = lt;
            }
            __syncthreads();
            if (half == 0) {
                const float m1 = mml[lane], l1 = mml[64 + lane];
                const float mn = fmaxf(m, m1), a0 = __builtin_amdgcn_exp2f(m - mn), a1 = __builtin_amdgcn_exp2f(m1 - mn);
                const float inv = __builtin_amdgcn_rcpf(lt * a0 + l1 * a1), f0 = a0 * inv, f1 = a1 * inv;
#pragma unroll
                for (int r = 0; r < 16; ++r) { o0[r] = o0[r] * f0 + mo[r * 64 + lane] * f1; o1[r] = o1[r] * f0 + mo[(16 + r) * 64 + lane] * f1; }
#pragma unroll
                for (int r = 0; r < 16; r += 2) {
                    const int d = (r & 3) + 8 * (r >> 2) + 4 * hi;
                    *(LAS unsigned*)(ost + ql * 72 + d) = cvt_pk_bf16(o0[r], o0[r + 1]);
                    *(LAS unsigned*)(ost + ql * 72 + 32 + d) = cvt_pk_bf16(o1[r], o1[r + 1]);
                }
                LDS_WAIT();
                bf16_t* yo = Y + ((size_t)b * SEQ + qb * 32 + (lane >> 1)) * DM + 512 + h * 64 + (lane & 1) * 32;
#pragma unroll
                for (int k = 0; k < 4; ++k) { const u32x4 v = *(const LAS u32x4*)(ost + (lane >> 1) * 72 + (lane & 1) * 32 + k * 8); *(u32x4*)(yo + k * 8) = v; }
            }
            __syncthreads();
        }
    }
}

#define RLX_AGENT __ATOMIC_RELAXED, __HIP_MEMORY_SCOPE_AGENT
#define XB_TMO      128
#define XB_XCNT(j)  (256  + 64 * (j))
#define XB_XSUB(j)  (1280 + 64 * (j))
#define XB_XGEN(j)  (2304 + 64 * (j))
#define XB_TOP      3328
#define XB_TOPGEN   3392
#define XCD_BAR_WORDS 3456
#define XB_SPIN_CAP (1u << 18)

__device__ __forceinline__ unsigned xb_ld(unsigned* p)              { return __hip_atomic_load(p, __ATOMIC_RELAXED, __HIP_MEMORY_SCOPE_AGENT); }
__device__ __forceinline__ unsigned xb_add(unsigned* p, unsigned v) { return __hip_atomic_fetch_add(p, v, __ATOMIC_RELAXED, __HIP_MEMORY_SCOPE_AGENT); }
__device__ __forceinline__ unsigned xb_xcc_id() { return (unsigned)__builtin_amdgcn_s_getreg((3 << 11) | 20) & 0xFu; }
#define XB_SPIN(cond, bar) do { unsigned _sp = 0; while (cond) { __builtin_amdgcn_s_sleep(1); \
    if ((++_sp & 255u) == 0u) { if (xb_ld(&(bar)[XB_TMO])) break; if (_sp > XB_SPIN_CAP) { atomicAdd(&(bar)[XB_TMO], 1u); break; } } } } while (0)

struct XcdBarrier {
    unsigned* bar; unsigned x;
    volatile LAS unsigned* st;
};

__device__ __forceinline__ XcdBarrier xcd_barrier_post(unsigned* bar, volatile LAS unsigned* st, int tid) {
    XcdBarrier b; b.bar = bar; b.x = xb_xcc_id(); b.st = st;
    if (tid == 0) (void)xb_add(&bar[XB_XCNT(b.x)], 1u);
    return b;
}
__device__ __forceinline__ void xcd_barrier_complete(unsigned* bar, unsigned x, unsigned& nloc, unsigned& nx) {
    const unsigned G = gridDim.x * gridDim.y * gridDim.z;
    unsigned sum, cnt, mine, sp = 0u;
    for (;;) {
        sum = 0u; cnt = 0u; mine = 0u;
#pragma unroll
        for (unsigned j = 0; j < 16; ++j) { const unsigned c = xb_ld(&bar[XB_XCNT(j)]); sum += c; cnt += (c > 0u) ? 1u : 0u; mine = (j == x) ? c : mine; }
        if (sum == G) break;
        __builtin_amdgcn_s_sleep(1);
        if ((++sp & 255u) == 0u) { if (xb_ld(&bar[XB_TMO])) break; if (sp > XB_SPIN_CAP) { atomicAdd(&bar[XB_TMO], 1u); break; } }
    }
    nloc = mine > 0u ? mine : 1u; nx = cnt > 0u ? cnt : 1u;
}

__device__ __forceinline__ void xcd_barrier(const XcdBarrier& b, int tid) {
    asm volatile("s_waitcnt vmcnt(0)" ::: "memory");
    __syncthreads();
    if (tid == 0) {
        unsigned* bar = b.bar;
        __builtin_amdgcn_s_waitcnt(0);
        unsigned nloc = b.st[0], nx = b.st[1];
        if (nloc == 0u) { xcd_barrier_complete(bar, b.x, nloc, nx); b.st[0] = nloc; b.st[1] = nx; }
        const unsigned old = xb_add(&bar[XB_XSUB(b.x)], 1u);
        const unsigned gen = old / nloc;
        if (old + 1u == (gen + 1u) * nloc) {
            __builtin_amdgcn_fence(__ATOMIC_RELEASE, "agent");
            asm volatile("s_waitcnt vmcnt(0)" ::: "memory");
            const unsigned og = xb_add(&bar[XB_TOP], 1u);
            const unsigned tg = og / nx, target = (tg + 1u) * nx;
            if (og + 1u != target) XB_SPIN(xb_ld(&bar[XB_TOP]) < target, bar);
            __builtin_amdgcn_fence(__ATOMIC_ACQUIRE, "agent");
            xb_add(&bar[XB_XGEN(b.x)], 1u);
            asm volatile("s_waitcnt vmcnt(0)" ::: "memory");
        } else {
            XB_SPIN(xb_ld(&bar[XB_XGEN(b.x)]) == gen, bar);
            __builtin_amdgcn_fence(__ATOMIC_ACQUIRE, "agent");
            asm volatile("s_waitcnt vmcnt(0)" ::: "memory");
        }
    }
    __syncthreads();
}

#ifndef PROBE_PH
#define PROBE_PH -1
#endif
#ifndef PROBE_SUB
#define PROBE_SUB 0
#endif
__global__ void __launch_bounds__(NTHREADS, 2) mega_fwd(Args A_unused) {
    extern __shared__ __attribute__((aligned(16))) unsigned char lds_raw[];
    LAS unsigned char* lds = (LAS unsigned char*)lds_raw;
    cg::grid_group grid = cg::this_grid();
    const int ph_lo = kargs()->ph_lo, ph_hi = kargs()->ph_hi;
    const int wave0 = __builtin_amdgcn_readfirstlane((int)(threadIdx.x >> 6));
    if (threadIdx.x < 16) ((volatile LAS unsigned*)(lds + LDS_BAR_OFF))[threadIdx.x] = 0u;
    __syncthreads();
    if (ph_hi - ph_lo > 1) { (void)xcd_barrier_post((unsigned*)(kargs()->ws + WS_CTL), (volatile LAS unsigned*)(lds + LDS_BAR_OFF), (int)threadIdx.x); }
    const int st_hi = (PROBE_PH >= 0) ? ph_hi + 1 : ph_hi;
    for (int st = ph_lo; st < st_hi; ++st) {
        const int ph = (PROBE_PH >= 0 && st > PROBE_PH) ? st - 1 : st;
        const int sub = (PROBE_PH >= 0 && st == PROBE_PH + 1) ? PROBE_SUB : 0;
        KArgs A = kargs();
        int G = gridDim.x; asm volatile("" : "+s"(G));
        unsigned char* ws = A->ws;
        bf16_t* XB = (bf16_t*)(ws + WS_XB); bf16_t* Yb = (bf16_t*)(ws + WS_Y); bf16_t* Zb = (bf16_t*)(ws + WS_Z); bf16_t* HID = Zb; bf16_t* Vb = (bf16_t*)(ws + WS_VB); bf16_t* Kb = (bf16_t*)(ws + WS_KB); bf16_t* KIb = (bf16_t*)(ws + WS_KI);
        float* ssqA = (float*)(ws + WS_SSQA); float* ssqB = (float*)(ws + WS_SSQB);
        float* ropec = (float*)(ws + WS_ROPE); float* ropes = ropec + SEQ * 32;
        unsigned* MASKb = (unsigned*)(ws + WS_MASK);
        int bid = blockIdx.x, wave = wave0; asm volatile("" : "+s"(bid), "+s"(wave));
        int lane = (int)__builtin_amdgcn_mbcnt_hi(~0u, __builtin_amdgcn_mbcnt_lo(~0u, 0u)); asm volatile("" : "+v"(lane));
        const int tid = wave * 64 + lane;
        if (ph == 0) {
#ifndef NO_PRO
            prologue(A, ws, lds, tid, wave, lane, bid, G, sub);
#endif
        } else if (ph == NPHASE - 1) {
            const float* gfin = A->in[17];
            if (G != 256) for (int row = bid * NWAVES + wave; row < MTOK; row += G * NWAVES) {
                const XL2 XLS{(bf16_t*)(ws + WS_MASK), (bf16_t*)(ws + WS_KB)};
                const float rs = row_rs(ssqA, row); f32x4* p = (f32x4*)(A->out + (size_t)row * DM) + lane; const f32x4* g = (const f32x4*)gfin + lane;
                const u32x2* ph_ = (const u32x2*)(XB + (size_t)row * DM) + lane; const u32x2* pl_ = (const u32x2*)xl_row(XLS, row) + lane;
#pragma unroll
                for (int j = 0; j < 4; ++j) { const u32x2 h2 = ph_[64 * j]; u32x2 l2 = {0u, 0u}; if (RES_LO) l2 = pl_[64 * j]; f32x4 v; v[0] = bflo(h2.x) + bflo(l2.x); v[1] = bfhi(h2.x) + bfhi(l2.x); v[2] = bflo(h2.y) + bflo(l2.y); v[3] = bfhi(h2.y) + bfhi(l2.y); p[64 * j] = v * rs * g[64 * j]; }
            }
        } else {
            const int l = (ph - 1) / 6, k = (ph - 1) % 6;
            if (k == 0) {
                pg8::Gemm g{XB, (bf16_t*)(ws + WS_WIN) + l * WIN_L, MTOK, NZ, DM}; pg8::StaticOrder S; S.init(MTOK, NZ, G, bid);
                EpiZ E{Zb, Vb, Kb, KIb, ssqA, ropec, ropes};
#ifndef NO_G0
                pg8::gemm_phase<EpiZ, pg8::StaticOrder, true, true>(lds, g, S, E, tid);
#endif
            } else if (k == 1) {
#ifndef NO_SEL
                if (sub != 2 && sub < 6) select_phase(Zb, KIb, MASKb, (unsigned*)(ws + WS_CTL) + CW_ITEM + l * 1024, lds, wave, lane, bid, G, sub);
#endif
#ifndef NO_MA
                if (sub == 0 || sub == 2 || sub == 8) mixer_a(Zb, Yb, A->in[3] + l * 3 * 256, bid * NTHREADS + tid, G * NTHREADS);
#endif
#ifndef NO_MB
                if (sub == 0 || sub == 2 || sub == 6 || sub == 7) mixer_bd(Zb, Yb, A->in[4] + l * 256, A->in[5] + l * 256, A->in[6] + (size_t)l * 4 * 128 * 128, A->in[7] + l * 4 * 128,
                                                                      A->in[8] + l * 31 * 256, A->in[9] + l * 256, A->in[10] + l * 256, A->in[11] + l * 256, lds, tid, wave, lane, bid, G);
#endif
            } else if (k == 2) {
#ifndef NO_ATT
                attn_phase(Zb, Kb, Vb, MASKb, (unsigned*)(ws + WS_CTL) + CW_ITEM + l * 1024, Yb, lds, wave, lane, bid, G);
#endif
            } else if (k == 3 || k == 5) {
                const XL2 XLD{(bf16_t*)A->out, (bf16_t*)A->out + (size_t)8192 * DM}, XLS{(bf16_t*)(ws + WS_MASK), (bf16_t*)(ws + WS_KB)};
                const bool last = (l == NLAYER - 1);
                pg8::Gemm g{k == 3 ? Yb : HID, k == 3 ? (bf16_t*)(ws + WS_WOUT) + l * WOUT_L : (bf16_t*)(ws + WS_WDN) + l * WDN_L, MTOK, DM, k == 3 ? DM : FF}; pg8::StaticOrder S; S.init(MTOK, DM, G, bid);
                if (k == 3 && l == 0) {
                    EpiRes<true> E{A->in[0], XLD, last ? XLS : XLD, XB, ssqB};
                    pg8::gemm_phase<EpiRes<true>, pg8::StaticOrder, true, true>(lds, g, S, E, tid);
                } else if (k == 5 && last && G == 256) {
                    EpiFinal E{XB, XLS, A->out, A->in[17], ssqB, (unsigned*)(ws + WS_CTL) + CW_PANEL};
                    pg8::gemm_phase<EpiFinal, pg8::StaticOrder, false, true>(lds, g, S, E, tid);
                } else {
                    EpiRes<false> E{nullptr, (k == 5 && last) ? XLS : XLD, last ? XLS : XLD, XB, k == 3 ? ssqB : ssqA};
                    pg8::gemm_phase<EpiRes<false>, pg8::StaticOrder, true, true>(lds, g, S, E, tid);
                }
            } else if (k == 4) {
                pg8::Gemm g{XB, (bf16_t*)(ws + WS_WGU) + l * WGU_L, MTOK, NGU, DM}; pg8::StaticOrder S; S.init(MTOK, NGU, G, bid);
                EpiGU E{HID, ssqB};
#ifndef NO_G2
                pg8::gemm_phase<EpiGU, pg8::StaticOrder, true, true>(lds, g, S, E, tid);
#endif
                if (l == 0) {
                    const int nwg = (MTOK / 256) * (NGU / 256), rem = nwg % G;
                    if (rem == 0) convert_weights(A, ws, lds, wave, lane, CV_I_L - CV_I_DN, NLAYER * CV_I_L, bid * NWAVES + wave, G * NWAVES);
                    else if (bid >= rem) convert_weights(A, ws, lds, wave, lane, CV_I_L - CV_I_DN, NLAYER * CV_I_L, (bid - rem) * NWAVES + wave, (G - rem) * NWAVES);
                }
            }
        }
        const bool flag_seam = (PROBE_PH < 0) && ph >= 1 && ph <= 12 && ((ph - 1) % 6) == 1;
        if (st + 1 < st_hi && !flag_seam) {
            if (ph_hi > 100000) grid.sync();
            XcdBarrier xb; xb.bar = (unsigned*)(ws + WS_CTL); xb.x = xb_xcc_id(); xb.st = (volatile LAS unsigned*)(lds + LDS_BAR_OFF);
            xcd_barrier(xb, tid);
        }
    }
}

#ifndef MK_COOP
#define MK_COOP 1
#endif
extern "C" void kernel_launch(void* const* d_in, const int* in_sizes, int n_in, void* d_out, int out_size, void* d_ws, size_t ws_size, hipStream_t stream) {
    static int grid = 0;
    if (grid == 0) {
        if (n_in != 18 || out_size != MTOK * DM || ws_size < WS_END) { fprintf(stderr, "kernel_launch: unexpected shapes (n_in %d out %d ws %zu)\n", n_in, out_size, ws_size); grid = -1; return; }
        int dev = 0, cus = 0, per_cu = 0;
        if (hipGetDevice(&dev) != hipSuccess || hipDeviceGetAttribute(&cus, hipDeviceAttributeMultiprocessorCount, dev) != hipSuccess) { grid = -1; return; }
        if (hipFuncSetAttribute((const void*)mega_fwd, hipFuncAttributeMaxDynamicSharedMemorySize, LDS_BYTES) != hipSuccess) { fprintf(stderr, "kernel_launch: hipFuncSetAttribute failed\n"); grid = -1; return; }
        if (hipOccupancyMaxActiveBlocksPerMultiprocessor(&per_cu, (const void*)mega_fwd, NTHREADS, LDS_BYTES) != hipSuccess || per_cu < 1) { fprintf(stderr, "kernel_launch: occupancy query says %d\n", per_cu); (void)hipGetLastError(); }
        grid = cus;
    }
    if (grid < 0) return;
    if (hipMemsetAsync((char*)d_ws + WS_CTL, 0, CTL_BYTES, stream) != hipSuccess) { fprintf(stderr, "kernel_launch: memset failed\n"); return; }
    Args a{};
    for (int i = 0; i < 18; ++i) a.in[i] = (const float*)d_in[i];
    a.out = (float*)d_out; a.ws = (unsigned char*)d_ws;
#if MK_COOP
    a.ph_lo = 0; a.ph_hi = (grid == 256) ? NPHASE - 1 : NPHASE;
    void* args[] = {&a};
    hipError_t e = hipLaunchCooperativeKernel((const void*)mega_fwd, dim3(grid), dim3(NTHREADS), args, LDS_BYTES, stream);
    if (e != hipSuccess) fprintf(stderr, "cooperative launch failed: %s (grid %d)\n", hipGetErrorString(e), grid);
#else
    for (int ph = 0; ph < NPHASE; ++ph) {
        a.ph_lo = ph; a.ph_hi = ph + 1;
        hipLaunchKernelGGL(mega_fwd, dim3(grid), dim3(NTHREADS), LDS_BYTES, stream, a);
    }
#endif
}
```

```cpp
#include <hip/hip_runtime.h>
#include <hip/hip_cooperative_groups.h>
#include <cstdio>
#include <cstdint>
namespace cg = cooperative_groups;
namespace pg8 {
#define PG8_LAS __attribute__((address_space(3)))
typedef unsigned short bf16_t;
typedef short bf16x8 __attribute__((ext_vector_type(8)));
typedef float f32x4 __attribute__((ext_vector_type(4)));
typedef unsigned u32x4 __attribute__((ext_vector_type(4)));
constexpr int BM = 256, BK = 64, HALF = 128, HTB = HALF * BK * 2  , STAGE_BYTES = 8 * HTB, NXCD = 8, WGM = 8;

__host__ __device__ __forceinline__ int lds_byte(int r, int c) { const int st = (r >> 4) * 2 + (c >> 5), rr = r & 15, cc = c & 31, ob = rr * 64 + cc * 2; return st * 1024 + (ob ^ (((ob >> 9) & 1) << 5)); }
__host__ __device__ __forceinline__ void stage_rc(int b, int& R, int& C) { const int st = b / 1024, sb = b % 1024, swz = sb ^ (((sb >> 9) & 1) << 5); R = (st >> 1) * 16 + swz / 64; C = (st & 1) * 32 + (swz % 64) / 2; }
__host__ __device__ __forceinline__ int perm32(int rho) { const int n = rho >> 4, i = rho & 15; return 8 * (i >> 2) + 4 * n + (i & 3); }

struct Unit { int pm, pn; };
struct Gemm { const bf16_t* A; const bf16_t* Bt; int M, N, K; };

struct StaticOrder {
    int nM, nN, nwg, G, c;
    __host__ __device__ void init(int M, int N, int G_, int c_) { nM = M / BM; nN = N / BM; nwg = nM * nN; G = G_; c = c_; }
    __host__ __device__ bool next(int i, Unit& u) const {
        const long L = (long)i * G + c; if (L >= nwg) return false;
        int wgid = (int)L; { const int q = nwg / NXCD, r = nwg % NXCD, xcd = wgid % NXCD, off = wgid / NXCD; wgid = (xcd < r ? xcd * (q + 1) : r * (q + 1) + (xcd - r) * q) + off; }
        const int nig = WGM * nN, gid = wgid / nig, fm = gid * WGM, gsz = (nM - fm) < WGM ? (nM - fm) : WGM;
        u.pm = fm + ((wgid % nig) % gsz); u.pn = (wgid % nig) / gsz; return true;
    }
    __device__ __forceinline__ void a_ready(const Unit&) const {}
    __device__ __forceinline__ void done(const Unit&) const {}
};

__device__ __forceinline__ unsigned cvt_pk_bf16(float lo, float hi) { unsigned r; asm volatile("v_cvt_pk_bf16_f32 %0, %1, %2" : "=v"(r) : "v"(lo), "v"(hi)); return r; }
template <class Epi, class Sched, bool ALIGN_EPI = false, bool SP2 = false>
__device__ __forceinline__ void gemm_phase(PG8_LAS unsigned char* lds, const Gemm g, const Sched& S, const Epi& E, int tid_in) {
    int tid_l = tid_in; asm volatile("" : "+v"(tid_l));
    const int tid = tid_l, wid = __builtin_amdgcn_readfirstlane(tid >> 6), lane = tid & 63, wr = wid >> 2, wc = wid & 3, fr = lane & 15, fq = lane >> 4;
    const int K = g.K, nt = K / BK;
    unsigned voffA[2], voffB[2];
#pragma unroll
    for (int i = 0; i < 2; ++i) { int R, C; stage_rc(tid * 16 + i * 8192, R, C); const int Rb = Epi::PERM ? ((R & ~31) + perm32(R & 31)) : R;
        voffA[i] = (unsigned)(R * K + C) * 2u; voffB[i] = (unsigned)(Rb * K + C) * 2u; }
    const size_t kstep = (size_t)(BK * 2);
    const size_t hstep = (size_t)HALF * K * 2;
    const size_t tstep = 2 * hstep;
    const unsigned ldsw = (unsigned)wid * 1024u;
    const int aoff = lds_byte(wr * 64 + fr, fq * 8), boff = lds_byte(wc * 32 + fr, fq * 8);
#define PG8_SA(b, h) (((b) * 2 + (h)) * HTB)
#define PG8_SB(b, h) ((4 + (b) * 2 + (h)) * HTB)
#define PG8_STAGE(bufoff, gbase, voff) do { _Pragma("unroll") for (int _i = 0; _i < 2; ++_i) \
        __builtin_amdgcn_global_load_lds((const unsigned*)((const char*)(gbase) + (voff)[_i]), (PG8_LAS unsigned*)(lds + (bufoff) + ldsw + _i * 8192), 16, 0, 0); } while (0)
#define PG8_LDA(dst, b, h) do { _Pragma("unroll") for (int m = 0; m < 4; ++m) _Pragma("unroll") for (int k = 0; k < 2; ++k) dst[m][k] = *(const PG8_LAS bf16x8*)(lds + PG8_SA(b, h) + aoff + m * 2048 + k * 1024); } while (0)
#define PG8_LDB(dst, b, h) do { _Pragma("unroll") for (int n = 0; n < 2; ++n) _Pragma("unroll") for (int k = 0; k < 2; ++k) dst[n][k] = *(const PG8_LAS bf16x8*)(lds + PG8_SB(b, h) + boff + n * 2048 + k * 1024); } while (0)
#define PG8_MMA(ai, bj, At, Bt) do { __builtin_amdgcn_s_setprio(1); _Pragma("unroll") for (int m = 0; m < 4; ++m) _Pragma("unroll") for (int n = 0; n < 2; ++n) _Pragma("unroll") for (int k = 0; k < 2; ++k) \
        acc[ai][bj][m][n] = __builtin_amdgcn_mfma_f32_16x16x32_bf16(Bt[n][k], At[m][k], acc[ai][bj][m][n], 0, 0, 0); __builtin_amdgcn_s_setprio(0); } while (0)
#define PG8_WAIT_V(n) asm volatile("s_waitcnt vmcnt(" #n ")" ::: "memory")
#define PG8_WAIT_L(n) asm volatile("s_waitcnt lgkmcnt(" #n ")" ::: "memory")
#define PG8_BAR __builtin_amdgcn_s_barrier()
#define PG8_SCHED __builtin_amdgcn_sched_barrier(0)
    Unit cur, nxt; int ui = 0;
    if (!S.next(0, cur)) return;
    f32x4 acc[2][2][4][2];
#pragma unroll
    for (int a = 0; a < 2; ++a)
#pragma unroll
        for (int b = 0; b < 2; ++b)
#pragma unroll
            for (int m = 0; m < 4; ++m)
#pragma unroll
                for (int n = 0; n < 2; ++n) acc[a][b][m][n] = (f32x4){0.f, 0.f, 0.f, 0.f};
    bf16x8 At[4][2], B0[2][2], B1[2][2];
    const char* cA = (const char*)g.A + (size_t)cur.pm * tstep; const char* cB = (const char*)g.Bt + (size_t)cur.pn * tstep;
    S.a_ready(cur);
    if constexpr (SP2) {
        PG8_STAGE(PG8_SB(0, 0), cB, voffB); PG8_STAGE(PG8_SB(0, 1), cB + hstep, voffB); PG8_STAGE(PG8_SA(0, 0), cA, voffA); PG8_STAGE(PG8_SA(0, 1), cA + hstep, voffA);
        if (wr == 1) PG8_BAR;
        PG8_WAIT_V(2); PG8_BAR;
        PG8_STAGE(PG8_SB(1, 0), cB + kstep, voffB); PG8_STAGE(PG8_SA(1, 0), cA + kstep, voffA); PG8_STAGE(PG8_SB(1, 1), cB + hstep + kstep, voffB);
        PG8_WAIT_V(6); PG8_BAR;
    } else {
        PG8_STAGE(PG8_SB(0, 0), cB, voffB); PG8_STAGE(PG8_SA(0, 0), cA, voffA); PG8_STAGE(PG8_SB(0, 1), cB + hstep, voffB); PG8_STAGE(PG8_SA(0, 1), cA + hstep, voffA);
        if (wr == 1) PG8_BAR;
        PG8_WAIT_V(4); PG8_BAR;
        PG8_STAGE(PG8_SB(1, 0), cB + kstep, voffB); PG8_STAGE(PG8_SA(1, 0), cA + kstep, voffA); PG8_STAGE(PG8_SB(1, 1), cB + hstep + kstep, voffB);
        PG8_WAIT_V(6); PG8_BAR;
    }
    for (;;) {
        const bool has_next = S.next(ui + 1, nxt);
        const char* nA = has_next ? (const char*)g.A + (size_t)nxt.pm * tstep : cA; const char* nB = has_next ? (const char*)g.Bt + (size_t)nxt.pn * tstep : cB;
        for (int t = 0; t < nt; t += 2) {
            const bool last = (t == nt - 2);
            const char* a1 = cA + (size_t)(t + 1) * kstep;
            const char* a2 = last ? nA : cA + (size_t)(t + 2) * kstep; const char* b2 = last ? nB : cB + (size_t)(t + 2) * kstep;
            const char* a3 = a2 + kstep; const char* b3 = b2 + kstep;
            if (last && has_next) S.a_ready(nxt);
            if constexpr (SP2) {
            PG8_LDB(B0, 0, 0); PG8_LDB(B1, 0, 1); PG8_SCHED; PG8_LDA(At, 0, 0); PG8_STAGE(PG8_SA(1, 1), a1 + hstep, voffA);
            PG8_WAIT_V(8); PG8_WAIT_L(0); PG8_BAR; PG8_MMA(0, 0, At, B0); PG8_MMA(0, 1, At, B1); PG8_BAR; PG8_SCHED;
            PG8_LDA(At, 0, 1); PG8_STAGE(PG8_SB(0, 0), b2, voffB); PG8_STAGE(PG8_SB(0, 1), b2 + hstep, voffB); PG8_STAGE(PG8_SA(0, 0), a2, voffA);
            PG8_WAIT_V(8); PG8_WAIT_L(0); PG8_BAR; PG8_MMA(1, 0, At, B0); PG8_MMA(1, 1, At, B1); PG8_BAR; PG8_SCHED;
            PG8_LDB(B0, 1, 0); PG8_LDB(B1, 1, 1); PG8_SCHED; PG8_LDA(At, 1, 0); PG8_STAGE(PG8_SA(0, 1), a2 + hstep, voffA);
            PG8_WAIT_V(8); PG8_WAIT_L(0); PG8_BAR; PG8_MMA(0, 0, At, B0); PG8_MMA(0, 1, At, B1); PG8_BAR; PG8_SCHED;
            PG8_LDA(At, 1, 1); PG8_STAGE(PG8_SB(1, 0), b3, voffB); PG8_STAGE(PG8_SB(1, 1), b3 + hstep, voffB); PG8_STAGE(PG8_SA(1, 0), a3, voffA);
            PG8_WAIT_V(8); PG8_WAIT_L(0); PG8_BAR; PG8_MMA(1, 0, At, B0); PG8_MMA(1, 1, At, B1); PG8_BAR; PG8_SCHED;
            } else {
            PG8_LDB(B0, 0, 0); PG8_SCHED; PG8_LDA(At, 0, 0); PG8_STAGE(PG8_SA(1, 1), a1 + hstep, voffA);
            PG8_WAIT_L(8); PG8_BAR; PG8_WAIT_L(0); PG8_MMA(0, 0, At, B0); PG8_BAR; PG8_SCHED;
            PG8_LDB(B1, 0, 1); PG8_STAGE(PG8_SB(0, 0), b2, voffB);
            PG8_BAR; PG8_WAIT_L(0); PG8_MMA(0, 1, At, B1); PG8_BAR;
            PG8_LDA(At, 0, 1); PG8_STAGE(PG8_SA(0, 0), a2, voffA);
            PG8_BAR; PG8_WAIT_L(0); PG8_MMA(1, 0, At, B0); PG8_BAR; PG8_SCHED;
            PG8_STAGE(PG8_SB(0, 1), b2 + hstep, voffB);
            PG8_WAIT_V(6); PG8_BAR; PG8_MMA(1, 1, At, B1); PG8_BAR;
            PG8_LDB(B0, 1, 0); PG8_SCHED; PG8_LDA(At, 1, 0); PG8_STAGE(PG8_SA(0, 1), a2 + hstep, voffA);
            PG8_WAIT_L(8); PG8_BAR; PG8_WAIT_L(0); PG8_MMA(0, 0, At, B0); PG8_BAR; PG8_SCHED;
            PG8_LDB(B1, 1, 1); PG8_STAGE(PG8_SB(1, 0), b3, voffB);
            PG8_BAR; PG8_WAIT_L(0); PG8_MMA(0, 1, At, B1); PG8_BAR;
            PG8_LDA(At, 1, 1); PG8_STAGE(PG8_SA(1, 0), a3, voffA);
            PG8_BAR; PG8_WAIT_L(0); PG8_MMA(1, 0, At, B0); PG8_BAR; PG8_SCHED;
            PG8_STAGE(PG8_SB(1, 1), b3 + hstep, voffB);
            PG8_WAIT_V(6); PG8_BAR; PG8_MMA(1, 1, At, B1); PG8_BAR;
            }
        }
        if constexpr (ALIGN_EPI) { if (wr == 0) PG8_BAR; }
        if constexpr (!Epi::AFTER_DRAIN) { E(acc, cur, wr, wc, fr, fq); S.done(cur); }
        if (!has_next) break;
#pragma unroll
        for (int a = 0; a < 2; ++a)
#pragma unroll
            for (int b = 0; b < 2; ++b)
#pragma unroll
                for (int m = 0; m < 4; ++m)
#pragma unroll
                    for (int n = 0; n < 2; ++n) acc[a][b][m][n] = (f32x4){0.f, 0.f, 0.f, 0.f};
        cur = nxt; cA = nA; cB = nB; ++ui;
        if constexpr (ALIGN_EPI) { if (wr == 1) PG8_BAR; }
    }
    PG8_WAIT_V(0);
    if constexpr (!ALIGN_EPI) { if (wr == 0) PG8_BAR; }
    PG8_BAR;
    if constexpr (Epi::AFTER_DRAIN) { E.fused(acc, cur, wr, wc, fr, fq, lds, wid, lane); S.done(cur); }
#undef PG8_SA
#undef PG8_SB
#undef PG8_STAGE
#undef PG8_LDA
#undef PG8_LDB
#undef PG8_MMA
#undef PG8_WAIT_V
#undef PG8_WAIT_L
#undef PG8_BAR
#undef PG8_SCHED
}
}
#define PROBE_PH -1
#define PROBE_SUB 0

#define LAS __attribute__((address_space(3)))
typedef unsigned short bf16_t;
typedef short bf16x8 __attribute__((ext_vector_type(8)));
typedef float f32x4 __attribute__((ext_vector_type(4)));
typedef float f32x16 __attribute__((ext_vector_type(16)));
typedef unsigned u32x4 __attribute__((ext_vector_type(4)));
typedef unsigned u32x2 __attribute__((ext_vector_type(2)));
using pg8::cvt_pk_bf16;

constexpr int NWAVES = 8, NTHREADS = 512;
constexpr int BATCH = 4, SEQ = 4096, DM = 1024, MTOK = BATCH * SEQ, NZ = 3072, FF = 2816, NGU = 2 * FF, NLAYER = 2, INC = 2884;
constexpr float C2 = 0.125f * 1.4426950408889634f;
constexpr float NEGF = -1e30f;
constexpr int LDS_BYTES = 153600;
constexpr int NPHASE = 14;

constexpr size_t MiB = 1u << 20;
constexpr size_t WS_WIN = 0, WS_WOUT = 12 * MiB, WS_WGU = 16 * MiB, WS_WDN = 38 * MiB, WS_ROPE = 49 * MiB, WS_SSQA = 50 * MiB, WS_SSQB = 51 * MiB,
                 WS_MASK = 52 * MiB, WS_VB = 60 * MiB, WS_XB = 68 * MiB, WS_Y = 100 * MiB, WS_Z = 132 * MiB, WS_KB = 228 * MiB, WS_KI = 236 * MiB, WS_CTL = 250 * MiB, WS_END = 251 * MiB;
constexpr size_t CTL_BYTES = 40960;
constexpr int CW_ITEM = 8192;
constexpr int CW_PANEL = 4096;
constexpr int LDS_BAR_OFF = LDS_BYTES - 64;
constexpr size_t WIN_L = (size_t)NZ * DM, WOUT_L = (size_t)DM * DM, WGU_L = (size_t)NGU * DM, WDN_L = (size_t)DM * FF;

__device__ const double INVF[32] = {1, 0.74989420933245587, 0.56234132519034907, 0.42169650342858223, 0.31622776601683794, 0.23713737056616552, 0.17782794100389229, 0.1333521432163324,
    0.10000000000000001, 0.074989420933245579, 0.056234132519034911, 0.042169650342858224, 0.031622776601683791, 0.023713737056616554, 0.017782794100389229, 0.013335214321633241,
    0.01, 0.0074989420933245579, 0.005623413251903491, 0.0042169650342858229, 0.0031622776601683794, 0.0023713737056616554, 0.0017782794100389228, 0.0013335214321633241,
    0.001, 0.00074989420933245586, 0.0005623413251903491, 0.00042169650342858224, 0.00031622776601683794, 0.00023713737056616554, 0.00017782794100389227, 0.0001333521432163324};

#define LDS_WAIT() asm volatile("s_waitcnt lgkmcnt(0)" ::: "memory")
__device__ __forceinline__ float bf2f(unsigned short h) { return __uint_as_float((unsigned)h << 16); }
__device__ __forceinline__ float bflo(unsigned w) { return __uint_as_float(w << 16); }
__device__ __forceinline__ float bfhi(unsigned w) { return __uint_as_float(w & 0xffff0000u); }
#define DPPF(v, ctrl, rm) __int_as_float(__builtin_amdgcn_update_dpp(0, __float_as_int(v), ctrl, rm, 0xf, false))
__device__ __forceinline__ float wave_sum(float v) {
    v += DPPF(v, 0x111, 0xf); v += DPPF(v, 0x112, 0xf); v += DPPF(v, 0x114, 0xf); v += DPPF(v, 0x118, 0xf);
    v += DPPF(v, 0x142, 0xa); v += DPPF(v, 0x143, 0xc);
    return __int_as_float(__builtin_amdgcn_readlane(__float_as_int(v), 63));
}
__device__ __forceinline__ unsigned wave_umax(unsigned v) {
#define DPPU(v, ctrl, rm) (unsigned)__builtin_amdgcn_update_dpp(0, (int)(v), ctrl, rm, 0xf, false)
    v = max(v, DPPU(v, 0x111, 0xf)); v = max(v, DPPU(v, 0x112, 0xf)); v = max(v, DPPU(v, 0x114, 0xf)); v = max(v, DPPU(v, 0x118, 0xf));
    v = max(v, DPPU(v, 0x142, 0xa)); v = max(v, DPPU(v, 0x143, 0xc));
    return (unsigned)__builtin_amdgcn_readlane((int)v, 63);
#undef DPPU
}
__device__ __forceinline__ float swap32(float v, int hi) { auto rr = __builtin_amdgcn_permlane32_swap(__float_as_uint(v), __float_as_uint(v), false, false); return hi ? __uint_as_float(rr[0]) : __uint_as_float(rr[1]); }
__device__ __forceinline__ float row_rs(const float* ssq, int r) {
    const f32x4* p = (const f32x4*)(ssq + (size_t)r * 16); const f32x4 a = p[0], b = p[1], c = p[2], d = p[3];
    const float s = (((a.x + a.y) + (a.z + a.w)) + ((b.x + b.y) + (b.z + b.w))) + (((c.x + c.y) + (c.z + c.w)) + ((d.x + d.y) + (d.z + d.w)));
    return __builtin_amdgcn_rsqf(s * (1.f / 1024.f) + 1e-6f);
}
__device__ __forceinline__ float xor16_add(float v) { auto rr = __builtin_amdgcn_permlane16_swap(__float_as_uint(v), __float_as_uint(v), false, false); return __uint_as_float(rr[0]) + __uint_as_float(rr[1]); }
__device__ __forceinline__ float xor32_add(float v) { auto rr = __builtin_amdgcn_permlane32_swap(__float_as_uint(v), __float_as_uint(v), false, false); return __uint_as_float(rr[0]) + __uint_as_float(rr[1]); }
__device__ __forceinline__ void row_rs8(const float* ssq, int rbase  , int fq, float (&rs)[8]) {
    f32x4 p[8];
#pragma unroll
    for (int i = 0; i < 8; ++i) p[i] = *(const f32x4*)(ssq + (size_t)(rbase + (i >> 2) * 128 + (i & 3) * 16) * 16 + fq * 4);
#pragma unroll
    for (int i = 0; i < 8; ++i) { float s = (p[i].x + p[i].y) + (p[i].z + p[i].w); s = xor16_add(s); s = xor32_add(s); rs[i] = __builtin_amdgcn_rsqf(s * (1.f / 1024.f) + 1e-6f); }
}
__device__ __forceinline__ float sigmoidf_(float x) { return __builtin_amdgcn_rcpf(1.f + __expf(-x)); }

struct EpiZ {
    static constexpr bool PERM = true, AFTER_DRAIN = false;
    bf16_t* Z; bf16_t* Vb; bf16_t* Kb; bf16_t* KIb; const float* ssq; const float* ropec; const float* ropes;
    __device__ __forceinline__ void operator()(const f32x4 (&acc)[2][2][4][2], const pg8::Unit& u, int wr, int wc, int fr, int fq) const {
        const int pn = u.pn; const bool rope_tile = (pn == 5) || (pn == 6) || (pn == 8) || (pn == 11);
        float rs8[8]; row_rs8(ssq, u.pm * 256 + wr * 64 + fr, fq, rs8);
#pragma unroll
        for (int ai = 0; ai < 2; ++ai)
        {
            f32x4 rc[4], rsn[4]; const int ri0 = ((wc * 32 + fq * 8) & 63) >> 1;
            if (rope_tile) {
#pragma unroll
                for (int m = 0; m < 4; ++m) { const int pos_ = (u.pm * 256 + ai * 128 + wr * 64 + m * 16 + fr) & (SEQ - 1); rc[m] = *(const f32x4*)(ropec + pos_ * 32 + ri0); rsn[m] = *(const f32x4*)(ropes + pos_ * 32 + ri0); }
            }
#pragma unroll
            for (int m = 0; m < 4; ++m) {
                const int r = u.pm * 256 + ai * 128 + wr * 64 + m * 16 + fr; const float rs = rs8[ai * 4 + m]; const int pos = r & (SEQ - 1);
#pragma unroll
                for (int bj = 0; bj < 2; ++bj) {
                    const int cl = bj * 128 + wc * 32 + fq * 8;
                    f32x4 v0 = acc[ai][bj][m][0] * rs, v1 = acc[ai][bj][m][1] * rs;
                    if (rope_tile && (pn != 11 || cl < 64)) {
                        const f32x4 c4 = rc[m], s4 = rsn[m];
                        float a, b;
                        a = v0[0]; b = v0[1]; v0[0] = a * c4[0] - b * s4[0]; v0[1] = b * c4[0] + a * s4[0];
                        a = v0[2]; b = v0[3]; v0[2] = a * c4[1] - b * s4[1]; v0[3] = b * c4[1] + a * s4[1];
                        a = v1[0]; b = v1[1]; v1[0] = a * c4[2] - b * s4[2]; v1[1] = b * c4[2] + a * s4[2];
                        a = v1[2]; b = v1[3]; v1[2] = a * c4[3] - b * s4[3]; v1[3] = b * c4[3] + a * s4[3];
                    }
                    u32x4 w; w.x = cvt_pk_bf16(v0[0], v0[1]); w.y = cvt_pk_bf16(v0[2], v0[3]); w.z = cvt_pk_bf16(v1[0], v1[1]); w.w = cvt_pk_bf16(v1[2], v1[3]);
                    const int b = r >> 12;
                    if (pn == 7) {
                        const int hh = cl >> 6, d0 = cl & 63, kt = pos >> 5, k32 = pos & 31, c = k32 >> 4, kk = k32 & 15, vh = (kk >> 2) & 1, e = (kk & 3) + 4 * (kk >> 3);
                        bf16_t* vp = Vb + ((((size_t)((b * 4 + hh) * 128 + kt) * 2 + (d0 >> 5)) * 2 + c) * 32 + (d0 & 31)) * 16 + vh * 8 + e;
                        vp[0 * 16] = (bf16_t)(w.x & 0xffffu); vp[1 * 16] = (bf16_t)(w.x >> 16); vp[2 * 16] = (bf16_t)(w.y & 0xffffu); vp[3 * 16] = (bf16_t)(w.y >> 16);
                        vp[4 * 16] = (bf16_t)(w.z & 0xffffu); vp[5 * 16] = (bf16_t)(w.z >> 16); vp[6 * 16] = (bf16_t)(w.w & 0xffffu); vp[7 * 16] = (bf16_t)(w.w >> 16);
                    } else if (pn == 6) {
                        const int hh = cl >> 6, c = (cl >> 4) & 3, kh = (cl >> 3) & 1;
                        *(u32x4*)(Kb + ((((size_t)((b * 4 + hh) * 128 + (pos >> 5)) * 4 + c) * 32 + (pos & 31)) * 16 + kh * 8)) = w;
                    } else if (pn == 11) {
                        if (cl < 64) *(u32x4*)(KIb + ((((size_t)(b * 256 + (pos >> 4)) * 2 + (cl >> 5)) * 16 + (pos & 15)) * 32 + ((cl >> 3) & 3) * 8)) = w;
                        else if (cl == 64) *(u32x4*)(Z + (size_t)r * NZ + pn * 256 + cl) = w;
                    } else {
                        *(u32x4*)(Z + (size_t)r * NZ + pn * 256 + cl) = w;
                    }
                }
                asm volatile("" ::: "memory");
            }
        }
    }
};
#ifndef RES_LO
#define RES_LO 0
#endif
struct XL2 { bf16_t* a; bf16_t* b; };
__device__ __forceinline__ bf16_t* xl_row(const XL2& x, int r) { return r < 8192 ? x.a + (size_t)r * DM : x.b + (size_t)(r - 8192) * DM; }
__device__ __forceinline__ void split_hilo(const f32x4& v0, const f32x4& v1, u32x4& hi, u32x4& lo) {
    hi.x = cvt_pk_bf16(v0[0], v0[1]); hi.y = cvt_pk_bf16(v0[2], v0[3]); hi.z = cvt_pk_bf16(v1[0], v1[1]); hi.w = cvt_pk_bf16(v1[2], v1[3]);
    lo.x = cvt_pk_bf16(v0[0] - bflo(hi.x), v0[1] - bfhi(hi.x)); lo.y = cvt_pk_bf16(v0[2] - bflo(hi.y), v0[3] - bfhi(hi.y));
    lo.z = cvt_pk_bf16(v1[0] - bflo(hi.z), v1[1] - bfhi(hi.z)); lo.w = cvt_pk_bf16(v1[2] - bflo(hi.w), v1[3] - bfhi(hi.w));
}
__device__ __forceinline__ void join_hilo(const u32x4& hi, const u32x4& lo, f32x4& v0, f32x4& v1) {
    v0[0] = bflo(hi.x) + bflo(lo.x); v0[1] = bfhi(hi.x) + bfhi(lo.x); v0[2] = bflo(hi.y) + bflo(lo.y); v0[3] = bfhi(hi.y) + bfhi(lo.y);
    v1[0] = bflo(hi.z) + bflo(lo.z); v1[1] = bfhi(hi.z) + bfhi(lo.z); v1[2] = bflo(hi.w) + bflo(lo.w); v1[3] = bfhi(hi.w) + bfhi(lo.w);
}
template <bool BASE_F32> struct EpiRes {
    static constexpr bool PERM = true, AFTER_DRAIN = false;
    const float* basef; XL2 xlin; XL2 xlout; bf16_t* xb; float* ssq;
    __device__ __forceinline__ void operator()(const f32x4 (&acc)[2][2][4][2], const pg8::Unit& u, int wr, int wc, int fr, int fq) const {
#pragma unroll
        for (int ai = 0; ai < 2; ++ai)
#pragma unroll
            for (int m = 0; m < 4; ++m) {
                const int r = u.pm * 256 + ai * 128 + wr * 64 + m * 16 + fr; float sq = 0.f;
#pragma unroll
                for (int bj = 0; bj < 2; ++bj) {
                    const int col = u.pn * 256 + bj * 128 + wc * 32 + fq * 8; const size_t off = (size_t)r * DM + col;
                    f32x4 b0, b1;
                    if (BASE_F32) { b0 = __builtin_nontemporal_load((const f32x4*)(basef + off)); b1 = __builtin_nontemporal_load((const f32x4*)(basef + off + 4)); }
                    else { const u32x4 hi_in = *(const u32x4*)(xb + off); u32x4 lo_in = {0u, 0u, 0u, 0u}; if (RES_LO) lo_in = *(const u32x4*)(xl_row(xlin, r) + col); join_hilo(hi_in, lo_in, b0, b1); }
                    const f32x4 v0 = acc[ai][bj][m][0] + b0, v1 = acc[ai][bj][m][1] + b1;
                    u32x4 hi, lo; split_hilo(v0, v1, hi, lo);
                    *(u32x4*)(xb + off) = hi; if (RES_LO) *(u32x4*)(xl_row(xlout, r) + col) = lo;
                    sq += ((v0[0] * v0[0] + v0[1] * v0[1]) + (v0[2] * v0[2] + v0[3] * v0[3])) + ((v1[0] * v1[0] + v1[1] * v1[1]) + (v1[2] * v1[2] + v1[3] * v1[3]));
                }
                sq = xor16_add(sq); sq = xor32_add(sq);
                if (fq == 0) ssq[(size_t)r * 16 + u.pn * 4 + wc] = sq;
                if (m == 3) asm volatile("" ::: "memory");
            }
    }
};
struct EpiFinal {
    static constexpr bool PERM = true, AFTER_DRAIN = true;
    const bf16_t* xb; XL2 xlin; float* out; const float* gfin; float* xbuf; unsigned* cnt;
    __device__ __forceinline__ void fused(f32x4 (&acc)[2][2][4][2], const pg8::Unit& u, int wr, int wc, int fr, int fq, LAS unsigned char* lds, int wid, int lane) const {
        LAS float* P = (LAS float*)lds;
        LAS float* S = (LAS float*)(lds + 4096);
#pragma unroll
        for (int ai = 0; ai < 2; ++ai)
#pragma unroll
            for (int m = 0; m < 4; ++m) {
                const int rl = ai * 128 + wr * 64 + m * 16 + fr; float sq = 0.f;
#pragma unroll
                for (int bj = 0; bj < 2; ++bj) {
                    const size_t off = (size_t)(u.pm * 256 + rl) * DM + u.pn * 256 + bj * 128 + wc * 32 + fq * 8;
                    f32x4 b0, b1; { const u32x4 hi_in = *(const u32x4*)(xb + off); u32x4 lo_in = {0u, 0u, 0u, 0u}; if (RES_LO) lo_in = *(const u32x4*)(xl_row(xlin, u.pm * 256 + rl) + (off - (size_t)(u.pm * 256 + rl) * DM)); join_hilo(hi_in, lo_in, b0, b1); }
                    const f32x4 v0 = acc[ai][bj][m][0] + b0, v1 = acc[ai][bj][m][1] + b1;
                    acc[ai][bj][m][0] = v0; acc[ai][bj][m][1] = v1;
                    sq += ((v0[0] * v0[0] + v0[1] * v0[1]) + (v0[2] * v0[2] + v0[3] * v0[3])) + ((v1[0] * v1[0] + v1[1] * v1[1]) + (v1[2] * v1[2] + v1[3] * v1[3]));
                }
                sq = xor16_add(sq); sq = xor32_add(sq);
                if (fq == 0) P[rl * 4 + wc] = sq;
                if (m == 3) asm volatile("" ::: "memory");
            }
        asm volatile("s_waitcnt lgkmcnt(0)" ::: "memory"); __builtin_amdgcn_s_barrier(); asm volatile("" ::: "memory");
        const int tid = wid * 64 + lane;
        if (tid < 256) {
            const float s = (P[tid * 4 + 0] + P[tid * 4 + 1]) + (P[tid * 4 + 2] + P[tid * 4 + 3]);
            __hip_atomic_store(xbuf + (size_t)(u.pm * 256 + tid) * 4 + u.pn, s, __ATOMIC_RELAXED, __HIP_MEMORY_SCOPE_AGENT);
        }
        asm volatile("s_waitcnt vmcnt(0)" ::: "memory");
        if (lane == 0) __hip_atomic_fetch_add(cnt + 64 * u.pm, 1u, __ATOMIC_RELAXED, __HIP_MEMORY_SCOPE_AGENT);
        if (wid == 0) {
            unsigned spins = 0;
            while ((unsigned)__builtin_amdgcn_readfirstlane(__hip_atomic_load(cnt + 64 * u.pm, __ATOMIC_RELAXED, __HIP_MEMORY_SCOPE_AGENT)) < 32u) { __builtin_amdgcn_s_sleep(2); if (++spins > (1u << 22)) break; }
            __builtin_amdgcn_fence(__ATOMIC_ACQUIRE, "agent");
        }
        asm volatile("s_waitcnt vmcnt(0) lgkmcnt(0)" ::: "memory"); __builtin_amdgcn_s_barrier(); asm volatile("" ::: "memory");
        if (tid < 256) {
            const float* xp = xbuf + (size_t)(u.pm * 256 + tid) * 4;
            const float a = __hip_atomic_load(xp + 0, __ATOMIC_RELAXED, __HIP_MEMORY_SCOPE_AGENT), b = __hip_atomic_load(xp + 1, __ATOMIC_RELAXED, __HIP_MEMORY_SCOPE_AGENT),
                        c = __hip_atomic_load(xp + 2, __ATOMIC_RELAXED, __HIP_MEMORY_SCOPE_AGENT), d = __hip_atomic_load(xp + 3, __ATOMIC_RELAXED, __HIP_MEMORY_SCOPE_AGENT);
            S[tid] = __builtin_amdgcn_rsqf(((a + b) + (c + d)) * (1.f / 1024.f) + 1e-6f);
        }
        asm volatile("s_waitcnt vmcnt(0) lgkmcnt(0)" ::: "memory"); __builtin_amdgcn_s_barrier(); asm volatile("" ::: "memory");
#pragma unroll
        for (int ai = 0; ai < 2; ++ai)
#pragma unroll
            for (int m = 0; m < 4; ++m) {
                const int rl = ai * 128 + wr * 64 + m * 16 + fr; const float rs = S[rl];
#pragma unroll
                for (int bj = 0; bj < 2; ++bj) {
                    const int col = u.pn * 256 + bj * 128 + wc * 32 + fq * 8; const size_t off = (size_t)(u.pm * 256 + rl) * DM + col;
                    *(f32x4*)(out + off) = acc[ai][bj][m][0] * rs * *(const f32x4*)(gfin + col); *(f32x4*)(out + off + 4) = acc[ai][bj][m][1] * rs * *(const f32x4*)(gfin + col + 4);
                }
            }
    }
};
struct EpiGU {
    static constexpr bool PERM = true, AFTER_DRAIN = false;
    bf16_t* H; const float* ssq;
    __device__ __forceinline__ void operator()(const f32x4 (&acc)[2][2][4][2], const pg8::Unit& u, int wr, int wc, int fr, int fq) const {
        float rs8[8]; row_rs8(ssq, u.pm * 256 + wr * 64 + fr, fq, rs8);
#pragma unroll
        for (int ai = 0; ai < 2; ++ai)
#pragma unroll
            for (int m = 0; m < 4; ++m) {
                const int r = u.pm * 256 + ai * 128 + wr * 64 + m * 16 + fr; const float rs = rs8[ai * 4 + m];
                u32x4 w;
#pragma unroll
                for (int n = 0; n < 2; ++n) {
                    const f32x4 g = acc[ai][0][m][n] * rs, up = acc[ai][1][m][n] * rs;
                    const float h0 = g[0] * sigmoidf_(g[0]) * up[0], h1 = g[1] * sigmoidf_(g[1]) * up[1], h2 = g[2] * sigmoidf_(g[2]) * up[2], h3 = g[3] * sigmoidf_(g[3]) * up[3];
                    if (n == 0) { w.x = cvt_pk_bf16(h0, h1); w.y = cvt_pk_bf16(h2, h3); } else { w.z = cvt_pk_bf16(h0, h1); w.w = cvt_pk_bf16(h2, h3); }
                }
                *(u32x4*)(H + (size_t)r * FF + u.pn * 128 + wc * 32 + fq * 8) = w;
            }
    }
};

__device__ __forceinline__ int il64(int p) { return (p & 1) ? (p >> 1) + 32 : (p >> 1); }
__device__ __forceinline__ void conv_item(const float* src, int ld, float cs, const float* gk, int K, bf16_t* WT, int n0, int k0, LAS float* scr, int lane) {
    float v[32];
    const float* sp = src + (size_t)(k0 + (lane >> 5)) * ld;
#pragma unroll
    for (int i = 0; i < 32; ++i) v[i] = __builtin_nontemporal_load(sp + (size_t)(2 * i) * ld);
    if (gk) {
        float g[32];
#pragma unroll
        for (int i = 0; i < 32; ++i) g[i] = gk[k0 + 2 * i + (lane >> 5)];
#pragma unroll
        for (int i = 0; i < 32; ++i) v[i] *= g[i];
    }
#pragma unroll
    for (int i = 0; i < 32; ++i) scr[(2 * i + (lane >> 5)) * 33 + (lane & 31)] = v[i] * cs;
    LDS_WAIT();
    const int c = lane & 7;
#pragma unroll
    for (int j = 0; j < 4; ++j) {
        const int n = (lane >> 3) + 8 * j; const LAS float* s = scr + (8 * c) * 33 + n;
        u32x4 o; o.x = cvt_pk_bf16(s[0 * 33], s[1 * 33]); o.y = cvt_pk_bf16(s[2 * 33], s[3 * 33]); o.z = cvt_pk_bf16(s[4 * 33], s[5 * 33]); o.w = cvt_pk_bf16(s[6 * 33], s[7 * 33]);
        *(u32x4*)(WT + (size_t)(n0 + n) * K + k0 + 8 * c) = o;
    }
    LDS_WAIT();
}

struct Args { const float* in[18]; float* out; unsigned char* ws; int ph_lo, ph_hi; };
typedef const Args __attribute__((address_space(4)))* KArgs;
__device__ __forceinline__ KArgs kargs() { KArgs p = (KArgs)__builtin_amdgcn_kernarg_segment_ptr(); asm volatile("" : "+s"(p)); return p; }

constexpr int CV_I_IN = 16 * 96, CV_I_OUT = 16 * 32, CV_I_GU = 16 * 176, CV_I_DN = 44 * 32, CV_I_L = CV_I_IN + CV_I_OUT + CV_I_GU + CV_I_DN;
__device__ __forceinline__ void convert_weights(KArgs A, unsigned char* ws, LAS unsigned char* lds, int wave, int lane, int it_lo, int it_hi, int gw, int NGW) {
    LAS float* scr = (LAS float*)(lds + wave * 16384);
    constexpr int I_IN = CV_I_IN, I_OUT = CV_I_OUT, I_GU = CV_I_GU, I_L = CV_I_L;
    for (int it = it_lo + gw; it < it_hi; it += NGW) {
        const int l = it / I_L; int r = it % I_L;
        if (r < I_IN) {
            const int kb = r / 96, nb = r % 96, n = nb * 32 + (lane & 31), tile = n >> 8, c = n & 255;
            int src; float cs = 1.f;
            if (tile <= 4) src = n;
            else if (tile == 5) { src = 1280 + (c & ~63) + il64(c & 63); cs = C2; }
            else if (tile == 6) src = 1536 + (c & ~63) + il64(c & 63);
            else if (tile == 7) src = 1792 + c;
            else if (tile == 8) src = 2048 + (c & ~63) + il64(c & 63);
            else if (tile == 9) src = 2372 + c;
            else if (tile == 10) src = 2628 + c;
            else { if (c < 64) src = 2304 + il64(c); else if (c < 68) { src = 2368 + (c - 64); cs = 0.0625f; } else { src = 0; cs = 0.f; } }
            const float* wl = A->in[2] + (size_t)l * DM * INC;
            conv_item(wl + src, INC, cs, A->in[1] + l * DM, DM, (bf16_t*)(ws + WS_WIN) + l * WIN_L, nb * 32, kb * 64, scr, lane);
            continue;
        }
        r -= I_IN;
        if (r < I_OUT) {
            const int kb = r / 32, nb = r % 32;
            conv_item(A->in[12] + (size_t)l * DM * DM + nb * 32 + (lane & 31), DM, 1.f, nullptr, DM, (bf16_t*)(ws + WS_WOUT) + l * WOUT_L, nb * 32, kb * 64, scr, lane);
            continue;
        }
        r -= I_OUT;
        if (r < I_GU) {
            const int kb = r / 176, nb = r % 176, n = nb * 32 + (lane & 31), c = n & 255, col = (n >> 8) * 128 + (c & 127);
            const float* wsrc = (c < 128 ? A->in[14] : A->in[15]) + (size_t)l * DM * FF + col;
            conv_item(wsrc, FF, 1.f, A->in[13] + l * DM, DM, (bf16_t*)(ws + WS_WGU) + l * WGU_L, nb * 32, kb * 64, scr, lane);
            continue;
        }
        r -= I_GU;
        { const int kb = r / 32, nb = r % 32;
          conv_item(A->in[16] + (size_t)l * FF * DM + nb * 32 + (lane & 31), DM, 1.f, nullptr, FF, (bf16_t*)(ws + WS_WDN) + l * WDN_L, nb * 32, kb * 64, scr, lane); }
    }
}
__device__ __forceinline__ void prologue(KArgs A, unsigned char* ws, LAS unsigned char* lds, int tid, int wave, int lane, int bid, int G, int sub) {
    const int gw = bid * NWAVES + wave, NGW = G * NWAVES;
    if (sub == 0 || sub == 1) convert_weights(A, ws, lds, wave, lane, 0, CV_I_L - CV_I_DN, gw, NGW);
    float* ropec = (float*)(ws + WS_ROPE); float* ropes = ropec + SEQ * 32;
    if (sub == 0 || sub == 2) for (int idx = bid * NTHREADS + tid; idx < SEQ * 32; idx += G * NTHREADS) {
        const int pos = idx >> 5, i = idx & 31;
        const double ang = (double)pos * INVF[i];
        const double nn = rint(ang * 0.15915494309189535);
        const double x = ang - nn * 6.283185307179586477, x2 = x * x;
        double c = 1.0, s = 1.0, tc = 1.0, ts = 1.0;
#pragma unroll
        for (int k = 1; k <= 15; ++k) { tc *= -x2 * (1.0 / (double)((2 * k - 1) * (2 * k))); c += tc; ts *= -x2 * (1.0 / (double)((2 * k) * (2 * k + 1))); s += ts; }
        ropec[idx] = (float)c; ropes[idx] = (float)(s * x);
    }
    const float* x = A->in[0]; bf16_t* XB = (bf16_t*)(ws + WS_XB); float* ssqA = (float*)(ws + WS_SSQA);
    if (sub == 0 || sub == 3) for (int row0 = gw; row0 < MTOK; row0 += 4 * NGW) {
        f32x4 v[4][4];
#pragma unroll
        for (int rr = 0; rr < 4; ++rr) { const int row = min(row0 + rr * NGW, MTOK - 1); const f32x4* xr = (const f32x4*)(x + (size_t)row * DM) + lane;
#pragma unroll
            for (int j = 0; j < 4; ++j) v[rr][j] = __builtin_nontemporal_load(xr + 64 * j); }
#pragma unroll
        for (int rr = 0; rr < 4; ++rr) { const int row = row0 + rr * NGW; if (row < MTOK) { u32x2* d = (u32x2*)(XB + (size_t)row * DM) + lane; float s = 0.f;
#pragma unroll
            for (int j = 0; j < 4; ++j) { const f32x4 t = v[rr][j]; s += (t.x * t.x + t.y * t.y) + (t.z * t.z + t.w * t.w); u32x2 o; o.x = cvt_pk_bf16(t.x, t.y); o.y = cvt_pk_bf16(t.z, t.w); d[64 * j] = o; }
            s = wave_sum(s);
            if (lane < 16) ssqA[(size_t)row * 16 + lane] = lane == 0 ? s : 0.f; } }
    }
}

__device__ __forceinline__ int wave_isum(int v) {
    v += __builtin_amdgcn_update_dpp(0, v, 0x111, 0xf, 0xf, false);
    v += __builtin_amdgcn_update_dpp(0, v, 0x112, 0xf, 0xf, false);
    v += __builtin_amdgcn_update_dpp(0, v, 0x114, 0xf, 0xf, false);
    v += __builtin_amdgcn_update_dpp(0, v, 0x118, 0xf, 0xf, false);
    v += __builtin_amdgcn_update_dpp(0, v, 0x142, 0xa, 0xf, false);
    v += __builtin_amdgcn_update_dpp(0, v, 0x143, 0xc, 0xf, false);
    return __builtin_amdgcn_readlane(v, 63);
}
#define CNT4(c0, c1, t, x0, x1, x2, x3) do { unsigned long long m0_, m1_, m2_, m3_, j0_, j1_; \
    asm("v_cmp_le_u32_e64 %[m0], %[tt], %[a0]\n\tv_cmp_le_u32_e64 %[m1], %[tt], %[a1]\n\tv_cmp_le_u32_e64 %[m2], %[tt], %[a2]\n\tv_cmp_le_u32_e64 %[m3], %[tt], %[a3]\n\t" \
        "v_addc_co_u32_e64 %[k0], %[j0], 0, %[k0], %[m0]\n\tv_addc_co_u32_e64 %[k1], %[j1], 0, %[k1], %[m1]\n\t" \
        "v_addc_co_u32_e64 %[k0], %[j0], 0, %[k0], %[m2]\n\tv_addc_co_u32_e64 %[k1], %[j1], 0, %[k1], %[m3]" \
        : [k0] "+v"(c0), [k1] "+v"(c1), [m0] "=&s"(m0_), [m1] "=&s"(m1_), [m2] "=&s"(m2_), [m3] "=&s"(m3_), [j0] "=&s"(j0_), [j1] "=&s"(j1_) \
        : [tt] "s"(t), [a0] "v"(x0), [a1] "v"(x1), [a2] "v"(x2), [a3] "v"(x3)); } while (0)
#define BIT4(w, t, x0, x1, x2, x3) do { unsigned long long m0_, m1_, m2_, m3_, j0_; \
    asm("v_cmp_gt_u32_e64 %[m0], %[a0], %[tt]\n\tv_cmp_gt_u32_e64 %[m1], %[a1], %[tt]\n\tv_cmp_gt_u32_e64 %[m2], %[a2], %[tt]\n\tv_cmp_gt_u32_e64 %[m3], %[a3], %[tt]\n\t" \
        "v_addc_co_u32_e64 %[k0], %[j0], %[k0], %[k0], %[m0]\n\tv_addc_co_u32_e64 %[k0], %[j0], %[k0], %[k0], %[m1]\n\t" \
        "v_addc_co_u32_e64 %[k0], %[j0], %[k0], %[k0], %[m2]\n\tv_addc_co_u32_e64 %[k0], %[j0], %[k0], %[k0], %[m3]" \
        : [k0] "+v"(w), [m0] "=&s"(m0_), [m1] "=&s"(m1_), [m2] "=&s"(m2_), [m3] "=&s"(m3_), [j0] "=&s"(j0_) \
        : [tt] "s"(t), [a0] "v"(x0), [a1] "v"(x1), [a2] "v"(x2), [a3] "v"(x3)); } while (0)
__device__ __forceinline__ int count_ge(const unsigned (&u)[64], unsigned cand, int nblk) {
    int c0 = 0, c1 = 0;
    const unsigned ts = __builtin_amdgcn_readfirstlane(cand);
#pragma unroll
    for (int B = 0; B < 2; ++B) {
        if (B < nblk) {
#pragma unroll
            for (int i = 0; i < 32; i += 4) CNT4(c0, c1, ts, u[B * 32 + i], u[B * 32 + i + 1], u[B * 32 + i + 2], u[B * 32 + i + 3]);
        }
    }
    return wave_isum(c0 + c1);
}
__device__ __forceinline__ float keyval(unsigned k) { return __uint_as_float((k & 0x80000000u) ? (k ^ 0x80000000u) : ~k); }
__device__ __forceinline__ unsigned valkey(float f) { const unsigned b = __float_as_uint(f); return b ^ ((unsigned)((int)b >> 31) | 0x80000000u); }
__device__ __forceinline__ void select_query(const unsigned (&u)[64], unsigned vmax, int q, int b, int lane, unsigned* MASKb) {
    const int n = q + 1, nblk = (n + 2047) >> 11;
    unsigned T = 0u, TG = 0u; int rrem = 0;
    if (n > 256) {
        const unsigned kmax = wave_umax(vmax);
        const unsigned K0 = 0x80000000u;
        bool exact = false, done = false;
        unsigned lo = 0u, hi = 0u; float Llo = 1.f, Lhi = 1.f;
        const float L256 = 8.0028150156f;
        const int cpos = count_ge(u, K0 + 1u, nblk);
        if (cpos == 256) { T = K0 + 1u; exact = true; done = true; }
        else if (cpos > 256) { lo = K0 + 1u; Llo = __log2f((float)cpos) - L256; hi = kmax + 1u; Lhi = L256 + 1.f; }
        else {
            const int c0 = count_ge(u, K0, nblk);
            if (c0 >= 256) { T = K0; exact = (c0 == 256); done = true; }
            else {
                unsigned vmin = 0xffffffffu;
#pragma unroll
                for (int i = 0; i < 64; ++i) vmin = min(vmin, u[i] - 1u);
                lo = ~wave_umax(~vmin) + 1u; Llo = __log2f((float)n) - L256; hi = K0; Lhi = L256 - __log2f(fmaxf((float)c0, 0.5f));
            }
        }
        int it = 0, last = 0;
        while (!done) {
            if (hi - lo <= 1u) { T = lo; exact = false; break; }
            const float vlo = keyval(lo), vhi = keyval(hi);
            const float frac = (it >= 9 && (it & 1)) ? 0.5f : Llo * __builtin_amdgcn_rcpf(Llo + Lhi);
            unsigned mid = valkey(vlo + frac * (vhi - vlo));
            if (mid <= lo) mid = lo + 1u;
            if (mid >= hi) mid = hi - 1u;
            mid = __builtin_amdgcn_readfirstlane(mid);
            const int c = count_ge(u, mid, nblk);
            if (c == 256) { T = mid; exact = true; break; }
            if (c > 256) { lo = mid; Llo = __log2f((float)c) - L256; if (last == 1) Lhi *= 0.5f; last = 1; }
            else { hi = mid; Lhi = L256 - __log2f(fmaxf((float)c, 0.5f)); if (last == 2) Llo *= 0.5f; last = 2; }
            ++it;
        }
        if (exact) TG = T - 1u; else { TG = T; rrem = 256 - count_ge(u, T + 1u, nblk); }
    }
    int tbase = 0;
#pragma unroll
    for (int B = 0; B < 2; ++B) {
        if (B < nblk) {
            unsigned w = 0u; const unsigned tgs = __builtin_amdgcn_readfirstlane(TG);
#pragma unroll
            for (int e = 31; e >= 3; e -= 4) BIT4(w, tgs, u[B * 32 + e], u[B * 32 + e - 1], u[B * 32 + e - 2], u[B * 32 + e - 3]);
            if (rrem > 0) {
                int ec = 0;
#pragma unroll
                for (int e = 0; e < 32; ++e) ec += (u[B * 32 + e] == T) ? 1 : 0;
                int incl = ec;
#pragma unroll
                for (int o = 1; o < 64; o <<= 1) { const int t = __shfl_up(incl, o); if (lane >= o) incl += t; }
                const int total = __builtin_amdgcn_readlane(incl, 63);
                const int quota = rrem - tbase - (incl - ec);
                int taken = 0;
#pragma unroll
                for (int e = 0; e < 32; ++e) { const bool is = (u[B * 32 + e] == T) && (taken < quota); w |= is ? (1u << e) : 0u; taken += is ? 1 : 0; }
                tbase += total;
            }
            if (64 * B + lane <= (q >> 5)) __hip_atomic_store(MASKb + ((size_t)(b * 128 + (q >> 5)) * 128 + 64 * B + lane) * 32 + (q & 31), w, __ATOMIC_RELAXED, __HIP_MEMORY_SCOPE_AGENT);
        }
    }
}
__device__ __forceinline__ void select_phase(const bf16_t* Z, const bf16_t* KIb, unsigned* MASKb, unsigned* itemcnt, LAS unsigned char* lds, int wave_in, int lane_in, int bid, int G, int sub) {
    constexpr int SCS = 2312;
    LAS float* sc = (LAS float*)lds;
    const int nrounds = (1024 + G - 1) / G;
    bf16x8 qf[4][2]; u32x2 wraw;
#define SEL_LOADQ(idx_) do { const int i_ = (idx_) < 1023 ? (idx_) : 1023; const bf16_t* zq_ = Z + ((size_t)(i_ & 3) * SEQ + (i_ >> 2) * 16 + (lane_in & 15)) * NZ; \
        _Pragma("unroll") for (int j = 0; j < 4; ++j) _Pragma("unroll") for (int ks = 0; ks < 2; ++ks) qf[j][ks] = *(const bf16x8*)(zq_ + 2048 + j * 64 + ks * 32 + (lane_in >> 4) * 8); \
        wraw = *(const u32x2*)(zq_ + 2816 + 64); } while (0)
    { const int r0 = nrounds - 1; int i0_ = r0 * G + ((r0 & 1) ? (G - 1 - bid) : bid); SEL_LOADQ(i0_); }
    for (int rd = 0; rd < nrounds; ++rd) {
        const int rr_ = nrounds - 1 - rd, rn_ = rr_ > 0 ? rr_ - 1 : 0;
        const int idx = rr_ * G + ((rr_ & 1) ? (G - 1 - bid) : bid);
        const int idxn = rn_ * G + ((rn_ & 1) ? (G - 1 - bid) : bid);
        if (idx >= 1024) continue;
        const int b = idx & 3, q0 = (idx >> 2) * 16;
        int wave = wave_in, lane = lane_in; asm volatile("" : "+s"(wave), "+v"(lane));
        const int fr = lane & 15, fq = lane >> 4;
        const float w0 = bflo(wraw.x), w1 = bfhi(wraw.x), w2 = bflo(wraw.y), w3 = bfhi(wraw.y);
        const int nkt = (q0 >> 4) + 1, nch = (nkt + 127) >> 7;
        const bf16_t* kib = KIb + (size_t)b * 256 * 1024 + fr * 32 + fq * 8;
        const int qa = q0 + 2 * wave, qb = qa + 1;
        unsigned ua[64], ub[64]; unsigned vmaxa = 0u, vmaxb = 0u;
#pragma unroll
        for (int c = 0; c < 2; ++c) {
            if (c < nch) {
                const int ktlo = 128 * c, kthi = min(nkt, ktlo + 128);
                bf16x8 ka[2][2], kb2[2][2];
#define KI_LOAD(dst, i0) do { _Pragma("unroll") for (int t_ = 0; t_ < 2; ++t_) { int kt_ = ktlo + wave + 8 * ((i0) + t_); kt_ = kt_ < kthi ? kt_ : kthi - 1; \
                dst[t_][0] = *(const bf16x8*)(kib + (size_t)kt_ * 1024); dst[t_][1] = *(const bf16x8*)(kib + (size_t)kt_ * 1024 + 512); } } while (0)
#define KI_COMP(src, i0) do { _Pragma("unroll") for (int t_ = 0; t_ < 2; ++t_) { int kt_ = ktlo + wave + 8 * ((i0) + t_); kt_ = (kt_ < kthi ? kt_ : kthi - 1) - ktlo; \
                f32x4 s4 = {0.f, 0.f, 0.f, 0.f}; \
                _Pragma("unroll") for (int j = 0; j < 4; ++j) { \
                    f32x4 a = __builtin_amdgcn_mfma_f32_16x16x32_bf16(src[t_][0], qf[j][0], (f32x4){0.f, 0.f, 0.f, 0.f}, 0, 0, 0); \
                    a = __builtin_amdgcn_mfma_f32_16x16x32_bf16(src[t_][1], qf[j][1], a, 0, 0, 0); \
                    const float wj = j == 0 ? w0 : j == 1 ? w1 : j == 2 ? w2 : w3; \
                    _Pragma("unroll") for (int i = 0; i < 4; ++i) s4[i] = fmaf(__int_as_float(max(__float_as_int(a[i]), 0)), wj, s4[i]); } \
                *(LAS f32x4*)(sc + fr * SCS + kt_ * 16 + (kt_ >> 1) * 4 + fq * 4) = s4; } } while (0)
                KI_LOAD(ka, 0);
                for (int i0 = 0; ktlo + wave + 8 * i0 < kthi; i0 += 4) { KI_LOAD(kb2, i0 + 2); KI_COMP(ka, i0); KI_LOAD(ka, i0 + 4); KI_COMP(kb2, i0 + 2); }
#undef KI_LOAD
#undef KI_COMP
                __syncthreads();
                if (c + 1 == nch) SEL_LOADQ(idxn);
                const LAS float* srow = sc + (2 * wave) * SCS + 36 * lane;
                const int ema = qa - 2048 * c - 32 * lane, emb = ema + 1;
                const int adma = (int)(ema >= 31 ? 0xffffffffu : ema < 0 ? 0u : ((2u << ema) - 1u)), admb = (int)(emb >= 31 ? 0xffffffffu : emb < 0 ? 0u : ((2u << emb) - 1u));
#pragma unroll
                for (int e4 = 0; e4 < 8; ++e4) {
                    const f32x4 va = *(const LAS f32x4*)(srow + 4 * e4), vb = *(const LAS f32x4*)(srow + SCS + 4 * e4);
#pragma unroll
                    for (int e = 0; e < 4; ++e) {
                        const int ii = c * 32 + e4 * 4 + e;
                        const unsigned ba = __float_as_uint(va[e]), bb = __float_as_uint(vb[e]);
                        ua[ii] = (ba ^ ((unsigned)((int)ba >> 31) | 0x80000000u)) & (unsigned)__builtin_amdgcn_sbfe(adma, e4 * 4 + e, 1);
                        ub[ii] = (bb ^ ((unsigned)((int)bb >> 31) | 0x80000000u)) & (unsigned)__builtin_amdgcn_sbfe(admb, e4 * 4 + e, 1);
                        vmaxa = max(vmaxa, ua[ii]); vmaxb = max(vmaxb, ub[ii]);
                    }
                }
                asm volatile("s_waitcnt lgkmcnt(0)" ::: "memory");
                __syncthreads();
            } else {
#pragma unroll
                for (int e = 0; e < 32; ++e) { ua[c * 32 + e] = 0u; ub[c * 32 + e] = 0u; }
            }
        }
        if (sub != 3) {
            select_query(ua, vmaxa, qa, b, lane, MASKb);
            select_query(ub, vmaxb, qb, b, lane, MASKb);
            asm volatile("s_waitcnt vmcnt(0)" ::: "memory");
            if (lane == 0) __hip_atomic_fetch_add(itemcnt + idx, 1u, __ATOMIC_RELAXED, __HIP_MEMORY_SCOPE_AGENT);
        }
    }
    __syncthreads();
#undef SEL_LOADQ
}

__device__ __forceinline__ void mixer_a(const bf16_t* __restrict__ Z, bf16_t* __restrict__ Y, const float* __restrict__ wc, int gtid, int NGT) {
#pragma unroll 2
    for (int it = gtid; it < MTOK * 32; it += NGT) {
        const int row = it >> 5, c8 = (it & 31) * 8, pos = row & (SEQ - 1);
        const bf16_t* zr = Z + (size_t)row * NZ;
        float acc[8];
#pragma unroll
        for (int i = 0; i < 8; ++i) acc[i] = 0.f;
#pragma unroll
        for (int j = 0; j < 3; ++j) {
            const int d = 2 - j; const float ok = (pos >= d) ? 1.f : 0.f;
            {
                const bf16_t* zz = zr - (size_t)((pos >= d) ? d : 0) * NZ;
                const u32x4 cc = *(const u32x4*)(zz + 256 + c8), hh = *(const u32x4*)(zz + 512 + c8);
                const f32x4 wa = *(const f32x4*)(wc + j * 256 + c8) * ok, wb = *(const f32x4*)(wc + j * 256 + c8 + 4) * ok;
                acc[0] += wa[0] * (bflo(cc.x) * bflo(hh.x)); acc[1] += wa[1] * (bfhi(cc.x) * bfhi(hh.x));
                acc[2] += wa[2] * (bflo(cc.y) * bflo(hh.y)); acc[3] += wa[3] * (bfhi(cc.y) * bfhi(hh.y));
                acc[4] += wb[0] * (bflo(cc.z) * bflo(hh.z)); acc[5] += wb[1] * (bfhi(cc.z) * bfhi(hh.z));
                acc[6] += wb[2] * (bflo(cc.w) * bflo(hh.w)); acc[7] += wb[3] * (bfhi(cc.w) * bfhi(hh.w));
            }
        }
        const u32x4 ab = *(const u32x4*)(zr + c8);
        u32x4 o;
        o.x = cvt_pk_bf16(bflo(ab.x) * acc[0], bfhi(ab.x) * acc[1]); o.y = cvt_pk_bf16(bflo(ab.y) * acc[2], bfhi(ab.y) * acc[3]);
        o.z = cvt_pk_bf16(bflo(ab.z) * acc[4], bfhi(ab.z) * acc[5]); o.w = cvt_pk_bf16(bflo(ab.w) * acc[6], bfhi(ab.w) * acc[7]);
        *(u32x4*)(Y + (size_t)row * DM + c8) = o;
    }
}

__device__ __forceinline__ void mixer_b(const bf16_t* __restrict__ Z, bf16_t* __restrict__ Y, const float* __restrict__ lng, const float* __restrict__ lnb, const float* __restrict__ wsp, const float* __restrict__ bsp,
                                        LAS unsigned char* lds, int wave, int lane, int bid, int G) {
    constexpr int VP = 132;
    LAS bf16_t* vt = (LAS bf16_t*)lds;
    const int fr = lane & 15, fq = lane >> 4;
    for (int un = bid; un < 256; un += G) {
        const int chunk = un >> 1, hf = un & 1; const size_t row0 = (size_t)chunk * 128;
#pragma unroll 8
        for (int k = 0; k < 16; ++k) {
            const int s = wave * 16 + k; const bf16_t* zr = Z + (row0 + s) * NZ + 4 * 256;
            const float v0 = bf2f(zr[lane]), v1 = bf2f(zr[lane + 64]), v2 = bf2f(zr[lane + 128]), v3 = bf2f(zr[lane + 192]);
            const float mean = wave_sum((v0 + v1) + (v2 + v3)) * (1.f / 256.f);
            const float d0 = v0 - mean, d1 = v1 - mean, d2 = v2 - mean, d3 = v3 - mean;
            const float var = wave_sum((d0 * d0 + d1 * d1) + (d2 * d2 + d3 * d3)) * (1.f / 256.f);
            const float rstd = __builtin_amdgcn_rsqf(var + 1e-5f);
            const int ca = hf * 128 + lane, cb = ca + 64;
            const float a = (hf ? d2 : d0) * rstd * lng[ca] + lnb[ca], b = (hf ? d3 : d1) * rstd * lng[cb] + lnb[cb];
            const unsigned pk = cvt_pk_bf16(a, b);
            vt[lane * VP + s] = (bf16_t)(pk & 0xffffu); vt[(lane + 64) * VP + s] = (bf16_t)(pk >> 16);
        }
        __syncthreads();
        const int t = wave * 16 + fr;
#pragma unroll
        for (int hh = 0; hh < 2; ++hh) {
            const int h = hf * 2 + hh; const float* W = wsp + (size_t)h * 128 * 128 + (size_t)t * 128;
            f32x4 acc[4];
#pragma unroll
            for (int nt = 0; nt < 4; ++nt) acc[nt] = (f32x4){0.f, 0.f, 0.f, 0.f};
#pragma unroll
            for (int ks = 0; ks < 4; ++ks) {
                const int s0 = ks * 32 + fq * 8;
                f32x4 wa = *(const f32x4*)(W + s0), wb = *(const f32x4*)(W + s0 + 4);
#pragma unroll
                for (int j = 0; j < 4; ++j) { if (s0 + j > t) wa[j] = 0.f; if (s0 + 4 + j > t) wb[j] = 0.f; }
                u32x4 wp; wp.x = cvt_pk_bf16(wa[0], wa[1]); wp.y = cvt_pk_bf16(wa[2], wa[3]); wp.z = cvt_pk_bf16(wb[0], wb[1]); wp.w = cvt_pk_bf16(wb[2], wb[3]);
                const bf16x8 wf = __builtin_bit_cast(bf16x8, wp);
#pragma unroll
                for (int nt = 0; nt < 4; ++nt) {
                    const LAS bf16_t* vp = vt + (hh * 64 + nt * 16 + fr) * VP + s0;
                    const u32x2 lo = *(const LAS u32x2*)vp, hi2 = *(const LAS u32x2*)(vp + 4);
                    u32x4 vv; vv.x = lo.x; vv.y = lo.y; vv.z = hi2.x; vv.w = hi2.y;
                    acc[nt] = __builtin_amdgcn_mfma_f32_16x16x32_bf16(__builtin_bit_cast(bf16x8, vv), wf, acc[nt], 0, 0, 0);
                }
            }
            const float bias = bsp[h * 128 + t]; const size_t row = row0 + t;
#pragma unroll
            for (int nt = 0; nt < 4; ++nt) {
                const int col = h * 64 + nt * 16 + fq * 4;
                const u32x2 uu = *(const u32x2*)(Z + row * NZ + 3 * 256 + col);
                u32x2 o; o.x = cvt_pk_bf16((acc[nt][0] + bias) * bflo(uu.x), (acc[nt][1] + bias) * bfhi(uu.x)); o.y = cvt_pk_bf16((acc[nt][2] + bias) * bflo(uu.y), (acc[nt][3] + bias) * bfhi(uu.y));
                *(u32x2*)(Y + row * DM + 256 + col) = o;
            }
        }
        __syncthreads();
    }
}

__device__ __forceinline__ void mixer_d(const bf16_t* Z, bf16_t* Y, const float* wcf, const float* bcf, const float* lng, const float* lnb,
                                        LAS unsigned char* lds, int tid, int wave, int lane, int bid, int G) {
    LAS float* yl = (LAS float*)lds;
    LAS float* cv = (LAS float*)(lds + 62 * 256 * 4);
    const int c = tid & 255, half = tid >> 8;
    float w[31];
#pragma unroll
    for (int j = 0; j < 31; ++j) w[j] = wcf[j * 256 + c];
    const float bias = bcf[c];
    const f32x4 g4 = *(const f32x4*)(lng + lane * 4), b4 = *(const f32x4*)(lnb + lane * 4);
    for (int un = bid; un < MTOK / 32; un += G) {
        const int row0 = un * 32, pos0 = row0 & (SEQ - 1);
#pragma unroll
        for (int i4 = 0; i4 < 4; ++i4) {
            const int it0 = tid + i4 * NTHREADS, it = it0 < 62 * 32 ? it0 : 62 * 32 - 1;
            const int rr = it >> 5, c8 = (it & 31) * 8, p = pos0 - 30 + rr;
            f32x4 o0, o1; const float ok = (p >= 0) ? 1.f : 0.f;
            {
                const bf16_t* zr = Z + (size_t)(row0 + ((p >= 0) ? rr - 30 : 0)) * NZ;
                const u32x4 a = *(const u32x4*)(zr + 9 * 256 + c8), gg = *(const u32x4*)(zr + 10 * 256 + c8);
                o0[0] = bflo(a.x) * sigmoidf_(bflo(gg.x)); o0[1] = bfhi(a.x) * sigmoidf_(bfhi(gg.x)); o0[2] = bflo(a.y) * sigmoidf_(bflo(gg.y)); o0[3] = bfhi(a.y) * sigmoidf_(bfhi(gg.y));
                o1[0] = bflo(a.z) * sigmoidf_(bflo(gg.z)); o1[1] = bfhi(a.z) * sigmoidf_(bfhi(gg.z)); o1[2] = bflo(a.w) * sigmoidf_(bflo(gg.w)); o1[3] = bfhi(a.w) * sigmoidf_(bfhi(gg.w));
            }
            *(LAS f32x4*)(yl + rr * 256 + c8) = o0 * ok; *(LAS f32x4*)(yl + rr * 256 + c8 + 4) = o1 * ok;
        }
        __syncthreads();
#pragma unroll
        for (int blk = 0; blk < 2; ++blk) {
            const int tb = half * 16 + blk * 8;
            float acc[8];
#pragma unroll
            for (int o = 0; o < 8; ++o) acc[o] = bias;
#pragma unroll
            for (int jj = 0; jj < 38; ++jj) {
                const float v = yl[(tb + jj) * 256 + c];
#pragma unroll
                for (int o = 0; o < 8; ++o) { const int j = jj - o; if (j >= 0 && j < 31) acc[o] += w[j] * v; }
            }
#pragma unroll
            for (int o = 0; o < 8; ++o) cv[(tb + o) * 256 + c] = acc[o];
        }
        __syncthreads();
#pragma unroll
        for (int k = 0; k < 4; ++k) {
            const int tt = wave * 4 + k;
            const f32x4 v = *(const LAS f32x4*)(cv + tt * 256 + lane * 4);
            const float mean = wave_sum((v[0] + v[1]) + (v[2] + v[3])) * (1.f / 256.f);
            const f32x4 d = v - mean;
            const float var = wave_sum((d[0] * d[0] + d[1] * d[1]) + (d[2] * d[2] + d[3] * d[3])) * (1.f / 256.f);
            const float rstd = __builtin_amdgcn_rsqf(var + 1e-5f);
            const f32x4 y = d * rstd * g4 + b4;
            u32x2 o; o.x = cvt_pk_bf16(y[0] * sigmoidf_(y[0]), y[1] * sigmoidf_(y[1])); o.y = cvt_pk_bf16(y[2] * sigmoidf_(y[2]), y[3] * sigmoidf_(y[3]));
            *(u32x2*)(Y + (size_t)(row0 + tt) * DM + 768 + lane * 4) = o;
        }
        __syncthreads();
    }
}

__device__ __forceinline__ void mixer_bd(const bf16_t* __restrict__ Z, bf16_t* __restrict__ Y, const float* __restrict__ lng, const float* __restrict__ lnb, const float* __restrict__ wsp, const float* __restrict__ bsp,
                                         const float* __restrict__ wcf, const float* __restrict__ bcf, const float* __restrict__ dlng, const float* __restrict__ dlnb,
                                         LAS unsigned char* lds, int tid, int wave, int lane, int bid, int G) {
    constexpr int VP = 132;
    LAS bf16_t* vt = (LAS bf16_t*)lds;
    LAS float* yl = (LAS float*)(lds + 36864);
    LAS float* cv = (LAS float*)(lds + 100352);
    const int fr = lane & 15, fq = lane >> 4;
    const int c = tid & 255, half = tid >> 8;
    float w[31];
#pragma unroll
    for (int j = 0; j < 31; ++j) w[j] = wcf[j * 256 + c];
    const float dbias = bcf[c];
    const f32x4 g4 = *(const f32x4*)(dlng + lane * 4), b4 = *(const f32x4*)(dlnb + lane * 4);
#define MD_GLU(dun) do { const int row0_ = (dun) * 32, pos0_ = row0_ & (SEQ - 1); \
        _Pragma("unroll") for (int i4 = 0; i4 < 4; ++i4) { \
            const int it0 = tid + i4 * NTHREADS, it = it0 < 62 * 32 ? it0 : 62 * 32 - 1; \
            const int rr = it >> 5, c8 = (it & 31) * 8, p = pos0_ - 30 + rr; \
            f32x4 o0, o1; const float ok = (p >= 0) ? 1.f : 0.f; \
            const bf16_t* zr = Z + (size_t)(row0_ + ((p >= 0) ? rr - 30 : 0)) * NZ; \
            const u32x4 a = *(const u32x4*)(zr + 9 * 256 + c8), gg = *(const u32x4*)(zr + 10 * 256 + c8); \
            o0[0] = bflo(a.x) * sigmoidf_(bflo(gg.x)); o0[1] = bfhi(a.x) * sigmoidf_(bfhi(gg.x)); o0[2] = bflo(a.y) * sigmoidf_(bflo(gg.y)); o0[3] = bfhi(a.y) * sigmoidf_(bfhi(gg.y)); \
            o1[0] = bflo(a.z) * sigmoidf_(bflo(gg.z)); o1[1] = bfhi(a.z) * sigmoidf_(bfhi(gg.z)); o1[2] = bflo(a.w) * sigmoidf_(bflo(gg.w)); o1[3] = bfhi(a.w) * sigmoidf_(bfhi(gg.w)); \
            *(LAS f32x4*)(yl + rr * 256 + c8) = o0 * ok; *(LAS f32x4*)(yl + rr * 256 + c8 + 4) = o1 * ok; } } while (0)
#define MD_CONV() do { _Pragma("unroll") for (int blk = 0; blk < 2; ++blk) { const int tb = half * 16 + blk * 8; float acc_[8]; \
            _Pragma("unroll") for (int o = 0; o < 8; ++o) acc_[o] = dbias; \
            _Pragma("unroll") for (int jj = 0; jj < 38; ++jj) { const float v = yl[(tb + jj) * 256 + c]; \
                _Pragma("unroll") for (int o = 0; o < 8; ++o) { const int j = jj - o; if (j >= 0 && j < 31) acc_[o] += w[j] * v; } } \
            _Pragma("unroll") for (int o = 0; o < 8; ++o) cv[(tb + o) * 256 + c] = acc_[o]; } } while (0)
#define MD_LN(dun) do { const int row0_ = (dun) * 32; _Pragma("unroll") for (int k = 0; k < 4; ++k) { const int tt = wave * 4 + k; \
            const f32x4 v = *(const LAS f32x4*)(cv + tt * 256 + lane * 4); \
            const float mean = wave_sum((v[0] + v[1]) + (v[2] + v[3])) * (1.f / 256.f); const f32x4 d = v - mean; \
            const float var = wave_sum((d[0] * d[0] + d[1] * d[1]) + (d[2] * d[2] + d[3] * d[3])) * (1.f / 256.f); const float rstd = __builtin_amdgcn_rsqf(var + 1e-5f); \
            const f32x4 y = d * rstd * g4 + b4; \
            u32x2 o; o.x = cvt_pk_bf16(y[0] * sigmoidf_(y[0]), y[1] * sigmoidf_(y[1])); o.y = cvt_pk_bf16(y[2] * sigmoidf_(y[2]), y[3] * sigmoidf_(y[3])); \
            *(u32x2*)(Y + (size_t)(row0_ + tt) * DM + 768 + lane * 4) = o; } } while (0)
    for (int un = bid; un < 256; un += G) {
        const int chunk = un >> 1, hf = un & 1; const size_t row0 = (size_t)chunk * 128;
        const int t = wave * 16 + fr; const size_t row = row0 + t;
        bf16x8 wf[2][4]; u32x2 uu[2][4]; float bias[2];
#pragma unroll
        for (int hh = 0; hh < 2; ++hh) {
            const int h = hf * 2 + hh; const float* W = wsp + (size_t)h * 128 * 128 + (size_t)t * 128;
            f32x4 wa[4], wb[4];
#pragma unroll
            for (int ks = 0; ks < 4; ++ks) { wa[ks] = *(const f32x4*)(W + ks * 32 + fq * 8); wb[ks] = *(const f32x4*)(W + ks * 32 + fq * 8 + 4); }
#pragma unroll
            for (int nt = 0; nt < 4; ++nt) uu[hh][nt] = *(const u32x2*)(Z + row * NZ + 3 * 256 + h * 64 + nt * 16 + fq * 4);
            bias[hh] = bsp[h * 128 + t];
#pragma unroll
            for (int ks = 0; ks < 4; ++ks) {
                const int s0 = ks * 32 + fq * 8;
#pragma unroll
                for (int j = 0; j < 4; ++j) { if (s0 + j > t) wa[ks][j] = 0.f; if (s0 + 4 + j > t) wb[ks][j] = 0.f; }
                u32x4 wp; wp.x = cvt_pk_bf16(wa[ks][0], wa[ks][1]); wp.y = cvt_pk_bf16(wa[ks][2], wa[ks][3]); wp.z = cvt_pk_bf16(wb[ks][0], wb[ks][1]); wp.w = cvt_pk_bf16(wb[ks][2], wb[ks][3]);
                wf[hh][ks] = __builtin_bit_cast(bf16x8, wp);
            }
        }
#pragma unroll 8
        for (int k = 0; k < 16; ++k) {
            const int s = wave * 16 + k; const bf16_t* zr = Z + (row0 + s) * NZ + 4 * 256;
            const float v0 = bf2f(zr[lane]), v1 = bf2f(zr[lane + 64]), v2 = bf2f(zr[lane + 128]), v3 = bf2f(zr[lane + 192]);
            const float mean = wave_sum((v0 + v1) + (v2 + v3)) * (1.f / 256.f);
            const float d0 = v0 - mean, d1 = v1 - mean, d2 = v2 - mean, d3 = v3 - mean;
            const float var = wave_sum((d0 * d0 + d1 * d1) + (d2 * d2 + d3 * d3)) * (1.f / 256.f);
            const float rstd = __builtin_amdgcn_rsqf(var + 1e-5f);
            const int ca = hf * 128 + lane, cb = ca + 64;
            const float a = (hf ? d2 : d0) * rstd * lng[ca] + lnb[ca], b = (hf ? d3 : d1) * rstd * lng[cb] + lnb[cb];
            const unsigned pk = cvt_pk_bf16(a, b);
            vt[lane * VP + s] = (bf16_t)(pk & 0xffffu); vt[(lane + 64) * VP + s] = (bf16_t)(pk >> 16);
        }
        MD_GLU(2 * un);
        __syncthreads();
#pragma unroll
        for (int hh = 0; hh < 2; ++hh) {
            const int h = hf * 2 + hh;
            f32x4 acc[4];
#pragma unroll
            for (int nt = 0; nt < 4; ++nt) acc[nt] = (f32x4){0.f, 0.f, 0.f, 0.f};
#pragma unroll
            for (int ks = 0; ks < 4; ++ks) {
                const int s0 = ks * 32 + fq * 8;
#pragma unroll
                for (int nt = 0; nt < 4; ++nt) {
                    const LAS bf16_t* vp = vt + (hh * 64 + nt * 16 + fr) * VP + s0;
                    const u32x2 lo = *(const LAS u32x2*)vp, hi2 = *(const LAS u32x2*)(vp + 4);
                    u32x4 vv; vv.x = lo.x; vv.y = lo.y; vv.z = hi2.x; vv.w = hi2.y;
                    acc[nt] = __builtin_amdgcn_mfma_f32_16x16x32_bf16(__builtin_bit_cast(bf16x8, vv), wf[hh][ks], acc[nt], 0, 0, 0);
                }
            }
#pragma unroll
            for (int nt = 0; nt < 4; ++nt) {
                const int col = h * 64 + nt * 16 + fq * 4; const u32x2 u2 = uu[hh][nt]; const float bs_ = bias[hh];
                u32x2 o; o.x = cvt_pk_bf16((acc[nt][0] + bs_) * bflo(u2.x), (acc[nt][1] + bs_) * bfhi(u2.x)); o.y = cvt_pk_bf16((acc[nt][2] + bs_) * bflo(u2.y), (acc[nt][3] + bs_) * bfhi(u2.y));
                *(u32x2*)(Y + row * DM + 256 + col) = o;
            }
        }
        MD_CONV();
        __syncthreads();
        MD_LN(2 * un);
        MD_GLU(2 * un + 1);
        __syncthreads();
        MD_CONV();
        __syncthreads();
        MD_LN(2 * un + 1);
        __syncthreads();
    }
#undef MD_GLU
#undef MD_CONV
#undef MD_LN
}

__device__ __forceinline__ void attn_phase(const bf16_t* Z, const bf16_t* Kb, const bf16_t* Vb, unsigned* MASKb, unsigned* itemcnt, bf16_t* Y, LAS unsigned char* lds, int wave, int lane, int bid, int G) {
    const int h = wave & 3, half = wave >> 2, ql = lane & 31, hi = lane >> 5;
    LAS float* mo = (LAS float*)lds + h * 2048;
    LAS float* mml = (LAS float*)(lds + 32768) + h * 128;
    LAS bf16_t* ost = (LAS bf16_t*)(lds + 36864) + h * (32 * 72);
    const unsigned NEGB = __float_as_uint(NEGF);
    for (int pu = bid; pu < 256; pu += G) {
        const int b = pu & 3, jj = pu >> 2;
        for (int rep = 0; rep < 2; ++rep) {
            const int qb = rep ? jj : 127 - jj;
            const int NT = qb + 1, n0 = (NT + 1) >> 1, tb = half ? n0 : 0, te = half ? NT : n0;
            if (wave == 0) {
                unsigned* c0 = itemcnt + (2 * qb) * 4 + b; unsigned* c1 = c0 + 4; unsigned spins = 0;
                while ((unsigned)__builtin_amdgcn_readfirstlane(__hip_atomic_load(c0, __ATOMIC_RELAXED, __HIP_MEMORY_SCOPE_AGENT)) < 8u ||
                       (unsigned)__builtin_amdgcn_readfirstlane(__hip_atomic_load(c1, __ATOMIC_RELAXED, __HIP_MEMORY_SCOPE_AGENT)) < 8u) { __builtin_amdgcn_s_sleep(4); if (++spins > (1u << 22)) break; }
                __builtin_amdgcn_fence(__ATOMIC_ACQUIRE, "agent");
            }
            __syncthreads();
            const size_t rowq = (size_t)b * SEQ + qb * 32 + ql;
            const bf16_t* zq = Z + rowq * NZ + 1280 + h * 64 + hi * 8;
            bf16x8 qf[4];
#pragma unroll
            for (int c = 0; c < 4; ++c) qf[c] = *(const bf16x8*)(zq + 16 * c);
            unsigned* mrow = MASKb + ((size_t)(b * 128 + qb) * 128) * 32 + ql;
            const bf16_t* kb = Kb + ((size_t)(b * 4 + h) * 128) * 2048 + ql * 16 + hi * 8;
            const bf16_t* vb = Vb + ((size_t)(b * 4 + h) * 128) * 2048 + ql * 16 + hi * 8;
            f32x16 o0, o1;
#pragma unroll
            for (int r = 0; r < 16; ++r) { o0[r] = 0.f; o1[r] = 0.f; }
            float m = NEGF, l = 0.f;
            bf16x8 kA[4], kB[4]; bf16x8 vA[2][2], vB[2][2]; unsigned mA = 0u, mB = 0u;
#define ATT_LOAD(KF, VR, MW, kt_) do { const bf16_t* kp_ = kb + (size_t)(kt_) * 2048; const bf16_t* vp_ = vb + (size_t)(kt_) * 2048; _Pragma("unroll") for (int c = 0; c < 4; ++c) KF[c] = *(const bf16x8*)(kp_ + c * 512); \
        _Pragma("unroll") for (int mt = 0; mt < 2; ++mt) _Pragma("unroll") for (int c = 0; c < 2; ++c) VR[mt][c] = *(const bf16x8*)(vp_ + (mt * 2 + c) * 512); \
        MW = __hip_atomic_load(mrow + (kt_) * 32, __ATOMIC_RELAXED, __HIP_MEMORY_SCOPE_AGENT); } while (0)
#define ATT_COMP(KF, VR, MW) do { \
        f32x16 s; \
        _Pragma("unroll") for (int r = 0; r < 16; ++r) s[r] = 0.f; \
        __builtin_amdgcn_s_setprio(1); \
        _Pragma("unroll") for (int c = 0; c < 4; ++c) s = __builtin_amdgcn_mfma_f32_32x32x16_bf16(KF[c], qf[c], s, 0, 0, 0); \
        __builtin_amdgcn_s_setprio(0); \
        const int mws = (int)(MW >> (4 * hi)); \
        float rm = NEGF; \
        _Pragma("unroll") for (int r = 0; r < 16; ++r) { \
            const unsigned sel = (unsigned)__builtin_amdgcn_sbfe(mws, (r & 3) + 8 * (r >> 2), 1); \
            s[r] = __uint_as_float((__float_as_uint(s[r]) & sel) | (NEGB & ~sel)); \
            rm = fmaxf(rm, s[r]); } \
        rm = fmaxf(rm, swap32(rm, hi)); \
        const float mn = fmaxf(m, rm); \
        if (__any(mn > m)) { \
            const float al = __builtin_amdgcn_exp2f(m - mn); l *= al; \
            _Pragma("unroll") for (int r = 0; r < 16; ++r) { o0[r] *= al; o1[r] *= al; } \
            m = mn; } \
        float ps = 0.f; \
        _Pragma("unroll") for (int r = 0; r < 16; ++r) { s[r] = __builtin_amdgcn_exp2f(s[r] - m); ps += s[r]; } \
        l += ps; \
        u32x4 p0, p1; \
        p0.x = cvt_pk_bf16(s[0], s[1]); p0.y = cvt_pk_bf16(s[2], s[3]); p0.z = cvt_pk_bf16(s[4], s[5]); p0.w = cvt_pk_bf16(s[6], s[7]); \
        p1.x = cvt_pk_bf16(s[8], s[9]); p1.y = cvt_pk_bf16(s[10], s[11]); p1.z = cvt_pk_bf16(s[12], s[13]); p1.w = cvt_pk_bf16(s[14], s[15]); \
        const bf16x8 pf0 = __builtin_bit_cast(bf16x8, p0), pf1 = __builtin_bit_cast(bf16x8, p1); \
        __builtin_amdgcn_s_setprio(1); \
        o0 = __builtin_amdgcn_mfma_f32_32x32x16_bf16(VR[0][0], pf0, o0, 0, 0, 0); o1 = __builtin_amdgcn_mfma_f32_32x32x16_bf16(VR[1][0], pf0, o1, 0, 0, 0); \
        o0 = __builtin_amdgcn_mfma_f32_32x32x16_bf16(VR[0][1], pf1, o0, 0, 0, 0); o1 = __builtin_amdgcn_mfma_f32_32x32x16_bf16(VR[1][1], pf1, o1, 0, 0, 0); \
        __builtin_amdgcn_s_setprio(0); } while (0)
            if (tb < te) ATT_LOAD(kA, vA, mA, tb);
            for (int kt = tb; kt < te; kt += 2) {
                { const int k1 = (kt + 1 < te) ? kt + 1 : kt; ATT_LOAD(kB, vB, mB, k1); }
                ATT_COMP(kA, vA, mA);
                { const int k2 = (kt + 2 < te) ? kt + 2 : te - 1; ATT_LOAD(kA, vA, mA, k2); }
                if (kt + 1 < te) ATT_COMP(kB, vB, mB);
            }
#undef ATT_COMP
#undef ATT_LOAD
            const float lt = l + swap32(l, hi);
            if (half == 1) {
#pragma unroll
                for (int r = 0; r < 16; ++r) { mo[r * 64 + lane] = o0[r]; mo[(16 + r) * 64 + lane] = o1[r]; }
                mml[lane] = m; mml[64 + lane] = lt;
            }
            __syncthreads();
            if (half == 0) {
                const float m1 = mml[lane], l1 = mml[64 + lane];
                const float mn = fmaxf(m, m1), a0 = __builtin_amdgcn_exp2f(m - mn), a1 = __builtin_amdgcn_exp2f(m1 - mn);
                const float inv = __builtin_amdgcn_rcpf(lt * a0 + l1 * a1), f0 = a0 * inv, f1 = a1 * inv;
#pragma unroll
                for (int r = 0; r < 16; ++r) { o0[r] = o0[r] * f0 + mo[r * 64 + lane] * f1; o1[r] = o1[r] * f0 + mo[(16 + r) * 64 + lane] * f1; }
#pragma unroll
                for (int r = 0; r < 16; r += 2) {
                    const int d = (r & 3) + 8 * (r >> 2) + 4 * hi;
                    *(LAS unsigned*)(ost + ql * 72 + d) = cvt_pk_bf16(o0[r], o0[r + 1]);
                    *(LAS unsigned*)(ost + ql * 72 + 32 + d) = cvt_pk_bf16(o1[r], o1[r + 1]);
                }
                LDS_WAIT();
                bf16_t* yo = Y + ((size_t)b * SEQ + qb * 32 + (lane >> 1)) * DM + 512 + h * 64 + (lane & 1) * 32;
#pragma unroll
                for (int k = 0; k < 4; ++k) { const u32x4 v = *(const LAS u32x4*)(ost + (lane >> 1) * 72 + (lane & 1) * 32 + k * 8); *(u32x4*)(yo + k * 8) = v; }
            }
            __syncthreads();
        }
    }
}

#define RLX_AGENT __ATOMIC_RELAXED, __HIP_MEMORY_SCOPE_AGENT
#define XB_TMO      128
#define XB_XCNT(j)  (256  + 64 * (j))
#define XB_XSUB(j)  (1280 + 64 * (j))
#define XB_XGEN(j)  (2304 + 64 * (j))
#define XB_TOP      3328
#define XB_TOPGEN   3392
#define XCD_BAR_WORDS 3456
#define XB_SPIN_CAP (1u << 18)

__device__ __forceinline__ unsigned xb_ld(unsigned* p)              { return __hip_atomic_load(p, __ATOMIC_RELAXED, __HIP_MEMORY_SCOPE_AGENT); }
__device__ __forceinline__ unsigned xb_add(unsigned* p, unsigned v) { return __hip_atomic_fetch_add(p, v, __ATOMIC_RELAXED, __HIP_MEMORY_SCOPE_AGENT); }
__device__ __forceinline__ unsigned xb_xcc_id() { return (unsigned)__builtin_amdgcn_s_getreg((3 << 11) | 20) & 0xFu; }
#define XB_SPIN(cond, bar) do { unsigned _sp = 0; while (cond) { __builtin_amdgcn_s_sleep(1); \
    if ((++_sp & 255u) == 0u) { if (xb_ld(&(bar)[XB_TMO])) break; if (_sp > XB_SPIN_CAP) { atomicAdd(&(bar)[XB_TMO], 1u); break; } } } } while (0)

struct XcdBarrier {
    unsigned* bar; unsigned x;
    volatile LAS unsigned* st;
};

__device__ __forceinline__ XcdBarrier xcd_barrier_post(unsigned* bar, volatile LAS unsigned* st, int tid) {
    XcdBarrier b; b.bar = bar; b.x = xb_xcc_id(); b.st = st;
    if (tid == 0) (void)xb_add(&bar[XB_XCNT(b.x)], 1u);
    return b;
}
__device__ __forceinline__ void xcd_barrier_complete(unsigned* bar, unsigned x, unsigned& nloc, unsigned& nx) {
    const unsigned G = gridDim.x * gridDim.y * gridDim.z;
    unsigned sum, cnt, mine, sp = 0u;
    for (;;) {
        sum = 0u; cnt = 0u; mine = 0u;
#pragma unroll
        for (unsigned j = 0; j < 16; ++j) { const unsigned c = xb_ld(&bar[XB_XCNT(j)]); sum += c; cnt += (c > 0u) ? 1u : 0u; mine = (j == x) ? c : mine; }
        if (sum == G) break;
        __builtin_amdgcn_s_sleep(1);
        if ((++sp & 255u) == 0u) { if (xb_ld(&bar[XB_TMO])) break; if (sp > XB_SPIN_CAP) { atomicAdd(&bar[XB_TMO], 1u); break; } }
    }
    nloc = mine > 0u ? mine : 1u; nx = cnt > 0u ? cnt : 1u;
}

__device__ __forceinline__ void xcd_barrier(const XcdBarrier& b, int tid) {
    asm volatile("s_waitcnt vmcnt(0)" ::: "memory");
    __syncthreads();
    if (tid == 0) {
        unsigned* bar = b.bar;
        __builtin_amdgcn_s_waitcnt(0);
        unsigned nloc = b.st[0], nx = b.st[1];
        if (nloc == 0u) { xcd_barrier_complete(bar, b.x, nloc, nx); b.st[0] = nloc; b.st[1] = nx; }
        const unsigned old = xb_add(&bar[XB_XSUB(b.x)], 1u);
        const unsigned gen = old / nloc;
        if (old + 1u == (gen + 1u) * nloc) {
            __builtin_amdgcn_fence(__ATOMIC_RELEASE, "agent");
            asm volatile("s_waitcnt vmcnt(0)" ::: "memory");
            const unsigned og = xb_add(&bar[XB_TOP], 1u);
            const unsigned tg = og / nx, target = (tg + 1u) * nx;
            if (og + 1u != target) XB_SPIN(xb_ld(&bar[XB_TOP]) < target, bar);
            __builtin_amdgcn_fence(__ATOMIC_ACQUIRE, "agent");
            xb_add(&bar[XB_XGEN(b.x)], 1u);
            asm volatile("s_waitcnt vmcnt(0)" ::: "memory");
        } else {
            XB_SPIN(xb_ld(&bar[XB_XGEN(b.x)]) == gen, bar);
            __builtin_amdgcn_fence(__ATOMIC_ACQUIRE, "agent");
            asm volatile("s_waitcnt vmcnt(0)" ::: "memory");
        }
    }
    __syncthreads();
}

#ifndef PROBE_PH
#define PROBE_PH -1
#endif
#ifndef PROBE_SUB
#define PROBE_SUB 0
#endif
__global__ void __launch_bounds__(NTHREADS, 2) mega_fwd(Args A_unused) {
    extern __shared__ __attribute__((aligned(16))) unsigned char lds_raw[];
    LAS unsigned char* lds = (LAS unsigned char*)lds_raw;
    cg::grid_group grid = cg::this_grid();
    const int ph_lo = kargs()->ph_lo, ph_hi = kargs()->ph_hi;
    const int wave0 = __builtin_amdgcn_readfirstlane((int)(threadIdx.x >> 6));
    if (threadIdx.x < 16) ((volatile LAS unsigned*)(lds + LDS_BAR_OFF))[threadIdx.x] = 0u;
    __syncthreads();
    if (ph_hi - ph_lo > 1) { (void)xcd_barrier_post((unsigned*)(kargs()->ws + WS_CTL), (volatile LAS unsigned*)(lds + LDS_BAR_OFF), (int)threadIdx.x); }
    const int st_hi = (PROBE_PH >= 0) ? ph_hi + 1 : ph_hi;
    for (int st = ph_lo; st < st_hi; ++st) {
        const int ph = (PROBE_PH >= 0 && st > PROBE_PH) ? st - 1 : st;
        const int sub = (PROBE_PH >= 0 && st == PROBE_PH + 1) ? PROBE_SUB : 0;
        KArgs A = kargs();
        int G = gridDim.x; asm volatile("" : "+s"(G));
        unsigned char* ws = A->ws;
        bf16_t* XB = (bf16_t*)(ws + WS_XB); bf16_t* Yb = (bf16_t*)(ws + WS_Y); bf16_t* Zb = (bf16_t*)(ws + WS_Z); bf16_t* HID = Zb; bf16_t* Vb = (bf16_t*)(ws + WS_VB); bf16_t* Kb = (bf16_t*)(ws + WS_KB); bf16_t* KIb = (bf16_t*)(ws + WS_KI);
        float* ssqA = (float*)(ws + WS_SSQA); float* ssqB = (float*)(ws + WS_SSQB);
        float* ropec = (float*)(ws + WS_ROPE); float* ropes = ropec + SEQ * 32;
        unsigned* MASKb = (unsigned*)(ws + WS_MASK);
        int bid = blockIdx.x, wave = wave0; asm volatile("" : "+s"(bid), "+s"(wave));
        int lane = (int)__builtin_amdgcn_mbcnt_hi(~0u, __builtin_amdgcn_mbcnt_lo(~0u, 0u)); asm volatile("" : "+v"(lane));
        const int tid = wave * 64 + lane;
        if (ph == 0) {
#ifndef NO_PRO
            prologue(A, ws, lds, tid, wave, lane, bid, G, sub);
#endif
        } else if (ph == NPHASE - 1) {
            const float* gfin = A->in[17];
            if (G != 256) for (int row = bid * NWAVES + wave; row < MTOK; row += G * NWAVES) {
                const XL2 XLS{(bf16_t*)(ws + WS_MASK), (bf16_t*)(ws + WS_KB)};
                const float rs = row_rs(ssqA, row); f32x4* p = (f32x4*)(A->out + (size_t)row * DM) + lane; const f32x4* g = (const f32x4*)gfin + lane;
                const u32x2* ph_ = (const u32x2*)(XB + (size_t)row * DM) + lane; const u32x2* pl_ = (const u32x2*)xl_row(XLS, row) + lane;
#pragma unroll
                for (int j = 0; j < 4; ++j) { const u32x2 h2 = ph_[64 * j]; u32x2 l2 = {0u, 0u}; if (RES_LO) l2 = pl_[64 * j]; f32x4 v; v[0] = bflo(h2.x) + bflo(l2.x); v[1] = bfhi(h2.x) + bfhi(l2.x); v[2] = bflo(h2.y) + bflo(l2.y); v[3] = bfhi(h2.y) + bfhi(l2.y); p[64 * j] = v * rs * g[64 * j]; }
            }
        } else {
            const int l = (ph - 1) / 6, k = (ph - 1) % 6;
            if (k == 0) {
                pg8::Gemm g{XB, (bf16_t*)(ws + WS_WIN) + l * WIN_L, MTOK, NZ, DM}; pg8::StaticOrder S; S.init(MTOK, NZ, G, bid);
                EpiZ E{Zb, Vb, Kb, KIb, ssqA, ropec, ropes};
#ifndef NO_G0
                pg8::gemm_phase<EpiZ, pg8::StaticOrder, true, true>(lds, g, S, E, tid);
#endif
            } else if (k == 1) {
#ifndef NO_SEL
                if (sub != 2 && sub < 6) select_phase(Zb, KIb, MASKb, (unsigned*)(ws + WS_CTL) + CW_ITEM + l * 1024, lds, wave, lane, bid, G, sub);
#endif
#ifndef NO_MA
                if (sub == 0 || sub == 2 || sub == 8) mixer_a(Zb, Yb, A->in[3] + l * 3 * 256, bid * NTHREADS + tid, G * NTHREADS);
#endif
#ifndef NO_MB
                if (sub == 0 || sub == 2 || sub == 6 || sub == 7) mixer_bd(Zb, Yb, A->in[4] + l * 256, A->in[5] + l * 256, A->in[6] + (size_t)l * 4 * 128 * 128, A->in[7] + l * 4 * 128,
                                                                      A->in[8] + l * 31 * 256, A->in[9] + l * 256, A->in[10] + l * 256, A->in[11] + l * 256, lds, tid, wave, lane, bid, G);
#endif
            } else if (k == 2) {
#ifndef NO_ATT
                attn_phase(Zb, Kb, Vb, MASKb, (unsigned*)(ws + WS_CTL) + CW_ITEM + l * 1024, Yb, lds, wave, lane, bid, G);
#endif
            } else if (k == 3 || k == 5) {
                const XL2 XLD{(bf16_t*)A->out, (bf16_t*)A->out + (size_t)8192 * DM}, XLS{(bf16_t*)(ws + WS_MASK), (bf16_t*)(ws + WS_KB)};
                const bool last = (l == NLAYER - 1);
                pg8::Gemm g{k == 3 ? Yb : HID, k == 3 ? (bf16_t*)(ws + WS_WOUT) + l * WOUT_L : (bf16_t*)(ws + WS_WDN) + l * WDN_L, MTOK, DM, k == 3 ? DM : FF}; pg8::StaticOrder S; S.init(MTOK, DM, G, bid);
                if (k == 3 && l == 0) {
                    EpiRes<true> E{A->in[0], XLD, last ? XLS : XLD, XB, ssqB};
                    pg8::gemm_phase<EpiRes<true>, pg8::StaticOrder, true, true>(lds, g, S, E, tid);
                } else if (k == 5 && last && G == 256) {
                    EpiFinal E{XB, XLS, A->out, A->in[17], ssqB, (unsigned*)(ws + WS_CTL) + CW_PANEL};
                    pg8::gemm_phase<EpiFinal, pg8::StaticOrder, false, true>(lds, g, S, E, tid);
                } else {
                    EpiRes<false> E{nullptr, (k == 5 && last) ? XLS : XLD, last ? XLS : XLD, XB, k == 3 ? ssqB : ssqA};
                    pg8::gemm_phase<EpiRes<false>, pg8::StaticOrder, true, true>(lds, g, S, E, tid);
                }
            } else if (k == 4) {
                pg8::Gemm g{XB, (bf16_t*)(ws + WS_WGU) + l * WGU_L, MTOK, NGU, DM}; pg8::StaticOrder S; S.init(MTOK, NGU, G, bid);
                EpiGU E{HID, ssqB};
#ifndef NO_G2
                pg8::gemm_phase<EpiGU, pg8::StaticOrder, true, true>(lds, g, S, E, tid);
#endif
                if (l == 0) {
                    const int nwg = (MTOK / 256) * (NGU / 256), rem = nwg % G;
                    if (rem == 0) convert_weights(A, ws, lds, wave, lane, CV_I_L - CV_I_DN, NLAYER * CV_I_L, bid * NWAVES + wave, G * NWAVES);
                    else if (bid >= rem) convert_weights(A, ws, lds, wave, lane, CV_I_L - CV_I_DN, NLAYER * CV_I_L, (bid - rem) * NWAVES + wave, (G - rem) * NWAVES);
                }
            }
        }
        const bool flag_seam = (PROBE_PH < 0) && ph >= 1 && ph <= 12 && ((ph - 1) % 6) == 1;
        if (st + 1 < st_hi && !flag_seam) {
            if (ph_hi > 100000) grid.sync();
            XcdBarrier xb; xb.bar = (unsigned*)(ws + WS_CTL); xb.x = xb_xcc_id(); xb.st = (volatile LAS unsigned*)(lds + LDS_BAR_OFF);
            xcd_barrier(xb, tid);
        }
    }
}

#ifndef MK_COOP
#define MK_COOP 1
#endif
extern "C" void kernel_launch(void* const* d_in, const int* in_sizes, int n_in, void* d_out, int out_size, void* d_ws, size_t ws_size, hipStream_t stream) {
    static int grid = 0;
    if (grid == 0) {
        if (n_in != 18 || out_size != MTOK * DM || ws_size < WS_END) { fprintf(stderr, "kernel_launch: unexpected shapes (n_in %d out %d ws %zu)\n", n_in, out_size, ws_size); grid = -1; return; }
        int dev = 0, cus = 0, per_cu = 0;
        if (hipGetDevice(&dev) != hipSuccess || hipDeviceGetAttribute(&cus, hipDeviceAttributeMultiprocessorCount, dev) != hipSuccess) { grid = -1; return; }
        if (hipFuncSetAttribute((const void*)mega_fwd, hipFuncAttributeMaxDynamicSharedMemorySize, LDS_BYTES) != hipSuccess) { fprintf(stderr, "kernel_launch: hipFuncSetAttribute failed\n"); grid = -1; return; }
        if (hipOccupancyMaxActiveBlocksPerMultiprocessor(&per_cu, (const void*)mega_fwd, NTHREADS, LDS_BYTES) != hipSuccess || per_cu < 1) { fprintf(stderr, "kernel_launch: occupancy query says %d\n", per_cu); (void)hipGetLastError(); }
        grid = cus;
    }
    if (grid < 0) return;
    if (hipMemsetAsync((char*)d_ws + WS_CTL, 0, CTL_BYTES, stream) != hipSuccess) { fprintf(stderr, "kernel_launch: memset failed\n"); return; }
    Args a{};
    for (int i = 0; i < 18; ++i) a.in[i] = (const float*)d_in[i];
    a.out = (float*)d_out; a.ws = (unsigned char*)d_ws;
#if MK_COOP
    a.ph_lo = 0; a.ph_hi = (grid == 256) ? NPHASE - 1 : NPHASE;
    void* args[] = {&a};
    hipError_t e = hipLaunchCooperativeKernel((const void*)mega_fwd, dim3(grid), dim3(NTHREADS), args, LDS_BYTES, stream);
    if (e != hipSuccess) fprintf(stderr, "cooperative launch failed: %s (grid %d)\n", hipGetErrorString(e), grid);
#else
    for (int ph = 0; ph < NPHASE; ++ph) {
        a.ph_lo = ph; a.ph_hi = ph + 1;
        hipLaunchKernelGGL(mega_fwd, dim3(grid), dim3(NTHREADS), LDS_BYTES, stream, a);
    }
#endif
}
```

```cpp
#include <hip/hip_runtime.h>
#include <hip/hip_cooperative_groups.h>
#include <cstdio>
#include <cstdint>
namespace cg = cooperative_groups;
namespace pg8 {
#define PG8_LAS __attribute__((address_space(3)))
typedef unsigned short bf16_t;
typedef short bf16x8 __attribute__((ext_vector_type(8)));
typedef float f32x4 __attribute__((ext_vector_type(4)));
typedef unsigned u32x4 __attribute__((ext_vector_type(4)));
constexpr int BM = 256, BK = 64, HALF = 128, HTB = HALF * BK * 2  , STAGE_BYTES = 8 * HTB, NXCD = 8, WGM = 8;

__host__ __device__ __forceinline__ int lds_byte(int r, int c) { const int st = (r >> 4) * 2 + (c >> 5), rr = r & 15, cc = c & 31, ob = rr * 64 + cc * 2; return st * 1024 + (ob ^ (((ob >> 9) & 1) << 5)); }
__host__ __device__ __forceinline__ void stage_rc(int b, int& R, int& C) { const int st = b / 1024, sb = b % 1024, swz = sb ^ (((sb >> 9) & 1) << 5); R = (st >> 1) * 16 + swz / 64; C = (st & 1) * 32 + (swz % 64) / 2; }
__host__ __device__ __forceinline__ int perm32(int rho) { const int n = rho >> 4, i = rho & 15; return 8 * (i >> 2) + 4 * n + (i & 3); }

struct Unit { int pm, pn; };
struct Gemm { const bf16_t* A; const bf16_t* Bt; int M, N, K; };

struct StaticOrder {
    int nM, nN, nwg, G, c;
    __host__ __device__ void init(int M, int N, int G_, int c_) { nM = M / BM; nN = N / BM; nwg = nM * nN; G = G_; c = c_; }
    __host__ __device__ bool next(int i, Unit& u) const {
        const long L = (long)i * G + c; if (L >= nwg) return false;
        int wgid = (int)L; { const int q = nwg / NXCD, r = nwg % NXCD, xcd = wgid % NXCD, off = wgid / NXCD; wgid = (xcd < r ? xcd * (q + 1) : r * (q + 1) + (xcd - r) * q) + off; }
        const int nig = WGM * nN, gid = wgid / nig, fm = gid * WGM, gsz = (nM - fm) < WGM ? (nM - fm) : WGM;
        u.pm = fm + ((wgid % nig) % gsz); u.pn = (wgid % nig) / gsz; return true;
    }
    __device__ __forceinline__ void a_ready(const Unit&) const {}
    __device__ __forceinline__ void done(const Unit&) const {}
};

__device__ __forceinline__ unsigned cvt_pk_bf16(float lo, float hi) { unsigned r; asm volatile("v_cvt_pk_bf16_f32 %0, %1, %2" : "=v"(r) : "v"(lo), "v"(hi)); return r; }
template <class Epi, class Sched, bool ALIGN_EPI = false, bool SP2 = false>
__device__ __forceinline__ void gemm_phase(PG8_LAS unsigned char* lds, const Gemm g, const Sched& S, const Epi& E, int tid_in) {
    int tid_l = tid_in; asm volatile("" : "+v"(tid_l));
    const int tid = tid_l, wid = __builtin_amdgcn_readfirstlane(tid >> 6), lane = tid & 63, wr = wid >> 2, wc = wid & 3, fr = lane & 15, fq = lane >> 4;
    const int K = g.K, nt = K / BK;
    unsigned voffA[2], voffB[2];
#pragma unroll
    for (int i = 0; i < 2; ++i) { int R, C; stage_rc(tid * 16 + i * 8192, R, C); const int Rb = Epi::PERM ? ((R & ~31) + perm32(R & 31)) : R;
        voffA[i] = (unsigned)(R * K + C) * 2u; voffB[i] = (unsigned)(Rb * K + C) * 2u; }
    const size_t kstep = (size_t)(BK * 2);
    const size_t hstep = (size_t)HALF * K * 2;
    const size_t tstep = 2 * hstep;
    const unsigned ldsw = (unsigned)wid * 1024u;
    const int aoff = lds_byte(wr * 64 + fr, fq * 8), boff = lds_byte(wc * 32 + fr, fq * 8);
#define PG8_SA(b, h) (((b) * 2 + (h)) * HTB)
#define PG8_SB(b, h) ((4 + (b) * 2 + (h)) * HTB)
#define PG8_STAGE(bufoff, gbase, voff) do { _Pragma("unroll") for (int _i = 0; _i < 2; ++_i) \
        __builtin_amdgcn_global_load_lds((const unsigned*)((const char*)(gbase) + (voff)[_i]), (PG8_LAS unsigned*)(lds + (bufoff) + ldsw + _i * 8192), 16, 0, 0); } while (0)
#define PG8_LDA(dst, b, h) do { _Pragma("unroll") for (int m = 0; m < 4; ++m) _Pragma("unroll") for (int k = 0; k < 2; ++k) dst[m][k] = *(const PG8_LAS bf16x8*)(lds + PG8_SA(b, h) + aoff + m * 2048 + k * 1024); } while (0)
#define PG8_LDB(dst, b, h) do { _Pragma("unroll") for (int n = 0; n < 2; ++n) _Pragma("unroll") for (int k = 0; k < 2; ++k) dst[n][k] = *(const PG8_LAS bf16x8*)(lds + PG8_SB(b, h) + boff + n * 2048 + k * 1024); } while (0)
#define PG8_MMA(ai, bj, At, Bt) do { __builtin_amdgcn_s_setprio(1); _Pragma("unroll") for (int m = 0; m < 4; ++m) _Pragma("unroll") for (int n = 0; n < 2; ++n) _Pragma("unroll") for (int k = 0; k < 2; ++k) \
        acc[ai][bj][m][n] = __builtin_amdgcn_mfma_f32_16x16x32_bf16(Bt[n][k], At[m][k], acc[ai][bj][m][n], 0, 0, 0); __builtin_amdgcn_s_setprio(0); } while (0)
#define PG8_WAIT_V(n) asm volatile("s_waitcnt vmcnt(" #n ")" ::: "memory")
#define PG8_WAIT_L(n) asm volatile("s_waitcnt lgkmcnt(" #n ")" ::: "memory")
#define PG8_BAR __builtin_amdgcn_s_barrier()
#define PG8_SCHED __builtin_amdgcn_sched_barrier(0)
    Unit cur, nxt; int ui = 0;
    if (!S.next(0, cur)) return;
    f32x4 acc[2][2][4][2];
#pragma unroll
    for (int a = 0; a < 2; ++a)
#pragma unroll
        for (int b = 0; b < 2; ++b)
#pragma unroll
            for (int m = 0; m < 4; ++m)
#pragma unroll
                for (int n = 0; n < 2; ++n) acc[a][b][m][n] = (f32x4){0.f, 0.f, 0.f, 0.f};
    bf16x8 At[4][2], B0[2][2], B1[2][2];
    const char* cA = (const char*)g.A + (size_t)cur.pm * tstep; const char* cB = (const char*)g.Bt + (size_t)cur.pn * tstep;
    S.a_ready(cur);
    if constexpr (SP2) {
        PG8_STAGE(PG8_SB(0, 0), cB, voffB); PG8_STAGE(PG8_SB(0, 1), cB + hstep, voffB); PG8_STAGE(PG8_SA(0, 0), cA, voffA); PG8_STAGE(PG8_SA(0, 1), cA + hstep, voffA);
        if (wr == 1) PG8_BAR;
        PG8_WAIT_V(2); PG8_BAR;
        PG8_STAGE(PG8_SB(1, 0), cB + kstep, voffB); PG8_STAGE(PG8_SA(1, 0), cA + kstep, voffA); PG8_STAGE(PG8_SB(1, 1), cB + hstep + kstep, voffB);
        PG8_WAIT_V(6); PG8_BAR;
    } else {
        PG8_STAGE(PG8_SB(0, 0), cB, voffB); PG8_STAGE(PG8_SA(0, 0), cA, voffA); PG8_STAGE(PG8_SB(0, 1), cB + hstep, voffB); PG8_STAGE(PG8_SA(0, 1), cA + hstep, voffA);
        if (wr == 1) PG8_BAR;
        PG8_WAIT_V(4); PG8_BAR;
        PG8_STAGE(PG8_SB(1, 0), cB + kstep, voffB); PG8_STAGE(PG8_SA(1, 0), cA + kstep, voffA); PG8_STAGE(PG8_SB(1, 1), cB + hstep + kstep, voffB);
        PG8_WAIT_V(6); PG8_BAR;
    }
    for (;;) {
        const bool has_next = S.next(ui + 1, nxt);
        const char* nA = has_next ? (const char*)g.A + (size_t)nxt.pm * tstep : cA; const char* nB = has_next ? (const char*)g.Bt + (size_t)nxt.pn * tstep : cB;
        for (int t = 0; t < nt; t += 2) {
            const bool last = (t == nt - 2);
            const char* a1 = cA + (size_t)(t + 1) * kstep;
            const char* a2 = last ? nA : cA + (size_t)(t + 2) * kstep; const char* b2 = last ? nB : cB + (size_t)(t + 2) * kstep;
            const char* a3 = a2 + kstep; const char* b3 = b2 + kstep;
            if (last && has_next) S.a_ready(nxt);
            if constexpr (SP2) {
            PG8_LDB(B0, 0, 0); PG8_LDB(B1, 0, 1); PG8_SCHED; PG8_LDA(At, 0, 0); PG8_STAGE(PG8_SA(1, 1), a1 + hstep, voffA);
            PG8_WAIT_V(8); PG8_WAIT_L(0); PG8_BAR; PG8_MMA(0, 0, At, B0); PG8_MMA(0, 1, At, B1); PG8_BAR; PG8_SCHED;
            PG8_LDA(At, 0, 1); PG8_STAGE(PG8_SB(0, 0), b2, voffB); PG8_STAGE(PG8_SB(0, 1), b2 + hstep, voffB); PG8_STAGE(PG8_SA(0, 0), a2, voffA);
            PG8_WAIT_V(8); PG8_WAIT_L(0); PG8_BAR; PG8_MMA(1, 0, At, B0); PG8_MMA(1, 1, At, B1); PG8_BAR; PG8_SCHED;
            PG8_LDB(B0, 1, 0); PG8_LDB(B1, 1, 1); PG8_SCHED; PG8_LDA(At, 1, 0); PG8_STAGE(PG8_SA(0, 1), a2 + hstep, voffA);
            PG8_WAIT_V(8); PG8_WAIT_L(0); PG8_BAR; PG8_MMA(0, 0, At, B0); PG8_MMA(0, 1, At, B1); PG8_BAR; PG8_SCHED;
            PG8_LDA(At, 1, 1); PG8_STAGE(PG8_SB(1, 0), b3, voffB); PG8_STAGE(PG8_SB(1, 1), b3 + hstep, voffB); PG8_STAGE(PG8_SA(1, 0), a3, voffA);
            PG8_WAIT_V(8); PG8_WAIT_L(0); PG8_BAR; PG8_MMA(1, 0, At, B0); PG8_MMA(1, 1, At, B1); PG8_BAR; PG8_SCHED;
            } else {
            PG8_LDB(B0, 0, 0); PG8_SCHED; PG8_LDA(At, 0, 0); PG8_STAGE(PG8_SA(1, 1), a1 + hstep, voffA);
            PG8_WAIT_L(8); PG8_BAR; PG8_WAIT_L(0); PG8_MMA(0, 0, At, B0); PG8_BAR; PG8_SCHED;
            PG8_LDB(B1, 0, 1); PG8_STAGE(PG8_SB(0, 0), b2, voffB);
            PG8_BAR; PG8_WAIT_L(0); PG8_MMA(0, 1, At, B1); PG8_BAR;
            PG8_LDA(At, 0, 1); PG8_STAGE(PG8_SA(0, 0), a2, voffA);
            PG8_BAR; PG8_WAIT_L(0); PG8_MMA(1, 0, At, B0); PG8_BAR; PG8_SCHED;
            PG8_STAGE(PG8_SB(0, 1), b2 + hstep, voffB);
            PG8_WAIT_V(6); PG8_BAR; PG8_MMA(1, 1, At, B1); PG8_BAR;
            PG8_LDB(B0, 1, 0); PG8_SCHED; PG8_LDA(At, 1, 0); PG8_STAGE(PG8_SA(0, 1), a2 + hstep, voffA);
            PG8_WAIT_L(8); PG8_BAR; PG8_WAIT_L(0); PG8_MMA(0, 0, At, B0); PG8_BAR; PG8_SCHED;
            PG8_LDB(B1, 1, 1); PG8_STAGE(PG8_SB(1, 0), b3, voffB);
            PG8_BAR; PG8_WAIT_L(0); PG8_MMA(0, 1, At, B1); PG8_BAR;
            PG8_LDA(At, 1, 1); PG8_STAGE(PG8_SA(1, 0), a3, voffA);
            PG8_BAR; PG8_WAIT_L(0); PG8_MMA(1, 0, At, B0); PG8_BAR; PG8_SCHED;
            PG8_STAGE(PG8_SB(1, 1), b3 + hstep, voffB);
            PG8_WAIT_V(6); PG8_BAR; PG8_MMA(1, 1, At, B1); PG8_BAR;
            }
        }
        if constexpr (ALIGN_EPI) { if (wr == 0) PG8_BAR; }
        if constexpr (!Epi::AFTER_DRAIN) { E(acc, cur, wr, wc, fr, fq); S.done(cur); }
        if (!has_next) break;
#pragma unroll
        for (int a = 0; a < 2; ++a)
#pragma unroll
            for (int b = 0; b < 2; ++b)
#pragma unroll
                for (int m = 0; m < 4; ++m)
#pragma unroll
                    for (int n = 0; n < 2; ++n) acc[a][b][m][n] = (f32x4){0.f, 0.f, 0.f, 0.f};
        cur = nxt; cA = nA; cB = nB; ++ui;
        if constexpr (ALIGN_EPI) { if (wr == 1) PG8_BAR; }
    }
    PG8_WAIT_V(0);
    if constexpr (!ALIGN_EPI) { if (wr == 0) PG8_BAR; }
    PG8_BAR;
    if constexpr (Epi::AFTER_DRAIN) { E.fused(acc, cur, wr, wc, fr, fq, lds, wid, lane); S.done(cur); }
#undef PG8_SA
#undef PG8_SB
#undef PG8_STAGE
#undef PG8_LDA
#undef PG8_LDB
#undef PG8_MMA
#undef PG8_WAIT_V
#undef PG8_WAIT_L
#undef PG8_BAR
#undef PG8_SCHED
}
}
#define PROBE_PH -1
#define PROBE_SUB 0

#define LAS __attribute__((address_space(3)))
typedef unsigned short bf16_t;
typedef short bf16x8 __attribute__((ext_vector_type(8)));
typedef float f32x4 __attribute__((ext_vector_type(4)));
typedef float f32x16 __attribute__((ext_vector_type(16)));
typedef unsigned u32x4 __attribute__((ext_vector_type(4)));
typedef unsigned u32x2 __attribute__((ext_vector_type(2)));
using pg8::cvt_pk_bf16;

constexpr int NWAVES = 8, NTHREADS = 512;
constexpr int BATCH = 4, SEQ = 4096, DM = 1024, MTOK = BATCH * SEQ, NZ = 3072, FF = 2816, NGU = 2 * FF, NLAYER = 2, INC = 2884;
constexpr float C2 = 0.125f * 1.4426950408889634f;
constexpr float NEGF = -1e30f;
constexpr int LDS_BYTES = 153600;
constexpr int NPHASE = 14;

constexpr size_t MiB = 1u << 20;
constexpr size_t WS_WIN = 0, WS_WOUT = 12 * MiB, WS_WGU = 16 * MiB, WS_WDN = 38 * MiB, WS_ROPE = 49 * MiB, WS_SSQA = 50 * MiB, WS_SSQB = 51 * MiB,
                 WS_MASK = 52 * MiB, WS_VB = 60 * MiB, WS_XB = 68 * MiB, WS_Y = 100 * MiB, WS_Z = 132 * MiB, WS_KB = 228 * MiB, WS_KI = 236 * MiB, WS_CTL = 250 * MiB, WS_END = 251 * MiB;
constexpr size_t CTL_BYTES = 40960;
constexpr int CW_ITEM = 8192;
constexpr int CW_PANEL = 4096;
constexpr int LDS_BAR_OFF = LDS_BYTES - 64;
constexpr size_t WIN_L = (size_t)NZ * DM, WOUT_L = (size_t)DM * DM, WGU_L = (size_t)NGU * DM, WDN_L = (size_t)DM * FF;

__device__ const double INVF[32] = {1, 0.74989420933245587, 0.56234132519034907, 0.42169650342858223, 0.31622776601683794, 0.23713737056616552, 0.17782794100389229, 0.1333521432163324,
    0.10000000000000001, 0.074989420933245579, 0.056234132519034911, 0.042169650342858224, 0.031622776601683791, 0.023713737056616554, 0.017782794100389229, 0.013335214321633241,
    0.01, 0.0074989420933245579, 0.005623413251903491, 0.0042169650342858229, 0.0031622776601683794, 0.0023713737056616554, 0.0017782794100389228, 0.0013335214321633241,
    0.001, 0.00074989420933245586, 0.0005623413251903491, 0.00042169650342858224, 0.00031622776601683794, 0.00023713737056616554, 0.00017782794100389227, 0.0001333521432163324};

#define LDS_WAIT() asm volatile("s_waitcnt lgkmcnt(0)" ::: "memory")
__device__ __forceinline__ float bf2f(unsigned short h) { return __uint_as_float((unsigned)h << 16); }
__device__ __forceinline__ float bflo(unsigned w) { return __uint_as_float(w << 16); }
__device__ __forceinline__ float bfhi(unsigned w) { return __uint_as_float(w & 0xffff0000u); }
#define DPPF(v, ctrl, rm) __int_as_float(__builtin_amdgcn_update_dpp(0, __float_as_int(v), ctrl, rm, 0xf, false))
__device__ __forceinline__ float wave_sum(float v) {
    v += DPPF(v, 0x111, 0xf); v += DPPF(v, 0x112, 0xf); v += DPPF(v, 0x114, 0xf); v += DPPF(v, 0x118, 0xf);
    v += DPPF(v, 0x142, 0xa); v += DPPF(v, 0x143, 0xc);
    return __int_as_float(__builtin_amdgcn_readlane(__float_as_int(v), 63));
}
__device__ __forceinline__ unsigned wave_umax(unsigned v) {
#define DPPU(v, ctrl, rm) (unsigned)__builtin_amdgcn_update_dpp(0, (int)(v), ctrl, rm, 0xf, false)
    v = max(v, DPPU(v, 0x111, 0xf)); v = max(v, DPPU(v, 0x112, 0xf)); v = max(v, DPPU(v, 0x114, 0xf)); v = max(v, DPPU(v, 0x118, 0xf));
    v = max(v, DPPU(v, 0x142, 0xa)); v = max(v, DPPU(v, 0x143, 0xc));
    return (unsigned)__builtin_amdgcn_readlane((int)v, 63);
#undef DPPU
}
__device__ __forceinline__ float swap32(float v, int hi) { auto rr = __builtin_amdgcn_permlane32_swap(__float_as_uint(v), __float_as_uint(v), false, false); return hi ? __uint_as_float(rr[0]) : __uint_as_float(rr[1]); }
__device__ __forceinline__ float row_rs(const float* ssq, int r) {
    const f32x4* p = (const f32x4*)(ssq + (size_t)r * 16); const f32x4 a = p[0], b = p[1], c = p[2], d = p[3];
    const float s = (((a.x + a.y) + (a.z + a.w)) + ((b.x + b.y) + (b.z + b.w))) + (((c.x + c.y) + (c.z + c.w)) + ((d.x + d.y) + (d.z + d.w)));
    return __builtin_amdgcn_rsqf(s * (1.f / 1024.f) + 1e-6f);
}
__device__ __forceinline__ float xor16_add(float v) { auto rr = __builtin_amdgcn_permlane16_swap(__float_as_uint(v), __float_as_uint(v), false, false); return __uint_as_float(rr[0]) + __uint_as_float(rr[1]); }
__device__ __forceinline__ float xor32_add(float v) { auto rr = __builtin_amdgcn_permlane32_swap(__float_as_uint(v), __float_as_uint(v), false, false); return __uint_as_float(rr[0]) + __uint_as_float(rr[1]); }
__device__ __forceinline__ void row_rs8(const float* ssq, int rbase  , int fq, float (&rs)[8]) {
    f32x4 p[8];
#pragma unroll
    for (int i = 0; i < 8; ++i) p[i] = *(const f32x4*)(ssq + (size_t)(rbase + (i >> 2) * 128 + (i & 3) * 16) * 16 + fq * 4);
#pragma unroll
    for (int i = 0; i < 8; ++i) { float s = (p[i].x + p[i].y) + (p[i].z + p[i].w); s = xor16_add(s); s = xor32_add(s); rs[i] = __builtin_amdgcn_rsqf(s * (1.f / 1024.f) + 1e-6f); }
}
__device__ __forceinline__ float sigmoidf_(float x) { return __builtin_amdgcn_rcpf(1.f + __expf(-x)); }

struct EpiZ {
    static constexpr bool PERM = true, AFTER_DRAIN = false;
    bf16_t* Z; bf16_t* Vb; bf16_t* Kb; bf16_t* KIb; const float* ssq; const float* ropec; const float* ropes;
    __device__ __forceinline__ void operator()(const f32x4 (&acc)[2][2][4][2], const pg8::Unit& u, int wr, int wc, int fr, int fq) const {
        const int pn = u.pn; const bool rope_tile = (pn == 5) || (pn == 6) || (pn == 8) || (pn == 11);
        float rs8[8]; row_rs8(ssq, u.pm * 256 + wr * 64 + fr, fq, rs8);
#pragma unroll
        for (int ai = 0; ai < 2; ++ai)
        {
            f32x4 rc[4], rsn[4]; const int ri0 = ((wc * 32 + fq * 8) & 63) >> 1;
            if (rope_tile) {
#pragma unroll
                for (int m = 0; m < 4; ++m) { const int pos_ = (u.pm * 256 + ai * 128 + wr * 64 + m * 16 + fr) & (SEQ - 1); rc[m] = *(const f32x4*)(ropec + pos_ * 32 + ri0); rsn[m] = *(const f32x4*)(ropes + pos_ * 32 + ri0); }
            }
#pragma unroll
            for (int m = 0; m < 4; ++m) {
                const int r = u.pm * 256 + ai * 128 + wr * 64 + m * 16 + fr; const float rs = rs8[ai * 4 + m]; const int pos = r & (SEQ - 1);
#pragma unroll
                for (int bj = 0; bj < 2; ++bj) {
                    const int cl = bj * 128 + wc * 32 + fq * 8;
                    f32x4 v0 = acc[ai][bj][m][0] * rs, v1 = acc[ai][bj][m][1] * rs;
                    if (rope_tile && (pn != 11 || cl < 64)) {
                        const f32x4 c4 = rc[m], s4 = rsn[m];
                        float a, b;
                        a = v0[0]; b = v0[1]; v0[0] = a * c4[0] - b * s4[0]; v0[1] = b * c4[0] + a * s4[0];
                        a = v0[2]; b = v0[3]; v0[2] = a * c4[1] - b * s4[1]; v0[3] = b * c4[1] + a * s4[1];
                        a = v1[0]; b = v1[1]; v1[0] = a * c4[2] - b * s4[2]; v1[1] = b * c4[2] + a * s4[2];
                        a = v1[2]; b = v1[3]; v1[2] = a * c4[3] - b * s4[3]; v1[3] = b * c4[3] + a * s4[3];
                    }
                    u32x4 w; w.x = cvt_pk_bf16(v0[0], v0[1]); w.y = cvt_pk_bf16(v0[2], v0[3]); w.z = cvt_pk_bf16(v1[0], v1[1]); w.w = cvt_pk_bf16(v1[2], v1[3]);
                    const int b = r >> 12;
                    if (pn == 7) {
                        const int hh = cl >> 6, d0 = cl & 63, kt = pos >> 5, k32 = pos & 31, c = k32 >> 4, kk = k32 & 15, vh = (kk >> 2) & 1, e = (kk & 3) + 4 * (kk >> 3);
                        bf16_t* vp = Vb + ((((size_t)((b * 4 + hh) * 128 + kt) * 2 + (d0 >> 5)) * 2 + c) * 32 + (d0 & 31)) * 16 + vh * 8 + e;
                        vp[0 * 16] = (bf16_t)(w.x & 0xffffu); vp[1 * 16] = (bf16_t)(w.x >> 16); vp[2 * 16] = (bf16_t)(w.y & 0xffffu); vp[3 * 16] = (bf16_t)(w.y >> 16);
                        vp[4 * 16] = (bf16_t)(w.z & 0xffffu); vp[5 * 16] = (bf16_t)(w.z >> 16); vp[6 * 16] = (bf16_t)(w.w & 0xffffu); vp[7 * 16] = (bf16_t)(w.w >> 16);
                    } else if (pn == 6) {
                        const int hh = cl >> 6, c = (cl >> 4) & 3, kh = (cl >> 3) & 1;
                        *(u32x4*)(Kb + ((((size_t)((b * 4 + hh) * 128 + (pos >> 5)) * 4 + c) * 32 + (pos & 31)) * 16 + kh * 8)) = w;
                    } else if (pn == 11) {
                        if (cl < 64) *(u32x4*)(KIb + ((((size_t)(b * 256 + (pos >> 4)) * 2 + (cl >> 5)) * 16 + (pos & 15)) * 32 + ((cl >> 3) & 3) * 8)) = w;
                        else if (cl == 64) *(u32x4*)(Z + (size_t)r * NZ + pn * 256 + cl) = w;
                    } else {
                        *(u32x4*)(Z + (size_t)r * NZ + pn * 256 + cl) = w;
                    }
                }
                asm volatile("" ::: "memory");
            }
        }
    }
};
#ifndef RES_LO
#define RES_LO 0
#endif
struct XL2 { bf16_t* a; bf16_t* b; };
__device__ __forceinline__ bf16_t* xl_row(const XL2& x, int r) { return r < 8192 ? x.a + (size_t)r * DM : x.b + (size_t)(r - 8192) * DM; }
__device__ __forceinline__ void split_hilo(const f32x4& v0, const f32x4& v1, u32x4& hi, u32x4& lo) {
    hi.x = cvt_pk_bf16(v0[0], v0[1]); hi.y = cvt_pk_bf16(v0[2], v0[3]); hi.z = cvt_pk_bf16(v1[0], v1[1]); hi.w = cvt_pk_bf16(v1[2], v1[3]);
    lo.x = cvt_pk_bf16(v0[0] - bflo(hi.x), v0[1] - bfhi(hi.x)); lo.y = cvt_pk_bf16(v0[2] - bflo(hi.y), v0[3] - bfhi(hi.y));
    lo.z = cvt_pk_bf16(v1[0] - bflo(hi.z), v1[1] - bfhi(hi.z)); lo.w = cvt_pk_bf16(v1[2] - bflo(hi.w), v1[3] - bfhi(hi.w));
}
__device__ __forceinline__ void join_hilo(const u32x4& hi, const u32x4& lo, f32x4& v0, f32x4& v1) {
    v0[0] = bflo(hi.x) + bflo(lo.x); v0[1] = bfhi(hi.x) + bfhi(lo.x); v0[2] = bflo(hi.y) + bflo(lo.y); v0[3] = bfhi(hi.y) + bfhi(lo.y);
    v1[0] = bflo(hi.z) + bflo(lo.z); v1[1] = bfhi(hi.z) + bfhi(lo.z); v1[2] = bflo(hi.w) + bflo(lo.w); v1[3] = bfhi(hi.w) + bfhi(lo.w);
}
template <bool BASE_F32> struct EpiRes {
    static constexpr bool PERM = true, AFTER_DRAIN = false;
    const float* basef; XL2 xlin; XL2 xlout; bf16_t* xb; float* ssq;
    __device__ __forceinline__ void operator()(const f32x4 (&acc)[2][2][4][2], const pg8::Unit& u, int wr, int wc, int fr, int fq) const {
#pragma unroll
        for (int ai = 0; ai < 2; ++ai)
#pragma unroll
            for (int m = 0; m < 4; ++m) {
                const int r = u.pm * 256 + ai * 128 + wr * 64 + m * 16 + fr; float sq = 0.f;
#pragma unroll
                for (int bj = 0; bj < 2; ++bj) {
                    const int col = u.pn * 256 + bj * 128 + wc * 32 + fq * 8; const size_t off = (size_t)r * DM + col;
                    f32x4 b0, b1;
                    if (BASE_F32) { b0 = __builtin_nontemporal_load((const f32x4*)(basef + off)); b1 = __builtin_nontemporal_load((const f32x4*)(basef + off + 4)); }
                    else { const u32x4 hi_in = *(const u32x4*)(xb + off); u32x4 lo_in = {0u, 0u, 0u, 0u}; if (RES_LO) lo_in = *(const u32x4*)(xl_row(xlin, r) + col); join_hilo(hi_in, lo_in, b0, b1); }
                    const f32x4 v0 = acc[ai][bj][m][0] + b0, v1 = acc[ai][bj][m][1] + b1;
                    u32x4 hi, lo; split_hilo(v0, v1, hi, lo);
                    *(u32x4*)(xb + off) = hi; if (RES_LO) *(u32x4*)(xl_row(xlout, r) + col) = lo;
                    sq += ((v0[0] * v0[0] + v0[1] * v0[1]) + (v0[2] * v0[2] + v0[3] * v0[3])) + ((v1[0] * v1[0] + v1[1] * v1[1]) + (v1[2] * v1[2] + v1[3] * v1[3]));
                }
                sq = xor16_add(sq); sq = xor32_add(sq);
                if (fq == 0) ssq[(size_t)r * 16 + u.pn * 4 + wc] = sq;
                if (m == 3) asm volatile("" ::: "memory");
            }
    }
};
struct EpiFinal {
    static constexpr bool PERM = true, AFTER_DRAIN = true;
    const bf16_t* xb; XL2 xlin; float* out; const float* gfin; float* xbuf; unsigned* cnt;
    __device__ __forceinline__ void fused(f32x4 (&acc)[2][2][4][2], const pg8::Unit& u, int wr, int wc, int fr, int fq, LAS unsigned char* lds, int wid, int lane) const {
        LAS float* P = (LAS float*)lds;
        LAS float* S = (LAS float*)(lds + 4096);
#pragma unroll
        for (int ai = 0; ai < 2; ++ai)
#pragma unroll
            for (int m = 0; m < 4; ++m) {
                const int rl = ai * 128 + wr * 64 + m * 16 + fr; float sq = 0.f;
#pragma unroll
                for (int bj = 0; bj < 2; ++bj) {
                    const size_t off = (size_t)(u.pm * 256 + rl) * DM + u.pn * 256 + bj * 128 + wc * 32 + fq * 8;
                    f32x4 b0, b1; { const u32x4 hi_in = *(const u32x4*)(xb + off); u32x4 lo_in = {0u, 0u, 0u, 0u}; if (RES_LO) lo_in = *(const u32x4*)(xl_row(xlin, u.pm * 256 + rl) + (off - (size_t)(u.pm * 256 + rl) * DM)); join_hilo(hi_in, lo_in, b0, b1); }
                    const f32x4 v0 = acc[ai][bj][m][0] + b0, v1 = acc[ai][bj][m][1] + b1;
                    acc[ai][bj][m][0] = v0; acc[ai][bj][m][1] = v1;
                    sq += ((v0[0] * v0[0] + v0[1] * v0[1]) + (v0[2] * v0[2] + v0[3] * v0[3])) + ((v1[0] * v1[0] + v1[1] * v1[1]) + (v1[2] * v1[2] + v1[3] * v1[3]));
                }
                sq = xor16_add(sq); sq = xor32_add(sq);
                if (fq == 0) P[rl * 4 + wc] = sq;
                if (m == 3) asm volatile("" ::: "memory");
            }
        asm volatile("s_waitcnt lgkmcnt(0)" ::: "memory"); __builtin_amdgcn_s_barrier(); asm volatile("" ::: "memory");
        const int tid = wid * 64 + lane;
        if (tid < 256) {
            const float s = (P[tid * 4 + 0] + P[tid * 4 + 1]) + (P[tid * 4 + 2] + P[tid * 4 + 3]);
            __hip_atomic_store(xbuf + (size_t)(u.pm * 256 + tid) * 4 + u.pn, s, __ATOMIC_RELAXED, __HIP_MEMORY_SCOPE_AGENT);
        }
        asm volatile("s_waitcnt vmcnt(0)" ::: "memory");
        if (lane == 0) __hip_atomic_fetch_add(cnt + 64 * u.pm, 1u, __ATOMIC_RELAXED, __HIP_MEMORY_SCOPE_AGENT);
        if (wid == 0) {
            unsigned spins = 0;
            while ((unsigned)__builtin_amdgcn_readfirstlane(__hip_atomic_load(cnt + 64 * u.pm, __ATOMIC_RELAXED, __HIP_MEMORY_SCOPE_AGENT)) < 32u) { __builtin_amdgcn_s_sleep(2); if (++spins > (1u << 22)) break; }
            __builtin_amdgcn_fence(__ATOMIC_ACQUIRE, "agent");
        }
        asm volatile("s_waitcnt vmcnt(0) lgkmcnt(0)" ::: "memory"); __builtin_amdgcn_s_barrier(); asm volatile("" ::: "memory");
        if (tid < 256) {
            const float* xp = xbuf + (size_t)(u.pm * 256 + tid) * 4;
            const float a = __hip_atomic_load(xp + 0, __ATOMIC_RELAXED, __HIP_MEMORY_SCOPE_AGENT), b = __hip_atomic_load(xp + 1, __ATOMIC_RELAXED, __HIP_MEMORY_SCOPE_AGENT),
                        c = __hip_atomic_load(xp + 2, __ATOMIC_RELAXED, __HIP_MEMORY_SCOPE_AGENT), d = __hip_atomic_load(xp + 3, __ATOMIC_RELAXED, __HIP_MEMORY_SCOPE_AGENT);
            S[tid] = __builtin_amdgcn_rsqf(((a + b) + (c + d)) * (1.f / 1024.f) + 1e-6f);
        }
        asm volatile("s_waitcnt vmcnt(0) lgkmcnt(0)" ::: "memory"); __builtin_amdgcn_s_barrier(); asm volatile("" ::: "memory");
#pragma unroll
        for (int ai = 0; ai < 2; ++ai)
#pragma unroll
            for (int m = 0; m < 4; ++m) {
                const int rl = ai * 128 + wr * 64 + m * 16 + fr; const float rs = S[rl];
#pragma unroll
                for (int bj = 0; bj < 2; ++bj) {
                    const int col = u.pn * 256 + bj * 128 + wc * 32 + fq * 8; const size_t off = (size_t)(u.pm * 256 + rl) * DM + col;
                    *(f32x4*)(out + off) = acc[ai][bj][m][0] * rs * *(const f32x4*)(gfin + col); *(f32x4*)(out + off + 4) = acc[ai][bj][m][1] * rs * *(const f32x4*)(gfin + col + 4);
                }
            }
    }
};
struct EpiGU {
    static constexpr bool PERM = true, AFTER_DRAIN = false;
    bf16_t* H; const float* ssq;
    __device__ __forceinline__ void operator()(const f32x4 (&acc)[2][2][4][2], const pg8::Unit& u, int wr, int wc, int fr, int fq) const {
        float rs8[8]; row_rs8(ssq, u.pm * 256 + wr * 64 + fr, fq, rs8);
#pragma unroll
        for (int ai = 0; ai < 2; ++ai)
#pragma unroll
            for (int m = 0; m < 4; ++m) {
                const int r = u.pm * 256 + ai * 128 + wr * 64 + m * 16 + fr; const float rs = rs8[ai * 4 + m];
                u32x4 w;
#pragma unroll
                for (int n = 0; n < 2; ++n) {
                    const f32x4 g = acc[ai][0][m][n] * rs, up = acc[ai][1][m][n] * rs;
                    const float h0 = g[0] * sigmoidf_(g[0]) * up[0], h1 = g[1] * sigmoidf_(g[1]) * up[1], h2 = g[2] * sigmoidf_(g[2]) * up[2], h3 = g[3] * sigmoidf_(g[3]) * up[3];
                    if (n == 0) { w.x = cvt_pk_bf16(h0, h1); w.y = cvt_pk_bf16(h2, h3); } else { w.z = cvt_pk_bf16(h0, h1); w.w = cvt_pk_bf16(h2, h3); }
                }
                *(u32x4*)(H + (size_t)r * FF + u.pn * 128 + wc * 32 + fq * 8) = w;
            }
    }
};

__device__ __forceinline__ int il64(int p) { return (p & 1) ? (p >> 1) + 32 : (p >> 1); }
__device__ __forceinline__ void conv_item(const float* src, int ld, float cs, const float* gk, int K, bf16_t* WT, int n0, int k0, LAS float* scr, int lane) {
    float v[32];
    const float* sp = src + (size_t)(k0 + (lane >> 5)) * ld;
#pragma unroll
    for (int i = 0; i < 32; ++i) v[i] = __builtin_nontemporal_load(sp + (size_t)(2 * i) * ld);
    if (gk) {
        float g[32];
#pragma unroll
        for (int i = 0; i < 32; ++i) g[i] = gk[k0 + 2 * i + (lane >> 5)];
#pragma unroll
        for (int i = 0; i < 32; ++i) v[i] *= g[i];
    }
#pragma unroll
    for (int i = 0; i < 32; ++i) scr[(2 * i + (lane >> 5)) * 33 + (lane & 31)] = v[i] * cs;
    LDS_WAIT();
    const int c = lane & 7;
#pragma unroll
    for (int j = 0; j < 4; ++j) {
        const int n = (lane >> 3) + 8 * j; const LAS float* s = scr + (8 * c) * 33 + n;
        u32x4 o; o.x = cvt_pk_bf16(s[0 * 33], s[1 * 33]); o.y = cvt_pk_bf16(s[2 * 33], s[3 * 33]); o.z = cvt_pk_bf16(s[4 * 33], s[5 * 33]); o.w = cvt_pk_bf16(s[6 * 33], s[7 * 33]);
        *(u32x4*)(WT + (size_t)(n0 + n) * K + k0 + 8 * c) = o;
    }
    LDS_WAIT();
}

struct Args { const float* in[18]; float* out; unsigned char* ws; int ph_lo, ph_hi; };
typedef const Args __attribute__((address_space(4)))* KArgs;
__device__ __forceinline__ KArgs kargs() { KArgs p = (KArgs)__builtin_amdgcn_kernarg_segment_ptr(); asm volatile("" : "+s"(p)); return p; }

constexpr int CV_I_IN = 16 * 96, CV_I_OUT = 16 * 32, CV_I_GU = 16 * 176, CV_I_DN = 44 * 32, CV_I_L = CV_I_IN + CV_I_OUT + CV_I_GU + CV_I_DN;
__device__ __forceinline__ void convert_weights(KArgs A, unsigned char* ws, LAS unsigned char* lds, int wave, int lane, int it_lo, int it_hi, int gw, int NGW) {
    LAS float* scr = (LAS float*)(lds + wave * 16384);
    constexpr int I_IN = CV_I_IN, I_OUT = CV_I_OUT, I_GU = CV_I_GU, I_L = CV_I_L;
    for (int it = it_lo + gw; it < it_hi; it += NGW) {
        const int l = it / I_L; int r = it % I_L;
        if (r < I_IN) {
            const int kb = r / 96, nb = r % 96, n = nb * 32 + (lane & 31), tile = n >> 8, c = n & 255;
            int src; float cs = 1.f;
            if (tile <= 4) src = n;
            else if (tile == 5) { src = 1280 + (c & ~63) + il64(c & 63); cs = C2; }
            else if (tile == 6) src = 1536 + (c & ~63) + il64(c & 63);
            else if (tile == 7) src = 1792 + c;
            else if (tile == 8) src = 2048 + (c & ~63) + il64(c & 63);
            else if (tile == 9) src = 2372 + c;
            else if (tile == 10) src = 2628 + c;
            else { if (c < 64) src = 2304 + il64(c); else if (c < 68) { src = 2368 + (c - 64); cs = 0.0625f; } else { src = 0; cs = 0.f; } }
            const float* wl = A->in[2] + (size_t)l * DM * INC;
            conv_item(wl + src, INC, cs, A->in[1] + l * DM, DM, (bf16_t*)(ws + WS_WIN) + l * WIN_L, nb * 32, kb * 64, scr, lane);
            continue;
        }
        r -= I_IN;
        if (r < I_OUT) {
            const int kb = r / 32, nb = r % 32;
            conv_item(A->in[12] + (size_t)l * DM * DM + nb * 32 + (lane & 31), DM, 1.f, nullptr, DM, (bf16_t*)(ws + WS_WOUT) + l * WOUT_L, nb * 32, kb * 64, scr, lane);
            continue;
        }
        r -= I_OUT;
        if (r < I_GU) {
            const int kb = r / 176, nb = r % 176, n = nb * 32 + (lane & 31), c = n & 255, col = (n >> 8) * 128 + (c & 127);
            const float* wsrc = (c < 128 ? A->in[14] : A->in[15]) + (size_t)l * DM * FF + col;
            conv_item(wsrc, FF, 1.f, A->in[13] + l * DM, DM, (bf16_t*)(ws + WS_WGU) + l * WGU_L, nb * 32, kb * 64, scr, lane);
            continue;
        }
        r -= I_GU;
        { const int kb = r / 32, nb = r % 32;
          conv_item(A->in[16] + (size_t)l * FF * DM + nb * 32 + (lane & 31), DM, 1.f, nullptr, FF, (bf16_t*)(ws + WS_WDN) + l * WDN_L, nb * 32, kb * 64, scr, lane); }
    }
}
__device__ __forceinline__ void prologue(KArgs A, unsigned char* ws, LAS unsigned char* lds, int tid, int wave, int lane, int bid, int G, int sub) {
    const int gw = bid * NWAVES + wave, NGW = G * NWAVES;
    float* ropec = (float*)(ws + WS_ROPE); float* ropes = ropec + SEQ * 32;
    if (sub == 0 || sub == 2) for (int idx = bid * NTHREADS + tid; idx < SEQ * 32; idx += G * NTHREADS) {
        const int pos = idx >> 5, i = idx & 31;
        const double ang = (double)pos * INVF[i];
        const double nn = rint(ang * 0.15915494309189535);
        const double x = ang - nn * 6.283185307179586477, x2 = x * x;
        double c = 1.0, s = 1.0, tc = 1.0, ts = 1.0;
#pragma unroll
        for (int k = 1; k <= 15; ++k) { tc *= -x2 * (1.0 / (double)((2 * k - 1) * (2 * k))); c += tc; ts *= -x2 * (1.0 / (double)((2 * k) * (2 * k + 1))); s += ts; }
        ropec[idx] = (float)c; ropes[idx] = (float)(s * x);
    }
    const float* x = A->in[0]; bf16_t* XB = (bf16_t*)(ws + WS_XB); float* ssqA = (float*)(ws + WS_SSQA);
    if (sub == 0 || sub == 3) for (int row0 = gw; row0 < MTOK; row0 += 4 * NGW) {
        f32x4 v[4][4];
#pragma unroll
        for (int rr = 0; rr < 4; ++rr) { const int row = min(row0 + rr * NGW, MTOK - 1); const f32x4* xr = (const f32x4*)(x + (size_t)row * DM) + lane;
#pragma unroll
            for (int j = 0; j < 4; ++j) v[rr][j] = __builtin_nontemporal_load(xr + 64 * j); }
#pragma unroll
        for (int rr = 0; rr < 4; ++rr) { const int row = row0 + rr * NGW; if (row < MTOK) { u32x2* d = (u32x2*)(XB + (size_t)row * DM) + lane; float s = 0.f;
#pragma unroll
            for (int j = 0; j < 4; ++j) { const f32x4 t = v[rr][j]; s += (t.x * t.x + t.y * t.y) + (t.z * t.z + t.w * t.w); u32x2 o; o.x = cvt_pk_bf16(t.x, t.y); o.y = cvt_pk_bf16(t.z, t.w); d[64 * j] = o; }
            s = wave_sum(s);
            if (lane < 16) ssqA[(size_t)row * 16 + lane] = lane == 0 ? s : 0.f; } }
    }
    if (sub == 0 || sub == 1) convert_weights(A, ws, lds, wave, lane, 0, CV_I_L - CV_I_DN, gw, NGW);
}

__device__ __forceinline__ int wave_isum(int v) {
    v += __builtin_amdgcn_update_dpp(0, v, 0x111, 0xf, 0xf, false);
    v += __builtin_amdgcn_update_dpp(0, v, 0x112, 0xf, 0xf, false);
    v += __builtin_amdgcn_update_dpp(0, v, 0x114, 0xf, 0xf, false);
    v += __builtin_amdgcn_update_dpp(0, v, 0x118, 0xf, 0xf, false);
    v += __builtin_amdgcn_update_dpp(0, v, 0x142, 0xa, 0xf, false);
    v += __builtin_amdgcn_update_dpp(0, v, 0x143, 0xc, 0xf, false);
    return __builtin_amdgcn_readlane(v, 63);
}
#define CNT4(c0, c1, t, x0, x1, x2, x3) do { unsigned long long m0_, m1_, m2_, m3_, j0_, j1_; \
    asm("v_cmp_le_u32_e64 %[m0], %[tt], %[a0]\n\tv_cmp_le_u32_e64 %[m1], %[tt], %[a1]\n\tv_cmp_le_u32_e64 %[m2], %[tt], %[a2]\n\tv_cmp_le_u32_e64 %[m3], %[tt], %[a3]\n\t" \
        "v_addc_co_u32_e64 %[k0], %[j0], 0, %[k0], %[m0]\n\tv_addc_co_u32_e64 %[k1], %[j1], 0, %[k1], %[m1]\n\t" \
        "v_addc_co_u32_e64 %[k0], %[j0], 0, %[k0], %[m2]\n\tv_addc_co_u32_e64 %[k1], %[j1], 0, %[k1], %[m3]" \
        : [k0] "+v"(c0), [k1] "+v"(c1), [m0] "=&s"(m0_), [m1] "=&s"(m1_), [m2] "=&s"(m2_), [m3] "=&s"(m3_), [j0] "=&s"(j0_), [j1] "=&s"(j1_) \
        : [tt] "s"(t), [a0] "v"(x0), [a1] "v"(x1), [a2] "v"(x2), [a3] "v"(x3)); } while (0)
#define BIT4(w, t, x0, x1, x2, x3) do { unsigned long long m0_, m1_, m2_, m3_, j0_; \
    asm("v_cmp_gt_u32_e64 %[m0], %[a0], %[tt]\n\tv_cmp_gt_u32_e64 %[m1], %[a1], %[tt]\n\tv_cmp_gt_u32_e64 %[m2], %[a2], %[tt]\n\tv_cmp_gt_u32_e64 %[m3], %[a3], %[tt]\n\t" \
        "v_addc_co_u32_e64 %[k0], %[j0], %[k0], %[k0], %[m0]\n\tv_addc_co_u32_e64 %[k0], %[j0], %[k0], %[k0], %[m1]\n\t" \
        "v_addc_co_u32_e64 %[k0], %[j0], %[k0], %[k0], %[m2]\n\tv_addc_co_u32_e64 %[k0], %[j0], %[k0], %[k0], %[m3]" \
        : [k0] "+v"(w), [m0] "=&s"(m0_), [m1] "=&s"(m1_), [m2] "=&s"(m2_), [m3] "=&s"(m3_), [j0] "=&s"(j0_) \
        : [tt] "s"(t), [a0] "v"(x0), [a1] "v"(x1), [a2] "v"(x2), [a3] "v"(x3)); } while (0)
__device__ __forceinline__ int count_ge(const unsigned (&u)[64], unsigned cand, int nblk) {
    int c0 = 0, c1 = 0;
    const unsigned ts = __builtin_amdgcn_readfirstlane(cand);
#pragma unroll
    for (int B = 0; B < 2; ++B) {
        if (B < nblk) {
#pragma unroll
            for (int i = 0; i < 32; i += 4) CNT4(c0, c1, ts, u[B * 32 + i], u[B * 32 + i + 1], u[B * 32 + i + 2], u[B * 32 + i + 3]);
        }
    }
    return wave_isum(c0 + c1);
}
__device__ __forceinline__ float keyval(unsigned k) { return __uint_as_float((k & 0x80000000u) ? (k ^ 0x80000000u) : ~k); }
__device__ __forceinline__ unsigned valkey(float f) { const unsigned b = __float_as_uint(f); return b ^ ((unsigned)((int)b >> 31) | 0x80000000u); }
__device__ __forceinline__ void select_query(const unsigned (&u)[64], unsigned vmax, int q, int b, int lane, unsigned* MASKb) {
    const int n = q + 1, nblk = (n + 2047) >> 11;
    unsigned T = 0u, TG = 0u; int rrem = 0;
    if (n > 256) {
        const unsigned kmax = wave_umax(vmax);
        const unsigned K0 = 0x80000000u;
        bool exact = false, done = false;
        unsigned lo = 0u, hi = 0u; float Llo = 1.f, Lhi = 1.f;
        const float L256 = 8.0028150156f;
        const int cpos = count_ge(u, K0 + 1u, nblk);
        if (cpos == 256) { T = K0 + 1u; exact = true; done = true; }
        else if (cpos > 256) { lo = K0 + 1u; Llo = __log2f((float)cpos) - L256; hi = kmax + 1u; Lhi = L256 + 1.f; }
        else {
            const int c0 = count_ge(u, K0, nblk);
            if (c0 >= 256) { T = K0; exact = (c0 == 256); done = true; }
            else {
                unsigned vmin = 0xffffffffu;
#pragma unroll
                for (int i = 0; i < 64; ++i) vmin = min(vmin, u[i] - 1u);
                lo = ~wave_umax(~vmin) + 1u; Llo = __log2f((float)n) - L256; hi = K0; Lhi = L256 - __log2f(fmaxf((float)c0, 0.5f));
            }
        }
        int it = 0, last = 0;
        while (!done) {
            if (hi - lo <= 1u) { T = lo; exact = false; break; }
            const float vlo = keyval(lo), vhi = keyval(hi);
            const float frac = (it >= 9 && (it & 1)) ? 0.5f : Llo * __builtin_amdgcn_rcpf(Llo + Lhi);
            unsigned mid = valkey(vlo + frac * (vhi - vlo));
            if (mid <= lo) mid = lo + 1u;
            if (mid >= hi) mid = hi - 1u;
            mid = __builtin_amdgcn_readfirstlane(mid);
            const int c = count_ge(u, mid, nblk);
            if (c == 256) { T = mid; exact = true; break; }
            if (c > 256) { lo = mid; Llo = __log2f((float)c) - L256; if (last == 1) Lhi *= 0.5f; last = 1; }
            else { hi = mid; Lhi = L256 - __log2f(fmaxf((float)c, 0.5f)); if (last == 2) Llo *= 0.5f; last = 2; }
            ++it;
        }
        if (exact) TG = T - 1u; else { TG = T; rrem = 256 - count_ge(u, T + 1u, nblk); }
    }
    int tbase = 0;
#pragma unroll
    for (int B = 0; B < 2; ++B) {
        if (B < nblk) {
            unsigned w = 0u; const unsigned tgs = __builtin_amdgcn_readfirstlane(TG);
#pragma unroll
            for (int e = 31; e >= 3; e -= 4) BIT4(w, tgs, u[B * 32 + e], u[B * 32 + e - 1], u[B * 32 + e - 2], u[B * 32 + e - 3]);
            if (rrem > 0) {
                int ec = 0;
#pragma unroll
                for (int e = 0; e < 32; ++e) ec += (u[B * 32 + e] == T) ? 1 : 0;
                int incl = ec;
#pragma unroll
                for (int o = 1; o < 64; o <<= 1) { const int t = __shfl_up(incl, o); if (lane >= o) incl += t; }
                const int total = __builtin_amdgcn_readlane(incl, 63);
                const int quota = rrem - tbase - (incl - ec);
                int taken = 0;
#pragma unroll
                for (int e = 0; e < 32; ++e) { const bool is = (u[B * 32 + e] == T) && (taken < quota); w |= is ? (1u << e) : 0u; taken += is ? 1 : 0; }
                tbase += total;
            }
            if (64 * B + lane <= (q >> 5)) __hip_atomic_store(MASKb + ((size_t)(b * 128 + (q >> 5)) * 128 + 64 * B + lane) * 32 + (q & 31), w, __ATOMIC_RELAXED, __HIP_MEMORY_SCOPE_AGENT);
        }
    }
}
__device__ __forceinline__ void select_phase(const bf16_t* Z, const bf16_t* KIb, unsigned* MASKb, unsigned* itemcnt, LAS unsigned char* lds, int wave_in, int lane_in, int bid, int G, int sub) {
    constexpr int SCS = 2312;
    LAS float* sc = (LAS float*)lds;
    const int nrounds = (1024 + G - 1) / G;
    bf16x8 qf[4][2]; u32x2 wraw;
#define SEL_LOADQ(idx_) do { const int i_ = (idx_) < 1023 ? (idx_) : 1023; const bf16_t* zq_ = Z + ((size_t)(i_ & 3) * SEQ + (i_ >> 2) * 16 + (lane_in & 15)) * NZ; \
        _Pragma("unroll") for (int j = 0; j < 4; ++j) _Pragma("unroll") for (int ks = 0; ks < 2; ++ks) qf[j][ks] = *(const bf16x8*)(zq_ + 2048 + j * 64 + ks * 32 + (lane_in >> 4) * 8); \
        wraw = *(const u32x2*)(zq_ + 2816 + 64); } while (0)
    { const int r0 = nrounds - 1; int i0_ = r0 * G + ((r0 & 1) ? (G - 1 - bid) : bid); SEL_LOADQ(i0_); }
    for (int rd = 0; rd < nrounds; ++rd) {
        const int rr_ = nrounds - 1 - rd, rn_ = rr_ > 0 ? rr_ - 1 : 0;
        const int idx = rr_ * G + ((rr_ & 1) ? (G - 1 - bid) : bid);
        const int idxn = rn_ * G + ((rn_ & 1) ? (G - 1 - bid) : bid);
        if (idx >= 1024) continue;
        const int b = idx & 3, q0 = (idx >> 2) * 16;
        int wave = wave_in, lane = lane_in; asm volatile("" : "+s"(wave), "+v"(lane));
        const int fr = lane & 15, fq = lane >> 4;
        const float w0 = bflo(wraw.x), w1 = bfhi(wraw.x), w2 = bflo(wraw.y), w3 = bfhi(wraw.y);
        const int nkt = (q0 >> 4) + 1, nch = (nkt + 127) >> 7;
        const bf16_t* kib = KIb + (size_t)b * 256 * 1024 + fr * 32 + fq * 8;
        const int qa = q0 + 2 * wave, qb = qa + 1;
        unsigned ua[64], ub[64]; unsigned vmaxa = 0u, vmaxb = 0u;
#pragma unroll
        for (int c = 0; c < 2; ++c) {
            if (c < nch) {
                const int ktlo = 128 * c, kthi = min(nkt, ktlo + 128);
                bf16x8 ka[2][2], kb2[2][2];
#define KI_LOAD(dst, i0) do { _Pragma("unroll") for (int t_ = 0; t_ < 2; ++t_) { int kt_ = ktlo + wave + 8 * ((i0) + t_); kt_ = kt_ < kthi ? kt_ : kthi - 1; \
                dst[t_][0] = *(const bf16x8*)(kib + (size_t)kt_ * 1024); dst[t_][1] = *(const bf16x8*)(kib + (size_t)kt_ * 1024 + 512); } } while (0)
#define KI_COMP(src, i0) do { _Pragma("unroll") for (int t_ = 0; t_ < 2; ++t_) { int kt_ = ktlo + wave + 8 * ((i0) + t_); kt_ = (kt_ < kthi ? kt_ : kthi - 1) - ktlo; \
                f32x4 s4 = {0.f, 0.f, 0.f, 0.f}; \
                _Pragma("unroll") for (int j = 0; j < 4; ++j) { \
                    f32x4 a = __builtin_amdgcn_mfma_f32_16x16x32_bf16(src[t_][0], qf[j][0], (f32x4){0.f, 0.f, 0.f, 0.f}, 0, 0, 0); \
                    a = __builtin_amdgcn_mfma_f32_16x16x32_bf16(src[t_][1], qf[j][1], a, 0, 0, 0); \
                    const float wj = j == 0 ? w0 : j == 1 ? w1 : j == 2 ? w2 : w3; \
                    _Pragma("unroll") for (int i = 0; i < 4; ++i) s4[i] = fmaf(__int_as_float(max(__float_as_int(a[i]), 0)), wj, s4[i]); } \
                *(LAS f32x4*)(sc + fr * SCS + kt_ * 16 + (kt_ >> 1) * 4 + fq * 4) = s4; } } while (0)
                KI_LOAD(ka, 0);
                for (int i0 = 0; ktlo + wave + 8 * i0 < kthi; i0 += 4) { KI_LOAD(kb2, i0 + 2); KI_COMP(ka, i0); KI_LOAD(ka, i0 + 4); KI_COMP(kb2, i0 + 2); }
#undef KI_LOAD
#undef KI_COMP
                __syncthreads();
                if (c + 1 == nch) SEL_LOADQ(idxn);
                const LAS float* srow = sc + (2 * wave) * SCS + 36 * lane;
                const int ema = qa - 2048 * c - 32 * lane, emb = ema + 1;
                const int adma = (int)(ema >= 31 ? 0xffffffffu : ema < 0 ? 0u : ((2u << ema) - 1u)), admb = (int)(emb >= 31 ? 0xffffffffu : emb < 0 ? 0u : ((2u << emb) - 1u));
#pragma unroll
                for (int e4 = 0; e4 < 8; ++e4) {
                    const f32x4 va = *(const LAS f32x4*)(srow + 4 * e4), vb = *(const LAS f32x4*)(srow + SCS + 4 * e4);
#pragma unroll
                    for (int e = 0; e < 4; ++e) {
                        const int ii = c * 32 + e4 * 4 + e;
                        const unsigned ba = __float_as_uint(va[e]), bb = __float_as_uint(vb[e]);
                        ua[ii] = (ba ^ ((unsigned)((int)ba >> 31) | 0x80000000u)) & (unsigned)__builtin_amdgcn_sbfe(adma, e4 * 4 + e, 1);
                        ub[ii] = (bb ^ ((unsigned)((int)bb >> 31) | 0x80000000u)) & (unsigned)__builtin_amdgcn_sbfe(admb, e4 * 4 + e, 1);
                        vmaxa = max(vmaxa, ua[ii]); vmaxb = max(vmaxb, ub[ii]);
                    }
                }
                asm volatile("s_waitcnt lgkmcnt(0)" ::: "memory");
                __syncthreads();
            } else {
#pragma unroll
                for (int e = 0; e < 32; ++e) { ua[c * 32 + e] = 0u; ub[c * 32 + e] = 0u; }
            }
        }
        if (sub != 3) {
            select_query(ua, vmaxa, qa, b, lane, MASKb);
            select_query(ub, vmaxb, qb, b, lane, MASKb);
            asm volatile("s_waitcnt vmcnt(0)" ::: "memory");
            if (lane == 0) __hip_atomic_fetch_add(itemcnt + idx, 1u, __ATOMIC_RELAXED, __HIP_MEMORY_SCOPE_AGENT);
        }
    }
    __syncthreads();
#undef SEL_LOADQ
}

__device__ __forceinline__ void mixer_a(const bf16_t* __restrict__ Z, bf16_t* __restrict__ Y, const float* __restrict__ wc, int gtid, int NGT) {
#pragma unroll 2
    for (int it = gtid; it < MTOK * 32; it += NGT) {
        const int row = it >> 5, c8 = (it & 31) * 8, pos = row & (SEQ - 1);
        const bf16_t* zr = Z + (size_t)row * NZ;
        float acc[8];
#pragma unroll
        for (int i = 0; i < 8; ++i) acc[i] = 0.f;
#pragma unroll
        for (int j = 0; j < 3; ++j) {
            const int d = 2 - j; const float ok = (pos >= d) ? 1.f : 0.f;
            {
                const bf16_t* zz = zr - (size_t)((pos >= d) ? d : 0) * NZ;
                const u32x4 cc = *(const u32x4*)(zz + 256 + c8), hh = *(const u32x4*)(zz + 512 + c8);
                const f32x4 wa = *(const f32x4*)(wc + j * 256 + c8) * ok, wb = *(const f32x4*)(wc + j * 256 + c8 + 4) * ok;
                acc[0] += wa[0] * (bflo(cc.x) * bflo(hh.x)); acc[1] += wa[1] * (bfhi(cc.x) * bfhi(hh.x));
                acc[2] += wa[2] * (bflo(cc.y) * bflo(hh.y)); acc[3] += wa[3] * (bfhi(cc.y) * bfhi(hh.y));
                acc[4] += wb[0] * (bflo(cc.z) * bflo(hh.z)); acc[5] += wb[1] * (bfhi(cc.z) * bfhi(hh.z));
                acc[6] += wb[2] * (bflo(cc.w) * bflo(hh.w)); acc[7] += wb[3] * (bfhi(cc.w) * bfhi(hh.w));
            }
        }
        const u32x4 ab = *(const u32x4*)(zr + c8);
        u32x4 o;
        o.x = cvt_pk_bf16(bflo(ab.x) * acc[0], bfhi(ab.x) * acc[1]); o.y = cvt_pk_bf16(bflo(ab.y) * acc[2], bfhi(ab.y) * acc[3]);
        o.z = cvt_pk_bf16(bflo(ab.z) * acc[4], bfhi(ab.z) * acc[5]); o.w = cvt_pk_bf16(bflo(ab.w) * acc[6], bfhi(ab.w) * acc[7]);
        *(u32x4*)(Y + (size_t)row * DM + c8) = o;
    }
}

__device__ __forceinline__ void mixer_b(const bf16_t* __restrict__ Z, bf16_t* __restrict__ Y, const float* __restrict__ lng, const float* __restrict__ lnb, const float* __restrict__ wsp, const float* __restrict__ bsp,
                                        LAS unsigned char* lds, int wave, int lane, int bid, int G) {
    constexpr int VP = 132;
    LAS bf16_t* vt = (LAS bf16_t*)lds;
    const int fr = lane & 15, fq = lane >> 4;
    for (int un = bid; un < 256; un += G) {
        const int chunk = un >> 1, hf = un & 1; const size_t row0 = (size_t)chunk * 128;
#pragma unroll 8
        for (int k = 0; k < 16; ++k) {
            const int s = wave * 16 + k; const bf16_t* zr = Z + (row0 + s) * NZ + 4 * 256;
            const float v0 = bf2f(zr[lane]), v1 = bf2f(zr[lane + 64]), v2 = bf2f(zr[lane + 128]), v3 = bf2f(zr[lane + 192]);
            const float mean = wave_sum((v0 + v1) + (v2 + v3)) * (1.f / 256.f);
            const float d0 = v0 - mean, d1 = v1 - mean, d2 = v2 - mean, d3 = v3 - mean;
            const float var = wave_sum((d0 * d0 + d1 * d1) + (d2 * d2 + d3 * d3)) * (1.f / 256.f);
            const float rstd = __builtin_amdgcn_rsqf(var + 1e-5f);
            const int ca = hf * 128 + lane, cb = ca + 64;
            const float a = (hf ? d2 : d0) * rstd * lng[ca] + lnb[ca], b = (hf ? d3 : d1) * rstd * lng[cb] + lnb[cb];
            const unsigned pk = cvt_pk_bf16(a, b);
            vt[lane * VP + s] = (bf16_t)(pk & 0xffffu); vt[(lane + 64) * VP + s] = (bf16_t)(pk >> 16);
        }
        __syncthreads();
        const int t = wave * 16 + fr;
#pragma unroll
        for (int hh = 0; hh < 2; ++hh) {
            const int h = hf * 2 + hh; const float* W = wsp + (size_t)h * 128 * 128 + (size_t)t * 128;
            f32x4 acc[4];
#pragma unroll
            for (int nt = 0; nt < 4; ++nt) acc[nt] = (f32x4){0.f, 0.f, 0.f, 0.f};
#pragma unroll
            for (int ks = 0; ks < 4; ++ks) {
                const int s0 = ks * 32 + fq * 8;
                f32x4 wa = *(const f32x4*)(W + s0), wb = *(const f32x4*)(W + s0 + 4);
#pragma unroll
                for (int j = 0; j < 4; ++j) { if (s0 + j > t) wa[j] = 0.f; if (s0 + 4 + j > t) wb[j] = 0.f; }
                u32x4 wp; wp.x = cvt_pk_bf16(wa[0], wa[1]); wp.y = cvt_pk_bf16(wa[2], wa[3]); wp.z = cvt_pk_bf16(wb[0], wb[1]); wp.w = cvt_pk_bf16(wb[2], wb[3]);
                const bf16x8 wf = __builtin_bit_cast(bf16x8, wp);
#pragma unroll
                for (int nt = 0; nt < 4; ++nt) {
                    const LAS bf16_t* vp = vt + (hh * 64 + nt * 16 + fr) * VP + s0;
                    const u32x2 lo = *(const LAS u32x2*)vp, hi2 = *(const LAS u32x2*)(vp + 4);
                    u32x4 vv; vv.x = lo.x; vv.y = lo.y; vv.z = hi2.x; vv.w = hi2.y;
                    acc[nt] = __builtin_amdgcn_mfma_f32_16x16x32_bf16(__builtin_bit_cast(bf16x8, vv), wf, acc[nt], 0, 0, 0);
                }
            }
            const float bias = bsp[h * 128 + t]; const size_t row = row0 + t;
#pragma unroll
            for (int nt = 0; nt < 4; ++nt) {
                const int col = h * 64 + nt * 16 + fq * 4;
                const u32x2 uu = *(const u32x2*)(Z + row * NZ + 3 * 256 + col);
                u32x2 o; o.x = cvt_pk_bf16((acc[nt][0] + bias) * bflo(uu.x), (acc[nt][1] + bias) * bfhi(uu.x)); o.y = cvt_pk_bf16((acc[nt][2] + bias) * bflo(uu.y), (acc[nt][3] + bias) * bfhi(uu.y));
                *(u32x2*)(Y + row * DM + 256 + col) = o;
            }
        }
        __syncthreads();
    }
}

__device__ __forceinline__ void mixer_d(const bf16_t* Z, bf16_t* Y, const float* wcf, const float* bcf, const float* lng, const float* lnb,
                                        LAS unsigned char* lds, int tid, int wave, int lane, int bid, int G) {
    LAS float* yl = (LAS float*)lds;
    LAS float* cv = (LAS float*)(lds + 62 * 256 * 4);
    const int c = tid & 255, half = tid >> 8;
    float w[31];
#pragma unroll
    for (int j = 0; j < 31; ++j) w[j] = wcf[j * 256 + c];
    const float bias = bcf[c];
    const f32x4 g4 = *(const f32x4*)(lng + lane * 4), b4 = *(const f32x4*)(lnb + lane * 4);
    for (int un = bid; un < MTOK / 32; un += G) {
        const int row0 = un * 32, pos0 = row0 & (SEQ - 1);
#pragma unroll
        for (int i4 = 0; i4 < 4; ++i4) {
            const int it0 = tid + i4 * NTHREADS, it = it0 < 62 * 32 ? it0 : 62 * 32 - 1;
            const int rr = it >> 5, c8 = (it & 31) * 8, p = pos0 - 30 + rr;
            f32x4 o0, o1; const float ok = (p >= 0) ? 1.f : 0.f;
            {
                const bf16_t* zr = Z + (size_t)(row0 + ((p >= 0) ? rr - 30 : 0)) * NZ;
                const u32x4 a = *(const u32x4*)(zr + 9 * 256 + c8), gg = *(const u32x4*)(zr + 10 * 256 + c8);
                o0[0] = bflo(a.x) * sigmoidf_(bflo(gg.x)); o0[1] = bfhi(a.x) * sigmoidf_(bfhi(gg.x)); o0[2] = bflo(a.y) * sigmoidf_(bflo(gg.y)); o0[3] = bfhi(a.y) * sigmoidf_(bfhi(gg.y));
                o1[0] = bflo(a.z) * sigmoidf_(bflo(gg.z)); o1[1] = bfhi(a.z) * sigmoidf_(bfhi(gg.z)); o1[2] = bflo(a.w) * sigmoidf_(bflo(gg.w)); o1[3] = bfhi(a.w) * sigmoidf_(bfhi(gg.w));
            }
            *(LAS f32x4*)(yl + rr * 256 + c8) = o0 * ok; *(LAS f32x4*)(yl + rr * 256 + c8 + 4) = o1 * ok;
        }
        __syncthreads();
#pragma unroll
        for (int blk = 0; blk < 2; ++blk) {
            const int tb = half * 16 + blk * 8;
            float acc[8];
#pragma unroll
            for (int o = 0; o < 8; ++o) acc[o] = bias;
#pragma unroll
            for (int jj = 0; jj < 38; ++jj) {
                const float v = yl[(tb + jj) * 256 + c];
#pragma unroll
                for (int o = 0; o < 8; ++o) { const int j = jj - o; if (j >= 0 && j < 31) acc[o] += w[j] * v; }
            }
#pragma unroll
            for (int o = 0; o < 8; ++o) cv[(tb + o) * 256 + c] = acc[o];
        }
        __syncthreads();
#pragma unroll
        for (int k = 0; k < 4; ++k) {
            const int tt = wave * 4 + k;
            const f32x4 v = *(const LAS f32x4*)(cv + tt * 256 + lane * 4);
            const float mean = wave_sum((v[0] + v[1]) + (v[2] + v[3])) * (1.f / 256.f);
            const f32x4 d = v - mean;
            const float var = wave_sum((d[0] * d[0] + d[1] * d[1]) + (d[2] * d[2] + d[3] * d[3])) * (1.f / 256.f);
            const float rstd = __builtin_amdgcn_rsqf(var + 1e-5f);
            const f32x4 y = d * rstd * g4 + b4;
            u32x2 o; o.x = cvt_pk_bf16(y[0] * sigmoidf_(y[0]), y[1] * sigmoidf_(y[1])); o.y = cvt_pk_bf16(y[2] * sigmoidf_(y[2]), y[3] * sigmoidf_(y[3]));
            *(u32x2*)(Y + (size_t)(row0 + tt) * DM + 768 + lane * 4) = o;
        }
        __syncthreads();
    }
}

__device__ __forceinline__ void mixer_bd(const bf16_t* __restrict__ Z, bf16_t* __restrict__ Y, const float* __restrict__ lng, const float* __restrict__ lnb, const float* __restrict__ wsp, const float* __restrict__ bsp,
                                         const float* __restrict__ wcf, const float* __restrict__ bcf, const float* __restrict__ dlng, const float* __restrict__ dlnb,
                                         LAS unsigned char* lds, int tid, int wave, int lane, int bid, int G) {
    constexpr int VP = 132;
    LAS bf16_t* vt = (LAS bf16_t*)lds;
    LAS float* yl = (LAS float*)(lds + 36864);
    LAS float* cv = (LAS float*)(lds + 100352);
    const int fr = lane & 15, fq = lane >> 4;
    const int c = tid & 255, half = tid >> 8;
    float w[31];
#pragma unroll
    for (int j = 0; j < 31; ++j) w[j] = wcf[j * 256 + c];
    const float dbias = bcf[c];
    const f32x4 g4 = *(const f32x4*)(dlng + lane * 4), b4 = *(const f32x4*)(dlnb + lane * 4);
#define MD_GLU(dun) do { const int row0_ = (dun) * 32, pos0_ = row0_ & (SEQ - 1); \
        _Pragma("unroll") for (int i4 = 0; i4 < 4; ++i4) { \
            const int it0 = tid + i4 * NTHREADS, it = it0 < 62 * 32 ? it0 : 62 * 32 - 1; \
            const int rr = it >> 5, c8 = (it & 31) * 8, p = pos0_ - 30 + rr; \
            f32x4 o0, o1; const float ok = (p >= 0) ? 1.f : 0.f; \
            const bf16_t* zr = Z + (size_t)(row0_ + ((p >= 0) ? rr - 30 : 0)) * NZ; \
            const u32x4 a = *(const u32x4*)(zr + 9 * 256 + c8), gg = *(const u32x4*)(zr + 10 * 256 + c8); \
            o0[0] = bflo(a.x) * sigmoidf_(bflo(gg.x)); o0[1] = bfhi(a.x) * sigmoidf_(bfhi(gg.x)); o0[2] = bflo(a.y) * sigmoidf_(bflo(gg.y)); o0[3] = bfhi(a.y) * sigmoidf_(bfhi(gg.y)); \
            o1[0] = bflo(a.z) * sigmoidf_(bflo(gg.z)); o1[1] = bfhi(a.z) * sigmoidf_(bfhi(gg.z)); o1[2] = bflo(a.w) * sigmoidf_(bflo(gg.w)); o1[3] = bfhi(a.w) * sigmoidf_(bfhi(gg.w)); \
            *(LAS f32x4*)(yl + rr * 256 + c8) = o0 * ok; *(LAS f32x4*)(yl + rr * 256 + c8 + 4) = o1 * ok; } } while (0)
#define MD_CONV() do { _Pragma("unroll") for (int blk = 0; blk < 2; ++blk) { const int tb = half * 16 + blk * 8; float acc_[8]; \
            _Pragma("unroll") for (int o = 0; o < 8; ++o) acc_[o] = dbias; \
            _Pragma("unroll") for (int jj = 0; jj < 38; ++jj) { const float v = yl[(tb + jj) * 256 + c]; \
                _Pragma("unroll") for (int o = 0; o < 8; ++o) { const int j = jj - o; if (j >= 0 && j < 31) acc_[o] += w[j] * v; } } \
            _Pragma("unroll") for (int o = 0; o < 8; ++o) cv[(tb + o) * 256 + c] = acc_[o]; } } while (0)
#define MD_LN(dun) do { const int row0_ = (dun) * 32; _Pragma("unroll") for (int k = 0; k < 4; ++k) { const int tt = wave * 4 + k; \
            const f32x4 v = *(const LAS f32x4*)(cv + tt * 256 + lane * 4); \
            const float mean = wave_sum((v[0] + v[1]) + (v[2] + v[3])) * (1.f / 256.f); const f32x4 d = v - mean; \
            const float var = wave_sum((d[0] * d[0] + d[1] * d[1]) + (d[2] * d[2] + d[3] * d[3])) * (1.f / 256.f); const float rstd = __builtin_amdgcn_rsqf(var + 1e-5f); \
            const f32x4 y = d * rstd * g4 + b4; \
            u32x2 o; o.x = cvt_pk_bf16(y[0] * sigmoidf_(y[0]), y[1] * sigmoidf_(y[1])); o.y = cvt_pk_bf16(y[2] * sigmoidf_(y[2]), y[3] * sigmoidf_(y[3])); \
            *(u32x2*)(Y + (size_t)(row0_ + tt) * DM + 768 + lane * 4) = o; } } while (0)
    for (int un = bid; un < 256; un += G) {
        const int chunk = un >> 1, hf = un & 1; const size_t row0 = (size_t)chunk * 128;
        const int t = wave * 16 + fr; const size_t row = row0 + t;
        bf16x8 wf[2][4]; u32x2 uu[2][4]; float bias[2];
#pragma unroll
        for (int hh = 0; hh < 2; ++hh) {
            const int h = hf * 2 + hh; const float* W = wsp + (size_t)h * 128 * 128 + (size_t)t * 128;
            f32x4 wa[4], wb[4];
#pragma unroll
            for (int ks = 0; ks < 4; ++ks) { wa[ks] = *(const f32x4*)(W + ks * 32 + fq * 8); wb[ks] = *(const f32x4*)(W + ks * 32 + fq * 8 + 4); }
#pragma unroll
            for (int nt = 0; nt < 4; ++nt) uu[hh][nt] = *(const u32x2*)(Z + row * NZ + 3 * 256 + h * 64 + nt * 16 + fq * 4);
            bias[hh] = bsp[h * 128 + t];
#pragma unroll
            for (int ks = 0; ks < 4; ++ks) {
                const int s0 = ks * 32 + fq * 8;
#pragma unroll
                for (int j = 0; j < 4; ++j) { if (s0 + j > t) wa[ks][j] = 0.f; if (s0 + 4 + j > t) wb[ks][j] = 0.f; }
                u32x4 wp; wp.x = cvt_pk_bf16(wa[ks][0], wa[ks][1]); wp.y = cvt_pk_bf16(wa[ks][2], wa[ks][3]); wp.z = cvt_pk_bf16(wb[ks][0], wb[ks][1]); wp.w = cvt_pk_bf16(wb[ks][2], wb[ks][3]);
                wf[hh][ks] = __builtin_bit_cast(bf16x8, wp);
            }
        }
#pragma unroll 8
        for (int k = 0; k < 16; ++k) {
            const int s = wave * 16 + k; const bf16_t* zr = Z + (row0 + s) * NZ + 4 * 256;
            const float v0 = bf2f(zr[lane]), v1 = bf2f(zr[lane + 64]), v2 = bf2f(zr[lane + 128]), v3 = bf2f(zr[lane + 192]);
            const float mean = wave_sum((v0 + v1) + (v2 + v3)) * (1.f / 256.f);
            const float d0 = v0 - mean, d1 = v1 - mean, d2 = v2 - mean, d3 = v3 - mean;
            const float var = wave_sum((d0 * d0 + d1 * d1) + (d2 * d2 + d3 * d3)) * (1.f / 256.f);
            const float rstd = __builtin_amdgcn_rsqf(var + 1e-5f);
            const int ca = hf * 128 + lane, cb = ca + 64;
            const float a = (hf ? d2 : d0) * rstd * lng[ca] + lnb[ca], b = (hf ? d3 : d1) * rstd * lng[cb] + lnb[cb];
            const unsigned pk = cvt_pk_bf16(a, b);
            vt[lane * VP + s] = (bf16_t)(pk & 0xffffu); vt[(lane + 64) * VP + s] = (bf16_t)(pk >> 16);
        }
        MD_GLU(2 * un);
        __syncthreads();
#pragma unroll
        for (int hh = 0; hh < 2; ++hh) {
            const int h = hf * 2 + hh;
            f32x4 acc[4];
#pragma unroll
            for (int nt = 0; nt < 4; ++nt) acc[nt] = (f32x4){0.f, 0.f, 0.f, 0.f};
#pragma unroll
            for (int ks = 0; ks < 4; ++ks) {
                const int s0 = ks * 32 + fq * 8;
#pragma unroll
                for (int nt = 0; nt < 4; ++nt) {
                    const LAS bf16_t* vp = vt + (hh * 64 + nt * 16 + fr) * VP + s0;
                    const u32x2 lo = *(const LAS u32x2*)vp, hi2 = *(const LAS u32x2*)(vp + 4);
                    u32x4 vv; vv.x = lo.x; vv.y = lo.y; vv.z = hi2.x; vv.w = hi2.y;
                    acc[nt] = __builtin_amdgcn_mfma_f32_16x16x32_bf16(__builtin_bit_cast(bf16x8, vv), wf[hh][ks], acc[nt], 0, 0, 0);
                }
            }
#pragma unroll
            for (int nt = 0; nt < 4; ++nt) {
                const int col = h * 64 + nt * 16 + fq * 4; const u32x2 u2 = uu[hh][nt]; const float bs_ = bias[hh];
                u32x2 o; o.x = cvt_pk_bf16((acc[nt][0] + bs_) * bflo(u2.x), (acc[nt][1] + bs_) * bfhi(u2.x)); o.y = cvt_pk_bf16((acc[nt][2] + bs_) * bflo(u2.y), (acc[nt][3] + bs_) * bfhi(u2.y));
                *(u32x2*)(Y + row * DM + 256 + col) = o;
            }
        }
        MD_CONV();
        __syncthreads();
        MD_LN(2 * un);
        MD_GLU(2 * un + 1);
        __syncthreads();
        MD_CONV();
        __syncthreads();
        MD_LN(2 * un + 1);
        __syncthreads();
    }
#undef MD_GLU
#undef MD_CONV
#undef MD_LN
}

__device__ __forceinline__ void attn_phase(const bf16_t* Z, const bf16_t* Kb, const bf16_t* Vb, unsigned* MASKb, unsigned* itemcnt, bf16_t* Y, LAS unsigned char* lds, int wave, int lane, int bid, int G) {
    const int h = wave & 3, half = wave >> 2, ql = lane & 31, hi = lane >> 5;
    LAS float* mo = (LAS float*)lds + h * 2048;
    LAS float* mml = (LAS float*)(lds + 32768) + h * 128;
    LAS bf16_t* ost = (LAS bf16_t*)(lds + 36864) + h * (32 * 72);
    const unsigned NEGB = __float_as_uint(NEGF);
    for (int pu = bid; pu < 256; pu += G) {
        const int b = pu & 3, jj = pu >> 2;
        for (int rep = 0; rep < 2; ++rep) {
            const int qb = rep ? jj : 127 - jj;
            const int NT = qb + 1, n0 = (NT + 1) >> 1, tb = half ? n0 : 0, te = half ? NT : n0;
            if (wave == 0) {
                unsigned* c0 = itemcnt + (2 * qb) * 4 + b; unsigned* c1 = c0 + 4; unsigned spins = 0;
                while ((unsigned)__builtin_amdgcn_readfirstlane(__hip_atomic_load(c0, __ATOMIC_RELAXED, __HIP_MEMORY_SCOPE_AGENT)) < 8u ||
                       (unsigned)__builtin_amdgcn_readfirstlane(__hip_atomic_load(c1, __ATOMIC_RELAXED, __HIP_MEMORY_SCOPE_AGENT)) < 8u) { __builtin_amdgcn_s_sleep(4); if (++spins > (1u << 22)) break; }
                __builtin_amdgcn_fence(__ATOMIC_ACQUIRE, "agent");
            }
            __syncthreads();
            const size_t rowq = (size_t)b * SEQ + qb * 32 + ql;
            const bf16_t* zq = Z + rowq * NZ + 1280 + h * 64 + hi * 8;
            bf16x8 qf[4];
#pragma unroll
            for (int c = 0; c < 4; ++c) qf[c] = *(const bf16x8*)(zq + 16 * c);
            unsigned* mrow = MASKb + ((size_t)(b * 128 + qb) * 128) * 32 + ql;
            const bf16_t* kb = Kb + ((size_t)(b * 4 + h) * 128) * 2048 + ql * 16 + hi * 8;
            const bf16_t* vb = Vb + ((size_t)(b * 4 + h) * 128) * 2048 + ql * 16 + hi * 8;
            f32x16 o0, o1;
#pragma unroll
            for (int r = 0; r < 16; ++r) { o0[r] = 0.f; o1[r] = 0.f; }
            float m = NEGF, l = 0.f;
            bf16x8 kA[4], kB[4]; bf16x8 vA[2][2], vB[2][2]; unsigned mA = 0u, mB = 0u;
#define ATT_LOAD(KF, VR, MW, kt_) do { const bf16_t* kp_ = kb + (size_t)(kt_) * 2048; const bf16_t* vp_ = vb + (size_t)(kt_) * 2048; _Pragma("unroll") for (int c = 0; c < 4; ++c) KF[c] = *(const bf16x8*)(kp_ + c * 512); \
        _Pragma("unroll") for (int mt = 0; mt < 2; ++mt) _Pragma("unroll") for (int c = 0; c < 2; ++c) VR[mt][c] = *(const bf16x8*)(vp_ + (mt * 2 + c) * 512); \
        MW = __hip_atomic_load(mrow + (kt_) * 32, __ATOMIC_RELAXED, __HIP_MEMORY_SCOPE_AGENT); } while (0)
#define ATT_COMP(KF, VR, MW) do { \
        f32x16 s; \
        _Pragma("unroll") for (int r = 0; r < 16; ++r) s[r] = 0.f; \
        __builtin_amdgcn_s_setprio(1); \
        _Pragma("unroll") for (int c = 0; c < 4; ++c) s = __builtin_amdgcn_mfma_f32_32x32x16_bf16(KF[c], qf[c], s, 0, 0, 0); \
        __builtin_amdgcn_s_setprio(0); \
        const int mws = (int)(MW >> (4 * hi)); \
        float rm = NEGF; \
        _Pragma("unroll") for (int r = 0; r < 16; ++r) { \
            const unsigned sel = (unsigned)__builtin_amdgcn_sbfe(mws, (r & 3) + 8 * (r >> 2), 1); \
            s[r] = __uint_as_float((__float_as_uint(s[r]) & sel) | (NEGB & ~sel)); \
            rm = fmaxf(rm, s[r]); } \
        rm = fmaxf(rm, swap32(rm, hi)); \
        const float mn = fmaxf(m, rm); \
        if (__any(mn > m)) { \
            const float al = __builtin_amdgcn_exp2f(m - mn); l *= al; \
            _Pragma("unroll") for (int r = 0; r < 16; ++r) { o0[r] *= al; o1[r] *= al; } \
            m = mn; } \
        float ps = 0.f; \
        _Pragma("unroll") for (int r = 0; r < 16; ++r) { s[r] = __builtin_amdgcn_exp2f(s[r] - m); ps += s[r]; } \
        l += ps; \
        u32x4 p0, p1; \
        p0.x = cvt_pk_bf16(s[0], s[1]); p0.y = cvt_pk_bf16(s[2], s[3]); p0.z = cvt_pk_bf16(s[4], s[5]); p0.w = cvt_pk_bf16(s[6], s[7]); \
        p1.x = cvt_pk_bf16(s[8], s[9]); p1.y = cvt_pk_bf16(s[10], s[11]); p1.z = cvt_pk_bf16(s[12], s[13]); p1.w = cvt_pk_bf16(s[14], s[15]); \
        const bf16x8 pf0 = __builtin_bit_cast(bf16x8, p0), pf1 = __builtin_bit_cast(bf16x8, p1); \
        __builtin_amdgcn_s_setprio(1); \
        o0 = __builtin_amdgcn_mfma_f32_32x32x16_bf16(VR[0][0], pf0, o0, 0, 0, 0); o1 = __builtin_amdgcn_mfma_f32_32x32x16_bf16(VR[1][0], pf0, o1, 0, 0, 0); \
        o0 = __builtin_amdgcn_mfma_f32_32x32x16_bf16(VR[0][1], pf1, o0, 0, 0, 0); o1 = __builtin_amdgcn_mfma_f32_32x32x16_bf16(VR[1][1], pf1, o1, 0, 0, 0); \
        __builtin_amdgcn_s_setprio(0); } while (0)
            if (tb < te) ATT_LOAD(kA, vA, mA, tb);
            for (int kt = tb; kt < te; kt += 2) {
                { const int k1 = (kt + 1 < te) ? kt + 1 : kt; ATT_LOAD(kB, vB, mB, k1); }
                ATT_COMP(kA, vA, mA);
                { const int k2 = (kt + 2 < te) ? kt + 2 : te - 1; ATT_LOAD(kA, vA, mA, k2); }
                if (kt + 1 < te) ATT_COMP(kB, vB, mB);
            }
#undef ATT_COMP
#undef ATT_LOAD
            const float lt = l + swap32(l, hi);
            if (half == 1) {
#pragma unroll
                for (int r = 0; r < 16; ++r) { mo[r * 64 + lane] = o0[r]; mo[(16 + r) * 64 + lane] = o1[r]; }
                mml[lane] = m; mml[64 + lane] = lt;
            }
            __syncthreads();
            if (half == 0) {
                const float m1 = mml[lane], l1 = mml[64 + lane];
                const float mn = fmaxf(m, m1), a0 = __builtin_amdgcn_exp2f(m - mn), a1 = __builtin_amdgcn_exp2f(m1 - mn);
                const float inv = __builtin_amdgcn_rcpf(lt * a0 + l1 * a1), f0 = a0 * inv, f1 = a1 * inv;
#pragma unroll
                for (int r = 0; r < 16; ++r) { o0[r] = o0[r] * f0 + mo[r * 64 + lane] * f1; o1[r] = o1[r] * f0 + mo[(16 + r) * 64 + lane] * f1; }
#pragma unroll
                for (int r = 0; r < 16; r += 2) {
                    const int d = (r & 3) + 8 * (r >> 2) + 4 * hi;
                    *(LAS unsigned*)(ost + ql * 72 + d) = cvt_pk_bf16(o0[r], o0[r + 1]);
                    *(LAS unsigned*)(ost + ql * 72 + 32 + d) = cvt_pk_bf16(o1[r], o1[r + 1]);
                }
                LDS_WAIT();
                bf16_t* yo = Y + ((size_t)b * SEQ + qb * 32 + (lane >> 1)) * DM + 512 + h * 64 + (lane & 1) * 32;
#pragma unroll
                for (int k = 0; k < 4; ++k) { const u32x4 v = *(const LAS u32x4*)(ost + (lane >> 1) * 72 + (lane & 1) * 32 + k * 8); *(u32x4*)(yo + k * 8) = v; }
            }
            __syncthreads();
        }
    }
}

#define RLX_AGENT __ATOMIC_RELAXED, __HIP_MEMORY_SCOPE_AGENT
#define XB_TMO      128
#define XB_XCNT(j)  (256  + 64 * (j))
#define XB_XSUB(j)  (1280 + 64 * (j))
#define XB_XGEN(j)  (2304 + 64 * (j))
#define XB_TOP      3328
#define XB_TOPGEN   3392
#define XCD_BAR_WORDS 3456
#define XB_SPIN_CAP (1u << 18)

__device__ __forceinline__ unsigned xb_ld(unsigned* p)              { return __hip_atomic_load(p, __ATOMIC_RELAXED, __HIP_MEMORY_SCOPE_AGENT); }
__device__ __forceinline__ unsigned xb_add(unsigned* p, unsigned v) { return __hip_atomic_fetch_add(p, v, __ATOMIC_RELAXED, __HIP_MEMORY_SCOPE_AGENT); }
__device__ __forceinline__ unsigned xb_xcc_id() { return (unsigned)__builtin_amdgcn_s_getreg((3 << 11) | 20) & 0xFu; }
#define XB_SPIN(cond, bar) do { unsigned _sp = 0; while (cond) { __builtin_amdgcn_s_sleep(1); \
    if ((++_sp & 255u) == 0u) { if (xb_ld(&(bar)[XB_TMO])) break; if (_sp > XB_SPIN_CAP) { atomicAdd(&(bar)[XB_TMO], 1u); break; } } } } while (0)

struct XcdBarrier {
    unsigned* bar; unsigned x;
    volatile LAS unsigned* st;
};

__device__ __forceinline__ XcdBarrier xcd_barrier_post(unsigned* bar, volatile LAS unsigned* st, int tid) {
    XcdBarrier b; b.bar = bar; b.x = xb_xcc_id(); b.st = st;
    if (tid == 0) (void)xb_add(&bar[XB_XCNT(b.x)], 1u);
    return b;
}
__device__ __forceinline__ void xcd_barrier_complete(unsigned* bar, unsigned x, unsigned& nloc, unsigned& nx) {
    const unsigned G = gridDim.x * gridDim.y * gridDim.z;
    unsigned sum, cnt, mine, sp = 0u;
    for (;;) {
        sum = 0u; cnt = 0u; mine = 0u;
#pragma unroll
        for (unsigned j = 0; j < 16; ++j) { const unsigned c = xb_ld(&bar[XB_XCNT(j)]); sum += c; cnt += (c > 0u) ? 1u : 0u; mine = (j == x) ? c : mine; }
        if (sum == G) break;
        __builtin_amdgcn_s_sleep(1);
        if ((++sp & 255u) == 0u) { if (xb_ld(&bar[XB_TMO])) break; if (sp > XB_SPIN_CAP) { atomicAdd(&bar[XB_TMO], 1u); break; } }
    }
    nloc = mine > 0u ? mine : 1u; nx = cnt > 0u ? cnt : 1u;
}

__device__ __forceinline__ void xcd_barrier(const XcdBarrier& b, int tid) {
    asm volatile("s_waitcnt vmcnt(0)" ::: "memory");
    __syncthreads();
    if (tid == 0) {
        unsigned* bar = b.bar;
        __builtin_amdgcn_s_waitcnt(0);
        unsigned nloc = b.st[0], nx = b.st[1];
        if (nloc == 0u) { xcd_barrier_complete(bar, b.x, nloc, nx); b.st[0] = nloc; b.st[1] = nx; }
        const unsigned old = xb_add(&bar[XB_XSUB(b.x)], 1u);
        const unsigned gen = old / nloc;
        if (old + 1u == (gen + 1u) * nloc) {
            __builtin_amdgcn_fence(__ATOMIC_RELEASE, "agent");
            asm volatile("s_waitcnt vmcnt(0)" ::: "memory");
            const unsigned og = xb_add(&bar[XB_TOP], 1u);
            const unsigned tg = og / nx, target = (tg + 1u) * nx;
            if (og + 1u != target) XB_SPIN(xb_ld(&bar[XB_TOP]) < target, bar);
            __builtin_amdgcn_fence(__ATOMIC_ACQUIRE, "agent");
            xb_add(&bar[XB_XGEN(b.x)], 1u);
            asm volatile("s_waitcnt vmcnt(0)" ::: "memory");
        } else {
            XB_SPIN(xb_ld(&bar[XB_XGEN(b.x)]) == gen, bar);
            __builtin_amdgcn_fence(__ATOMIC_ACQUIRE, "agent");
            asm volatile("s_waitcnt vmcnt(0)" ::: "memory");
        }
    }
    __syncthreads();
}

#ifndef PROBE_PH
#define PROBE_PH -1
#endif
#ifndef PROBE_SUB
#define PROBE_SUB 0
#endif
__global__ void __launch_bounds__(NTHREADS, 2) mega_fwd(Args A_unused) {
    extern __shared__ __attribute__((aligned(16))) unsigned char lds_raw[];
    LAS unsigned char* lds = (LAS unsigned char*)lds_raw;
    cg::grid_group grid = cg::this_grid();
    const int ph_lo = kargs()->ph_lo, ph_hi = kargs()->ph_hi;
    const int wave0 = __builtin_amdgcn_readfirstlane((int)(threadIdx.x >> 6));
    if (threadIdx.x < 16) ((volatile LAS unsigned*)(lds + LDS_BAR_OFF))[threadIdx.x] = 0u;
    __syncthreads();
    if (ph_hi - ph_lo > 1) { (void)xcd_barrier_post((unsigned*)(kargs()->ws + WS_CTL), (volatile LAS unsigned*)(lds + LDS_BAR_OFF), (int)threadIdx.x); }
    const int st_hi = (PROBE_PH >= 0) ? ph_hi + 1 : ph_hi;
    for (int st = ph_lo; st < st_hi; ++st) {
        const int ph = (PROBE_PH >= 0 && st > PROBE_PH) ? st - 1 : st;
        const int sub = (PROBE_PH >= 0 && st == PROBE_PH + 1) ? PROBE_SUB : 0;
        KArgs A = kargs();
        int G = gridDim.x; asm volatile("" : "+s"(G));
        unsigned char* ws = A->ws;
        bf16_t* XB = (bf16_t*)(ws + WS_XB); bf16_t* Yb = (bf16_t*)(ws + WS_Y); bf16_t* Zb = (bf16_t*)(ws + WS_Z); bf16_t* HID = Zb; bf16_t* Vb = (bf16_t*)(ws + WS_VB); bf16_t* Kb = (bf16_t*)(ws + WS_KB); bf16_t* KIb = (bf16_t*)(ws + WS_KI);
        float* ssqA = (float*)(ws + WS_SSQA); float* ssqB = (float*)(ws + WS_SSQB);
        float* ropec = (float*)(ws + WS_ROPE); float* ropes = ropec + SEQ * 32;
        unsigned* MASKb = (unsigned*)(ws + WS_MASK);
        int bid = blockIdx.x, wave = wave0; asm volatile("" : "+s"(bid), "+s"(wave));
        int lane = (int)__builtin_amdgcn_mbcnt_hi(~0u, __builtin_amdgcn_mbcnt_lo(~0u, 0u)); asm volatile("" : "+v"(lane));
        const int tid = wave * 64 + lane;
        if (ph == 0) {
#ifndef NO_PRO
            prologue(A, ws, lds, tid, wave, lane, bid, G, sub);
#endif
        } else if (ph == NPHASE - 1) {
            const float* gfin = A->in[17];
            if (G != 256) for (int row = bid * NWAVES + wave; row < MTOK; row += G * NWAVES) {
                const XL2 XLS{(bf16_t*)(ws + WS_MASK), (bf16_t*)(ws + WS_KB)};
                const float rs = row_rs(ssqA, row); f32x4* p = (f32x4*)(A->out + (size_t)row * DM) + lane; const f32x4* g = (const f32x4*)gfin + lane;
                const u32x2* ph_ = (const u32x2*)(XB + (size_t)row * DM) + lane; const u32x2* pl_ = (const u32x2*)xl_row(XLS, row) + lane;
#pragma unroll
                for (int j = 0; j < 4; ++j) { const u32x2 h2 = ph_[64 * j]; u32x2 l2 = {0u, 0u}; if (RES_LO) l2 = pl_[64 * j]; f32x4 v; v[0] = bflo(h2.x) + bflo(l2.x); v[1] = bfhi(h2.x) + bfhi(l2.x); v[2] = bflo(h2.y) + bflo(l2.y); v[3] = bfhi(h2.y) + bfhi(l2.y); p[64 * j] = v * rs * g[64 * j]; }
            }
        } else {
            const int l = (ph - 1) / 6, k = (ph - 1) % 6;
            if (k == 0) {
                pg8::Gemm g{XB, (bf16_t*)(ws + WS_WIN) + l * WIN_L, MTOK, NZ, DM}; pg8::StaticOrder S; S.init(MTOK, NZ, G, bid);
                EpiZ E{Zb, Vb, Kb, KIb, ssqA, ropec, ropes};
#ifndef NO_G0
                pg8::gemm_phase<EpiZ, pg8::StaticOrder, true, true>(lds, g, S, E, tid);
#endif
            } else if (k == 1) {
#ifndef NO_SEL
                if (sub != 2 && sub < 6) select_phase(Zb, KIb, MASKb, (unsigned*)(ws + WS_CTL) + CW_ITEM + l * 1024, lds, wave, lane, bid, G, sub);
#endif
#ifndef NO_MA
                if (sub == 0 || sub == 2 || sub == 8) mixer_a(Zb, Yb, A->in[3] + l * 3 * 256, bid * NTHREADS + tid, G * NTHREADS);
#endif
#ifndef NO_MB
                if (sub == 0 || sub == 2 || sub == 6 || sub == 7) mixer_bd(Zb, Yb, A->in[4] + l * 256, A->in[5] + l * 256, A->in[6] + (size_t)l * 4 * 128 * 128, A->in[7] + l * 4 * 128,
                                                                      A->in[8] + l * 31 * 256, A->in[9] + l * 256, A->in[10] + l * 256, A->in[11] + l * 256, lds, tid, wave, lane, bid, G);
#endif
            } else if (k == 2) {
#ifndef NO_ATT
                attn_phase(Zb, Kb, Vb, MASKb, (unsigned*)(ws + WS_CTL) + CW_ITEM + l * 1024, Yb, lds, wave, lane, bid, G);
#endif
            } else if (k == 3 || k == 5) {
                const XL2 XLD{(bf16_t*)A->out, (bf16_t*)A->out + (size_t)8192 * DM}, XLS{(bf16_t*)(ws + WS_MASK), (bf16_t*)(ws + WS_KB)};
                const bool last = (l == NLAYER - 1);
                pg8::Gemm g{k == 3 ? Yb : HID, k == 3 ? (bf16_t*)(ws + WS_WOUT) + l * WOUT_L : (bf16_t*)(ws + WS_WDN) + l * WDN_L, MTOK, DM, k == 3 ? DM : FF}; pg8::StaticOrder S; S.init(MTOK, DM, G, bid);
                if (k == 3 && l == 0) {
                    EpiRes<true> E{A->in[0], XLD, last ? XLS : XLD, XB, ssqB};
                    pg8::gemm_phase<EpiRes<true>, pg8::StaticOrder, true, true>(lds, g, S, E, tid);
                } else if (k == 5 && last && G == 256) {
                    EpiFinal E{XB, XLS, A->out, A->in[17], ssqB, (unsigned*)(ws + WS_CTL) + CW_PANEL};
                    pg8::gemm_phase<EpiFinal, pg8::StaticOrder, false, true>(lds, g, S, E, tid);
                } else {
                    EpiRes<false> E{nullptr, (k == 5 && last) ? XLS : XLD, last ? XLS : XLD, XB, k == 3 ? ssqB : ssqA};
                    pg8::gemm_phase<EpiRes<false>, pg8::StaticOrder, true, true>(lds, g, S, E, tid);
                }
            } else if (k == 4) {
                pg8::Gemm g{XB, (bf16_t*)(ws + WS_WGU) + l * WGU_L, MTOK, NGU, DM}; pg8::StaticOrder S; S.init(MTOK, NGU, G, bid);
                EpiGU E{HID, ssqB};
#ifndef NO_G2
                pg8::gemm_phase<EpiGU, pg8::StaticOrder, true, true>(lds, g, S, E, tid);
#endif
                if (l == 0) {
                    const int nwg = (MTOK / 256) * (NGU / 256), rem = nwg % G;
                    if (rem == 0) convert_weights(A, ws, lds, wave, lane, CV_I_L - CV_I_DN, NLAYER * CV_I_L, bid * NWAVES + wave, G * NWAVES);
                    else if (bid >= rem) convert_weights(A, ws, lds, wave, lane, CV_I_L - CV_I_DN, NLAYER * CV_I_L, (bid - rem) * NWAVES + wave, (G - rem) * NWAVES);
                }
            }
        }
        const bool flag_seam = (PROBE_PH < 0) && ph >= 1 && ph <= 12 && ((ph - 1) % 6) == 1;
        if (st + 1 < st_hi && !flag_seam) {
            if (ph_hi > 100000) grid.sync();
            XcdBarrier xb; xb.bar = (unsigned*)(ws + WS_CTL); xb.x = xb_xcc_id(); xb.st = (volatile LAS unsigned*)(lds + LDS_BAR_OFF);
            xcd_barrier(xb, tid);
        }
    }
}

#ifndef MK_COOP
#define MK_COOP 1
#endif
extern "C" void kernel_launch(void* const* d_in, const int* in_sizes, int n_in, void* d_out, int out_size, void* d_ws, size_t ws_size, hipStream_t stream) {
    static int grid = 0;
    if (grid == 0) {
        if (n_in != 18 || out_size != MTOK * DM || ws_size < WS_END) { fprintf(stderr, "kernel_launch: unexpected shapes (n_in %d out %d ws %zu)\n", n_in, out_size, ws_size); grid = -1; return; }
        int dev = 0, cus = 0, per_cu = 0;
        if (hipGetDevice(&dev) != hipSuccess || hipDeviceGetAttribute(&cus, hipDeviceAttributeMultiprocessorCount, dev) != hipSuccess) { grid = -1; return; }
        if (hipFuncSetAttribute((const void*)mega_fwd, hipFuncAttributeMaxDynamicSharedMemorySize, LDS_BYTES) != hipSuccess) { fprintf(stderr, "kernel_launch: hipFuncSetAttribute failed\n"); grid = -1; return; }
        if (hipOccupancyMaxActiveBlocksPerMultiprocessor(&per_cu, (const void*)mega_fwd, NTHREADS, LDS_BYTES) != hipSuccess || per_cu < 1) { fprintf(stderr, "kernel_launch: occupancy query says %d\n", per_cu); (void)hipGetLastError(); }
        grid = cus;
    }
    if (grid < 0) return;
    if (hipMemsetAsync((char*)d_ws + WS_CTL, 0, CTL_BYTES, stream) != hipSuccess) { fprintf(stderr, "kernel_launch: memset failed\n"); return; }
    Args a{};
    for (int i = 0; i < 18; ++i) a.in[i] = (const float*)d_in[i];
    a.out = (float*)d_out; a.ws = (unsigned char*)d_ws;
#if MK_COOP
    a.ph_lo = 0; a.ph_hi = (grid == 256) ? NPHASE - 1 : NPHASE;
    void* args[] = {&a};
    hipError_t e = hipLaunchCooperativeKernel((const void*)mega_fwd, dim3(grid), dim3(NTHREADS), args, LDS_BYTES, stream);
    if (e != hipSuccess) fprintf(stderr, "cooperative launch failed: %s (grid %d)\n", hipGetErrorString(e), grid);
#else
    for (int ph = 0; ph < NPHASE; ++ph) {
        a.ph_lo = ph; a.ph_hi = ph + 1;
        hipLaunchKernelGGL(mega_fwd, dim3(grid), dim3(NTHREADS), LDS_BYTES, stream, a);
    }
#endif
}
```

```cpp
#include <hip/hip_runtime.h>
#include <hip/hip_cooperative_groups.h>
#include <cstdio>
#include <cstdint>
namespace cg = cooperative_groups;
namespace pg8 {
#define PG8_LAS __attribute__((address_space(3)))
typedef unsigned short bf16_t;
typedef short bf16x8 __attribute__((ext_vector_type(8)));
typedef float f32x4 __attribute__((ext_vector_type(4)));
typedef unsigned u32x4 __attribute__((ext_vector_type(4)));
constexpr int BM = 256, BK = 64, HALF = 128, HTB = HALF * BK * 2  , STAGE_BYTES = 8 * HTB, NXCD = 8, WGM = 8;

__host__ __device__ __forceinline__ int lds_byte(int r, int c) { const int st = (r >> 4) * 2 + (c >> 5), rr = r & 15, cc = c & 31, ob = rr * 64 + cc * 2; return st * 1024 + (ob ^ (((ob >> 9) & 1) << 5)); }
__host__ __device__ __forceinline__ void stage_rc(int b, int& R, int& C) { const int st = b / 1024, sb = b % 1024, swz = sb ^ (((sb >> 9) & 1) << 5); R = (st >> 1) * 16 + swz / 64; C = (st & 1) * 32 + (swz % 64) / 2; }
__host__ __device__ __forceinline__ int perm32(int rho) { const int n = rho >> 4, i = rho & 15; return 8 * (i >> 2) + 4 * n + (i & 3); }

struct Unit { int pm, pn; };
struct Gemm { const bf16_t* A; const bf16_t* Bt; int M, N, K; };

struct StaticOrder {
    int nM, nN, nwg, G, c;
    __host__ __device__ void init(int M, int N, int G_, int c_) { nM = M / BM; nN = N / BM; nwg = nM * nN; G = G_; c = c_; }
    __host__ __device__ bool next(int i, Unit& u) const {
        const long L = (long)i * G + c; if (L >= nwg) return false;
        int wgid = (int)L; { const int q = nwg / NXCD, r = nwg % NXCD, xcd = wgid % NXCD, off = wgid / NXCD; wgid = (xcd < r ? xcd * (q + 1) : r * (q + 1) + (xcd - r) * q) + off; }
        const int nig = WGM * nN, gid = wgid / nig, fm = gid * WGM, gsz = (nM - fm) < WGM ? (nM - fm) : WGM;
        u.pm = fm + ((wgid % nig) % gsz); u.pn = (wgid % nig) / gsz; return true;
    }
    __device__ __forceinline__ void a_ready(const Unit&) const {}
    __device__ __forceinline__ void done(const Unit&) const {}
};

__device__ __forceinline__ unsigned cvt_pk_bf16(float lo, float hi) { unsigned r; asm volatile("v_cvt_pk_bf16_f32 %0, %1, %2" : "=v"(r) : "v"(lo), "v"(hi)); return r; }
template <class Epi, class Sched, bool ALIGN_EPI = false, bool SP2 = false>
__device__ __forceinline__ void gemm_phase(PG8_LAS unsigned char* lds, const Gemm g, const Sched& S, const Epi& E, int tid_in) {
    int tid_l = tid_in; asm volatile("" : "+v"(tid_l));
    const int tid = tid_l, wid = __builtin_amdgcn_readfirstlane(tid >> 6), lane = tid & 63, wr = wid >> 2, wc = wid & 3, fr = lane & 15, fq = lane >> 4;
    const int K = g.K, nt = K / BK;
    unsigned voffA[2], voffB[2];
#pragma unroll
    for (int i = 0; i < 2; ++i) { int R, C; stage_rc(tid * 16 + i * 8192, R, C); const int Rb = Epi::PERM ? ((R & ~31) + perm32(R & 31)) : R;
        voffA[i] = (unsigned)(R * K + C) * 2u; voffB[i] = (unsigned)(Rb * K + C) * 2u; }
    const size_t kstep = (size_t)(BK * 2);
    const size_t hstep = (size_t)HALF * K * 2;
    const size_t tstep = 2 * hstep;
    const unsigned ldsw = (unsigned)wid * 1024u;
    const int aoff = lds_byte(wr * 64 + fr, fq * 8), boff = lds_byte(wc * 32 + fr, fq * 8);
#define PG8_SA(b, h) (((b) * 2 + (h)) * HTB)
#define PG8_SB(b, h) ((4 + (b) * 2 + (h)) * HTB)
#define PG8_STAGE(bufoff, gbase, voff) do { _Pragma("unroll") for (int _i = 0; _i < 2; ++_i) \
        __builtin_amdgcn_global_load_lds((const unsigned*)((const char*)(gbase) + (voff)[_i]), (PG8_LAS unsigned*)(lds + (bufoff) + ldsw + _i * 8192), 16, 0, 0); } while (0)
#define PG8_LDA(dst, b, h) do { _Pragma("unroll") for (int m = 0; m < 4; ++m) _Pragma("unroll") for (int k = 0; k < 2; ++k) dst[m][k] = *(const PG8_LAS bf16x8*)(lds + PG8_SA(b, h) + aoff + m * 2048 + k * 1024); } while (0)
#define PG8_LDB(dst, b, h) do { _Pragma("unroll") for (int n = 0; n < 2; ++n) _Pragma("unroll") for (int k = 0; k < 2; ++k) dst[n][k] = *(const PG8_LAS bf16x8*)(lds + PG8_SB(b, h) + boff + n * 2048 + k * 1024); } while (0)
#define PG8_MMA(ai, bj, At, Bt) do { __builtin_amdgcn_s_setprio(1); _Pragma("unroll") for (int m = 0; m < 4; ++m) _Pragma("unroll") for (int n = 0; n < 2; ++n) _Pragma("unroll") for (int k = 0; k < 2; ++k) \
        acc[ai][bj][m][n] = __builtin_amdgcn_mfma_f32_16x16x32_bf16(Bt[n][k], At[m][k], acc[ai][bj][m][n], 0, 0, 0); __builtin_amdgcn_s_setprio(0); } while (0)
#define PG8_WAIT_V(n) asm volatile("s_waitcnt vmcnt(" #n ")" ::: "memory")
#define PG8_WAIT_L(n) asm volatile("s_waitcnt lgkmcnt(" #n ")" ::: "memory")
#define PG8_BAR __builtin_amdgcn_s_barrier()
#define PG8_SCHED __builtin_amdgcn_sched_barrier(0)
    Unit cur, nxt; int ui = 0;
    if (!S.next(0, cur)) return;
    f32x4 acc[2][2][4][2];
#pragma unroll
    for (int a = 0; a < 2; ++a)
#pragma unroll
        for (int b = 0; b < 2; ++b)
#pragma unroll
            for (int m = 0; m < 4; ++m)
#pragma unroll
                for (int n = 0; n < 2; ++n) acc[a][b][m][n] = (f32x4){0.f, 0.f, 0.f, 0.f};
    bf16x8 At[4][2], B0[2][2], B1[2][2];
    const char* cA = (const char*)g.A + (size_t)cur.pm * tstep; const char* cB = (const char*)g.Bt + (size_t)cur.pn * tstep;
    S.a_ready(cur);
    if constexpr (SP2) {
        PG8_STAGE(PG8_SB(0, 0), cB, voffB); PG8_STAGE(PG8_SB(0, 1), cB + hstep, voffB); PG8_STAGE(PG8_SA(0, 0), cA, voffA); PG8_STAGE(PG8_SA(0, 1), cA + hstep, voffA);
        if (wr == 1) PG8_BAR;
        PG8_WAIT_V(2); PG8_BAR;
        PG8_STAGE(PG8_SB(1, 0), cB + kstep, voffB); PG8_STAGE(PG8_SA(1, 0), cA + kstep, voffA); PG8_STAGE(PG8_SB(1, 1), cB + hstep + kstep, voffB);
        PG8_WAIT_V(6); PG8_BAR;
    } else {
        PG8_STAGE(PG8_SB(0, 0), cB, voffB); PG8_STAGE(PG8_SA(0, 0), cA, voffA); PG8_STAGE(PG8_SB(0, 1), cB + hstep, voffB); PG8_STAGE(PG8_SA(0, 1), cA + hstep, voffA);
        if (wr == 1) PG8_BAR;
        PG8_WAIT_V(4); PG8_BAR;
        PG8_STAGE(PG8_SB(1, 0), cB + kstep, voffB); PG8_STAGE(PG8_SA(1, 0), cA + kstep, voffA); PG8_STAGE(PG8_SB(1, 1), cB + hstep + kstep, voffB);
        PG8_WAIT_V(6); PG8_BAR;
    }
    for (;;) {
        const bool has_next = S.next(ui + 1, nxt);
        const char* nA = has_next ? (const char*)g.A + (size_t)nxt.pm * tstep : cA; const char* nB = has_next ? (const char*)g.Bt + (size_t)nxt.pn * tstep : cB;
        for (int t = 0; t < nt; t += 2) {
            const bool last = (t == nt - 2);
            const char* a1 = cA + (size_t)(t + 1) * kstep;
            const char* a2 = last ? nA : cA + (size_t)(t + 2) * kstep; const char* b2 = last ? nB : cB + (size_t)(t + 2) * kstep;
            const char* a3 = a2 + kstep; const char* b3 = b2 + kstep;
            if (last && has_next) S.a_ready(nxt);
            if constexpr (SP2) {
            PG8_LDB(B0, 0, 0); PG8_LDB(B1, 0, 1); PG8_SCHED; PG8_LDA(At, 0, 0); PG8_STAGE(PG8_SA(1, 1), a1 + hstep, voffA);
            PG8_WAIT_V(8); PG8_WAIT_L(0); PG8_BAR; PG8_MMA(0, 0, At, B0); PG8_MMA(0, 1, At, B1); PG8_BAR; PG8_SCHED;
            PG8_LDA(At, 0, 1); PG8_STAGE(PG8_SB(0, 0), b2, voffB); PG8_STAGE(PG8_SB(0, 1), b2 + hstep, voffB); PG8_STAGE(PG8_SA(0, 0), a2, voffA);
            PG8_WAIT_V(8); PG8_WAIT_L(0); PG8_BAR; PG8_MMA(1, 0, At, B0); PG8_MMA(1, 1, At, B1); PG8_BAR; PG8_SCHED;
            PG8_LDB(B0, 1, 0); PG8_LDB(B1, 1, 1); PG8_SCHED; PG8_LDA(At, 1, 0); PG8_STAGE(PG8_SA(0, 1), a2 + hstep, voffA);
            PG8_WAIT_V(8); PG8_WAIT_L(0); PG8_BAR; PG8_MMA(0, 0, At, B0); PG8_MMA(0, 1, At, B1); PG8_BAR; PG8_SCHED;
            PG8_LDA(At, 1, 1); PG8_STAGE(PG8_SB(1, 0), b3, voffB); PG8_STAGE(PG8_SB(1, 1), b3 + hstep, voffB); PG8_STAGE(PG8_SA(1, 0), a3, voffA);
            PG8_WAIT_V(8); PG8_WAIT_L(0); PG8_BAR; PG8_MMA(1, 0, At, B0); PG8_MMA(1, 1, At, B1); PG8_BAR; PG8_SCHED;
            } else {
            PG8_LDB(B0, 0, 0); PG8_SCHED; PG8_LDA(At, 0, 0); PG8_STAGE(PG8_SA(1, 1), a1 + hstep, voffA);
            PG8_WAIT_L(8); PG8_BAR; PG8_WAIT_L(0); PG8_MMA(0, 0, At, B0); PG8_BAR; PG8_SCHED;
            PG8_LDB(B1, 0, 1); PG8_STAGE(PG8_SB(0, 0), b2, voffB);
            PG8_BAR; PG8_WAIT_L(0); PG8_MMA(0, 1, At, B1); PG8_BAR;
            PG8_LDA(At, 0, 1); PG8_STAGE(PG8_SA(0, 0), a2, voffA);
            PG8_BAR; PG8_WAIT_L(0); PG8_MMA(1, 0, At, B0); PG8_BAR; PG8_SCHED;
            PG8_STAGE(PG8_SB(0, 1), b2 + hstep, voffB);
            PG8_WAIT_V(6); PG8_BAR; PG8_MMA(1, 1, At, B1); PG8_BAR;
            PG8_LDB(B0, 1, 0); PG8_SCHED; PG8_LDA(At, 1, 0); PG8_STAGE(PG8_SA(0, 1), a2 + hstep, voffA);
            PG8_WAIT_L(8); PG8_BAR; PG8_WAIT_L(0); PG8_MMA(0, 0, At, B0); PG8_BAR; PG8_SCHED;
            PG8_LDB(B1, 1, 1); PG8_STAGE(PG8_SB(1, 0), b3, voffB);
            PG8_BAR; PG8_WAIT_L(0); PG8_MMA(0, 1, At, B1); PG8_BAR;
            PG8_LDA(At, 1, 1); PG8_STAGE(PG8_SA(1, 0), a3, voffA);
            PG8_BAR; PG8_WAIT_L(0); PG8_MMA(1, 0, At, B0); PG8_BAR; PG8_SCHED;
            PG8_STAGE(PG8_SB(1, 1), b3 + hstep, voffB);
            PG8_WAIT_V(6); PG8_BAR; PG8_MMA(1, 1, At, B1); PG8_BAR;
            }
        }
        if constexpr (ALIGN_EPI) { if (wr == 0) PG8_BAR; }
        if constexpr (!Epi::AFTER_DRAIN) { E(acc, cur, wr, wc, fr, fq); S.done(cur); }
        if (!has_next) break;
#pragma unroll
        for (int a = 0; a < 2; ++a)
#pragma unroll
            for (int b = 0; b < 2; ++b)
#pragma unroll
                for (int m = 0; m < 4; ++m)
#pragma unroll
                    for (int n = 0; n < 2; ++n) acc[a][b][m][n] = (f32x4){0.f, 0.f, 0.f, 0.f};
        cur = nxt; cA = nA; cB = nB; ++ui;
        if constexpr (ALIGN_EPI) { if (wr == 1) PG8_BAR; }
    }
    PG8_WAIT_V(0);
    if constexpr (!ALIGN_EPI) { if (wr == 0) PG8_BAR; }
    PG8_BAR;
    if constexpr (Epi::AFTER_DRAIN) { E.fused(acc, cur, wr, wc, fr, fq, lds, wid, lane); S.done(cur); }
#undef PG8_SA
#undef PG8_SB
#undef PG8_STAGE
#undef PG8_LDA
#undef PG8_LDB
#undef PG8_MMA
#undef PG8_WAIT_V
#undef PG8_WAIT_L
#undef PG8_BAR
#undef PG8_SCHED
}
}
#define PROBE_PH -1
#define PROBE_SUB 0

#define LAS __attribute__((address_space(3)))
typedef unsigned short bf16_t;
typedef short bf16x8 __attribute__((ext_vector_type(8)));
typedef float f32x4 __attribute__((ext_vector_type(4)));
typedef float f32x16 __attribute__((ext_vector_type(16)));
typedef unsigned u32x4 __attribute__((ext_vector_type(4)));
typedef unsigned u32x2 __attribute__((ext_vector_type(2)));
using pg8::cvt_pk_bf16;

constexpr int NWAVES = 8, NTHREADS = 512;
constexpr int BATCH = 4, SEQ = 4096, DM = 1024, MTOK = BATCH * SEQ, NZ = 3072, FF = 2816, NGU = 2 * FF, NLAYER = 2, INC = 2884;
constexpr float C2 = 0.125f * 1.4426950408889634f;
constexpr float NEGF = -1e30f;
constexpr int LDS_BYTES = 153600;
constexpr int NPHASE = 14;

constexpr size_t MiB = 1u << 20;
constexpr size_t WS_WIN = 0, WS_WOUT = 12 * MiB, WS_WGU = 16 * MiB, WS_WDN = 38 * MiB, WS_ROPE = 49 * MiB, WS_SSQA = 50 * MiB, WS_SSQB = 51 * MiB,
                 WS_MASK = 52 * MiB, WS_VB = 60 * MiB, WS_XB = 68 * MiB, WS_Y = 100 * MiB, WS_Z = 132 * MiB, WS_KB = 228 * MiB, WS_KI = 236 * MiB, WS_CTL = 250 * MiB, WS_END = 251 * MiB;
constexpr size_t CTL_BYTES = 40960;
constexpr int CW_ITEM = 8192;
constexpr int CW_PANEL = 4096;
constexpr int LDS_BAR_OFF = LDS_BYTES - 64;
constexpr size_t WIN_L = (size_t)NZ * DM, WOUT_L = (size_t)DM * DM, WGU_L = (size_t)NGU * DM, WDN_L = (size_t)DM * FF;

__device__ const double INVF[32] = {1, 0.74989420933245587, 0.56234132519034907, 0.42169650342858223, 0.31622776601683794, 0.23713737056616552, 0.17782794100389229, 0.1333521432163324,
    0.10000000000000001, 0.074989420933245579, 0.056234132519034911, 0.042169650342858224, 0.031622776601683791, 0.023713737056616554, 0.017782794100389229, 0.013335214321633241,
    0.01, 0.0074989420933245579, 0.005623413251903491, 0.0042169650342858229, 0.0031622776601683794, 0.0023713737056616554, 0.0017782794100389228, 0.0013335214321633241,
    0.001, 0.00074989420933245586, 0.0005623413251903491, 0.00042169650342858224, 0.00031622776601683794, 0.00023713737056616554, 0.00017782794100389227, 0.0001333521432163324};

#define LDS_WAIT() asm volatile("s_waitcnt lgkmcnt(0)" ::: "memory")
__device__ __forceinline__ float bf2f(unsigned short h) { return __uint_as_float((unsigned)h << 16); }
__device__ __forceinline__ float bflo(unsigned w) { return __uint_as_float(w << 16); }
__device__ __forceinline__ float bfhi(unsigned w) { return __uint_as_float(w & 0xffff0000u); }
#define DPPF(v, ctrl, rm) __int_as_float(__builtin_amdgcn_update_dpp(0, __float_as_int(v), ctrl, rm, 0xf, false))
__device__ __forceinline__ float wave_sum(float v) {
    v += DPPF(v, 0x111, 0xf); v += DPPF(v, 0x112, 0xf); v += DPPF(v, 0x114, 0xf); v += DPPF(v, 0x118, 0xf);
    v += DPPF(v, 0x142, 0xa); v += DPPF(v, 0x143, 0xc);
    return __int_as_float(__builtin_amdgcn_readlane(__float_as_int(v), 63));
}
__device__ __forceinline__ unsigned wave_umax(unsigned v) {
#define DPPU(v, ctrl, rm) (unsigned)__builtin_amdgcn_update_dpp(0, (int)(v), ctrl, rm, 0xf, false)
    v = max(v, DPPU(v, 0x111, 0xf)); v = max(v, DPPU(v, 0x112, 0xf)); v = max(v, DPPU(v, 0x114, 0xf)); v = max(v, DPPU(v, 0x118, 0xf));
    v = max(v, DPPU(v, 0x142, 0xa)); v = max(v, DPPU(v, 0x143, 0xc));
    return (unsigned)__builtin_amdgcn_readlane((int)v, 63);
#undef DPPU
}
__device__ __forceinline__ float swap32(float v, int hi) { auto rr = __builtin_amdgcn_permlane32_swap(__float_as_uint(v), __float_as_uint(v), false, false); return hi ? __uint_as_float(rr[0]) : __uint_as_float(rr[1]); }
__device__ __forceinline__ float row_rs(const float* ssq, int r) {
    const f32x4* p = (const f32x4*)(ssq + (size_t)r * 16); const f32x4 a = p[0], b = p[1], c = p[2], d = p[3];
    const float s = (((a.x + a.y) + (a.z + a.w)) + ((b.x + b.y) + (b.z + b.w))) + (((c.x + c.y) + (c.z + c.w)) + ((d.x + d.y) + (d.z + d.w)));
    return __builtin_amdgcn_rsqf(s * (1.f / 1024.f) + 1e-6f);
}
__device__ __forceinline__ float xor16_add(float v) { auto rr = __builtin_amdgcn_permlane16_swap(__float_as_uint(v), __float_as_uint(v), false, false); return __uint_as_float(rr[0]) + __uint_as_float(rr[1]); }
__device__ __forceinline__ float xor32_add(float v) { auto rr = __builtin_amdgcn_permlane32_swap(__float_as_uint(v), __float_as_uint(v), false, false); return __uint_as_float(rr[0]) + __uint_as_float(rr[1]); }
__device__ __forceinline__ void row_rs8(const float* ssq, int rbase  , int fq, float (&rs)[8]) {
    f32x4 p[8];
#pragma unroll
    for (int i = 0; i < 8; ++i) p[i] = *(const f32x4*)(ssq + (size_t)(rbase + (i >> 2) * 128 + (i & 3) * 16) * 16 + fq * 4);
#pragma unroll
    for (int i = 0; i < 8; ++i) { float s = (p[i].x + p[i].y) + (p[i].z + p[i].w); s = xor16_add(s); s = xor32_add(s); rs[i] = __builtin_amdgcn_rsqf(s * (1.f / 1024.f) + 1e-6f); }
}
__device__ __forceinline__ float sigmoidf_(float x) { return __builtin_amdgcn_rcpf(1.f + __expf(-x)); }

struct EpiZ {
    static constexpr bool PERM = true, AFTER_DRAIN = false;
    bf16_t* Z; bf16_t* Vb; bf16_t* Kb; bf16_t* KIb; const float* ssq; const float* ropec; const float* ropes;
    __device__ __forceinline__ void operator()(const f32x4 (&acc)[2][2][4][2], const pg8::Unit& u, int wr, int wc, int fr, int fq) const {
        const int pn = u.pn; const bool rope_tile = (pn == 5) || (pn == 6) || (pn == 8) || (pn == 11);
        float rs8[8]; row_rs8(ssq, u.pm * 256 + wr * 64 + fr, fq, rs8);
#pragma unroll
        for (int ai = 0; ai < 2; ++ai)
        {
            f32x4 rc[4], rsn[4]; const int ri0 = ((wc * 32 + fq * 8) & 63) >> 1;
            if (rope_tile) {
#pragma unroll
                for (int m = 0; m < 4; ++m) { const int pos_ = (u.pm * 256 + ai * 128 + wr * 64 + m * 16 + fr) & (SEQ - 1); rc[m] = *(const f32x4*)(ropec + pos_ * 32 + ri0); rsn[m] = *(const f32x4*)(ropes + pos_ * 32 + ri0); }
            }
#pragma unroll
            for (int m = 0; m < 4; ++m) {
                const int r = u.pm * 256 + ai * 128 + wr * 64 + m * 16 + fr; const float rs = rs8[ai * 4 + m]; const int pos = r & (SEQ - 1);
#pragma unroll
                for (int bj = 0; bj < 2; ++bj) {
                    const int cl = bj * 128 + wc * 32 + fq * 8;
                    f32x4 v0 = acc[ai][bj][m][0] * rs, v1 = acc[ai][bj][m][1] * rs;
                    if (rope_tile && (pn != 11 || cl < 64)) {
                        const f32x4 c4 = rc[m], s4 = rsn[m];
                        float a, b;
                        a = v0[0]; b = v0[1]; v0[0] = a * c4[0] - b * s4[0]; v0[1] = b * c4[0] + a * s4[0];
                        a = v0[2]; b = v0[3]; v0[2] = a * c4[1] - b * s4[1]; v0[3] = b * c4[1] + a * s4[1];
                        a = v1[0]; b = v1[1]; v1[0] = a * c4[2] - b * s4[2]; v1[1] = b * c4[2] + a * s4[2];
                        a = v1[2]; b = v1[3]; v1[2] = a * c4[3] - b * s4[3]; v1[3] = b * c4[3] + a * s4[3];
                    }
                    u32x4 w; w.x = cvt_pk_bf16(v0[0], v0[1]); w.y = cvt_pk_bf16(v0[2], v0[3]); w.z = cvt_pk_bf16(v1[0], v1[1]); w.w = cvt_pk_bf16(v1[2], v1[3]);
                    const int b = r >> 12;
                    if (pn == 7) {
                        const int hh = cl >> 6, d0 = cl & 63, kt = pos >> 5, k32 = pos & 31, c = k32 >> 4, kk = k32 & 15, vh = (kk >> 2) & 1, e = (kk & 3) + 4 * (kk >> 3);
                        bf16_t* vp = Vb + ((((size_t)((b * 4 + hh) * 128 + kt) * 2 + (d0 >> 5)) * 2 + c) * 32 + (d0 & 31)) * 16 + vh * 8 + e;
                        vp[0 * 16] = (bf16_t)(w.x & 0xffffu); vp[1 * 16] = (bf16_t)(w.x >> 16); vp[2 * 16] = (bf16_t)(w.y & 0xffffu); vp[3 * 16] = (bf16_t)(w.y >> 16);
                        vp[4 * 16] = (bf16_t)(w.z & 0xffffu); vp[5 * 16] = (bf16_t)(w.z >> 16); vp[6 * 16] = (bf16_t)(w.w & 0xffffu); vp[7 * 16] = (bf16_t)(w.w >> 16);
                    } else if (pn == 6) {
                        const int hh = cl >> 6, c = (cl >> 4) & 3, kh = (cl >> 3) & 1;
                        *(u32x4*)(Kb + ((((size_t)((b * 4 + hh) * 128 + (pos >> 5)) * 4 + c) * 32 + (pos & 31)) * 16 + kh * 8)) = w;
                    } else if (pn == 11) {
                        if (cl < 64) *(u32x4*)(KIb + ((((size_t)(b * 256 + (pos >> 4)) * 2 + (cl >> 5)) * 16 + (pos & 15)) * 32 + ((cl >> 3) & 3) * 8)) = w;
                        else if (cl == 64) *(u32x4*)(Z + (size_t)r * NZ + pn * 256 + cl) = w;
                    } else {
                        *(u32x4*)(Z + (size_t)r * NZ + pn * 256 + cl) = w;
                    }
                }
                asm volatile("" ::: "memory");
            }
        }
    }
};
#ifndef RES_LO
#define RES_LO 0
#endif
struct XL2 { bf16_t* a; bf16_t* b; };
__device__ __forceinline__ bf16_t* xl_row(const XL2& x, int r) { return r < 8192 ? x.a + (size_t)r * DM : x.b + (size_t)(r - 8192) * DM; }
__device__ __forceinline__ void split_hilo(const f32x4& v0, const f32x4& v1, u32x4& hi, u32x4& lo) {
    hi.x = cvt_pk_bf16(v0[0], v0[1]); hi.y = cvt_pk_bf16(v0[2], v0[3]); hi.z = cvt_pk_bf16(v1[0], v1[1]); hi.w = cvt_pk_bf16(v1[2], v1[3]);
    lo.x = cvt_pk_bf16(v0[0] - bflo(hi.x), v0[1] - bfhi(hi.x)); lo.y = cvt_pk_bf16(v0[2] - bflo(hi.y), v0[3] - bfhi(hi.y));
    lo.z = cvt_pk_bf16(v1[0] - bflo(hi.z), v1[1] - bfhi(hi.z)); lo.w = cvt_pk_bf16(v1[2] - bflo(hi.w), v1[3] - bfhi(hi.w));
}
__device__ __forceinline__ void join_hilo(const u32x4& hi, const u32x4& lo, f32x4& v0, f32x4& v1) {
    v0[0] = bflo(hi.x) + bflo(lo.x); v0[1] = bfhi(hi.x) + bfhi(lo.x); v0[2] = bflo(hi.y) + bflo(lo.y); v0[3] = bfhi(hi.y) + bfhi(lo.y);
    v1[0] = bflo(hi.z) + bflo(lo.z); v1[1] = bfhi(hi.z) + bfhi(lo.z); v1[2] = bflo(hi.w) + bflo(lo.w); v1[3] = bfhi(hi.w) + bfhi(lo.w);
}
template <bool BASE_F32> struct EpiRes {
    static constexpr bool PERM = true, AFTER_DRAIN = false;
    const float* basef; XL2 xlin; XL2 xlout; bf16_t* xb; float* ssq;
    __device__ __forceinline__ void operator()(const f32x4 (&acc)[2][2][4][2], const pg8::Unit& u, int wr, int wc, int fr, int fq) const {
#pragma unroll
        for (int ai = 0; ai < 2; ++ai)
#pragma unroll
            for (int m = 0; m < 4; ++m) {
                const int r = u.pm * 256 + ai * 128 + wr * 64 + m * 16 + fr; float sq = 0.f;
#pragma unroll
                for (int bj = 0; bj < 2; ++bj) {
                    const int col = u.pn * 256 + bj * 128 + wc * 32 + fq * 8; const size_t off = (size_t)r * DM + col;
                    f32x4 b0, b1;
                    if (BASE_F32) { b0 = __builtin_nontemporal_load((const f32x4*)(basef + off)); b1 = __builtin_nontemporal_load((const f32x4*)(basef + off + 4)); }
                    else { const u32x4 hi_in = *(const u32x4*)(xb + off); u32x4 lo_in = {0u, 0u, 0u, 0u}; if (RES_LO) lo_in = *(const u32x4*)(xl_row(xlin, r) + col); join_hilo(hi_in, lo_in, b0, b1); }
                    const f32x4 v0 = acc[ai][bj][m][0] + b0, v1 = acc[ai][bj][m][1] + b1;
                    u32x4 hi, lo; split_hilo(v0, v1, hi, lo);
                    *(u32x4*)(xb + off) = hi; if (RES_LO) *(u32x4*)(xl_row(xlout, r) + col) = lo;
                    sq += ((v0[0] * v0[0] + v0[1] * v0[1]) + (v0[2] * v0[2] + v0[3] * v0[3])) + ((v1[0] * v1[0] + v1[1] * v1[1]) + (v1[2] * v1[2] + v1[3] * v1[3]));
                }
                sq = xor16_add(sq); sq = xor32_add(sq);
                if (fq == 0) ssq[(size_t)r * 16 + u.pn * 4 + wc] = sq;
                if (m == 3) asm volatile("" ::: "memory");
            }
    }
};
struct EpiFinal {
    static constexpr bool PERM = true, AFTER_DRAIN = true;
    const bf16_t* xb; XL2 xlin; float* out; const float* gfin; float* xbuf; unsigned* cnt;
    __device__ __forceinline__ void fused(f32x4 (&acc)[2][2][4][2], const pg8::Unit& u, int wr, int wc, int fr, int fq, LAS unsigned char* lds, int wid, int lane) const {
        LAS float* P = (LAS float*)lds;
        LAS float* S = (LAS float*)(lds + 4096);
#pragma unroll
        for (int ai = 0; ai < 2; ++ai)
#pragma unroll
            for (int m = 0; m < 4; ++m) {
                const int rl = ai * 128 + wr * 64 + m * 16 + fr; float sq = 0.f;
#pragma unroll
                for (int bj = 0; bj < 2; ++bj) {
                    const size_t off = (size_t)(u.pm * 256 + rl) * DM + u.pn * 256 + bj * 128 + wc * 32 + fq * 8;
                    f32x4 b0, b1; { const u32x4 hi_in = *(const u32x4*)(xb + off); u32x4 lo_in = {0u, 0u, 0u, 0u}; if (RES_LO) lo_in = *(const u32x4*)(xl_row(xlin, u.pm * 256 + rl) + (off - (size_t)(u.pm * 256 + rl) * DM)); join_hilo(hi_in, lo_in, b0, b1); }
                    const f32x4 v0 = acc[ai][bj][m][0] + b0, v1 = acc[ai][bj][m][1] + b1;
                    acc[ai][bj][m][0] = v0; acc[ai][bj][m][1] = v1;
                    sq += ((v0[0] * v0[0] + v0[1] * v0[1]) + (v0[2] * v0[2] + v0[3] * v0[3])) + ((v1[0] * v1[0] + v1[1] * v1[1]) + (v1[2] * v1[2] + v1[3] * v1[3]));
                }
                sq = xor16_add(sq); sq = xor32_add(sq);
                if (fq == 0) P[rl * 4 + wc] = sq;
                if (m == 3) asm volatile("" ::: "memory");
            }
        asm volatile("s_waitcnt lgkmcnt(0)" ::: "memory"); __builtin_amdgcn_s_barrier(); asm volatile("" ::: "memory");
        const int tid = wid * 64 + lane;
        if (tid < 256) {
            const float s = (P[tid * 4 + 0] + P[tid * 4 + 1]) + (P[tid * 4 + 2] + P[tid * 4 + 3]);
            __hip_atomic_store(xbuf + (size_t)(u.pm * 256 + tid) * 4 + u.pn, s, __ATOMIC_RELAXED, __HIP_MEMORY_SCOPE_AGENT);
        }
        asm volatile("s_waitcnt vmcnt(0)" ::: "memory");
        if (lane == 0) __hip_atomic_fetch_add(cnt + 64 * u.pm, 1u, __ATOMIC_RELAXED, __HIP_MEMORY_SCOPE_AGENT);
        if (wid == 0) {
            unsigned spins = 0;
            while ((unsigned)__builtin_amdgcn_readfirstlane(__hip_atomic_load(cnt + 64 * u.pm, __ATOMIC_RELAXED, __HIP_MEMORY_SCOPE_AGENT)) < 32u) { __builtin_amdgcn_s_sleep(2); if (++spins > (1u << 22)) break; }
            __builtin_amdgcn_fence(__ATOMIC_ACQUIRE, "agent");
        }
        asm volatile("s_waitcnt vmcnt(0) lgkmcnt(0)" ::: "memory"); __builtin_amdgcn_s_barrier(); asm volatile("" ::: "memory");
        if (tid < 256) {
            const float* xp = xbuf + (size_t)(u.pm * 256 + tid) * 4;
            const float a = __hip_atomic_load(xp + 0, __ATOMIC_RELAXED, __HIP_MEMORY_SCOPE_AGENT), b = __hip_atomic_load(xp + 1, __ATOMIC_RELAXED, __HIP_MEMORY_SCOPE_AGENT),
                        c = __hip_atomic_load(xp + 2, __ATOMIC_RELAXED, __HIP_MEMORY_SCOPE_AGENT), d = __hip_atomic_load(xp + 3, __ATOMIC_RELAXED, __HIP_MEMORY_SCOPE_AGENT);
            S[tid] = __builtin_amdgcn_rsqf(((a + b) + (c + d)) * (1.f / 1024.f) + 1e-6f);
        }
        asm volatile("s_waitcnt vmcnt(0) lgkmcnt(0)" ::: "memory"); __builtin_amdgcn_s_barrier(); asm volatile("" ::: "memory");
#pragma unroll
        for (int ai = 0; ai < 2; ++ai)
#pragma unroll
            for (int m = 0; m < 4; ++m) {
                const int rl = ai * 128 + wr * 64 + m * 16 + fr; const float rs = S[rl];
#pragma unroll
                for (int bj = 0; bj < 2; ++bj) {
                    const int col = u.pn * 256 + bj * 128 + wc * 32 + fq * 8; const size_t off = (size_t)(u.pm * 256 + rl) * DM + col;
                    *(f32x4*)(out + off) = acc[ai][bj][m][0] * rs * *(const f32x4*)(gfin + col); *(f32x4*)(out + off + 4) = acc[ai][bj][m][1] * rs * *(const f32x4*)(gfin + col + 4);
                }
            }
    }
};
struct EpiGU {
    static constexpr bool PERM = true, AFTER_DRAIN = false;
    bf16_t* H; const float* ssq;
    __device__ __forceinline__ void operator()(const f32x4 (&acc)[2][2][4][2], const pg8::Unit& u, int wr, int wc, int fr, int fq) const {
        float rs8[8]; row_rs8(ssq, u.pm * 256 + wr * 64 + fr, fq, rs8);
#pragma unroll
        for (int ai = 0; ai < 2; ++ai)
#pragma unroll
            for (int m = 0; m < 4; ++m) {
                const int r = u.pm * 256 + ai * 128 + wr * 64 + m * 16 + fr; const float rs = rs8[ai * 4 + m];
                u32x4 w;
#pragma unroll
                for (int n = 0; n < 2; ++n) {
                    const f32x4 g = acc[ai][0][m][n] * rs, up = acc[ai][1][m][n] * rs;
                    const float h0 = g[0] * sigmoidf_(g[0]) * up[0], h1 = g[1] * sigmoidf_(g[1]) * up[1], h2 = g[2] * sigmoidf_(g[2]) * up[2], h3 = g[3] * sigmoidf_(g[3]) * up[3];
                    if (n == 0) { w.x = cvt_pk_bf16(h0, h1); w.y = cvt_pk_bf16(h2, h3); } else { w.z = cvt_pk_bf16(h0, h1); w.w = cvt_pk_bf16(h2, h3); }
                }
                *(u32x4*)(H + (size_t)r * FF + u.pn * 128 + wc * 32 + fq * 8) = w;
            }
    }
};

__device__ __forceinline__ int il64(int p) { return (p & 1) ? (p >> 1) + 32 : (p >> 1); }
__device__ __forceinline__ void conv_item(const float* src, int ld, float cs, const float* gk, int K, bf16_t* WT, int n0, int k0, LAS float* scr, int lane) {
    float v[32];
    const float* sp = src + (size_t)(k0 + (lane >> 5)) * ld;
#pragma unroll
    for (int i = 0; i < 32; ++i) v[i] = __builtin_nontemporal_load(sp + (size_t)(2 * i) * ld);
    if (gk) {
        float g[32];
#pragma unroll
        for (int i = 0; i < 32; ++i) g[i] = gk[k0 + 2 * i + (lane >> 5)];
#pragma unroll
        for (int i = 0; i < 32; ++i) v[i] *= g[i];
    }
#pragma unroll
    for (int i = 0; i < 32; ++i) scr[(2 * i + (lane >> 5)) * 33 + (lane & 31)] = v[i] * cs;
    LDS_WAIT();
    const int c = lane & 7;
#pragma unroll
    for (int j = 0; j < 4; ++j) {
        const int n = (lane >> 3) + 8 * j; const LAS float* s = scr + (8 * c) * 33 + n;
        u32x4 o; o.x = cvt_pk_bf16(s[0 * 33], s[1 * 33]); o.y = cvt_pk_bf16(s[2 * 33], s[3 * 33]); o.z = cvt_pk_bf16(s[4 * 33], s[5 * 33]); o.w = cvt_pk_bf16(s[6 * 33], s[7 * 33]);
        *(u32x4*)(WT + (size_t)(n0 + n) * K + k0 + 8 * c) = o;
    }
    LDS_WAIT();
}

struct Args { const float* in[18]; float* out; unsigned char* ws; int ph_lo, ph_hi; };
typedef const Args __attribute__((address_space(4)))* KArgs;
__device__ __forceinline__ KArgs kargs() { KArgs p = (KArgs)__builtin_amdgcn_kernarg_segment_ptr(); asm volatile("" : "+s"(p)); return p; }

constexpr int CV_I_IN = 16 * 96, CV_I_OUT = 16 * 32, CV_I_GU = 16 * 176, CV_I_DN = 44 * 32, CV_I_L = CV_I_IN + CV_I_OUT + CV_I_GU + CV_I_DN;
__device__ __forceinline__ void convert_weights(KArgs A, unsigned char* ws, LAS unsigned char* lds, int wave, int lane, int it_lo, int it_hi, int gw, int NGW) {
    LAS float* scr = (LAS float*)(lds + wave * 16384);
    constexpr int I_IN = CV_I_IN, I_OUT = CV_I_OUT, I_GU = CV_I_GU, I_L = CV_I_L;
    for (int it = it_lo + gw; it < it_hi; it += NGW) {
        const int l = it / I_L; int r = it % I_L;
        if (r < I_IN) {
            const int kb = r / 96, nb = r % 96, n = nb * 32 + (lane & 31), tile = n >> 8, c = n & 255;
            int src; float cs = 1.f;
            if (tile <= 4) src = n;
            else if (tile == 5) { src = 1280 + (c & ~63) + il64(c & 63); cs = C2; }
            else if (tile == 6) src = 1536 + (c & ~63) + il64(c & 63);
            else if (tile == 7) src = 1792 + c;
            else if (tile == 8) src = 2048 + (c & ~63) + il64(c & 63);
            else if (tile == 9) src = 2372 + c;
            else if (tile == 10) src = 2628 + c;
            else { if (c < 64) src = 2304 + il64(c); else if (c < 68) { src = 2368 + (c - 64); cs = 0.0625f; } else { src = 0; cs = 0.f; } }
            const float* wl = A->in[2] + (size_t)l * DM * INC;
            conv_item(wl + src, INC, cs, A->in[1] + l * DM, DM, (bf16_t*)(ws + WS_WIN) + l * WIN_L, nb * 32, kb * 64, scr, lane);
            continue;
        }
        r -= I_IN;
        if (r < I_OUT) {
            const int kb = r / 32, nb = r % 32;
            conv_item(A->in[12] + (size_t)l * DM * DM + nb * 32 + (lane & 31), DM, 1.f, nullptr, DM, (bf16_t*)(ws + WS_WOUT) + l * WOUT_L, nb * 32, kb * 64, scr, lane);
            continue;
        }
        r -= I_OUT;
        if (r < I_GU) {
            const int kb = r / 176, nb = r % 176, n = nb * 32 + (lane & 31), c = n & 255, col = (n >> 8) * 128 + (c & 127);
            const float* wsrc = (c < 128 ? A->in[14] : A->in[15]) + (size_t)l * DM * FF + col;
            conv_item(wsrc, FF, 1.f, A->in[13] + l * DM, DM, (bf16_t*)(ws + WS_WGU) + l * WGU_L, nb * 32, kb * 64, scr, lane);
            continue;
        }
        r -= I_GU;
        { const int kb = r / 32, nb = r % 32;
          conv_item(A->in[16] + (size_t)l * FF * DM + nb * 32 + (lane & 31), DM, 1.f, nullptr, FF, (bf16_t*)(ws + WS_WDN) + l * WDN_L, nb * 32, kb * 64, scr, lane); }
    }
}
__device__ __forceinline__ void prologue(KArgs A, unsigned char* ws, LAS unsigned char* lds, int tid, int wave, int lane, int bid, int G, int sub) {
    const int gw = bid * NWAVES + wave, NGW = G * NWAVES;
    float* ropec = (float*)(ws + WS_ROPE); float* ropes = ropec + SEQ * 32;
    if (sub == 0 || sub == 2) for (int idx = bid * NTHREADS + tid; idx < SEQ * 32; idx += G * NTHREADS) {
        const int pos = idx >> 5, i = idx & 31;
        const double ang = (double)pos * INVF[i];
        const double nn = rint(ang * 0.15915494309189535);
        const double x = ang - nn * 6.283185307179586477, x2 = x * x;
        double c = 1.0, s = 1.0, tc = 1.0, ts = 1.0;
#pragma unroll
        for (int k = 1; k <= 15; ++k) { tc *= -x2 * (1.0 / (double)((2 * k - 1) * (2 * k))); c += tc; ts *= -x2 * (1.0 / (double)((2 * k) * (2 * k + 1))); s += ts; }
        ropec[idx] = (float)c; ropes[idx] = (float)(s * x);
    }
    const float* x = A->in[0]; bf16_t* XB = (bf16_t*)(ws + WS_XB); float* ssqA = (float*)(ws + WS_SSQA);
    if (sub == 0 || sub == 3) for (int row0 = gw; row0 < MTOK; row0 += 4 * NGW) {
        f32x4 v[4][4];
#pragma unroll
        for (int rr = 0; rr < 4; ++rr) { const int row = min(row0 + rr * NGW, MTOK - 1); const f32x4* xr = (const f32x4*)(x + (size_t)row * DM) + lane;
#pragma unroll
            for (int j = 0; j < 4; ++j) v[rr][j] = __builtin_nontemporal_load(xr + 64 * j); }
#pragma unroll
        for (int rr = 0; rr < 4; ++rr) { const int row = row0 + rr * NGW; if (row < MTOK) { u32x2* d = (u32x2*)(XB + (size_t)row * DM) + lane; float s = 0.f;
#pragma unroll
            for (int j = 0; j < 4; ++j) { const f32x4 t = v[rr][j]; s += (t.x * t.x + t.y * t.y) + (t.z * t.z + t.w * t.w); u32x2 o; o.x = cvt_pk_bf16(t.x, t.y); o.y = cvt_pk_bf16(t.z, t.w); d[64 * j] = o; }
            s = wave_sum(s);
            if (lane < 16) ssqA[(size_t)row * 16 + lane] = lane == 0 ? s : 0.f; } }
    }
    if (sub == 0 || sub == 1) convert_weights(A, ws, lds, wave, lane, 0, CV_I_L - CV_I_DN, gw, NGW);
}

__device__ __forceinline__ int wave_isum(int v) {
    v += __builtin_amdgcn_update_dpp(0, v, 0x111, 0xf, 0xf, false);
    v += __builtin_amdgcn_update_dpp(0, v, 0x112, 0xf, 0xf, false);
    v += __builtin_amdgcn_update_dpp(0, v, 0x114, 0xf, 0xf, false);
    v += __builtin_amdgcn_update_dpp(0, v, 0x118, 0xf, 0xf, false);
    v += __builtin_amdgcn_update_dpp(0, v, 0x142, 0xa, 0xf, false);
    v += __builtin_amdgcn_update_dpp(0, v, 0x143, 0xc, 0xf, false);
    return __builtin_amdgcn_readlane(v, 63);
}
#define CNT4(c0, c1, t, x0, x1, x2, x3) do { unsigned long long m0_, m1_, m2_, m3_, j0_, j1_; \
    asm("v_cmp_le_u32_e64 %[m0], %[tt], %[a0]\n\tv_cmp_le_u32_e64 %[m1], %[tt], %[a1]\n\tv_cmp_le_u32_e64 %[m2], %[tt], %[a2]\n\tv_cmp_le_u32_e64 %[m3], %[tt], %[a3]\n\t" \
        "v_addc_co_u32_e64 %[k0], %[j0], 0, %[k0], %[m0]\n\tv_addc_co_u32_e64 %[k1], %[j1], 0, %[k1], %[m1]\n\t" \
        "v_addc_co_u32_e64 %[k0], %[j0], 0, %[k0], %[m2]\n\tv_addc_co_u32_e64 %[k1], %[j1], 0, %[k1], %[m3]" \
        : [k0] "+v"(c0), [k1] "+v"(c1), [m0] "=&s"(m0_), [m1] "=&s"(m1_), [m2] "=&s"(m2_), [m3] "=&s"(m3_), [j0] "=&s"(j0_), [j1] "=&s"(j1_) \
        : [tt] "s"(t), [a0] "v"(x0), [a1] "v"(x1), [a2] "v"(x2), [a3] "v"(x3)); } while (0)
#define BIT4(w, t, x0, x1, x2, x3) do { unsigned long long m0_, m1_, m2_, m3_, j0_; \
    asm("v_cmp_gt_u32_e64 %[m0], %[a0], %[tt]\n\tv_cmp_gt_u32_e64 %[m1], %[a1], %[tt]\n\tv_cmp_gt_u32_e64 %[m2], %[a2], %[tt]\n\tv_cmp_gt_u32_e64 %[m3], %[a3], %[tt]\n\t" \
        "v_addc_co_u32_e64 %[k0], %[j0], %[k0], %[k0], %[m0]\n\tv_addc_co_u32_e64 %[k0], %[j0], %[k0], %[k0], %[m1]\n\t" \
        "v_addc_co_u32_e64 %[k0], %[j0], %[k0], %[k0], %[m2]\n\tv_addc_co_u32_e64 %[k0], %[j0], %[k0], %[k0], %[m3]" \
        : [k0] "+v"(w), [m0] "=&s"(m0_), [m1] "=&s"(m1_), [m2] "=&s"(m2_), [m3] "=&s"(m3_), [j0] "=&s"(j0_) \
        : [tt] "s"(t), [a0] "v"(x0), [a1] "v"(x1), [a2] "v"(x2), [a3] "v"(x3)); } while (0)
__device__ __forceinline__ int count_ge(const unsigned (&u)[64], unsigned cand, int nblk) {
    int c0 = 0, c1 = 0;
    const unsigned ts = __builtin_amdgcn_readfirstlane(cand);
#pragma unroll
    for (int B = 0; B < 2; ++B) {
        if (B < nblk) {
#pragma unroll
            for (int i = 0; i < 32; i += 4) CNT4(c0, c1, ts, u[B * 32 + i], u[B * 32 + i + 1], u[B * 32 + i + 2], u[B * 32 + i + 3]);
        }
    }
    return wave_isum(c0 + c1);
}
__device__ __forceinline__ float keyval(unsigned k) { return __uint_as_float((k & 0x80000000u) ? (k ^ 0x80000000u) : ~k); }
__device__ __forceinline__ unsigned valkey(float f) { const unsigned b = __float_as_uint(f); return b ^ ((unsigned)((int)b >> 31) | 0x80000000u); }
__device__ __forceinline__ void select_query(const unsigned (&u)[64], unsigned vmax, int q, int b, int lane, unsigned* MASKb) {
    const int n = q + 1, nblk = (n + 2047) >> 11;
    unsigned T = 0u, TG = 0u; int rrem = 0;
    if (n > 256) {
        const unsigned kmax = wave_umax(vmax);
        const unsigned K0 = 0x80000000u;
        bool exact = false, done = false;
        unsigned lo = 0u, hi = 0u; float Llo = 1.f, Lhi = 1.f;
        const float L256 = 8.0028150156f;
        const int cpos = count_ge(u, K0 + 1u, nblk);
        if (cpos == 256) { T = K0 + 1u; exact = true; done = true; }
        else if (cpos > 256) { lo = K0 + 1u; Llo = __log2f((float)cpos) - L256; hi = kmax + 1u; Lhi = L256 + 1.f; }
        else {
            const int c0 = count_ge(u, K0, nblk);
            if (c0 >= 256) { T = K0; exact = (c0 == 256); done = true; }
            else {
                unsigned vmin = 0xffffffffu;
#pragma unroll
                for (int i = 0; i < 64; ++i) vmin = min(vmin, u[i] - 1u);
                lo = ~wave_umax(~vmin) + 1u; Llo = __log2f((float)n) - L256; hi = K0; Lhi = L256 - __log2f(fmaxf((float)c0, 0.5f));
            }
        }
        int it = 0, last = 0;
        while (!done) {
            if (hi - lo <= 1u) { T = lo; exact = false; break; }
            const float vlo = keyval(lo), vhi = keyval(hi);
            const float frac = (it >= 9 && (it & 1)) ? 0.5f : Llo * __builtin_amdgcn_rcpf(Llo + Lhi);
            unsigned mid = valkey(vlo + frac * (vhi - vlo));
            if (mid <= lo) mid = lo + 1u;
            if (mid >= hi) mid = hi - 1u;
            mid = __builtin_amdgcn_readfirstlane(mid);
            const int c = count_ge(u, mid, nblk);
            if (c == 256) { T = mid; exact = true; break; }
            if (c > 256) { lo = mid; Llo = __log2f((float)c) - L256; if (last == 1) Lhi *= 0.5f; last = 1; }
            else { hi = mid; Lhi = L256 - __log2f(fmaxf((float)c, 0.5f)); if (last == 2) Llo *= 0.5f; last = 2; }
            ++it;
        }
        if (exact) TG = T - 1u; else { TG = T; rrem = 256 - count_ge(u, T + 1u, nblk); }
    }
    int tbase = 0;
#pragma unroll
    for (int B = 0; B < 2; ++B) {
        if (B < nblk) {
            unsigned w = 0u; const unsigned tgs = __builtin_amdgcn_readfirstlane(TG);
#pragma unroll
            for (int e = 31; e >= 3; e -= 4) BIT4(w, tgs, u[B * 32 + e], u[B * 32 + e - 1], u[B * 32 + e - 2], u[B * 32 + e - 3]);
            if (rrem > 0) {
                int ec = 0;
#pragma unroll
                for (int e = 0; e < 32; ++e) ec += (u[B * 32 + e] == T) ? 1 : 0;
                int incl = ec;
#pragma unroll
                for (int o = 1; o < 64; o <<= 1) { const int t = __shfl_up(incl, o); if (lane >= o) incl += t; }
                const int total = __builtin_amdgcn_readlane(incl, 63);
                const int quota = rrem - tbase - (incl - ec);
                int taken = 0;
#pragma unroll
                for (int e = 0; e < 32; ++e) { const bool is = (u[B * 32 + e] == T) && (taken < quota); w |= is ? (1u << e) : 0u; taken += is ? 1 : 0; }
                tbase += total;
            }
            if (64 * B + lane <= (q >> 5)) __hip_atomic_store(MASKb + ((size_t)(b * 128 + (q >> 5)) * 128 + 64 * B + lane) * 32 + (q & 31), w, __ATOMIC_RELAXED, __HIP_MEMORY_SCOPE_AGENT);
        }
    }
}
__device__ __forceinline__ void select_phase(const bf16_t* Z, const bf16_t* KIb, unsigned* MASKb, unsigned* itemcnt, LAS unsigned char* lds, int wave_in, int lane_in, int bid, int G, int sub) {
    constexpr int SCS = 2312;
    LAS float* sc = (LAS float*)lds;
    const int nrounds = (1024 + G - 1) / G;
    bf16x8 qf[4][2]; u32x2 wraw;
#define SEL_LOADQ(idx_) do { const int i_ = (idx_) < 1023 ? (idx_) : 1023; const bf16_t* zq_ = Z + ((size_t)(i_ & 3) * SEQ + (i_ >> 2) * 16 + (lane_in & 15)) * NZ; \
        _Pragma("unroll") for (int j = 0; j < 4; ++j) _Pragma("unroll") for (int ks = 0; ks < 2; ++ks) qf[j][ks] = *(const bf16x8*)(zq_ + 2048 + j * 64 + ks * 32 + (lane_in >> 4) * 8); \
        wraw = *(const u32x2*)(zq_ + 2816 + 64); } while (0)
    { const int r0 = nrounds - 1; int i0_ = r0 * G + ((r0 & 1) ? (G - 1 - bid) : bid); SEL_LOADQ(i0_); }
    for (int rd = 0; rd < nrounds; ++rd) {
        const int rr_ = nrounds - 1 - rd, rn_ = rr_ > 0 ? rr_ - 1 : 0;
        const int idx = rr_ * G + ((rr_ & 1) ? (G - 1 - bid) : bid);
        const int idxn = rn_ * G + ((rn_ & 1) ? (G - 1 - bid) : bid);
        if (idx >= 1024) continue;
        const int b = idx & 3, q0 = (idx >> 2) * 16;
        int wave = wave_in, lane = lane_in; asm volatile("" : "+s"(wave), "+v"(lane));
        const int fr = lane & 15, fq = lane >> 4;
        const float w0 = bflo(wraw.x), w1 = bfhi(wraw.x), w2 = bflo(wraw.y), w3 = bfhi(wraw.y);
        const int nkt = (q0 >> 4) + 1, nch = (nkt + 127) >> 7;
        const bf16_t* kib = KIb + (size_t)b * 256 * 1024 + fr * 32 + fq * 8;
        const int qa = q0 + 2 * wave, qb = qa + 1;
        unsigned ua[64], ub[64]; unsigned vmaxa = 0u, vmaxb = 0u;
#pragma unroll
        for (int c = 0; c < 2; ++c) {
            if (c < nch) {
                const int ktlo = 128 * c, kthi = min(nkt, ktlo + 128);
                bf16x8 ka[2][2], kb2[2][2];
#define KI_LOAD(dst, i0) do { _Pragma("unroll") for (int t_ = 0; t_ < 2; ++t_) { int kt_ = ktlo + wave + 8 * ((i0) + t_); kt_ = kt_ < kthi ? kt_ : kthi - 1; \
                dst[t_][0] = *(const bf16x8*)(kib + (size_t)kt_ * 1024); dst[t_][1] = *(const bf16x8*)(kib + (size_t)kt_ * 1024 + 512); } } while (0)
#define KI_COMP(src, i0) do { _Pragma("unroll") for (int t_ = 0; t_ < 2; ++t_) { int kt_ = ktlo + wave + 8 * ((i0) + t_); kt_ = (kt_ < kthi ? kt_ : kthi - 1) - ktlo; \
                f32x4 s4 = {0.f, 0.f, 0.f, 0.f}; \
                _Pragma("unroll") for (int j = 0; j < 4; ++j) { \
                    f32x4 a = __builtin_amdgcn_mfma_f32_16x16x32_bf16(src[t_][0], qf[j][0], (f32x4){0.f, 0.f, 0.f, 0.f}, 0, 0, 0); \
                    a = __builtin_amdgcn_mfma_f32_16x16x32_bf16(src[t_][1], qf[j][1], a, 0, 0, 0); \
                    const float wj = j == 0 ? w0 : j == 1 ? w1 : j == 2 ? w2 : w3; \
                    _Pragma("unroll") for (int i = 0; i < 4; ++i) s4[i] = fmaf(__int_as_float(max(__float_as_int(a[i]), 0)), wj, s4[i]); } \
                *(LAS f32x4*)(sc + fr * SCS + kt_ * 16 + (kt_ >> 1) * 4 + fq * 4) = s4; } } while (0)
                KI_LOAD(ka, 0);
                for (int i0 = 0; ktlo + wave + 8 * i0 < kthi; i0 += 4) { KI_LOAD(kb2, i0 + 2); KI_COMP(ka, i0); KI_LOAD(ka, i0 + 4); KI_COMP(kb2, i0 + 2); }
#undef KI_LOAD
#undef KI_COMP
                __syncthreads();
                if (c + 1 == nch) SEL_LOADQ(idxn);
                const LAS float* srow = sc + (2 * wave) * SCS + 36 * lane;
                const int ema = qa - 2048 * c - 32 * lane, emb = ema + 1;
                const int adma = (int)(ema >= 31 ? 0xffffffffu : ema < 0 ? 0u : ((2u << ema) - 1u)), admb = (int)(emb >= 31 ? 0xffffffffu : emb < 0 ? 0u : ((2u << emb) - 1u));
#pragma unroll
                for (int e4 = 0; e4 < 8; ++e4) {
                    const f32x4 va = *(const LAS f32x4*)(srow + 4 * e4), vb = *(const LAS f32x4*)(srow + SCS + 4 * e4);
#pragma unroll
                    for (int e = 0; e < 4; ++e) {
                        const int ii = c * 32 + e4 * 4 + e;
                        const unsigned ba = __float_as_uint(va[e]), bb = __float_as_uint(vb[e]);
                        ua[ii] = (ba ^ ((unsigned)((int)ba >> 31) | 0x80000000u)) & (unsigned)__builtin_amdgcn_sbfe(adma, e4 * 4 + e, 1);
                        ub[ii] = (bb ^ ((unsigned)((int)bb >> 31) | 0x80000000u)) & (unsigned)__builtin_amdgcn_sbfe(admb, e4 * 4 + e, 1);
                        vmaxa = max(vmaxa, ua[ii]); vmaxb = max(vmaxb, ub[ii]);
                    }
                }
                asm volatile("s_waitcnt lgkmcnt(0)" ::: "memory");
                __syncthreads();
            } else {
#pragma unroll
                for (int e = 0; e < 32; ++e) { ua[c * 32 + e] = 0u; ub[c * 32 + e] = 0u; }
            }
        }
        if (sub != 3) {
            select_query(ua, vmaxa, qa, b, lane, MASKb);
            select_query(ub, vmaxb, qb, b, lane, MASKb);
            asm volatile("s_waitcnt vmcnt(0)" ::: "memory");
            if (lane == 0) __hip_atomic_fetch_add(itemcnt + idx, 1u, __ATOMIC_RELAXED, __HIP_MEMORY_SCOPE_AGENT);
        }
    }
#undef SEL_LOADQ
}

__device__ __forceinline__ void mixer_a(const bf16_t* __restrict__ Z, bf16_t* __restrict__ Y, const float* __restrict__ wc, int gtid, int NGT) {
#pragma unroll 2
    for (int it = gtid; it < MTOK * 32; it += NGT) {
        const int row = it >> 5, c8 = (it & 31) * 8, pos = row & (SEQ - 1);
        const bf16_t* zr = Z + (size_t)row * NZ;
        float acc[8];
#pragma unroll
        for (int i = 0; i < 8; ++i) acc[i] = 0.f;
#pragma unroll
        for (int j = 0; j < 3; ++j) {
            const int d = 2 - j; const float ok = (pos >= d) ? 1.f : 0.f;
            {
                const bf16_t* zz = zr - (size_t)((pos >= d) ? d : 0) * NZ;
                const u32x4 cc = *(const u32x4*)(zz + 256 + c8), hh = *(const u32x4*)(zz + 512 + c8);
                const f32x4 wa = *(const f32x4*)(wc + j * 256 + c8) * ok, wb = *(const f32x4*)(wc + j * 256 + c8 + 4) * ok;
                acc[0] += wa[0] * (bflo(cc.x) * bflo(hh.x)); acc[1] += wa[1] * (bfhi(cc.x) * bfhi(hh.x));
                acc[2] += wa[2] * (bflo(cc.y) * bflo(hh.y)); acc[3] += wa[3] * (bfhi(cc.y) * bfhi(hh.y));
                acc[4] += wb[0] * (bflo(cc.z) * bflo(hh.z)); acc[5] += wb[1] * (bfhi(cc.z) * bfhi(hh.z));
                acc[6] += wb[2] * (bflo(cc.w) * bflo(hh.w)); acc[7] += wb[3] * (bfhi(cc.w) * bfhi(hh.w));
            }
        }
        const u32x4 ab = *(const u32x4*)(zr + c8);
        u32x4 o;
        o.x = cvt_pk_bf16(bflo(ab.x) * acc[0], bfhi(ab.x) * acc[1]); o.y = cvt_pk_bf16(bflo(ab.y) * acc[2], bfhi(ab.y) * acc[3]);
        o.z = cvt_pk_bf16(bflo(ab.z) * acc[4], bfhi(ab.z) * acc[5]); o.w = cvt_pk_bf16(bflo(ab.w) * acc[6], bfhi(ab.w) * acc[7]);
        *(u32x4*)(Y + (size_t)row * DM + c8) = o;
    }
}

__device__ __forceinline__ void mixer_b(const bf16_t* __restrict__ Z, bf16_t* __restrict__ Y, const float* __restrict__ lng, const float* __restrict__ lnb, const float* __restrict__ wsp, const float* __restrict__ bsp,
                                        LAS unsigned char* lds, int wave, int lane, int bid, int G) {
    constexpr int VP = 132;
    LAS bf16_t* vt = (LAS bf16_t*)lds;
    const int fr = lane & 15, fq = lane >> 4;
    for (int un = bid; un < 256; un += G) {
        const int chunk = un >> 1, hf = un & 1; const size_t row0 = (size_t)chunk * 128;
#pragma unroll 8
        for (int k = 0; k < 16; ++k) {
            const int s = wave * 16 + k; const bf16_t* zr = Z + (row0 + s) * NZ + 4 * 256;
            const float v0 = bf2f(zr[lane]), v1 = bf2f(zr[lane + 64]), v2 = bf2f(zr[lane + 128]), v3 = bf2f(zr[lane + 192]);
            const float mean = wave_sum((v0 + v1) + (v2 + v3)) * (1.f / 256.f);
            const float d0 = v0 - mean, d1 = v1 - mean, d2 = v2 - mean, d3 = v3 - mean;
            const float var = wave_sum((d0 * d0 + d1 * d1) + (d2 * d2 + d3 * d3)) * (1.f / 256.f);
            const float rstd = __builtin_amdgcn_rsqf(var + 1e-5f);
            const int ca = hf * 128 + lane, cb = ca + 64;
            const float a = (hf ? d2 : d0) * rstd * lng[ca] + lnb[ca], b = (hf ? d3 : d1) * rstd * lng[cb] + lnb[cb];
            const unsigned pk = cvt_pk_bf16(a, b);
            vt[lane * VP + s] = (bf16_t)(pk & 0xffffu); vt[(lane + 64) * VP + s] = (bf16_t)(pk >> 16);
        }
        __syncthreads();
        const int t = wave * 16 + fr;
#pragma unroll
        for (int hh = 0; hh < 2; ++hh) {
            const int h = hf * 2 + hh; const float* W = wsp + (size_t)h * 128 * 128 + (size_t)t * 128;
            f32x4 acc[4];
#pragma unroll
            for (int nt = 0; nt < 4; ++nt) acc[nt] = (f32x4){0.f, 0.f, 0.f, 0.f};
#pragma unroll
            for (int ks = 0; ks < 4; ++ks) {
                const int s0 = ks * 32 + fq * 8;
                f32x4 wa = *(const f32x4*)(W + s0), wb = *(const f32x4*)(W + s0 + 4);
#pragma unroll
                for (int j = 0; j < 4; ++j) { if (s0 + j > t) wa[j] = 0.f; if (s0 + 4 + j > t) wb[j] = 0.f; }
                u32x4 wp; wp.x = cvt_pk_bf16(wa[0], wa[1]); wp.y = cvt_pk_bf16(wa[2], wa[3]); wp.z = cvt_pk_bf16(wb[0], wb[1]); wp.w = cvt_pk_bf16(wb[2], wb[3]);
                const bf16x8 wf = __builtin_bit_cast(bf16x8, wp);
#pragma unroll
                for (int nt = 0; nt < 4; ++nt) {
                    const LAS bf16_t* vp = vt + (hh * 64 + nt * 16 + fr) * VP + s0;
                    const u32x2 lo = *(const LAS u32x2*)vp, hi2 = *(const LAS u32x2*)(vp + 4);
                    u32x4 vv; vv.x = lo.x; vv.y = lo.y; vv.z = hi2.x; vv.w = hi2.y;
                    acc[nt] = __builtin_amdgcn_mfma_f32_16x16x32_bf16(__builtin_bit_cast(bf16x8, vv), wf, acc[nt], 0, 0, 0);
                }
            }
            const float bias = bsp[h * 128 + t]; const size_t row = row0 + t;
#pragma unroll
            for (int nt = 0; nt < 4; ++nt) {
                const int col = h * 64 + nt * 16 + fq * 4;
                const u32x2 uu = *(const u32x2*)(Z + row * NZ + 3 * 256 + col);
                u32x2 o; o.x = cvt_pk_bf16((acc[nt][0] + bias) * bflo(uu.x), (acc[nt][1] + bias) * bfhi(uu.x)); o.y = cvt_pk_bf16((acc[nt][2] + bias) * bflo(uu.y), (acc[nt][3] + bias) * bfhi(uu.y));
                *(u32x2*)(Y + row * DM + 256 + col) = o;
            }
        }
        __syncthreads();
    }
}

__device__ __forceinline__ void mixer_d(const bf16_t* Z, bf16_t* Y, const float* wcf, const float* bcf, const float* lng, const float* lnb,
                                        LAS unsigned char* lds, int tid, int wave, int lane, int bid, int G) {
    LAS float* yl = (LAS float*)lds;
    LAS float* cv = (LAS float*)(lds + 62 * 256 * 4);
    const int c = tid & 255, half = tid >> 8;
    float w[31];
#pragma unroll
    for (int j = 0; j < 31; ++j) w[j] = wcf[j * 256 + c];
    const float bias = bcf[c];
    const f32x4 g4 = *(const f32x4*)(lng + lane * 4), b4 = *(const f32x4*)(lnb + lane * 4);
    for (int un = bid; un < MTOK / 32; un += G) {
        const int row0 = un * 32, pos0 = row0 & (SEQ - 1);
#pragma unroll
        for (int i4 = 0; i4 < 4; ++i4) {
            const int it0 = tid + i4 * NTHREADS, it = it0 < 62 * 32 ? it0 : 62 * 32 - 1;
            const int rr = it >> 5, c8 = (it & 31) * 8, p = pos0 - 30 + rr;
            f32x4 o0, o1; const float ok = (p >= 0) ? 1.f : 0.f;
            {
                const bf16_t* zr = Z + (size_t)(row0 + ((p >= 0) ? rr - 30 : 0)) * NZ;
                const u32x4 a = *(const u32x4*)(zr + 9 * 256 + c8), gg = *(const u32x4*)(zr + 10 * 256 + c8);
                o0[0] = bflo(a.x) * sigmoidf_(bflo(gg.x)); o0[1] = bfhi(a.x) * sigmoidf_(bfhi(gg.x)); o0[2] = bflo(a.y) * sigmoidf_(bflo(gg.y)); o0[3] = bfhi(a.y) * sigmoidf_(bfhi(gg.y));
                o1[0] = bflo(a.z) * sigmoidf_(bflo(gg.z)); o1[1] = bfhi(a.z) * sigmoidf_(bfhi(gg.z)); o1[2] = bflo(a.w) * sigmoidf_(bflo(gg.w)); o1[3] = bfhi(a.w) * sigmoidf_(bfhi(gg.w));
            }
            *(LAS f32x4*)(yl + rr * 256 + c8) = o0 * ok; *(LAS f32x4*)(yl + rr * 256 + c8 + 4) = o1 * ok;
        }
        __syncthreads();
#pragma unroll
        for (int blk = 0; blk < 2; ++blk) {
            const int tb = half * 16 + blk * 8;
            float acc[8];
#pragma unroll
            for (int o = 0; o < 8; ++o) acc[o] = bias;
#pragma unroll
            for (int jj = 0; jj < 38; ++jj) {
                const float v = yl[(tb + jj) * 256 + c];
#pragma unroll
                for (int o = 0; o < 8; ++o) { const int j = jj - o; if (j >= 0 && j < 31) acc[o] += w[j] * v; }
            }
#pragma unroll
            for (int o = 0; o < 8; ++o) cv[(tb + o) * 256 + c] = acc[o];
        }
        __syncthreads();
#pragma unroll
        for (int k = 0; k < 4; ++k) {
            const int tt = wave * 4 + k;
            const f32x4 v = *(const LAS f32x4*)(cv + tt * 256 + lane * 4);
            const float mean = wave_sum((v[0] + v[1]) + (v[2] + v[3])) * (1.f / 256.f);
            const f32x4 d = v - mean;
            const float var = wave_sum((d[0] * d[0] + d[1] * d[1]) + (d[2] * d[2] + d[3] * d[3])) * (1.f / 256.f);
            const float rstd = __builtin_amdgcn_rsqf(var + 1e-5f);
            const f32x4 y = d * rstd * g4 + b4;
            u32x2 o; o.x = cvt_pk_bf16(y[0] * sigmoidf_(y[0]), y[1] * sigmoidf_(y[1])); o.y = cvt_pk_bf16(y[2] * sigmoidf_(y[2]), y[3] * sigmoidf_(y[3]));
            *(u32x2*)(Y + (size_t)(row0 + tt) * DM + 768 + lane * 4) = o;
        }
        __syncthreads();
    }
}

__device__ __forceinline__ void mixer_bd(const bf16_t* __restrict__ Z, bf16_t* __restrict__ Y, const float* __restrict__ lng, const float* __restrict__ lnb, const float* __restrict__ wsp, const float* __restrict__ bsp,
                                         const float* __restrict__ wcf, const float* __restrict__ bcf, const float* __restrict__ dlng, const float* __restrict__ dlnb,
                                         LAS unsigned char* lds, int tid, int wave, int lane, int bid, int G) {
    constexpr int VP = 132;
    LAS bf16_t* vt = (LAS bf16_t*)lds;
    LAS float* yl = (LAS float*)(lds + 36864);
    LAS float* cv = (LAS float*)(lds + 100352);
    const int fr = lane & 15, fq = lane >> 4;
    const int c = tid & 255, half = tid >> 8;
    float w[31];
#pragma unroll
    for (int j = 0; j < 31; ++j) w[j] = wcf[j * 256 + c];
    const float dbias = bcf[c];
    const f32x4 g4 = *(const f32x4*)(dlng + lane * 4), b4 = *(const f32x4*)(dlnb + lane * 4);
#define MD_GLU(dun) do { const int row0_ = (dun) * 32, pos0_ = row0_ & (SEQ - 1); \
        _Pragma("unroll") for (int i4 = 0; i4 < 4; ++i4) { \
            const int it0 = tid + i4 * NTHREADS, it = it0 < 62 * 32 ? it0 : 62 * 32 - 1; \
            const int rr = it >> 5, c8 = (it & 31) * 8, p = pos0_ - 30 + rr; \
            f32x4 o0, o1; const float ok = (p >= 0) ? 1.f : 0.f; \
            const bf16_t* zr = Z + (size_t)(row0_ + ((p >= 0) ? rr - 30 : 0)) * NZ; \
            const u32x4 a = *(const u32x4*)(zr + 9 * 256 + c8), gg = *(const u32x4*)(zr + 10 * 256 + c8); \
            o0[0] = bflo(a.x) * sigmoidf_(bflo(gg.x)); o0[1] = bfhi(a.x) * sigmoidf_(bfhi(gg.x)); o0[2] = bflo(a.y) * sigmoidf_(bflo(gg.y)); o0[3] = bfhi(a.y) * sigmoidf_(bfhi(gg.y)); \
            o1[0] = bflo(a.z) * sigmoidf_(bflo(gg.z)); o1[1] = bfhi(a.z) * sigmoidf_(bfhi(gg.z)); o1[2] = bflo(a.w) * sigmoidf_(bflo(gg.w)); o1[3] = bfhi(a.w) * sigmoidf_(bfhi(gg.w)); \
            *(LAS f32x4*)(yl + rr * 256 + c8) = o0 * ok; *(LAS f32x4*)(yl + rr * 256 + c8 + 4) = o1 * ok; } } while (0)
#define MD_CONV() do { _Pragma("unroll") for (int blk = 0; blk < 2; ++blk) { const int tb = half * 16 + blk * 8; float acc_[8]; \
            _Pragma("unroll") for (int o = 0; o < 8; ++o) acc_[o] = dbias; \
            _Pragma("unroll") for (int jj = 0; jj < 38; ++jj) { const float v = yl[(tb + jj) * 256 + c]; \
                _Pragma("unroll") for (int o = 0; o < 8; ++o) { const int j = jj - o; if (j >= 0 && j < 31) acc_[o] += w[j] * v; } } \
            _Pragma("unroll") for (int o = 0; o < 8; ++o) cv[(tb + o) * 256 + c] = acc_[o]; } } while (0)
#define MD_LN(dun) do { const int row0_ = (dun) * 32; _Pragma("unroll") for (int k = 0; k < 4; ++k) { const int tt = wave * 4 + k; \
            const f32x4 v = *(const LAS f32x4*)(cv + tt * 256 + lane * 4); \
            const float mean = wave_sum((v[0] + v[1]) + (v[2] + v[3])) * (1.f / 256.f); const f32x4 d = v - mean; \
            const float var = wave_sum((d[0] * d[0] + d[1] * d[1]) + (d[2] * d[2] + d[3] * d[3])) * (1.f / 256.f); const float rstd = __builtin_amdgcn_rsqf(var + 1e-5f); \
            const f32x4 y = d * rstd * g4 + b4; \
            u32x2 o; o.x = cvt_pk_bf16(y[0] * sigmoidf_(y[0]), y[1] * sigmoidf_(y[1])); o.y = cvt_pk_bf16(y[2] * sigmoidf_(y[2]), y[3] * sigmoidf_(y[3])); \
            *(u32x2*)(Y + (size_t)(row0_ + tt) * DM + 768 + lane * 4) = o; } } while (0)
    for (int un = bid; un < 256; un += G) {
        const int chunk = un >> 1, hf = un & 1; const size_t row0 = (size_t)chunk * 128;
        const int t = wave * 16 + fr; const size_t row = row0 + t;
        bf16x8 wf[2][4]; u32x2 uu[2][4]; float bias[2];
#pragma unroll
        for (int hh = 0; hh < 2; ++hh) {
            const int h = hf * 2 + hh; const float* W = wsp + (size_t)h * 128 * 128 + (size_t)t * 128;
            f32x4 wa[4], wb[4];
#pragma unroll
            for (int ks = 0; ks < 4; ++ks) { wa[ks] = *(const f32x4*)(W + ks * 32 + fq * 8); wb[ks] = *(const f32x4*)(W + ks * 32 + fq * 8 + 4); }
#pragma unroll
            for (int nt = 0; nt < 4; ++nt) uu[hh][nt] = *(const u32x2*)(Z + row * NZ + 3 * 256 + h * 64 + nt * 16 + fq * 4);
            bias[hh] = bsp[h * 128 + t];
#pragma unroll
            for (int ks = 0; ks < 4; ++ks) {
                const int s0 = ks * 32 + fq * 8;
#pragma unroll
                for (int j = 0; j < 4; ++j) { if (s0 + j > t) wa[ks][j] = 0.f; if (s0 + 4 + j > t) wb[ks][j] = 0.f; }
                u32x4 wp; wp.x = cvt_pk_bf16(wa[ks][0], wa[ks][1]); wp.y = cvt_pk_bf16(wa[ks][2], wa[ks][3]); wp.z = cvt_pk_bf16(wb[ks][0], wb[ks][1]); wp.w = cvt_pk_bf16(wb[ks][2], wb[ks][3]);
                wf[hh][ks] = __builtin_bit_cast(bf16x8, wp);
            }
        }
#pragma unroll 8
        for (int k = 0; k < 16; ++k) {
            const int s = wave * 16 + k; const bf16_t* zr = Z + (row0 + s) * NZ + 4 * 256;
            const float v0 = bf2f(zr[lane]), v1 = bf2f(zr[lane + 64]), v2 = bf2f(zr[lane + 128]), v3 = bf2f(zr[lane + 192]);
            const float mean = wave_sum((v0 + v1) + (v2 + v3)) * (1.f / 256.f);
            const float d0 = v0 - mean, d1 = v1 - mean, d2 = v2 - mean, d3 = v3 - mean;
            const float var = wave_sum((d0 * d0 + d1 * d1) + (d2 * d2 + d3 * d3)) * (1.f / 256.f);
            const float rstd = __builtin_amdgcn_rsqf(var + 1e-5f);
            const int ca = hf * 128 + lane, cb = ca + 64;
            const float a = (hf ? d2 : d0) * rstd * lng[ca] + lnb[ca], b = (hf ? d3 : d1) * rstd * lng[cb] + lnb[cb];
            const unsigned pk = cvt_pk_bf16(a, b);
            vt[lane * VP + s] = (bf16_t)(pk & 0xffffu); vt[(lane + 64) * VP + s] = (bf16_t)(pk >> 16);
        }
        MD_GLU(2 * un);
        __syncthreads();
#pragma unroll
        for (int hh = 0; hh < 2; ++hh) {
            const int h = hf * 2 + hh;
            f32x4 acc[4];
#pragma unroll
            for (int nt = 0; nt < 4; ++nt) acc[nt] = (f32x4){0.f, 0.f, 0.f, 0.f};
#pragma unroll
            for (int ks = 0; ks < 4; ++ks) {
                const int s0 = ks * 32 + fq * 8;
#pragma unroll
                for (int nt = 0; nt < 4; ++nt) {
                    const LAS bf16_t* vp = vt + (hh * 64 + nt * 16 + fr) * VP + s0;
                    const u32x2 lo = *(const LAS u32x2*)vp, hi2 = *(const LAS u32x2*)(vp + 4);
                    u32x4 vv; vv.x = lo.x; vv.y = lo.y; vv.z = hi2.x; vv.w = hi2.y;
                    acc[nt] = __builtin_amdgcn_mfma_f32_16x16x32_bf16(__builtin_bit_cast(bf16x8, vv), wf[hh][ks], acc[nt], 0, 0, 0);
                }
            }
#pragma unroll
            for (int nt = 0; nt < 4; ++nt) {
                const int col = h * 64 + nt * 16 + fq * 4; const u32x2 u2 = uu[hh][nt]; const float bs_ = bias[hh];
                u32x2 o; o.x = cvt_pk_bf16((acc[nt][0] + bs_) * bflo(u2.x), (acc[nt][1] + bs_) * bfhi(u2.x)); o.y = cvt_pk_bf16((acc[nt][2] + bs_) * bflo(u2.y), (acc[nt][3] + bs_) * bfhi(u2.y));
                *(u32x2*)(Y + row * DM + 256 + col) = o;
            }
        }
        MD_CONV();
        __syncthreads();
        MD_LN(2 * un);
        MD_GLU(2 * un + 1);
        __syncthreads();
        MD_CONV();
        __syncthreads();
        MD_LN(2 * un + 1);
        __syncthreads();
    }
#undef MD_GLU
#undef MD_CONV
#undef MD_LN
}

__device__ __forceinline__ void attn_phase(const bf16_t* Z, const bf16_t* Kb, const bf16_t* Vb, unsigned* MASKb, unsigned* itemcnt, bf16_t* Y, LAS unsigned char* lds, int wave, int lane, int bid, int G) {
    const int h = wave & 3, half = wave >> 2, ql = lane & 31, hi = lane >> 5;
    LAS float* mo = (LAS float*)lds + h * 2048;
    LAS float* mml = (LAS float*)(lds + 32768) + h * 128;
    LAS bf16_t* ost = (LAS bf16_t*)(lds + 36864) + h * (32 * 72);
    const unsigned NEGB = __float_as_uint(NEGF);
    for (int pu = bid; pu < 256; pu += G) {
        const int b = pu & 3, jj = pu >> 2;
        for (int rep = 0; rep < 2; ++rep) {
            const int qb = rep ? jj : 127 - jj;
            const int NT = qb + 1, n0 = (NT + 1) >> 1, tb = half ? n0 : 0, te = half ? NT : n0;
            if (wave == 0) {
                unsigned* c0 = itemcnt + (2 * qb) * 4 + b; unsigned* c1 = c0 + 4; unsigned spins = 0;
                while ((unsigned)__builtin_amdgcn_readfirstlane(__hip_atomic_load(c0, __ATOMIC_RELAXED, __HIP_MEMORY_SCOPE_AGENT)) < 8u ||
                       (unsigned)__builtin_amdgcn_readfirstlane(__hip_atomic_load(c1, __ATOMIC_RELAXED, __HIP_MEMORY_SCOPE_AGENT)) < 8u) { __builtin_amdgcn_s_sleep(4); if (++spins > (1u << 22)) break; }
                __builtin_amdgcn_fence(__ATOMIC_ACQUIRE, "agent");
            }
            __syncthreads();
            const size_t rowq = (size_t)b * SEQ + qb * 32 + ql;
            const bf16_t* zq = Z + rowq * NZ + 1280 + h * 64 + hi * 8;
            bf16x8 qf[4];
#pragma unroll
            for (int c = 0; c < 4; ++c) qf[c] = *(const bf16x8*)(zq + 16 * c);
            unsigned* mrow = MASKb + ((size_t)(b * 128 + qb) * 128) * 32 + ql;
            const bf16_t* kb = Kb + ((size_t)(b * 4 + h) * 128) * 2048 + ql * 16 + hi * 8;
            const bf16_t* vb = Vb + ((size_t)(b * 4 + h) * 128) * 2048 + ql * 16 + hi * 8;
            f32x16 o0, o1;
#pragma unroll
            for (int r = 0; r < 16; ++r) { o0[r] = 0.f; o1[r] = 0.f; }
            float m = NEGF, l = 0.f;
            bf16x8 kA[4], kB[4]; bf16x8 vA[2][2], vB[2][2]; unsigned mA = 0u, mB = 0u;
#define ATT_LOAD(KF, VR, MW, kt_) do { const bf16_t* kp_ = kb + (size_t)(kt_) * 2048; const bf16_t* vp_ = vb + (size_t)(kt_) * 2048; _Pragma("unroll") for (int c = 0; c < 4; ++c) KF[c] = *(const bf16x8*)(kp_ + c * 512); \
        _Pragma("unroll") for (int mt = 0; mt < 2; ++mt) _Pragma("unroll") for (int c = 0; c < 2; ++c) VR[mt][c] = *(const bf16x8*)(vp_ + (mt * 2 + c) * 512); \
        MW = __hip_atomic_load(mrow + (kt_) * 32, __ATOMIC_RELAXED, __HIP_MEMORY_SCOPE_AGENT); } while (0)
#define ATT_COMP(KF, VR, MW) do { \
        f32x16 s; \
        _Pragma("unroll") for (int r = 0; r < 16; ++r) s[r] = 0.f; \
        __builtin_amdgcn_s_setprio(1); \
        _Pragma("unroll") for (int c = 0; c < 4; ++c) s = __builtin_amdgcn_mfma_f32_32x32x16_bf16(KF[c], qf[c], s, 0, 0, 0); \
        __builtin_amdgcn_s_setprio(0); \
        const int mws = (int)(MW >> (4 * hi)); \
        float rm = NEGF; \
        _Pragma("unroll") for (int r = 0; r < 16; ++r) { \
            const unsigned sel = (unsigned)__builtin_amdgcn_sbfe(mws, (r & 3) + 8 * (r >> 2), 1); \
            s[r] = __uint_as_float((__float_as_uint(s[r]) & sel) | (NEGB & ~sel)); \
            rm = fmaxf(rm, s[r]); } \
        rm = fmaxf(rm, swap32(rm, hi)); \
        const float mn = fmaxf(m, rm); \
        if (__any(mn > m)) { \
            const float al = __builtin_amdgcn_exp2f(m - mn); l *= al; \
            _Pragma("unroll") for (int r = 0; r < 16; ++r) { o0[r] *= al; o1[r] *= al; } \
            m = mn; } \
        float ps = 0.f; \
        _Pragma("unroll") for (int r = 0; r < 16; ++r) { s[r] = __builtin_amdgcn_exp2f(s[r] - m); ps += s[r]; } \
        l += ps; \
        u32x4 p0, p1; \
        p0.x = cvt_pk_bf16(s[0], s[1]); p0.y = cvt_pk_bf16(s[2], s[3]); p0.z = cvt_pk_bf16(s[4], s[5]); p0.w = cvt_pk_bf16(s[6], s[7]); \
        p1.x = cvt_pk_bf16(s[8], s[9]); p1.y = cvt_pk_bf16(s[10], s[11]); p1.z = cvt_pk_bf16(s[12], s[13]); p1.w = cvt_pk_bf16(s[14], s[15]); \
        const bf16x8 pf0 = __builtin_bit_cast(bf16x8, p0), pf1 = __builtin_bit_cast(bf16x8, p1); \
        __builtin_amdgcn_s_setprio(1); \
        o0 = __builtin_amdgcn_mfma_f32_32x32x16_bf16(VR[0][0], pf0, o0, 0, 0, 0); o1 = __builtin_amdgcn_mfma_f32_32x32x16_bf16(VR[1][0], pf0, o1, 0, 0, 0); \
        o0 = __builtin_amdgcn_mfma_f32_32x32x16_bf16(VR[0][1], pf1, o0, 0, 0, 0); o1 = __builtin_amdgcn_mfma_f32_32x32x16_bf16(VR[1][1], pf1, o1, 0, 0, 0); \
        __builtin_amdgcn_s_setprio(0); } while (0)
            if (tb < te) ATT_LOAD(kA, vA, mA, tb);
            for (int kt = tb; kt < te; kt += 2) {
                { const int k1 = (kt + 1 < te) ? kt + 1 : kt; ATT_LOAD(kB, vB, mB, k1); }
                ATT_COMP(kA, vA, mA);
                { const int k2 = (kt + 2 < te) ? kt + 2 : te - 1; ATT_LOAD(kA, vA, mA, k2); }
                if (kt + 1 < te) ATT_COMP(kB, vB, mB);
            }
#undef ATT_COMP
#undef ATT_LOAD
            const float lt = l + swap32(l, hi);
            if (half == 1) {
#pragma unroll
                for (int r = 0; r < 16; ++r) { mo[r * 64 + lane] = o0[r]; mo[(16 + r) * 64 + lane] = o1[r]; }
                mml[lane] = m; mml[64 + lane] = lt;
            }
            __syncthreads();
            if (half == 0) {
                const float m1 = mml[lane], l1 = mml[64 + lane];
                const float mn = fmaxf(m, m1), a0 = __builtin_amdgcn_exp2f(m - mn), a1 = __builtin_amdgcn_exp2f(m1 - mn);
                const float inv = __builtin_amdgcn_rcpf(lt * a0 + l1 * a1), f0 = a0 * inv, f1 = a1 * inv;
#pragma unroll
                for (int r = 0; r < 16; ++r) { o0[r] = o0[r] * f0 + mo[r * 64 + lane] * f1; o1[r] = o1[r] * f0 + mo[(16 + r) * 64 + lane] * f1; }
#pragma unroll
                for (int r = 0; r < 16; r += 2) {
                    const int d = (r & 3) + 8 * (r >> 2) + 4 * hi;
                    *(LAS unsigned*)(ost + ql * 72 + d) = cvt_pk_bf16(o0[r], o0[r + 1]);
                    *(LAS unsigned*)(ost + ql * 72 + 32 + d) = cvt_pk_bf16(o1[r], o1[r + 1]);
                }
                LDS_WAIT();
                bf16_t* yo = Y + ((size_t)b * SEQ + qb * 32 + (lane >> 1)) * DM + 512 + h * 64 + (lane & 1) * 32;
#pragma unroll
                for (int k = 0; k < 4; ++k) { const u32x4 v = *(const LAS u32x4*)(ost + (lane >> 1) * 72 + (lane & 1) * 32 + k * 8); *(u32x4*)(yo + k * 8) = v; }
            }
            __syncthreads();
        }
    }
}

#define RLX_AGENT __ATOMIC_RELAXED, __HIP_MEMORY_SCOPE_AGENT
#define XB_TMO      128
#define XB_XCNT(j)  (256  + 64 * (j))
#define XB_XSUB(j)  (1280 + 64 * (j))
#define XB_XGEN(j)  (2304 + 64 * (j))
#define XB_TOP      3328
#define XB_TOPGEN   3392
#define XCD_BAR_WORDS 3456
#define XB_SPIN_CAP (1u << 18)

__device__ __forceinline__ unsigned xb_ld(unsigned* p)              { return __hip_atomic_load(p, __ATOMIC_RELAXED, __HIP_MEMORY_SCOPE_AGENT); }
__device__ __forceinline__ unsigned xb_add(unsigned* p, unsigned v) { return __hip_atomic_fetch_add(p, v, __ATOMIC_RELAXED, __HIP_MEMORY_SCOPE_AGENT); }
__device__ __forceinline__ unsigned xb_xcc_id() { return (unsigned)__builtin_amdgcn_s_getreg((3 << 11) | 20) & 0xFu; }
#define XB_SPIN(cond, bar) do { unsigned _sp = 0; while (cond) { __builtin_amdgcn_s_sleep(1); \
    if ((++_sp & 255u) == 0u) { if (xb_ld(&(bar)[XB_TMO])) break; if (_sp > XB_SPIN_CAP) { atomicAdd(&(bar)[XB_TMO], 1u); break; } } } } while (0)

struct XcdBarrier {
    unsigned* bar; unsigned x;
    volatile LAS unsigned* st;
};

__device__ __forceinline__ XcdBarrier xcd_barrier_post(unsigned* bar, volatile LAS unsigned* st, int tid) {
    XcdBarrier b; b.bar = bar; b.x = xb_xcc_id(); b.st = st;
    if (tid == 0) (void)xb_add(&bar[XB_XCNT(b.x)], 1u);
    return b;
}
__device__ __forceinline__ void xcd_barrier_complete(unsigned* bar, unsigned x, unsigned& nloc, unsigned& nx) {
    const unsigned G = gridDim.x * gridDim.y * gridDim.z;
    unsigned sum, cnt, mine, sp = 0u;
    for (;;) {
        sum = 0u; cnt = 0u; mine = 0u;
#pragma unroll
        for (unsigned j = 0; j < 16; ++j) { const unsigned c = xb_ld(&bar[XB_XCNT(j)]); sum += c; cnt += (c > 0u) ? 1u : 0u; mine = (j == x) ? c : mine; }
        if (sum == G) break;
        __builtin_amdgcn_s_sleep(1);
        if ((++sp & 255u) == 0u) { if (xb_ld(&bar[XB_TMO])) break; if (sp > XB_SPIN_CAP) { atomicAdd(&bar[XB_TMO], 1u); break; } }
    }
    nloc = mine > 0u ? mine : 1u; nx = cnt > 0u ? cnt : 1u;
}

__device__ __forceinline__ void xcd_barrier(const XcdBarrier& b, int tid) {
    asm volatile("s_waitcnt vmcnt(0)" ::: "memory");
    __syncthreads();
    if (tid == 0) {
        unsigned* bar = b.bar;
        __builtin_amdgcn_s_waitcnt(0);
        unsigned nloc = b.st[0], nx = b.st[1];
        if (nloc == 0u) { xcd_barrier_complete(bar, b.x, nloc, nx); b.st[0] = nloc; b.st[1] = nx; }
        const unsigned old = xb_add(&bar[XB_XSUB(b.x)], 1u);
        const unsigned gen = old / nloc;
        if (old + 1u == (gen + 1u) * nloc) {
            __builtin_amdgcn_fence(__ATOMIC_RELEASE, "agent");
            asm volatile("s_waitcnt vmcnt(0)" ::: "memory");
            const unsigned og = xb_add(&bar[XB_TOP], 1u);
            const unsigned tg = og / nx, target = (tg + 1u) * nx;
            if (og + 1u != target) XB_SPIN(xb_ld(&bar[XB_TOP]) < target, bar);
            __builtin_amdgcn_fence(__ATOMIC_ACQUIRE, "agent");
            xb_add(&bar[XB_XGEN(b.x)], 1u);
            asm volatile("s_waitcnt vmcnt(0)" ::: "memory");
        } else {
            XB_SPIN(xb_ld(&bar[XB_XGEN(b.x)]) == gen, bar);
            __builtin_amdgcn_fence(__ATOMIC_ACQUIRE, "agent");
            asm volatile("s_waitcnt vmcnt(0)" ::: "memory");
        }
    }
    __syncthreads();
}

#ifndef PROBE_PH
#define PROBE_PH -1
#endif
#ifndef PROBE_SUB
#define PROBE_SUB 0
#endif
__global__ void __launch_bounds__(NTHREADS, 2) mega_fwd(Args A_unused) {
    extern __shared__ __attribute__((aligned(16))) unsigned char lds_raw[];
    LAS unsigned char* lds = (LAS unsigned char*)lds_raw;
    cg::grid_group grid = cg::this_grid();
    const int ph_lo = kargs()->ph_lo, ph_hi = kargs()->ph_hi;
    const int wave0 = __builtin_amdgcn_readfirstlane((int)(threadIdx.x >> 6));
    if (threadIdx.x < 16) ((volatile LAS unsigned*)(lds + LDS_BAR_OFF))[threadIdx.x] = 0u;
    __syncthreads();
    if (ph_hi - ph_lo > 1) { (void)xcd_barrier_post((unsigned*)(kargs()->ws + WS_CTL), (volatile LAS unsigned*)(lds + LDS_BAR_OFF), (int)threadIdx.x); }
    const int st_hi = (PROBE_PH >= 0) ? ph_hi + 1 : ph_hi;
    for (int st = ph_lo; st < st_hi; ++st) {
        const int ph = (PROBE_PH >= 0 && st > PROBE_PH) ? st - 1 : st;
        const int sub = (PROBE_PH >= 0 && st == PROBE_PH + 1) ? PROBE_SUB : 0;
        KArgs A = kargs();
        int G = gridDim.x; asm volatile("" : "+s"(G));
        unsigned char* ws = A->ws;
        bf16_t* XB = (bf16_t*)(ws + WS_XB); bf16_t* Yb = (bf16_t*)(ws + WS_Y); bf16_t* Zb = (bf16_t*)(ws + WS_Z); bf16_t* HID = Zb; bf16_t* Vb = (bf16_t*)(ws + WS_VB); bf16_t* Kb = (bf16_t*)(ws + WS_KB); bf16_t* KIb = (bf16_t*)(ws + WS_KI);
        float* ssqA = (float*)(ws + WS_SSQA); float* ssqB = (float*)(ws + WS_SSQB);
        float* ropec = (float*)(ws + WS_ROPE); float* ropes = ropec + SEQ * 32;
        unsigned* MASKb = (unsigned*)(ws + WS_MASK);
        int bid = blockIdx.x, wave = wave0; asm volatile("" : "+s"(bid), "+s"(wave));
        int lane = (int)__builtin_amdgcn_mbcnt_hi(~0u, __builtin_amdgcn_mbcnt_lo(~0u, 0u)); asm volatile("" : "+v"(lane));
        const int tid = wave * 64 + lane;
        if (ph == 0) {
#ifndef NO_PRO
            prologue(A, ws, lds, tid, wave, lane, bid, G, sub);
#endif
        } else if (ph == NPHASE - 1) {
            const float* gfin = A->in[17];
            if (G != 256) for (int row = bid * NWAVES + wave; row < MTOK; row += G * NWAVES) {
                const XL2 XLS{(bf16_t*)(ws + WS_MASK), (bf16_t*)(ws + WS_KB)};
                const float rs = row_rs(ssqA, row); f32x4* p = (f32x4*)(A->out + (size_t)row * DM) + lane; const f32x4* g = (const f32x4*)gfin + lane;
                const u32x2* ph_ = (const u32x2*)(XB + (size_t)row * DM) + lane; const u32x2* pl_ = (const u32x2*)xl_row(XLS, row) + lane;
#pragma unroll
                for (int j = 0; j < 4; ++j) { const u32x2 h2 = ph_[64 * j]; u32x2 l2 = {0u, 0u}; if (RES_LO) l2 = pl_[64 * j]; f32x4 v; v[0] = bflo(h2.x) + bflo(l2.x); v[1] = bfhi(h2.x) + bfhi(l2.x); v[2] = bflo(h2.y) + bflo(l2.y); v[3] = bfhi(h2.y) + bfhi(l2.y); p[64 * j] = v * rs * g[64 * j]; }
            }
        } else {
            const int l = (ph - 1) / 6, k = (ph - 1) % 6;
            if (k == 0) {
                pg8::Gemm g{XB, (bf16_t*)(ws + WS_WIN) + l * WIN_L, MTOK, NZ, DM}; pg8::StaticOrder S; S.init(MTOK, NZ, G, bid);
                EpiZ E{Zb, Vb, Kb, KIb, ssqA, ropec, ropes};
#ifndef NO_G0
                pg8::gemm_phase<EpiZ, pg8::StaticOrder, true, true>(lds, g, S, E, tid);
#endif
            } else if (k == 1) {
#ifndef NO_SEL
                if (sub != 2 && sub < 6) select_phase(Zb, KIb, MASKb, (unsigned*)(ws + WS_CTL) + CW_ITEM + l * 1024, lds, wave, lane, bid, G, sub);
#endif
#ifndef NO_MA
                if (sub == 0 || sub == 2 || sub == 8) mixer_a(Zb, Yb, A->in[3] + l * 3 * 256, bid * NTHREADS + tid, G * NTHREADS);
#endif
#ifndef NO_MB
                if (sub == 0 || sub == 2 || sub == 6 || sub == 7) mixer_bd(Zb, Yb, A->in[4] + l * 256, A->in[5] + l * 256, A->in[6] + (size_t)l * 4 * 128 * 128, A->in[7] + l * 4 * 128,
                                                                      A->in[8] + l * 31 * 256, A->in[9] + l * 256, A->in[10] + l * 256, A->in[11] + l * 256, lds, tid, wave, lane, bid, G);
#endif
            } else if (k == 2) {
#ifndef NO_ATT
                attn_phase(Zb, Kb, Vb, MASKb, (unsigned*)(ws + WS_CTL) + CW_ITEM + l * 1024, Yb, lds, wave, lane, bid, G);
#endif
            } else if (k == 3 || k == 5) {
                const XL2 XLD{(bf16_t*)A->out, (bf16_t*)A->out + (size_t)8192 * DM}, XLS{(bf16_t*)(ws + WS_MASK), (bf16_t*)(ws + WS_KB)};
                const bool last = (l == NLAYER - 1);
                pg8::Gemm g{k == 3 ? Yb : HID, k == 3 ? (bf16_t*)(ws + WS_WOUT) + l * WOUT_L : (bf16_t*)(ws + WS_WDN) + l * WDN_L, MTOK, DM, k == 3 ? DM : FF}; pg8::StaticOrder S; S.init(MTOK, DM, G, bid);
                if (k == 3 && l == 0) {
                    EpiRes<true> E{A->in[0], XLD, last ? XLS : XLD, XB, ssqB};
                    pg8::gemm_phase<EpiRes<true>, pg8::StaticOrder, true, true>(lds, g, S, E, tid);
                } else if (k == 5 && last && G == 256) {
                    EpiFinal E{XB, XLS, A->out, A->in[17], ssqB, (unsigned*)(ws + WS_CTL) + CW_PANEL};
                    pg8::gemm_phase<EpiFinal, pg8::StaticOrder, false, true>(lds, g, S, E, tid);
                } else {
                    EpiRes<false> E{nullptr, (k == 5 && last) ? XLS : XLD, last ? XLS : XLD, XB, k == 3 ? ssqB : ssqA};
                    pg8::gemm_phase<EpiRes<false>, pg8::StaticOrder, true, true>(lds, g, S, E, tid);
                }
            } else if (k == 4) {
                pg8::Gemm g{XB, (bf16_t*)(ws + WS_WGU) + l * WGU_L, MTOK, NGU, DM}; pg8::StaticOrder S; S.init(MTOK, NGU, G, bid);
                EpiGU E{HID, ssqB};
#ifndef NO_G2
                pg8::gemm_phase<EpiGU, pg8::StaticOrder, true, true>(lds, g, S, E, tid);
#endif
                if (l == 0) {
                    const int nwg = (MTOK / 256) * (NGU / 256), rem = nwg % G;
                    if (rem == 0) convert_weights(A, ws, lds, wave, lane, CV_I_L - CV_I_DN, NLAYER * CV_I_L, bid * NWAVES + wave, G * NWAVES);
                    else if (bid >= rem) convert_weights(A, ws, lds, wave, lane, CV_I_L - CV_I_DN, NLAYER * CV_I_L, (bid - rem) * NWAVES + wave, (G - rem) * NWAVES);
                }
            }
        }
        const bool flag_seam = (PROBE_PH < 0) && ph >= 1 && ph <= 12 && ((ph - 1) % 6) == 1;
        if (st + 1 < st_hi && !flag_seam) {
            if (ph_hi > 100000) grid.sync();
            XcdBarrier xb; xb.bar = (unsigned*)(ws + WS_CTL); xb.x = xb_xcc_id(); xb.st = (volatile LAS unsigned*)(lds + LDS_BAR_OFF);
            xcd_barrier(xb, tid);
        }
    }
}

#ifndef MK_COOP
#define MK_COOP 1
#endif
extern "C" void kernel_launch(void* const* d_in, const int* in_sizes, int n_in, void* d_out, int out_size, void* d_ws, size_t ws_size, hipStream_t stream) {
    static int grid = 0;
    if (grid == 0) {
        if (n_in != 18 || out_size != MTOK * DM || ws_size < WS_END) { fprintf(stderr, "kernel_launch: unexpected shapes (n_in %d out %d ws %zu)\n", n_in, out_size, ws_size); grid = -1; return; }
        int dev = 0, cus = 0, per_cu = 0;
        if (hipGetDevice(&dev) != hipSuccess || hipDeviceGetAttribute(&cus, hipDeviceAttributeMultiprocessorCount, dev) != hipSuccess) { grid = -1; return; }
        if (hipFuncSetAttribute((const void*)mega_fwd, hipFuncAttributeMaxDynamicSharedMemorySize, LDS_BYTES) != hipSuccess) { fprintf(stderr, "kernel_launch: hipFuncSetAttribute failed\n"); grid = -1; return; }
        if (hipOccupancyMaxActiveBlocksPerMultiprocessor(&per_cu, (const void*)mega_fwd, NTHREADS, LDS_BYTES) != hipSuccess || per_cu < 1) { fprintf(stderr, "kernel_launch: occupancy query says %d\n", per_cu); (void)hipGetLastError(); }
        grid = cus;
    }
    if (grid < 0) return;
    if (hipMemsetAsync((char*)d_ws + WS_CTL, 0, CTL_BYTES, stream) != hipSuccess) { fprintf(stderr, "kernel_launch: memset failed\n"); return; }
    Args a{};
    for (int i = 0; i < 18; ++i) a.in[i] = (const float*)d_in[i];
    a.out = (float*)d_out; a.ws = (unsigned char*)d_ws;
#if MK_COOP
    a.ph_lo = 0; a.ph_hi = (grid == 256) ? NPHASE - 1 : NPHASE;
    void* args[] = {&a};
    hipError_t e = hipLaunchCooperativeKernel((const void*)mega_fwd, dim3(grid), dim3(NTHREADS), args, LDS_BYTES, stream);
    if (e != hipSuccess) fprintf(stderr, "cooperative launch failed: %s (grid %d)\n", hipGetErrorString(e), grid);
#else
    for (int ph = 0; ph < NPHASE; ++ph) {
        a.ph_lo = ph; a.ph_hi = ph + 1;
        hipLaunchKernelGGL(mega_fwd, dim3(grid), dim3(NTHREADS), LDS_BYTES, stream, a);
    }
#endif
}
```
